# Optimizing an MI355X kernel written in HIP

```python
import math
import jax
import jax.numpy as jnp
from jax import lax
import numpy as np

D_MODEL = 2048
BATCH = 8
SEQ = 4096
DEPTH = 2
DEC_BATCH = 8
DEC_SEQ = 64
PAST_LEN = 1024

CHUNK = 64
N_EVEN = (DEPTH + 1) // 2
N_ODD = DEPTH // 2

A_HEADS = 8
A_HEAD_DIM = 128
A_WIDTH = A_HEADS * A_HEAD_DIM
IDX_HEADS = 16
IDX_DIM = 64
IDX_W_SCALE = (IDX_HEADS * IDX_DIM) ** -0.5
TOPK_MAX = 256
A_QBLOCK = 32
N_BUCKETS = 32
MAX_DISTANCE = 128

B_HEAD_DIM = 64
B_WIDTH = D_MODEL
B_HEADS = B_WIDTH // B_HEAD_DIM
B_GROUPS = 4
B_HPG = B_HEADS // B_GROUPS
B_STATE = 128
CONV_W = 4
B_CONV_DIM = B_WIDTH + 2 * B_GROUPS * B_STATE
DT_MIN = 1e-3
DT_MAX = 1e-1

C_HEADS = 16
Q_LORA = 512
KV_LORA = 512
QK_NOPE = 128
QK_ROPE = 64
V_DIM = 128
C_WIDTH = C_HEADS * V_DIM
ROPE_THETA = 10000.0
MLA_SCALE = (QK_NOPE + QK_ROPE) ** -0.5
C_QBLOCK = 128

ALPHA = (2 * DEPTH) ** 0.25
BETA = (8 * DEPTH) ** -0.25
EPS = 1e-5

SPLIT0 = (A_WIDTH, A_WIDTH, A_WIDTH, A_WIDTH, IDX_HEADS * IDX_DIM, IDX_DIM, IDX_HEADS, B_WIDTH, B_CONV_DIM, B_HEADS)
SPLIT1 = (Q_LORA, KV_LORA, QK_ROPE, C_WIDTH)
W_IN0 = sum(SPLIT0)
W_IN1 = sum(SPLIT1)
F32 = jnp.float32

kernel_name = 'hybrid_dsa_ssd_mla_stream_step'


def split_cols(h, sizes):
    return jnp.split(h, np.cumsum(sizes)[:-1].tolist(), axis=-1)


def layer_norm(x, g, b):
    xf = x.astype(F32)
    mu = jnp.mean(xf, axis=-1, keepdims=True)
    var = jnp.mean(jnp.square(xf - mu), axis=-1, keepdims=True)
    return ((xf - mu) * lax.rsqrt(var + EPS) * g.astype(F32) + b.astype(F32)).astype(x.dtype)


def rms_norm(x, g):
    xf = x.astype(F32)
    return (xf * lax.rsqrt(jnp.mean(jnp.square(xf), axis=-1, keepdims=True) + EPS) * g.astype(F32)).astype(x.dtype)


def chunk_visible(q_pos, k_pos):
    return (k_pos[None, :] // CHUNK) <= (q_pos[:, None] // CHUNK)


def to_blocks(a, size):
    b, t = a.shape[:2]
    return jnp.moveaxis(a.reshape((b, t // size, size) + a.shape[2:]), 1, 0)


def from_blocks(a):
    nb, b, size = a.shape[:3]
    return jnp.moveaxis(a, 0, 1).reshape((b, nb * size) + a.shape[3:])


def t5_bucket(rel):
    half = N_BUCKETS // 2
    max_exact = half // 2
    ret = jnp.where(rel < 0, half, 0)
    n = jnp.abs(rel)
    nf = jnp.maximum(n, 1).astype(F32)
    large = max_exact + (jnp.log(nf / max_exact) / math.log(MAX_DISTANCE / max_exact) * (half - max_exact)).astype(jnp.int32)
    large = jnp.minimum(large, half - 1)
    return ret + jnp.where(n < max_exact, n, large)


def rope(x, pos):
    half = QK_ROPE // 2
    inv = ROPE_THETA ** (-jnp.arange(half, dtype=F32) / half)
    ang = pos.astype(F32)[:, None] * inv[None, :]
    shape = (1, x.shape[1]) + (1,) * (x.ndim - 3) + (half,)
    cos = jnp.cos(ang).reshape(shape)
    sin = jnp.sin(ang).reshape(shape)
    x1 = x[..., :half].astype(F32)
    x2 = x[..., half:].astype(F32)
    return jnp.concatenate([x1 * cos - x2 * sin, x1 * sin + x2 * cos], axis=-1).astype(x.dtype)


def dsa_attend(q, qi, wi, q_pos, k, v, ki, k_pos, n_sel, bias_table):
    dots = jnp.einsum('bqhd,bld->bqhl', qi.astype(F32), ki.astype(F32))
    score = jnp.einsum('bqh,bqhl->bql', wi.astype(F32), jax.nn.relu(dots))
    score = jnp.where(chunk_visible(q_pos, k_pos)[None], score, -jnp.inf)
    _, sel = lax.top_k(score, n_sel)
    sel_pos = k_pos[sel]
    valid = (sel_pos // CHUNK) <= (q_pos[None, :, None] // CHUNK)
    kg = jax.vmap(lambda kb, ib: kb[ib])(k, sel)
    vg = jax.vmap(lambda vb, ib: vb[ib])(v, sel)
    logits = jnp.einsum('bqhd,bqnhd->bqhn', q, kg).astype(F32) * (A_HEAD_DIM ** -0.5)
    bias = bias_table[t5_bucket(q_pos[None, :, None] - sel_pos)]
    logits = logits + jnp.swapaxes(bias, -1, -2).astype(F32)
    logits = jnp.where(valid[:, :, None, :], logits, -jnp.inf)
    p = jax.nn.softmax(logits, axis=-1).astype(v.dtype)
    return jnp.einsum('bqhn,bqnhd->bqhd', p, vg)


def dsa_prompt(q, qi, wi, k, v, ki, bias_table):
    t = q.shape[1]
    n_sel = min(TOPK_MAX, t // 4)
    pos = jnp.arange(t, dtype=jnp.int32)

    def step(args):
        qb, qib, wib, pb = args
        return dsa_attend(qb, qib, wib, pb, k, v, ki, pos, n_sel, bias_table)

    out = lax.map(step, (to_blocks(q, A_QBLOCK), to_blocks(qi, A_QBLOCK), to_blocks(wi, A_QBLOCK),
                         pos.reshape(t // A_QBLOCK, A_QBLOCK)))
    return from_blocks(out)


def causal_conv(xpad, w, b):
    t = xpad.shape[1] - (CONV_W - 1)
    return b + sum(xpad[:, j:j + t] * w[j] for j in range(CONV_W))


def ssd_chunk(h0, x, dt, bm, cm, a):
    x = x.astype(F32)
    bm = bm.astype(F32)
    cm = cm.astype(F32)
    l = x.shape[1]
    acum = jnp.cumsum(dt * a, axis=1)
    seg = acum[:, :, None] - acum[:, None]
    causal = jnp.tril(jnp.ones((l, l), dtype=bool))[None, :, :, None, None]
    decay = jnp.exp(jnp.where(causal, seg, -jnp.inf))
    cb = jnp.einsum('btgn,bsgn->btsg', cm, bm)
    w = cb[..., None] * decay * dt[:, None]
    y = jnp.einsum('btsgr,bsgrp->btgrp', w, x)
    y = y + jnp.einsum('btgn,bgrpn->btgrp', cm, h0) * jnp.exp(acum)[..., None]
    tail = jnp.exp(acum[:, -1:] - acum) * dt
    h = h0 * jnp.exp(acum[:, -1])[..., None, None] + jnp.einsum('bsgr,bsgn,bsgrp->bgrpn', tail, bm, x)
    return h, y


def mamba_mix(z, xbc_pad, dt_raw, h0, conv_w, conv_b, dt_bias, a_log, d_skip, norm_w, scan_chunks):
    b, t = z.shape[:2]
    xbc = jax.nn.silu(causal_conv(xbc_pad, conv_w, conv_b))
    xs, bm, cm = split_cols(xbc, (B_WIDTH, B_GROUPS * B_STATE, B_GROUPS * B_STATE))
    xs = xs.reshape(b, t, B_GROUPS, B_HPG, B_HEAD_DIM)
    bm = bm.reshape(b, t, B_GROUPS, B_STATE)
    cm = cm.reshape(b, t, B_GROUPS, B_STATE)
    dt = jax.nn.softplus((dt_raw + dt_bias).astype(F32)).reshape(b, t, B_GROUPS, B_HPG)
    a = -jnp.exp(a_log.astype(F32)).reshape(B_GROUPS, B_HPG)
    hinit = h0.astype(F32).reshape(b, B_GROUPS, B_HPG, B_HEAD_DIM, B_STATE)
    if scan_chunks:
        h, ys = lax.scan(lambda hc, inp: ssd_chunk(hc, inp[0], inp[1], inp[2], inp[3], a), hinit,
                         (to_blocks(xs, CHUNK), to_blocks(dt, CHUNK), to_blocks(bm, CHUNK), to_blocks(cm, CHUNK)))
        y = from_blocks(ys)
    else:
        h, y = ssd_chunk(hinit, xs, dt, bm, cm, a)
    y = y + d_skip.astype(F32).reshape(B_GROUPS, B_HPG)[..., None] * xs.astype(F32)
    y = y.reshape(b, t, B_WIDTH) * jax.nn.silu(z.astype(F32))
    yg = y.reshape(b, t, B_GROUPS, B_WIDTH // B_GROUPS)
    yg = yg * lax.rsqrt(jnp.mean(jnp.square(yg), axis=-1, keepdims=True) + EPS)
    y = (yg.reshape(b, t, B_WIDTH) * norm_w.astype(F32)).astype(z.dtype)
    return y, h.reshape(b, B_HEADS, B_HEAD_DIM, B_STATE).astype(h0.dtype)


def even_layer(x, past, w_in, w_out, conv_w, conv_b, dt_bias, a_log, d_skip, norm_w, ln_g, ln_b, t5_bias):
    b, t, _ = x.shape
    aq, ak, av, ag, iq, ik, iw, bz, bxbc, bdt = split_cols(x @ w_in, SPLIT0)
    aq = aq.reshape(b, t, A_HEADS, A_HEAD_DIM)
    ak = ak.reshape(b, t, A_HEADS, A_HEAD_DIM)
    av = av.reshape(b, t, A_HEADS, A_HEAD_DIM)
    iq = iq.reshape(b, t, IDX_HEADS, IDX_DIM)
    iw = iw * IDX_W_SCALE
    if past is None:
        a_out = dsa_prompt(aq, iq, iw, ak, av, ik, t5_bias)
        xbc_pad = jnp.pad(bxbc, ((0, 0), (CONV_W - 1, 0), (0, 0)))
        h0 = jnp.zeros((b, B_HEADS, B_HEAD_DIM, B_STATE), x.dtype)
        scan_chunks = True
    else:
        pk, pv, pki, pconv, pssm = past
        p_len = pk.shape[1]
        q_pos = p_len + jnp.arange(t, dtype=jnp.int32)
        k_pos = jnp.arange(p_len + t, dtype=jnp.int32)
        n_sel = min(TOPK_MAX, (p_len + t) // 4)
        a_out = dsa_attend(aq, iq, iw, q_pos,
                           jnp.concatenate([pk, ak], axis=1), jnp.concatenate([pv, av], axis=1),
                           jnp.concatenate([pki, ik], axis=1), k_pos, n_sel, t5_bias)
        xbc_pad = jnp.concatenate([pconv, bxbc], axis=1)
        h0 = pssm
        scan_chunks = False
    b_out, ssm_new = mamba_mix(bz, xbc_pad, bdt, h0, conv_w, conv_b, dt_bias, a_log, d_skip, norm_w, scan_chunks)
    a_out = a_out.reshape(b, t, A_WIDTH) * jax.nn.silu(ag)
    mix = jnp.concatenate([a_out, b_out], axis=-1) @ w_out
    y = layer_norm(ALPHA * x + mix, ln_g, ln_b)
    return y, (ak, av, ik, xbc_pad[:, -(CONV_W - 1):], ssm_new)


def mla_attend(q_nope, q_rope, q_pos, k_nope, k_rope, v, k_pos):
    s = jnp.einsum('bqhd,bkhd->bhqk', q_nope, k_nope) + jnp.einsum('bqhd,bkd->bhqk', q_rope, k_rope)
    s = jnp.where(chunk_visible(q_pos, k_pos)[None, None], s.astype(F32) * MLA_SCALE, -jnp.inf)
    p = jax.nn.softmax(s, axis=-1).astype(v.dtype)
    return jnp.einsum('bhqk,bkhd->bqhd', p, v)


def mla_prompt(q_nope, q_rope, k_nope, k_rope, v):
    t = q_nope.shape[1]
    pos = jnp.arange(t, dtype=jnp.int32)

    def step(args):
        qn, qr, pb = args
        return mla_attend(qn, qr, pb, k_nope, k_rope, v, pos)

    out = lax.map(step, (to_blocks(q_nope, C_QBLOCK), to_blocks(q_rope, C_QBLOCK),
                         pos.reshape(t // C_QBLOCK, C_QBLOCK)))
    return from_blocks(out)


def odd_layer(x, past, w_in, q_norm_w, kv_norm_w, w_uq, w_ukv, w_out, ln_g, ln_b):
    b, t, _ = x.shape
    cq, ckv, kr, gate = split_cols(x @ w_in, SPLIT1)
    cq = rms_norm(cq, q_norm_w)
    ckv = rms_norm(ckv, kv_norm_w)
    q = (cq @ w_uq).reshape(b, t, C_HEADS, QK_NOPE + QK_ROPE)
    p_len = 0 if past is None else past[0].shape[1]
    q_pos = p_len + jnp.arange(t, dtype=jnp.int32)
    q_nope = q[..., :QK_NOPE]
    q_rope = rope(q[..., QK_NOPE:], q_pos)
    kr = rope(kr, q_pos)
    if past is None:
        lat, kr_all = ckv, kr
    else:
        lat = jnp.concatenate([past[0], ckv], axis=1)
        kr_all = jnp.concatenate([past[1], kr], axis=1)
    kv = (lat @ w_ukv).reshape(b, p_len + t, C_HEADS, QK_NOPE + V_DIM)
    k_nope = kv[..., :QK_NOPE]
    v = kv[..., QK_NOPE:]
    if past is None:
        o = mla_prompt(q_nope, q_rope, k_nope, kr_all, v)
    else:
        o = mla_attend(q_nope, q_rope, q_pos, k_nope, kr_all, v, jnp.arange(p_len + t, dtype=jnp.int32))
    o = o.reshape(b, t, C_WIDTH) * jax.nn.silu(gate)
    y = layer_norm(ALPHA * x + o @ w_out, ln_g, ln_b)
    return y, (ckv, kr)


def setup_inputs(seed: int = 0) -> dict:
    key = jax.random.key(seed)
    ks = iter(jax.random.split(key, 32))

    def nrm(shape, scale=1.0):
        return jax.random.normal(next(ks), shape, F32) * scale

    x_prompt = nrm((BATCH, SEQ, D_MODEL))
    x_sample = nrm((DEC_BATCH, DEC_SEQ, D_MODEL))
    cache_a_k = nrm((N_EVEN, DEC_BATCH, PAST_LEN, A_HEADS, A_HEAD_DIM))
    cache_a_v = nrm((N_EVEN, DEC_BATCH, PAST_LEN, A_HEADS, A_HEAD_DIM))
    cache_a_kidx = nrm((N_EVEN, DEC_BATCH, PAST_LEN, IDX_DIM))
    state_b_conv = nrm((N_EVEN, DEC_BATCH, CONV_W - 1, B_CONV_DIM))
    state_b_ssm = nrm((N_EVEN, DEC_BATCH, B_HEADS, B_HEAD_DIM, B_STATE), 0.1)
    cache_c_latent = nrm((N_ODD, DEC_BATCH, PAST_LEN, KV_LORA))
    cache_c_krope = nrm((N_ODD, DEC_BATCH, PAST_LEN, QK_ROPE))
    t5_bias = nrm((N_BUCKETS, A_HEADS), 0.5)
    w_in0 = nrm((N_EVEN, D_MODEL, W_IN0), D_MODEL ** -0.5)
    w_out0 = nrm((N_EVEN, A_WIDTH + B_WIDTH, D_MODEL), BETA * (A_WIDTH + B_WIDTH) ** -0.5)
    conv_w = nrm((N_EVEN, CONV_W, B_CONV_DIM), CONV_W ** -0.5)
    conv_b = nrm((N_EVEN, B_CONV_DIM), 0.02)
    u = jax.random.uniform(next(ks), (N_EVEN, B_HEADS), F32)
    dt0 = jnp.exp(u * (math.log(DT_MAX) - math.log(DT_MIN)) + math.log(DT_MIN))
    dt_bias = dt0 + jnp.log(-jnp.expm1(-dt0))
    a_log = jnp.log(jax.random.uniform(next(ks), (N_EVEN, B_HEADS), F32, 1.0, 16.0))
    d_skip = 1.0 + nrm((N_EVEN, B_HEADS), 0.1)
    ssm_norm_w = 1.0 + nrm((N_EVEN, B_WIDTH), 0.1)
    ln0_g = 1.0 + nrm((N_EVEN, D_MODEL), 0.1)
    ln0_b = nrm((N_EVEN, D_MODEL), 0.02)
    w_in1 = nrm((N_ODD, D_MODEL, W_IN1), D_MODEL ** -0.5)
    q_norm_w = 1.0 + nrm((N_ODD, Q_LORA), 0.1)
    kv_norm_w = 1.0 + nrm((N_ODD, KV_LORA), 0.1)
    w_uq = nrm((N_ODD, Q_LORA, C_HEADS * (QK_NOPE + QK_ROPE)), Q_LORA ** -0.5)
    w_ukv = nrm((N_ODD, KV_LORA, C_HEADS * (QK_NOPE + V_DIM)), KV_LORA ** -0.5)
    w_out1 = nrm((N_ODD, C_WIDTH, D_MODEL), BETA * C_WIDTH ** -0.5)
    ln1_g = 1.0 + nrm((N_ODD, D_MODEL), 0.1)
    ln1_b = nrm((N_ODD, D_MODEL), 0.02)
    return {'x_prompt': x_prompt, 'x_sample': x_sample,
            'cache_a_k': cache_a_k, 'cache_a_v': cache_a_v, 'cache_a_kidx': cache_a_kidx,
            'state_b_conv': state_b_conv, 'state_b_ssm': state_b_ssm,
            'cache_c_latent': cache_c_latent, 'cache_c_krope': cache_c_krope,
            't5_bias': t5_bias, 'w_in0': w_in0, 'w_out0': w_out0, 'conv_w': conv_w, 'conv_b': conv_b,
            'dt_bias': dt_bias, 'a_log': a_log, 'd_skip': d_skip, 'ssm_norm_w': ssm_norm_w,
            'ln0_g': ln0_g, 'ln0_b': ln0_b, 'w_in1': w_in1, 'q_norm_w': q_norm_w, 'kv_norm_w': kv_norm_w,
            'w_uq': w_uq, 'w_ukv': w_ukv, 'w_out1': w_out1, 'ln1_g': ln1_g, 'ln1_b': ln1_b}


def reference(x_prompt, x_sample, cache_a_k, cache_a_v, cache_a_kidx, state_b_conv, state_b_ssm,
              cache_c_latent, cache_c_krope, t5_bias, w_in0, w_out0, conv_w, conv_b, dt_bias, a_log,
              d_skip, ssm_norm_w, ln0_g, ln0_b, w_in1, q_norm_w, kv_norm_w, w_uq, w_ukv, w_out1,
              ln1_g, ln1_b):
    yp, ys = x_prompt, x_sample
    even_p, even_s, odd_p, odd_s = [], [], [], []
    for layer in range(DEPTH):
        if layer % 2 == 0:
            e = layer // 2
            prm = (w_in0[e], w_out0[e], conv_w[e], conv_b[e], dt_bias[e], a_log[e], d_skip[e],
                   ssm_norm_w[e], ln0_g[e], ln0_b[e], t5_bias)
            yp, st_p = even_layer(yp, None, *prm)
            past = (cache_a_k[e], cache_a_v[e], cache_a_kidx[e], state_b_conv[e], state_b_ssm[e])
            ys, st_s = even_layer(ys, past, *prm)
            even_p.append(st_p)
            even_s.append(st_s)
        else:
            o = layer // 2
            prm = (w_in1[o], q_norm_w[o], kv_norm_w[o], w_uq[o], w_ukv[o], w_out1[o], ln1_g[o], ln1_b[o])
            yp, st_p = odd_layer(yp, None, *prm)
            ys, st_s = odd_layer(ys, (cache_c_latent[o], cache_c_krope[o]), *prm)
            odd_p.append(st_p)
            odd_s.append(st_s)
    a_k_p, a_v_p, a_ki_p, b_conv_p, b_ssm_p = [jnp.stack(s) for s in zip(*even_p)]
    a_k_s, a_v_s, a_ki_s, b_conv_s, b_ssm_s = [jnp.stack(s) for s in zip(*even_s)]
    c_lat_p, c_kr_p = [jnp.stack(s) for s in zip(*odd_p)]
    c_lat_s, c_kr_s = [jnp.stack(s) for s in zip(*odd_s)]
    return (yp, ys, a_k_p, a_k_s, a_v_p, a_v_s, a_ki_p, a_ki_s, b_conv_p, b_conv_s,
            b_ssm_p, b_ssm_s, c_lat_p, c_lat_s, c_kr_p, c_kr_s)
```

```cpp
#include <hip/hip_runtime.h>
#include <hip/hip_cooperative_groups.h>
#include <cstdio>
#include <cstdint>
namespace cg = cooperative_groups;

#define LAS __attribute__((address_space(3)))
typedef unsigned short bf16_t;
typedef short bf16x8 __attribute__((ext_vector_type(8)));
typedef short s16x4 __attribute__((ext_vector_type(4)));
typedef float f32x4 __attribute__((ext_vector_type(4)));
typedef float f32x8 __attribute__((ext_vector_type(8)));
typedef float f32x16 __attribute__((ext_vector_type(16)));
typedef unsigned u32x4 __attribute__((ext_vector_type(4)));
typedef unsigned u32x2 __attribute__((ext_vector_type(2)));
typedef unsigned long long u64;

constexpr int DM = 2048, NP = 32768, NS = 512, MALL = NP + NS  , TP = 4096, TS = 64, PAST = 1024, LS = PAST + TS  ;
constexpr int NIN0 = 10352, NIN0P = 10496, NIN1 = 3136, NIN1P = 3328;
constexpr int LATROWS = NP + 8 * LS;
constexpr float ALPHA_RES = 1.4142135623730951f;
constexpr float LOG2E = 1.4426950408889634f;
constexpr float EPSV = 1e-5f;

enum { I_XP = 0, I_XS, I_CAK, I_CAV, I_CAKI, I_SCONV, I_SSSM, I_CLAT, I_CKR, I_T5, I_WIN0, I_WOUT0, I_CONVW, I_CONVB, I_DTB, I_ALOG, I_DSKIP,
       I_SNORM, I_LN0G, I_LN0B, I_WIN1, I_QNW, I_KVNW, I_WUQ, I_WUKV, I_WOUT1, I_LN1G, I_LN1B, N_IN };

constexpr size_t O_Y = 0;
constexpr size_t O_AKP = (size_t)MALL * DM;
constexpr size_t O_AKS = O_AKP + (size_t)NP * 1024;
constexpr size_t O_AVP = O_AKS + (size_t)NS * 1024;
constexpr size_t O_AVS = O_AVP + (size_t)NP * 1024;
constexpr size_t O_KIP = O_AVS + (size_t)NS * 1024;
constexpr size_t O_KIS = O_KIP + (size_t)NP * 64;
constexpr size_t O_BCP = O_KIS + (size_t)NS * 64;
constexpr size_t O_BCS = O_BCP + (size_t)8 * 3 * 3072;
constexpr size_t O_BSP = O_BCS + (size_t)8 * 3 * 3072;
constexpr size_t O_BSS = O_BSP + (size_t)8 * 32 * 64 * 128;
constexpr size_t O_CLP = O_BSS + (size_t)8 * 32 * 64 * 128;
constexpr size_t O_CLS = O_CLP + (size_t)NP * 512;
constexpr size_t O_CKP = O_CLS + (size_t)NS * 512;
constexpr size_t O_CKS = O_CKP + (size_t)NP * 64;
constexpr size_t O_END = O_CKS + (size_t)NS * 64;

constexpr size_t MiB = 1ull << 20;
constexpr size_t W_BT0 = 0;
constexpr size_t W_BTOUT0 = 41 * MiB;
constexpr size_t W_BT1 = 53 * MiB;
constexpr size_t W_BTUQ = 66 * MiB;
constexpr size_t W_BTUKV = 69 * MiB;
constexpr size_t W_BTOUT1 = 73 * MiB;
constexpr size_t W_ROPE = 81 * MiB;
constexpr size_t W_KIDXP = 82 * MiB;
constexpr size_t W_KIDXS = 86 * MiB;
constexpr size_t W_IW = 88 * MiB;
constexpr size_t W_DT = 91 * MiB;
constexpr size_t W_MASKP = 96 * MiB;
constexpr size_t W_MASKS = 112 * MiB;
constexpr size_t W_SSQ = 113 * MiB;
constexpr size_t W_XB = 120 * MiB;
constexpr size_t W_MIX = 250 * MiB;
constexpr size_t W_KP = 445 * MiB;
constexpr size_t W_KS = 509 * MiB;
constexpr size_t W_VP = 526 * MiB;
constexpr size_t W_VS = 590 * MiB;
constexpr size_t W_SG = 607 * MiB;
constexpr size_t W_IQ = 672 * MiB;
constexpr size_t W_XBC = 737 * MiB;
constexpr size_t W_KVALL = 120 * MiB;
constexpr size_t W_CQKV = 445 * MiB;
constexpr size_t W_CQN = 584 * MiB;
constexpr size_t W_LAT = 617 * MiB;
constexpr size_t W_KR = 658 * MiB;
constexpr size_t W_Q2 = 664 * MiB;
constexpr size_t W_SGATE = 860 * MiB;
constexpr size_t W_END = 990 * MiB;

struct Params { const float* in[N_IN]; float* out; char* ws; };
#define CPARAMS const __attribute__((address_space(4))) Params

constexpr int LDS_BYTES = 131072 + 2048;

typedef __bf16 bf16x2_t __attribute__((ext_vector_type(2)));
typedef float f32x2_t __attribute__((ext_vector_type(2)));
__device__ __forceinline__ unsigned cvtpk(float lo, float hi) { const f32x2_t v = {lo, hi}; const bf16x2_t r = __builtin_convertvector(v, bf16x2_t); return __builtin_bit_cast(unsigned, r); }
__device__ __forceinline__ bf16_t f2bf(float f) { return (bf16_t)(cvtpk(f, f) & 0xffffu); }
__device__ __forceinline__ float bf2f(bf16_t b) { return __uint_as_float(((unsigned)b) << 16); }
__device__ __forceinline__ float silu_f(float v) { return v / (1.f + __expf(-v)); }
__device__ __forceinline__ bf16x8 pack8(const float* x) { u32x4 w = {cvtpk(x[0], x[1]), cvtpk(x[2], x[3]), cvtpk(x[4], x[5]), cvtpk(x[6], x[7])}; return *reinterpret_cast<bf16x8*>(&w); }
__device__ __forceinline__ u32x2 pack4(f32x4 v) { u32x2 w = {cvtpk(v[0], v[1]), cvtpk(v[2], v[3])}; return w; }
__device__ __forceinline__ float wave_sum(float v) {
#pragma unroll
  for (int o = 32; o > 0; o >>= 1) v += __shfl_xor(v, o);
  return v;
}
__device__ __forceinline__ int wave_sum_i(int v) {
#pragma unroll
  for (int o = 32; o > 0; o >>= 1) v += __shfl_xor(v, o);
  return v;
}
__device__ __forceinline__ int latrow_of(int row) { if (row < NP) return row; const int r = row - NP; return NP + (r >> 6) * LS + PAST + (r & 63); }
__device__ __forceinline__ int pos_of(int row) { return row < NP ? (row & (TP - 1)) : PAST + ((row - NP) & 63); }
namespace pg8 {
#define PG8_LAS __attribute__((address_space(3)))
constexpr int BM = 256, BK = 64, HALF = 128, HTB = HALF * BK * 2  , STAGE_BYTES = 8 * HTB, NXCD = 8, WGM = 8;

__host__ __device__ __forceinline__ int lds_byte(int r, int c) { const int st = (r >> 4) * 2 + (c >> 5), rr = r & 15, cc = c & 31, ob = rr * 64 + cc * 2; return st * 1024 + (ob ^ (((ob >> 9) & 1) << 5)); }
__host__ __device__ __forceinline__ void stage_rc(int b, int& R, int& C) { const int st = b / 1024, sb = b % 1024, swz = sb ^ (((sb >> 9) & 1) << 5); R = (st >> 1) * 16 + swz / 64; C = (st & 1) * 32 + (swz % 64) / 2; }
__host__ __device__ __forceinline__ int perm32(int rho) { const int n = rho >> 4, i = rho & 15; return 8 * (i >> 2) + 4 * n + (i & 3); }

struct Unit { int pm, pn; };
struct Gemm { const bf16_t* A; const bf16_t* Bt; int M, N, K, lda; };

struct StaticOrder {
    int nM, nN, nwg, G, c;
    __host__ __device__ void init(int M, int N, int G_, int c_) { nM = M / BM; nN = N / BM; nwg = nM * nN; G = G_; c = c_; }
    __host__ __device__ bool next(int i, Unit& u) const {
        const long L = (long)i * G + c; if (L >= nwg) return false;
        int wgid = (int)L; { const int q = nwg / NXCD, r = nwg % NXCD, xcd = wgid % NXCD, off = wgid / NXCD; wgid = (xcd < r ? xcd * (q + 1) : r * (q + 1) + (xcd - r) * q) + off; }
        const int nig = WGM * nN, gid = wgid / nig, fm = gid * WGM, gsz = (nM - fm) < WGM ? (nM - fm) : WGM;
        u.pm = fm + ((wgid % nig) % gsz); u.pn = (wgid % nig) / gsz; return true;
    }
    __device__ __forceinline__ void a_ready(const Unit&) const {}
    __device__ __forceinline__ void done(const Unit&) const {}
};

template <class Epi, class Sched>
__device__ __forceinline__ void gemm_phase(PG8_LAS unsigned char* lds, const Gemm g, const Sched& S, const Epi& E) {
    constexpr bool STAMP = false; unsigned long long* stamps = nullptr;
    int tid_ = threadIdx.x; asm volatile("" : "+v"(tid_));
    const int tid = tid_, wid = __builtin_amdgcn_readfirstlane(tid >> 6), lane = tid & 63, wr = wid >> 2, wc = wid & 3, fr = lane & 15, fq = lane >> 4;
    const int K = g.K, nt = K / BK;
    int ts_lo = 0, ts_hi = 0, nts = 0; const unsigned long long rt_entry = STAMP ? (unsigned long long)wall_clock64() : 0ull;
#define PG8_STAMP() do { if (STAMP && wid == 0 && nts < 64) { const unsigned long long _c = (unsigned long long)clock64(); \
        ts_lo = (lane == nts) ? (int)(unsigned)_c : ts_lo; ts_hi = (lane == nts) ? (int)(unsigned)(_c >> 32) : ts_hi; ++nts; } } while (0)
    PG8_STAMP();
    unsigned voffA[2], voffB[2];
#pragma unroll
    for (int i = 0; i < 2; ++i) { int R, C; stage_rc(tid * 16 + i * 8192, R, C); const int Rb = Epi::PERM ? ((R & ~31) + perm32(R & 31)) : R;
        voffA[i] = (unsigned)(R * g.lda + C) * 2u; voffB[i] = (unsigned)(Rb * K + C) * 2u; }
    const size_t kstep = (size_t)(BK * 2);
    const size_t hstep = (size_t)HALF * K * 2; const size_t hstepA = (size_t)HALF * g.lda * 2;
    const size_t tstep = 2 * hstep; const size_t tstepA = 2 * hstepA;
    const unsigned ldsw = (unsigned)wid * 1024u;
    const int aoff = lds_byte(wr * 64 + fr, fq * 8), boff = lds_byte(wc * 32 + fr, fq * 8);
#define PG8_SA(b, h) (((b) * 2 + (h)) * HTB)
#define PG8_SB(b, h) ((4 + (b) * 2 + (h)) * HTB)
#define PG8_STAGE(bufoff, gbase, voff) do { _Pragma("unroll") for (int _i = 0; _i < 2; ++_i) \
        __builtin_amdgcn_global_load_lds((const unsigned*)((const char*)(gbase) + (voff)[_i]), (PG8_LAS unsigned*)(lds + (bufoff) + ldsw + _i * 8192), 16, 0, 0); } while (0)
#define PG8_LDA(dst, b, h) do { _Pragma("unroll") for (int m = 0; m < 4; ++m) _Pragma("unroll") for (int k = 0; k < 2; ++k) dst[m][k] = *(const PG8_LAS bf16x8*)(lds + PG8_SA(b, h) + aoff + m * 2048 + k * 1024); } while (0)
#define PG8_LDB(dst, b, h) do { _Pragma("unroll") for (int n = 0; n < 2; ++n) _Pragma("unroll") for (int k = 0; k < 2; ++k) dst[n][k] = *(const PG8_LAS bf16x8*)(lds + PG8_SB(b, h) + boff + n * 2048 + k * 1024); } while (0)
#define PG8_MMA(ai, bj, At, Bt) do { __builtin_amdgcn_s_setprio(1); _Pragma("unroll") for (int m = 0; m < 4; ++m) _Pragma("unroll") for (int n = 0; n < 2; ++n) _Pragma("unroll") for (int k = 0; k < 2; ++k) \
        acc[ai][bj][m][n] = __builtin_amdgcn_mfma_f32_16x16x32_bf16(Bt[n][k], At[m][k], acc[ai][bj][m][n], 0, 0, 0); __builtin_amdgcn_s_setprio(0); } while (0)
#define PG8_WAIT_V(n) asm volatile("s_waitcnt vmcnt(" #n ")" ::: "memory")
#define PG8_WAIT_L(n) asm volatile("s_waitcnt lgkmcnt(" #n ")" ::: "memory")
#define PG8_BAR __builtin_amdgcn_s_barrier()
#define PG8_SCHED __builtin_amdgcn_sched_barrier(0)
    Unit cur, nxt; int ui = 0;
    if (!S.next(0, cur)) return;
    f32x4 acc[2][2][4][2];
#pragma unroll
    for (int a = 0; a < 2; ++a)
#pragma unroll
        for (int b = 0; b < 2; ++b)
#pragma unroll
            for (int m = 0; m < 4; ++m)
#pragma unroll
                for (int n = 0; n < 2; ++n) acc[a][b][m][n] = (f32x4){0.f, 0.f, 0.f, 0.f};
    bf16x8 At[4][2], B0[2][2], B1[2][2];
    const char* cA = (const char*)g.A + (size_t)cur.pm * tstepA; const char* cB = (const char*)g.Bt + (size_t)cur.pn * tstep;
    S.a_ready(cur);
    PG8_STAGE(PG8_SB(0, 0), cB, voffB); PG8_STAGE(PG8_SA(0, 0), cA, voffA); PG8_STAGE(PG8_SB(0, 1), cB + hstep, voffB); PG8_STAGE(PG8_SA(0, 1), cA + hstepA, voffA);
    if (wr == 1) PG8_BAR;
    PG8_WAIT_V(4); PG8_BAR;
    PG8_STAGE(PG8_SB(1, 0), cB + kstep, voffB); PG8_STAGE(PG8_SA(1, 0), cA + kstep, voffA); PG8_STAGE(PG8_SB(1, 1), cB + hstep + kstep, voffB);
    PG8_WAIT_V(6); PG8_BAR;
    PG8_STAMP();
    for (;;) {
        const bool has_next = S.next(ui + 1, nxt);
        const char* nA = has_next ? (const char*)g.A + (size_t)nxt.pm * tstepA : cA; const char* nB = has_next ? (const char*)g.Bt + (size_t)nxt.pn * tstep : cB;
        for (int t = 0; t < nt; t += 2) {
            const bool last = (t == nt - 2);
            const char* a1 = cA + (size_t)(t + 1) * kstep;
            const char* a2 = last ? nA : cA + (size_t)(t + 2) * kstep; const char* b2 = last ? nB : cB + (size_t)(t + 2) * kstep;
            const char* a3 = a2 + kstep; const char* b3 = b2 + kstep;
            if (last && has_next) S.a_ready(nxt);
            PG8_LDB(B0, 0, 0); PG8_SCHED; PG8_LDA(At, 0, 0); PG8_STAGE(PG8_SA(1, 1), a1 + hstepA, voffA);
            PG8_WAIT_L(8); PG8_BAR; PG8_WAIT_L(0); PG8_MMA(0, 0, At, B0); PG8_BAR; PG8_SCHED;
            PG8_LDB(B1, 0, 1); PG8_STAGE(PG8_SB(0, 0), b2, voffB);
            PG8_BAR; PG8_WAIT_L(0); PG8_MMA(0, 1, At, B1); PG8_BAR;
            PG8_LDA(At, 0, 1); PG8_STAGE(PG8_SA(0, 0), a2, voffA);
            PG8_BAR; PG8_WAIT_L(0); PG8_MMA(1, 0, At, B0); PG8_BAR; PG8_SCHED;
            PG8_STAGE(PG8_SB(0, 1), b2 + hstep, voffB);
            PG8_WAIT_V(6); PG8_BAR; PG8_MMA(1, 1, At, B1); PG8_BAR;
            PG8_LDB(B0, 1, 0); PG8_SCHED; PG8_LDA(At, 1, 0); PG8_STAGE(PG8_SA(0, 1), a2 + hstepA, voffA);
            PG8_WAIT_L(8); PG8_BAR; PG8_WAIT_L(0); PG8_MMA(0, 0, At, B0); PG8_BAR; PG8_SCHED;
            PG8_LDB(B1, 1, 1); PG8_STAGE(PG8_SB(1, 0), b3, voffB);
            PG8_BAR; PG8_WAIT_L(0); PG8_MMA(0, 1, At, B1); PG8_BAR;
            PG8_LDA(At, 1, 1); PG8_STAGE(PG8_SA(1, 0), a3, voffA);
            PG8_BAR; PG8_WAIT_L(0); PG8_MMA(1, 0, At, B0); PG8_BAR; PG8_SCHED;
            PG8_STAGE(PG8_SB(1, 1), b3 + hstep, voffB);
            PG8_WAIT_V(6); PG8_BAR; PG8_MMA(1, 1, At, B1); PG8_BAR;
        }
        PG8_STAMP();
        if constexpr (!Epi::AFTER_DRAIN) { E(acc, cur, wr, wc, fr, fq); S.done(cur); }
        PG8_STAMP();
        if (!has_next) break;
#pragma unroll
        for (int a = 0; a < 2; ++a)
#pragma unroll
            for (int b = 0; b < 2; ++b)
#pragma unroll
                for (int m = 0; m < 4; ++m)
#pragma unroll
                    for (int n = 0; n < 2; ++n) acc[a][b][m][n] = (f32x4){0.f, 0.f, 0.f, 0.f};
        cur = nxt; cA = nA; cB = nB; ++ui;
    }
    PG8_WAIT_V(0);
    if (wr == 0) PG8_BAR;
    PG8_BAR;
    if constexpr (Epi::AFTER_DRAIN) { E.fused(acc, cur, wr, wc, fr, fq, lds, wid, lane); S.done(cur); }
    PG8_STAMP();
    if (STAMP && wid == 0) { stamps[lane] = lane < nts ? (((unsigned long long)(unsigned)ts_hi << 32) | (unsigned)ts_lo) : 0ull;
        if (lane == 62) stamps[62] = rt_entry; if (lane == 63) stamps[63] = (unsigned long long)wall_clock64(); }
#undef PG8_STAMP
#undef PG8_SA
#undef PG8_SB
#undef PG8_STAGE
#undef PG8_LDA
#undef PG8_LDB
#undef PG8_MMA
#undef PG8_WAIT_V
#undef PG8_WAIT_L
#undef PG8_BAR
#undef PG8_SCHED
}
}


template <class F> struct EpiGen {
    static constexpr bool PERM = false, AFTER_DRAIN = false;
    F f;
    __device__ __forceinline__ void operator()(const f32x4 (&acc)[2][2][4][2], const pg8::Unit& u, int wr, int wc, int fr, int fq) const {
        int row0 = u.pm * 256 + wr * 64 + fr, col0 = u.pn * 256 + wc * 32 + 4 * fq;
        asm volatile("" : "+v"(row0), "+v"(col0));
#pragma unroll
        for (int ai = 0; ai < 2; ++ai)
#pragma unroll
            for (int m = 0; m < 4; ++m) {
                const int row = row0 + ai * 128 + m * 16;
#pragma unroll
                for (int bj = 0; bj < 2; ++bj)
#pragma unroll
                    for (int n = 0; n < 2; ++n) f(row, col0 + bj * 128 + n * 16, acc[ai][bj][m][n], u.pn);
                __builtin_amdgcn_sched_barrier(0);
            }
    }
};

#define EPI_ITER(...) do { int row0_ = row0, col0_ = col0; asm volatile("" : "+v"(row0_), "+v"(col0_)); _Pragma("unroll") for (int ai = 0; ai < 2; ++ai) _Pragma("unroll") for (int m = 0; m < 4; ++m) { const int row = row0_ + ai * 128 + m * 16; \
    _Pragma("unroll") for (int bj = 0; bj < 2; ++bj) _Pragma("unroll") for (int n = 0; n < 2; ++n) { const int col = col0_ + bj * 128 + n * 16; const f32x4 v = acc[ai][bj][m][n]; __VA_ARGS__ } __builtin_amdgcn_sched_barrier(0); } } while (0)
struct EpiInProj0 {
    static constexpr bool PERM = false, AFTER_DRAIN = false;
    char* ws; float* out; const float* dtb;
    __device__ __forceinline__ void operator()(const f32x4 (&acc)[2][2][4][2], const pg8::Unit& u, int wr, int wc, int fr, int fq) const {
        int row0 = u.pm * 256 + wr * 64 + fr, col0 = u.pn * 256 + wc * 32 + 4 * fq; const int pn = u.pn;
        asm volatile("" : "+v"(row0), "+v"(col0));
        if (pn < 4) {
            EPI_ITER({ *(u32x2*)((bf16_t*)(ws + W_MIX) + (size_t)row * 3072 + col) = pack4(v); });
        } else if (pn < 12) {
            const bool isv = pn >= 8; const int cs = isv ? 2048 : 1024;
            bf16_t* kp = (bf16_t*)(ws + (isv ? W_VP : W_KP)); bf16_t* ks = (bf16_t*)(ws + (isv ? W_VS : W_KS)); float* op = out + (isv ? O_AVP : O_AKP); float* os = out + (isv ? O_AVS : O_AKS);
            EPI_ITER({ const int c = col - cs; bf16_t* kb; float* o;
                if (row < NP) { kb = kp + (size_t)row * 1024 + c; o = op + (size_t)row * 1024 + c; }
                else { const int r = row - NP; kb = ks + ((size_t)(r >> 6) * LS + PAST + (r & 63)) * 1024 + c; o = os + (size_t)r * 1024 + c; }
                *(u32x2*)kb = pack4(v); *(f32x4*)o = v; });
        } else if (pn < 16) {
            EPI_ITER({ f32x4 s = {silu_f(v[0]), silu_f(v[1]), silu_f(v[2]), silu_f(v[3])}; *(u32x2*)((bf16_t*)(ws + W_SG) + (size_t)row * 1024 + (col - 3072)) = pack4(s); });
        } else if (pn < 20) {
            EPI_ITER({ *(u32x2*)((bf16_t*)(ws + W_IQ) + (size_t)row * 1024 + (col - 4096)) = pack4(v); });
        } else if (pn < 28) {
            EPI_ITER({ f32x4 s = {silu_f(v[0]), silu_f(v[1]), silu_f(v[2]), silu_f(v[3])}; *(u32x2*)((bf16_t*)(ws + W_MIX) + (size_t)row * 3072 + 1024 + (col - 5120)) = pack4(s); });
        } else if (pn < 40) {
            EPI_ITER({ const int c = col - 7168;
                *(u32x2*)((bf16_t*)(ws + W_XBC) + (size_t)row * 3072 + c) = pack4(v);
                if (row < NP) { const int t = row & (TP - 1); if (t >= TP - 3) *(f32x4*)(out + O_BCP + ((size_t)(row >> 12) * 3 + (t - (TP - 3))) * 3072 + c) = v; }
                else { const int r = row - NP, t = r & 63; if (t >= TS - 3) *(f32x4*)(out + O_BCS + ((size_t)(r >> 6) * 3 + (t - (TS - 3))) * 3072 + c) = v; } });
        } else {
            int r0 = row0, c0 = col0; asm volatile("" : "+v"(r0), "+v"(c0));
#pragma unroll
            for (int n = 0; n < 2; ++n) {
                const int c = c0 - 10240 + n * 16;
                if (c < 64) {
#pragma unroll
                    for (int ai = 0; ai < 2; ++ai)
#pragma unroll
                        for (int m = 0; m < 4; ++m) { const int row = r0 + ai * 128 + m * 16; const f32x4 v = acc[ai][0][m][n]; bf16_t* kb; float* o;
                            if (row < NP) { kb = (bf16_t*)(ws + W_KIDXP) + (size_t)row * 64 + c; o = out + O_KIP + (size_t)row * 64 + c; }
                            else { const int r = row - NP; kb = (bf16_t*)(ws + W_KIDXS) + ((size_t)(r >> 6) * LS + PAST + (r & 63)) * 64 + c; o = out + O_KIS + (size_t)r * 64 + c; }
                            *(u32x2*)kb = pack4(v); *(f32x4*)o = v; }
                } else if (c < 80) {
#pragma unroll
                    for (int ai = 0; ai < 2; ++ai)
#pragma unroll
                        for (int m = 0; m < 4; ++m) { const int row = r0 + ai * 128 + m * 16; *(f32x4*)((float*)(ws + W_IW) + (size_t)row * 16 + (c - 64)) = acc[ai][0][m][n] * 0.03125f; }
                } else if (c < 112) {
                    const f32x4 db = *(const f32x4*)(dtb + (c - 80));
#pragma unroll
                    for (int ai = 0; ai < 2; ++ai)
#pragma unroll
                        for (int m = 0; m < 4; ++m) { const int row = r0 + ai * 128 + m * 16; const f32x4 v = acc[ai][0][m][n] + db; f32x4 d;
#pragma unroll
                            for (int j = 0; j < 4; ++j) d[j] = v[j] > 20.f ? v[j] : log1pf(__expf(v[j]));
                            *(f32x4*)((float*)(ws + W_DT) + (size_t)row * 32 + (c - 80)) = d; }
                }
            }
        }
    }
};

struct FResid {
    const float* r0; const float* r1; float* y;
    __device__ __forceinline__ void operator()(int row, int col, f32x4 v, int) const {
        const float* rp = row < NP ? r0 + (size_t)row * DM + col : r1 + (size_t)(row - NP) * DM + col;
        const f32x4 x = *(const f32x4*)rp;
        *(f32x4*)(y + (size_t)row * DM + col) = v + x * ALPHA_RES;
    }
};

struct FInProj1 {
    char* ws;
    __device__ __forceinline__ void operator()(int row, int col, f32x4 v, int pn) const {
        if (pn < 4) *(f32x4*)((float*)(ws + W_CQKV) + (size_t)row * 1088 + col) = v;
        else if (pn < 12) { f32x4 s = {silu_f(v[0]), silu_f(v[1]), silu_f(v[2]), silu_f(v[3])}; *(u32x2*)((bf16_t*)(ws + W_SGATE) + (size_t)row * 2048 + (col - 1024)) = pack4(s); }
        else { const int c = col - 3072; if (c < 64) *(f32x4*)((float*)(ws + W_CQKV) + (size_t)row * 1088 + 1024 + c) = v; }
    }
};

struct FQUp {
    char* ws;
    __device__ __forceinline__ void operator()(int row, int col, f32x4 v, int pn) const {
        if (pn >= 8) {
            const int jj = (col - 2048) & 63, i0 = (jj >> 2) * 2, pos = pos_of(row);
            const float2* tab = (const float2*)(ws + W_ROPE) + (size_t)pos * 32 + i0;
            const float2 c0 = tab[0], c1 = tab[1];
            f32x4 o; o[0] = v[0] * c0.x - v[2] * c0.y; o[2] = v[0] * c0.y + v[2] * c0.x; o[1] = v[1] * c1.x - v[3] * c1.y; o[3] = v[1] * c1.y + v[3] * c1.x; v = o;
        }
        *(u32x2*)((bf16_t*)(ws + W_Q2) + (size_t)row * 3072 + col) = pack4(v);
    }
};
struct FKvUp { char* ws; __device__ __forceinline__ void operator()(int row, int col, f32x4 v, int) const { *(u32x2*)((bf16_t*)(ws + W_KVALL) + (size_t)row * 4096 + col) = pack4(v); } };

template <class F> __device__ __forceinline__ void run_gemm(char* lds, const bf16_t* A, int lda, const bf16_t* Bt, int M, int N, int K, const F& f) {
    pg8::Gemm g; g.A = A; g.Bt = Bt; g.M = M; g.N = N; g.K = K; g.lda = lda;
    pg8::StaticOrder S; S.init(M, N, (int)gridDim.x, (int)blockIdx.x);
    EpiGen<F> E{f};
    pg8::gemm_phase<EpiGen<F>, pg8::StaticOrder>((PG8_LAS unsigned char*)lds, g, S, E);
}

__device__ __forceinline__ int orig_col(int w, int n) {
    switch (w) {
    case 0: if (n < 5120) return n; if (n < 7168) return 5200 + (n - 5120); if (n < 10240) return 7248 + (n - 7168); if (n < 10304) return 5120 + (n - 10240);
            if (n < 10320) return 5184 + (n - 10304); if (n < 10352) return n; return -1;
    case 2: if (n < 1024) return n; if (n < 3072) return 1088 + (n - 1024); if (n < 3136) return 1024 + (n - 3072); return -1;
    case 3: if (n < 2048) return (n >> 7) * 192 + (n & 127);
            { const int j = n - 2048, h = j >> 6, jj = j & 63, g4 = jj >> 2, e = jj & 3; return h * 192 + 128 + (e >> 1) * 32 + 2 * g4 + (e & 1); }
    case 4: if (n < 2048) return (n >> 7) * 256 + (n & 127); { const int j = n - 2048; return (j >> 7) * 256 + 128 + (j & 127); }
    default: return n;
    }
}
__device__ __forceinline__ void phase_prep(CPARAMS& p, char* lds) {
    const int tid = threadIdx.x;
    {
        bf16_t* tile = (bf16_t*)lds;
        int base = 0;
#pragma unroll 1
        for (int w = 0; w < 6; ++w) {
            int K, N, NPd; const float* W; bf16_t* Bt;
            switch (w) {
            case 0: K = 2048; N = NIN0; NPd = NIN0P; W = p.in[I_WIN0]; Bt = (bf16_t*)(p.ws + W_BT0); break;
            case 1: K = 3072; N = 2048; NPd = 2048; W = p.in[I_WOUT0]; Bt = (bf16_t*)(p.ws + W_BTOUT0); break;
            case 2: K = 2048; N = NIN1; NPd = NIN1P; W = p.in[I_WIN1]; Bt = (bf16_t*)(p.ws + W_BT1); break;
            case 3: K = 512; N = 3072; NPd = 3072; W = p.in[I_WUQ]; Bt = (bf16_t*)(p.ws + W_BTUQ); break;
            case 4: K = 512; N = 4096; NPd = 4096; W = p.in[I_WUKV]; Bt = (bf16_t*)(p.ws + W_BTUKV); break;
            default: K = 2048; N = 2048; NPd = 2048; W = p.in[I_WOUT1]; Bt = (bf16_t*)(p.ws + W_BTOUT1); break;
            }
            const int nkt = K / 64, nnt = NPd / 64, ntiles = nkt * nnt;
            int first = (int)blockIdx.x - (base % (int)gridDim.x); if (first < 0) first += gridDim.x;
#pragma unroll 1
            for (int tix = first; tix < ntiles; tix += gridDim.x) {
                const int kt = tix % nkt, nt = tix / nkt;
                const int nl = tid & 63, n = nt * 64 + nl, oc = orig_col(w, n);
#pragma unroll
                for (int i = 0; i < 8; ++i) {
                    const int kl = i * 8 + (tid >> 6), k = kt * 64 + kl;
                    const float v = oc >= 0 ? W[(size_t)k * N + oc] : 0.f;
                    tile[nl * 66 + kl] = f2bf(v);
                }
                __syncthreads();
                { const int nr = tid >> 3, ks = (tid & 7) * 8; const unsigned* src = (const unsigned*)(tile + nr * 66 + ks);
                  u32x4 o = {src[0], src[1], src[2], src[3]};
                  *(u32x4*)(Bt + (size_t)(nt * 64 + nr) * K + kt * 64 + ks) = o; }
                __syncthreads();
            }
            base += ntiles;
        }
    }
    const size_t gtid = (size_t)blockIdx.x * 512 + tid, gstride = (size_t)gridDim.x * 512;
    { bf16_t* xb = (bf16_t*)(p.ws + W_XB); const size_t n8p = (size_t)NP * DM / 8, n8 = (size_t)MALL * DM / 8;
      for (size_t i = gtid; i < n8; i += gstride) { const float* s = i < n8p ? p.in[I_XP] + i * 8 : p.in[I_XS] + (i - n8p) * 8;
        const f32x4 a = *(const f32x4*)s, b = *(const f32x4*)(s + 4); const float t[8] = {a[0], a[1], a[2], a[3], b[0], b[1], b[2], b[3]}; *(bf16x8*)(xb + i * 8) = pack8(t); } }
    { const size_t n8 = (size_t)8 * PAST * 1024 / 8;
      for (size_t i = gtid; i < 2 * n8; i += gstride) { const bool isv = i >= n8; const size_t j = isv ? i - n8 : i; const float* s = p.in[isv ? I_CAV : I_CAK] + j * 8;
        const size_t e = j * 8, b = e / ((size_t)PAST * 1024), rem = e % ((size_t)PAST * 1024);
        const f32x4 a = *(const f32x4*)s, c = *(const f32x4*)(s + 4); const float t[8] = {a[0], a[1], a[2], a[3], c[0], c[1], c[2], c[3]};
        *(bf16x8*)((bf16_t*)(p.ws + (isv ? W_VS : W_KS)) + b * (size_t)LS * 1024 + rem) = pack8(t); }
      const size_t m8 = (size_t)8 * PAST * 64 / 8;
      for (size_t i = gtid; i < m8; i += gstride) { const float* s = p.in[I_CAKI] + i * 8; const size_t e = i * 8, b = e / ((size_t)PAST * 64), rem = e % ((size_t)PAST * 64);
        const f32x4 a = *(const f32x4*)s, c = *(const f32x4*)(s + 4); const float t[8] = {a[0], a[1], a[2], a[3], c[0], c[1], c[2], c[3]};
        *(bf16x8*)((bf16_t*)(p.ws + W_KIDXS) + b * (size_t)LS * 64 + rem) = pack8(t); } }
    { float2* tab = (float2*)(p.ws + W_ROPE);
      for (size_t i = gtid; i < (size_t)4096 * 32; i += gstride) { const int pos = (int)(i >> 5), f = (int)(i & 31);
        const float inv = powf(10000.f, -(float)f / 32.f), ang = (float)pos * inv; float s, c; sincosf(ang, &s, &c); tab[i] = make_float2(c, s); } }
}

__device__ __forceinline__ void phase_index(CPARAMS& p, char* lds) {
    const int tid = threadIdx.x, wid = tid >> 6, lane = tid & 63, r32 = lane & 31, hi = lane >> 5;
    unsigned* sk = (unsigned*)lds;
    const int NU = 4096 + 64;
#pragma unroll 1
    for (int idx = blockIdx.x; idx < NU; idx += gridDim.x) {
        int b, t0, n, nblk_tot, rowg; const bf16_t* ki; u64* mrow; int ldm; bool sample;
        if (idx < 4096) { const int k = idx >> 8, w = idx & 255; b = k >> 1; const int j = (k & 1) ? 511 - w : w; t0 = j * 8; n = ((t0 >> 6) + 1) * 64; nblk_tot = ((t0 >> 8) + 1) * 4;
            rowg = b * TP + t0; ki = (const bf16_t*)(p.ws + W_KIDXP) + (size_t)b * TP * 64; mrow = (u64*)(p.ws + W_MASKP) + (size_t)rowg * 64; ldm = 64; sample = false; }
        else { const int s = idx - 4096; b = s >> 3; t0 = (s & 7) * 8; n = LS; nblk_tot = 17; rowg = NP + b * 64 + t0;
            ki = (const bf16_t*)(p.ws + W_KIDXS) + (size_t)b * LS * 64; mrow = (u64*)(p.ws + W_MASKS) + (size_t)(b * 64 + t0) * 32; ldm = 32; sample = true; }
        (void)sample;
        if (n <= 256) {
            if (lane < nblk_tot) mrow[(size_t)wid * ldm + lane] = (lane * 64 < n) ? ~0ull : 0ull;
            continue;
        }
        {
            const int pr = wid >> 1, par = wid & 1;
            const int qsel = (r32 >> 2) & 1, head = (r32 & 3) + 4 * (r32 >> 3);
            const bf16_t* qp = (const bf16_t*)(p.ws + W_IQ) + (size_t)(rowg + 2 * pr + qsel) * 1024 + head * 64 + hi * 8;
            bf16x8 qa[4];
#pragma unroll
            for (int s = 0; s < 4; ++s) qa[s] = *(const bf16x8*)(qp + s * 16);
            const float* wp = (const float*)(p.ws + W_IW) + (size_t)(rowg + 2 * pr + hi) * 16;
            float wv[16];
#pragma unroll
            for (int s = 0; s < 4; ++s) { const f32x4 t = *(const f32x4*)(wp + s * 4); wv[s * 4] = t[0]; wv[s * 4 + 1] = t[1]; wv[s * 4 + 2] = t[2]; wv[s * 4 + 3] = t[3]; }
            unsigned* dst = sk + (2 * pr + hi) * 4096 + r32;
            const int nkb = n >> 5;
#pragma unroll 2
            for (int kb = par; kb < nkb; kb += 2) {
                const bf16_t* kp = ki + (size_t)(kb * 32 + r32) * 64 + hi * 8;
                f32x16 acc = {};
#pragma unroll
                for (int s = 0; s < 4; ++s) { const bf16x8 kf = *(const bf16x8*)(kp + s * 16); acc = __builtin_amdgcn_mfma_f32_32x32x16_bf16(qa[s], kf, acc, 0, 0, 0); }
                float sc = 0.f;
#pragma unroll
                for (int r = 0; r < 16; ++r) sc = fmaf(wv[r], fmaxf(acc[r], 0.f), sc);
                sc += 0.f;
                const unsigned u = __float_as_uint(sc);
                dst[kb * 32] = (u & 0x80000000u) ? ~u : (u | 0x80000000u);
            }
        }
        __syncthreads();
        {
            const unsigned* k = sk + wid * 4096;
            unsigned prefix = 0;
#pragma unroll 1
            for (int bit = 31; bit >= 0; --bit) {
                const unsigned cand = prefix | (1u << bit);
                int cnt = 0;
                for (int i = lane * 4; i < n; i += 256) { const u32x4 v = *(const u32x4*)(k + i); cnt += (v[0] >= cand) + (v[1] >= cand) + (v[2] >= cand) + (v[3] >= cand); }
                cnt = wave_sum_i(cnt);
                if (cnt >= 256) prefix = cand;
            }
            int cgt = 0;
            for (int i = lane * 4; i < n; i += 256) { const u32x4 v = *(const u32x4*)(k + i); cgt += (v[0] > prefix) + (v[1] > prefix) + (v[2] > prefix) + (v[3] > prefix); }
            cgt = wave_sum_i(cgt);
            const int need = 256 - cgt; int running = 0;
            u64* mr = mrow + (size_t)wid * ldm;
            const u64 lt = (1ull << lane) - 1ull;
#pragma unroll 1
            for (int blk = 0; blk < nblk_tot; ++blk) {
                u64 word = 0ull;
                if (blk * 64 < n) {
                    const unsigned v = k[blk * 64 + lane];
                    const u64 eqm = __ballot(v == prefix);
                    const int rank = running + __popcll(eqm & lt);
                    const bool sel = (v > prefix) || (v == prefix && rank < need);
                    word = __ballot(sel); running += __popcll(eqm);
                }
                if (lane == 0) mr[blk] = word;
            }
        }
        __syncthreads();
    }
}

#define KSWZ(row, colB) ((row) * 256 + ((colB) ^ (((row) & 7) << 4)))
#define KRSWZ(row, colB) ((row) * 128 + ((colB) ^ ((((row) >> 1) & 7) << 4)))
__device__ __forceinline__ int crow(int r, int hi) { return (r & 3) + 8 * (r >> 2) + 4 * hi; }
__device__ __forceinline__ int v_st(int k, int c) { const int kk = (k & ~0xC) | ((k & 4) << 1) | ((k & 8) >> 1); return ((kk >> 3) * 4 + (c >> 5)) * 512 + ((kk & 7) * 32 + (c & 31)) * 2; }
__device__ __forceinline__ int v_rd_base(int lane) { return ((lane & 3) << 3) | (((lane >> 2) & 3) << 6) | (((lane >> 4) & 1) << 5) | (((lane >> 5) & 1) << 8); }
constexpr int v_rd_off(int d0, int ks, int half) { return d0 * 512 + ks * 4096 + half * 2048; }
template <int OFF> __device__ __forceinline__ s16x4 tr_read(int vb) { s16x4 r; asm volatile("ds_read_b64_tr_b16 %0, %1 offset:%2" : "=&v"(r) : "v"(vb), "i"(OFF) : "memory"); return r; }
template <int D0> __device__ __forceinline__ void pv_one(f32x16& od, int vb, bf16x8 pa0, bf16x8 pa1, bf16x8 pa2, bf16x8 pa3) {
    const s16x4 l0 = tr_read<v_rd_off(D0, 0, 0)>(vb), h0 = tr_read<v_rd_off(D0, 0, 1)>(vb), l1 = tr_read<v_rd_off(D0, 1, 0)>(vb), h1 = tr_read<v_rd_off(D0, 1, 1)>(vb);
    const s16x4 l2 = tr_read<v_rd_off(D0, 2, 0)>(vb), h2 = tr_read<v_rd_off(D0, 2, 1)>(vb), l3 = tr_read<v_rd_off(D0, 3, 0)>(vb), h3 = tr_read<v_rd_off(D0, 3, 1)>(vb);
    asm volatile("s_waitcnt lgkmcnt(0)" ::: "memory"); __builtin_amdgcn_sched_barrier(0);
#define PKV(L, H) (bf16x8){L[0], L[1], L[2], L[3], H[0], H[1], H[2], H[3]}
    od = __builtin_amdgcn_mfma_f32_32x32x16_bf16(pa0, PKV(l0, h0), od, 0, 0, 0);
    od = __builtin_amdgcn_mfma_f32_32x32x16_bf16(pa1, PKV(l1, h1), od, 0, 0, 0);
    od = __builtin_amdgcn_mfma_f32_32x32x16_bf16(pa2, PKV(l2, h2), od, 0, 0, 0);
    od = __builtin_amdgcn_mfma_f32_32x32x16_bf16(pa3, PKV(l3, h3), od, 0, 0, 0);
#undef PKV
}

struct AttnUnit {
    const bf16_t* Q; const bf16_t* Qr; const bf16_t* K; const bf16_t* V; const bf16_t* Kr; bf16_t* O; const bf16_t* G; const u64* M;
    int ldq, ldqr, ldk, ldo, ldg, ldm, nvalid, qpos0, NT, head;
};
constexpr int AT_V = 0, AT_K = 32768, AT_KR = 65536, AT_WS = 81920, AT_TB = 81920 + 2048;

template <int MODE>
__device__ __forceinline__ void attn_unit(const AttnUnit& u, char* lds, const float* t5, const float Cs  ) {
    const int tid = threadIdx.x, wid = __builtin_amdgcn_readfirstlane(tid >> 6), lane = tid & 63, r32 = lane & 31, hi = lane >> 5;
    float* wsf = (float*)(lds + AT_WS) + wid * 64; float* al_l = wsf; float* li_l = wsf + 32;
    float* tb = (float*)(lds + AT_TB);
    const int rowb = wid * 32 + r32, rowc = rowb < u.nvalid ? rowb : u.nvalid - 1;
    const int wrow0 = (wid * 32 < u.nvalid) ? wid * 32 : u.nvalid - 1;
    const int qc_w = (u.qpos0 + wrow0) >> 6;
    const int qpos = u.qpos0 + rowc;
    constexpr int NQ = MODE == 1 ? 12 : 8;
    bf16x8 qr[NQ];
    { const bf16_t* Qw = u.Q + (size_t)rowc * u.ldq + hi * 8;
#pragma unroll
      for (int d0 = 0; d0 < 8; ++d0) qr[d0] = *(const bf16x8*)(Qw + d0 * 16);
      if constexpr (MODE == 1) { const bf16_t* Qw2 = u.Qr + (size_t)rowc * u.ldqr + hi * 8;
#pragma unroll
        for (int d0 = 0; d0 < 4; ++d0) qr[8 + d0] = *(const bf16x8*)(Qw2 + d0 * 16); } }
    if constexpr (MODE == 0) {
        if (tid < 155) { const int rel = tid - 63, nn = rel < 0 ? -rel : rel;
            const int bk = (rel < 0 ? 16 : 0) + (nn < 8 ? nn : 8 + (nn >= 12) + (nn >= 16) + (nn >= 23) + (nn >= 32) + (nn >= 46) + (nn >= 64) + (nn >= 91));
            tb[tid] = t5[bk * 8 + u.head] * LOG2E; }
    }
    float m_reg = -1e29f, l_reg = 0.f; f32x16 o[4];
#pragma unroll
    for (int d = 0; d < 4; ++d) o[d] = (f32x16){};
    const int vb0 = (int)(uintptr_t)(lds + AT_V) + v_rd_base(lane);
    int koff[2], voff[2], kroff = 0;
#pragma unroll
    for (int i = 0; i < 2; ++i) { const int X = (i * 8 + wid) * 1024 + lane * 16;
        { const int row = X >> 8, colB = (X & 255) ^ ((row & 7) << 4); koff[i] = row * u.ldk + (colB >> 1); }
        { const int sub = X >> 9, y = X & 511, kk = (sub >> 2) * 8 + (y >> 6), k = (kk & ~0xC) | ((kk & 4) << 1) | ((kk & 8) >> 1), c = (sub & 3) * 32 + ((y & 63) >> 1); voff[i] = k * u.ldk + c; } }
    if constexpr (MODE == 1) { const int X = wid * 1024 + lane * 16, row = X >> 7, colB = (X & 127) ^ (((row >> 1) & 7) << 4); kroff = row * 64 + (colB >> 1); }
    LAS char* ldl = (LAS char*)lds;
#define AT_ISSUE(b, k0) do { const bf16_t* kb_ = u.K + (size_t)(k0) * u.ldk; const bf16_t* vb_ = u.V + (size_t)(k0) * u.ldk; \
        _Pragma("unroll") for (int i_ = 0; i_ < 2; ++i_) { \
            __builtin_amdgcn_global_load_lds((const unsigned*)(kb_ + koff[i_]), (LAS unsigned*)(ldl + AT_K + (b) * 16384 + (i_ * 8 + wid) * 1024), 16, 0, 0); \
            __builtin_amdgcn_global_load_lds((const unsigned*)(vb_ + voff[i_]), (LAS unsigned*)(ldl + AT_V + (b) * 16384 + (i_ * 8 + wid) * 1024), 16, 0, 0); } \
        if constexpr (MODE == 1) __builtin_amdgcn_global_load_lds((const unsigned*)(u.Kr + (size_t)(k0) * 64 + kroff), (LAS unsigned*)(ldl + AT_KR + (b) * 8192 + wid * 1024), 16, 0, 0); } while (0)
    AT_ISSUE(0, 0);
    asm volatile("s_waitcnt vmcnt(0)" ::: "memory");
    __syncthreads();
#pragma unroll 1
    for (int j = 0; j < u.NT; ++j) {
        const int cur = j & 1;
        if (j + 1 < u.NT) AT_ISSUE(cur ^ 1, (j + 1) * 64);
        if (j <= qc_w) {
            u64 mw = 0;
            if constexpr (MODE == 0) mw = u.M[(size_t)rowc * u.ldm + j];
            f32x16 p0 = {}, p1 = {};
            const char* Ks = lds + AT_K + cur * 16384;
#pragma unroll
            for (int d0 = 0; d0 < 8; ++d0) { const int cb = (d0 * 16 + hi * 8) * 2;
                const bf16x8 b0 = *(const bf16x8*)(Ks + KSWZ(r32, cb)), b1 = *(const bf16x8*)(Ks + KSWZ(32 + r32, cb));
                p0 = __builtin_amdgcn_mfma_f32_32x32x16_bf16(b0, qr[d0], p0, 0, 0, 0); p1 = __builtin_amdgcn_mfma_f32_32x32x16_bf16(b1, qr[d0], p1, 0, 0, 0);
                if (d0 & 1) __builtin_amdgcn_sched_barrier(0); }
            if constexpr (MODE == 1) { const char* Krs = lds + AT_KR + cur * 8192;
#pragma unroll
                for (int d0 = 0; d0 < 4; ++d0) { const int cb = (d0 * 16 + hi * 8) * 2;
                    const bf16x8 b0 = *(const bf16x8*)(Krs + KRSWZ(r32, cb)), b1 = *(const bf16x8*)(Krs + KRSWZ(32 + r32, cb));
                    p0 = __builtin_amdgcn_mfma_f32_32x32x16_bf16(b0, qr[8 + d0], p0, 0, 0, 0); p1 = __builtin_amdgcn_mfma_f32_32x32x16_bf16(b1, qr[8 + d0], p1, 0, 0, 0); } }
            if constexpr (MODE == 0) {
                const unsigned mlo = (unsigned)mw >> (4 * hi), mhi = (unsigned)(mw >> 32) >> (4 * hi);
                const int kb = j * 64;
                const bool far = (u.qpos0 + wrow0) - (kb + 63) >= 91;
                if (far) { const float bb = tb[154];
#pragma unroll
                    for (int r = 0; r < 16; ++r) { const int c0 = crow(r, 0);
                        p0[r] = ((mlo >> c0) & 1u) ? fmaf(p0[r], Cs, bb) : -1e30f; p1[r] = ((mhi >> c0) & 1u) ? fmaf(p1[r], Cs, bb) : -1e30f; }
                } else { const int rel0 = qpos - kb - 4 * hi;
#pragma unroll
                    for (int r = 0; r < 16; ++r) { const int c0 = crow(r, 0);
                        int i0 = rel0 - c0; i0 = i0 < -63 ? -63 : (i0 > 91 ? 91 : i0); int i1 = rel0 - c0 - 32; i1 = i1 < -63 ? -63 : (i1 > 91 ? 91 : i1);
                        p0[r] = ((mlo >> c0) & 1u) ? fmaf(p0[r], Cs, tb[i0 + 63]) : -1e30f; p1[r] = ((mhi >> c0) & 1u) ? fmaf(p1[r], Cs, tb[i1 + 63]) : -1e30f; }
                }
            } else {
#pragma unroll
                for (int r = 0; r < 16; ++r) { p0[r] *= Cs; p1[r] *= Cs; }
            }
            float pmax = p0[0];
#pragma unroll
            for (int r = 1; r < 16; ++r) pmax = fmaxf(pmax, p0[r]);
#pragma unroll
            for (int r = 0; r < 16; ++r) pmax = fmaxf(pmax, p1[r]);
            { auto rr = __builtin_amdgcn_permlane32_swap(__float_as_uint(pmax), __float_as_uint(pmax), false, false); pmax = fmaxf(__uint_as_float(rr[0]), __uint_as_float(rr[1])); }
            const float mn = fmaxf(m_reg, pmax), alpha = __builtin_amdgcn_exp2f(m_reg - mn);
            m_reg = mn;
            float ps = 0.f;
#pragma unroll
            for (int r = 0; r < 16; ++r) { p0[r] = __builtin_amdgcn_exp2f(p0[r] - mn); p1[r] = __builtin_amdgcn_exp2f(p1[r] - mn); ps += p0[r] + p1[r]; }
            { auto rr = __builtin_amdgcn_permlane32_swap(__float_as_uint(ps), __float_as_uint(ps), false, false); ps = __uint_as_float(rr[0]) + __uint_as_float(rr[1]); }
            l_reg = l_reg * alpha + ps;
            if (__any(alpha < 1.f)) {
                if (hi == 0) al_l[r32] = alpha;
                asm volatile("s_waitcnt lgkmcnt(0)" ::: "memory");
#pragma unroll
                for (int r = 0; r < 16; ++r) { const float a = al_l[crow(r, hi)];
#pragma unroll
                    for (int d = 0; d < 4; ++d) o[d][r] *= a; }
            }
            bf16x8 pa0, pa1, pa2, pa3;
#define PK4(P, BASE, OUT) do { unsigned a0 = cvtpk(P[BASE + 0], P[BASE + 1]), a1 = cvtpk(P[BASE + 2], P[BASE + 3]);   \
    unsigned b0 = cvtpk(P[BASE + 4], P[BASE + 5]), b1 = cvtpk(P[BASE + 6], P[BASE + 7]);                              \
    auto r0 = __builtin_amdgcn_permlane32_swap(a0, b0, false, false); auto r1 = __builtin_amdgcn_permlane32_swap(a1, b1, false, false); \
    u32x4 w = {r0[0], r1[0], r0[1], r1[1]}; OUT = *reinterpret_cast<bf16x8*>(&w); } while (0)
            PK4(p0, 0, pa0); PK4(p0, 8, pa1); PK4(p1, 0, pa2); PK4(p1, 8, pa3);
#undef PK4
            const int vb = vb0 + cur * 16384;
            pv_one<0>(o[0], vb, pa0, pa1, pa2, pa3); pv_one<1>(o[1], vb, pa0, pa1, pa2, pa3); pv_one<2>(o[2], vb, pa0, pa1, pa2, pa3); pv_one<3>(o[3], vb, pa0, pa1, pa2, pa3);
        }
        asm volatile("s_waitcnt vmcnt(0)" ::: "memory");
        __syncthreads();
    }
#undef AT_ISSUE
    if (hi == 0) li_l[r32] = l_reg;
    asm volatile("s_waitcnt lgkmcnt(0)" ::: "memory");
#pragma unroll
    for (int r = 0; r < 16; ++r) {
        const int orow = wid * 32 + crow(r, hi);
        const float rl = __builtin_amdgcn_rcpf(li_l[crow(r, hi)]);
        if (orow < u.nvalid) {
#pragma unroll
            for (int d0 = 0; d0 < 4; ++d0) { const int c = d0 * 32 + r32;
                const float g = bf2f(u.G[(size_t)orow * u.ldg + c]);
                u.O[(size_t)orow * u.ldo + c] = f2bf(o[d0][r] * rl * g); }
        }
    }
    __syncthreads();
}

__device__ __forceinline__ void phase_attn_dsa(CPARAMS& p, char* lds) {
    const float Cs = 0.08838834764831845f * LOG2E;
    const int NU = 1024 + 64;
#pragma unroll 1
    for (int idx = blockIdx.x; idx < NU; idx += gridDim.x) {
        AttnUnit u;
        bf16_t* mix = (bf16_t*)(p.ws + W_MIX);
        if (idx < 1024) { const int k = idx >> 8, w = idx & 255, h = w & 7, qb0 = (w >> 3) & 15, b = (w >> 7) + 2 * k, qb = (k & 1) ? 15 - qb0 : qb0;
            const size_t row0 = (size_t)b * TP + qb * 256;
            u.Q = mix + row0 * 3072 + h * 128; u.O = mix + row0 * 3072 + h * 128; u.G = (const bf16_t*)(p.ws + W_SG) + row0 * 1024 + h * 128;
            u.K = (const bf16_t*)(p.ws + W_KP) + (size_t)b * TP * 1024 + h * 128; u.V = (const bf16_t*)(p.ws + W_VP) + (size_t)b * TP * 1024 + h * 128;
            u.M = (const u64*)(p.ws + W_MASKP) + row0 * 64; u.ldm = 64; u.nvalid = 256; u.qpos0 = qb * 256; u.NT = 4 * (qb + 1); u.head = h;
        } else { const int s = idx - 1024, b = s >> 3, h = s & 7; const size_t row0 = (size_t)NP + b * 64;
            u.Q = mix + row0 * 3072 + h * 128; u.O = mix + row0 * 3072 + h * 128; u.G = (const bf16_t*)(p.ws + W_SG) + row0 * 1024 + h * 128;
            u.K = (const bf16_t*)(p.ws + W_KS) + (size_t)b * LS * 1024 + h * 128; u.V = (const bf16_t*)(p.ws + W_VS) + (size_t)b * LS * 1024 + h * 128;
            u.M = (const u64*)(p.ws + W_MASKS) + (size_t)b * 64 * 32; u.ldm = 32; u.nvalid = 64; u.qpos0 = PAST; u.NT = 17; u.head = h; }
        u.Qr = nullptr; u.Kr = nullptr; u.ldq = 3072; u.ldqr = 0; u.ldk = 1024; u.ldo = 3072; u.ldg = 1024;
        attn_unit<0>(u, lds, p.in[I_T5], Cs);
    }
}
__device__ __forceinline__ void phase_attn_mla(CPARAMS& p, char* lds) {
    const float Cs = 0.07216878364870323f * LOG2E;
    const int NU = 2048 + 128;
#pragma unroll 1
    for (int idx = blockIdx.x; idx < NU; idx += gridDim.x) {
        AttnUnit u;
        bf16_t* q2 = (bf16_t*)(p.ws + W_Q2); const bf16_t* kv = (const bf16_t*)(p.ws + W_KVALL); const bf16_t* kr = (const bf16_t*)(p.ws + W_KR);
        size_t row0, lrow0; int h;
        if (idx < 2048) { const int k = idx >> 8, w = idx & 255, qb0 = (w >> 4) & 15, b = k, qb = (k & 1) ? 15 - qb0 : qb0; h = w & 15;
            row0 = (size_t)b * TP + qb * 256; lrow0 = (size_t)b * TP; u.nvalid = 256; u.qpos0 = qb * 256; u.NT = 4 * (qb + 1);
        } else { const int s = idx - 2048, b = s >> 4; h = s & 15; row0 = (size_t)NP + b * 64; lrow0 = (size_t)NP + (size_t)b * LS; u.nvalid = 64; u.qpos0 = PAST; u.NT = 17; }
        u.Q = q2 + row0 * 3072 + h * 128; u.Qr = q2 + row0 * 3072 + 2048 + h * 64; u.O = q2 + row0 * 3072 + h * 128; u.G = (const bf16_t*)(p.ws + W_SGATE) + row0 * 2048 + h * 128;
        u.K = kv + lrow0 * 4096 + h * 128; u.V = kv + lrow0 * 4096 + 2048 + h * 128; u.Kr = kr + lrow0 * 64; u.M = nullptr;
        u.ldq = 3072; u.ldqr = 3072; u.ldk = 4096; u.ldo = 3072; u.ldg = 2048; u.ldm = 0; u.head = h;
        attn_unit<1>(u, lds, nullptr, Cs);
    }
}

constexpr int SD_XT = 0, SD_BS = 9216, SD_BTT = 26624, SD_CS = 45056, SD_CS2 = 62464, SD_WS = 79872, SD_H0 = 89088, SD_F = 106496;
__device__ __forceinline__ void phase_ssd(CPARAMS& p, char* lds) {
    const int tid = threadIdx.x, wid = tid >> 6, lane = tid & 63, l16 = lane & 15, lq = lane >> 4;
    bf16_t* XT = (bf16_t*)(lds + SD_XT); bf16_t* Bs = (bf16_t*)(lds + SD_BS); bf16_t* BTt = (bf16_t*)(lds + SD_BTT); bf16_t* Cs = (bf16_t*)(lds + SD_CS);
    bf16_t* Cs2 = (bf16_t*)(lds + SD_CS2); bf16_t* Ws = (bf16_t*)(lds + SD_WS); bf16_t* H0 = (bf16_t*)(lds + SD_H0);
    float* s_acum = (float*)(lds + SD_F); float* s_dt = s_acum + 64; float* s_ea = s_acum + 128; float* s_tail = s_acum + 192; float* s_ssq = s_acum + 256;
    const bf16_t* xbc = (const bf16_t*)(p.ws + W_XBC); bf16_t* mix = (bf16_t*)(p.ws + W_MIX);
    const float* dtbuf = (const float*)(p.ws + W_DT); float* ssqg = (float*)(p.ws + W_SSQ);
#pragma unroll 1
    for (int idx = blockIdx.x; idx < 512; idx += gridDim.x) {
        const bool sample = idx >= 256; const int bh = idx & 255, b = bh >> 5, h = bh & 31, g = h >> 3;
        const size_t row0 = sample ? (size_t)NP + b * 64 : (size_t)b * TP; const int nch = sample ? 1 : 64;
        const float a_h = -__expf(p.in[I_ALOG][h]), d_h = p.in[I_DSKIP][h];
        f32x4 hacc[4];
        const int pt = wid >> 1;
#pragma unroll
        for (int j = 0; j < 4; ++j) { const int nt = (wid & 1) * 4 + j;
#pragma unroll
            for (int i = 0; i < 4; ++i) { const int pp = pt * 16 + 4 * lq + i, nn = nt * 16 + l16;
                hacc[j][i] = sample ? p.in[I_SSSM][(((size_t)b * 32 + h) * 64 + pp) * 128 + nn] : 0.f;
                H0[pp * 136 + nn] = f2bf(hacc[j][i]); } }
        const int cg8 = tid % 40, rb = tid / 40;
        const int chcol = cg8 < 8 ? h * 64 + cg8 * 8 : (cg8 < 24 ? 2048 + g * 128 + (cg8 - 8) * 8 : 2560 + g * 128 + (cg8 - 24) * 8);
#pragma unroll 1
        for (int c = 0; c < nch; ++c) {
            const size_t crow0 = row0 + (size_t)c * 64;
            if (wid == 0) {
                if (c > 0) ssqg[(size_t)h * MALL + (crow0 - 64 + lane)] = (s_ssq[lane] + s_ssq[64 + lane]) + (s_ssq[128 + lane] + s_ssq[192 + lane]);
                const float dtv = dtbuf[(crow0 + lane) * 32 + h]; float ac = dtv * a_h;
#pragma unroll
                for (int o = 1; o < 64; o <<= 1) { const float t = __shfl_up(ac, o); if (lane >= o) ac += t; }
                const float a63 = __shfl(ac, 63);
                s_acum[lane] = ac; s_dt[lane] = dtv; s_ea[lane] = __expf(ac); s_tail[lane] = __expf(a63 - ac) * dtv;
            }
            __syncthreads();
            if (tid < 320) {
#pragma unroll 1
                for (int hf = 0; hf < 2; ++hf) {
                    const int cc = chcol + hf * 4;
                    float cw[4][4], cb[4];
                    { const float* cwp = p.in[I_CONVW] + cc;
#pragma unroll
                      for (int j = 0; j < 4; ++j) { const f32x4 a = *(const f32x4*)(cwp + j * 3072); cw[j][0] = a[0]; cw[j][1] = a[1]; cw[j][2] = a[2]; cw[j][3] = a[3]; }
                      const f32x4 a = *(const f32x4*)(p.in[I_CONVB] + cc); cb[0] = a[0]; cb[1] = a[1]; cb[2] = a[2]; cb[3] = a[3]; }
                    float win[3][4];
#pragma unroll
                    for (int j = 0; j < 3; ++j) {
                        const int tl = rb * 8 + j - 3;
                        if (c == 0 && tl < 0) {
                            if (sample) { const f32x4 a = *(const f32x4*)(p.in[I_SCONV] + ((size_t)b * 3 + (tl + 3)) * 3072 + cc); win[j][0] = a[0]; win[j][1] = a[1]; win[j][2] = a[2]; win[j][3] = a[3]; }
                            else { win[j][0] = 0.f; win[j][1] = 0.f; win[j][2] = 0.f; win[j][3] = 0.f; }
                        } else { const s16x4 r = *(const s16x4*)(xbc + (size_t)((long)crow0 + tl) * 3072 + cc);
#pragma unroll
                            for (int e = 0; e < 4; ++e) win[j][e] = bf2f((bf16_t)r[e]); }
                    }
                    float vout[8][4];
#pragma unroll
                    for (int r = 0; r < 8; ++r) {
                        const s16x4 rw = *(const s16x4*)(xbc + (crow0 + rb * 8 + r) * 3072 + cc);
#pragma unroll
                        for (int e = 0; e < 4; ++e) { const float cur = bf2f((bf16_t)rw[e]);
                            const float v = cb[e] + cw[0][e] * win[0][e] + cw[1][e] * win[1][e] + cw[2][e] * win[2][e] + cw[3][e] * cur;
                            vout[r][e] = silu_f(v); win[0][e] = win[1][e]; win[1][e] = win[2][e]; win[2][e] = cur; }
                    }
                    const int t0l = rb * 8;
                    if (cg8 < 8) {
#pragma unroll
                        for (int e = 0; e < 4; ++e) { float t[8];
#pragma unroll
                            for (int r = 0; r < 8; ++r) t[r] = vout[r][e];
                            *(bf16x8*)(XT + (cg8 * 8 + hf * 4 + e) * 72 + t0l) = pack8(t); }
                    } else if (cg8 < 24) {
                        const int n0 = (cg8 - 8) * 8 + hf * 4;
#pragma unroll
                        for (int r = 0; r < 8; ++r) { const f32x4 q = {vout[r][0], vout[r][1], vout[r][2], vout[r][3]}; *(u32x2*)(Bs + (t0l + r) * 136 + n0) = pack4(q); }
                        float tl8[8];
#pragma unroll
                        for (int r = 0; r < 8; ++r) tl8[r] = s_tail[t0l + r];
#pragma unroll
                        for (int e = 0; e < 4; ++e) { float t[8];
#pragma unroll
                            for (int r = 0; r < 8; ++r) t[r] = vout[r][e] * tl8[r];
                            *(bf16x8*)(BTt + (n0 + e) * 72 + t0l) = pack8(t); }
                    } else {
                        const int n0 = (cg8 - 24) * 8 + hf * 4;
#pragma unroll
                        for (int r = 0; r < 8; ++r) { const f32x4 q = {vout[r][0], vout[r][1], vout[r][2], vout[r][3]}; *(u32x2*)(Cs + (t0l + r) * 136 + n0) = pack4(q);
                            const float ea = s_ea[t0l + r]; *(u32x2*)(Cs2 + (t0l + r) * 136 + n0) = pack4(q * ea); }
                    }
                }
            }
            __syncthreads();
#pragma unroll
            for (int q = 0; q < 2; ++q) { const int id = wid * 2 + q, mt = id >> 2, nt = id & 3;
                f32x4 acc = {0.f, 0.f, 0.f, 0.f};
                if (nt <= mt) {
#pragma unroll
                    for (int ks = 0; ks < 4; ++ks) { const bf16x8 af = *(const bf16x8*)(Cs + (mt * 16 + l16) * 136 + ks * 32 + lq * 8), bf = *(const bf16x8*)(Bs + (nt * 16 + l16) * 136 + ks * 32 + lq * 8);
                        acc = __builtin_amdgcn_mfma_f32_16x16x32_bf16(af, bf, acc, 0, 0, 0); }
                }
                const int s = nt * 16 + l16; const float as = s_acum[s], dts = s_dt[s];
#pragma unroll
                for (int i = 0; i < 4; ++i) { const int t = mt * 16 + 4 * lq + i; const float w = (s <= t) ? acc[i] * __expf(s_acum[t] - as) * dts : 0.f; Ws[t * 72 + s] = f2bf(w); }
            }
            __syncthreads();
#pragma unroll
            for (int q = 0; q < 2; ++q) { const int id = wid * 2 + q, mt = id >> 2, nt = id & 3;
                f32x4 acc = {0.f, 0.f, 0.f, 0.f};
#pragma unroll
                for (int ks = 0; ks < 2; ++ks) { const bf16x8 af = *(const bf16x8*)(Ws + (mt * 16 + l16) * 72 + ks * 32 + lq * 8), bf = *(const bf16x8*)(XT + (nt * 16 + l16) * 72 + ks * 32 + lq * 8);
                    acc = __builtin_amdgcn_mfma_f32_16x16x32_bf16(af, bf, acc, 0, 0, 0); }
#pragma unroll
                for (int ks = 0; ks < 4; ++ks) { const bf16x8 af = *(const bf16x8*)(Cs2 + (mt * 16 + l16) * 136 + ks * 32 + lq * 8), bf = *(const bf16x8*)(H0 + (nt * 16 + l16) * 136 + ks * 32 + lq * 8);
                    acc = __builtin_amdgcn_mfma_f32_16x16x32_bf16(af, bf, acc, 0, 0, 0); }
                const int pp = nt * 16 + l16;
#pragma unroll
                for (int i = 0; i < 4; ++i) { const int t = mt * 16 + 4 * lq + i;
                    const float xv = bf2f(XT[pp * 72 + t]);
                    bf16_t* zp = mix + (crow0 + t) * 3072 + 1024 + h * 64 + pp;
#ifdef PROBE_NOSZ
                    const float yg = (acc[i] + d_h * xv);
#else
                    const float yg = (acc[i] + d_h * xv) * bf2f(*zp);
#endif
                    *zp = f2bf(yg);
                    float sq = yg * yg;
                    sq += __shfl_xor(sq, 1); sq += __shfl_xor(sq, 2); sq += __shfl_xor(sq, 4); sq += __shfl_xor(sq, 8);
                    if (l16 == 0) s_ssq[nt * 64 + t] = sq; }
            }
            const float e63 = s_ea[63];
            __syncthreads();
#pragma unroll
            for (int j = 0; j < 4; ++j) { const int nt = (wid & 1) * 4 + j;
                f32x4 acc = hacc[j] * e63;
#pragma unroll
                for (int ks = 0; ks < 2; ++ks) { const bf16x8 af = *(const bf16x8*)(XT + (pt * 16 + l16) * 72 + ks * 32 + lq * 8), bf = *(const bf16x8*)(BTt + (nt * 16 + l16) * 72 + ks * 32 + lq * 8);
                    acc = __builtin_amdgcn_mfma_f32_16x16x32_bf16(af, bf, acc, 0, 0, 0); }
                hacc[j] = acc;
#pragma unroll
                for (int i = 0; i < 4; ++i) H0[(pt * 16 + 4 * lq + i) * 136 + nt * 16 + l16] = f2bf(acc[i]);
            }
        }
        __syncthreads();
        if (wid == 0) ssqg[(size_t)h * MALL + (row0 + (size_t)(nch - 1) * 64 + lane)] = (s_ssq[lane] + s_ssq[64 + lane]) + (s_ssq[128 + lane] + s_ssq[192 + lane]);
        { float* ho = p.out + (sample ? O_BSS : O_BSP) + ((size_t)b * 32 + h) * 64 * 128;
#pragma unroll
          for (int j = 0; j < 4; ++j) { const int nt = (wid & 1) * 4 + j;
#pragma unroll
              for (int i = 0; i < 4; ++i) ho[(size_t)(pt * 16 + 4 * lq + i) * 128 + nt * 16 + l16] = hacc[j][i]; } }
        __syncthreads();
    }
}

__device__ __forceinline__ void phase_bnorm(CPARAMS& p) {
    bf16_t* mix = (bf16_t*)(p.ws + W_MIX); const float* ssq = (const float*)(p.ws + W_SSQ); const float* nw = p.in[I_SNORM];
    const size_t n = (size_t)MALL * 256;
    for (size_t i = (size_t)blockIdx.x * 512 + threadIdx.x; i < n; i += (size_t)gridDim.x * 512) {
        const size_t row = i >> 8; const int c0 = (int)(i & 255) * 8, g = c0 >> 9;
        float tot = 0.f;
#pragma unroll
        for (int hh = 0; hh < 8; ++hh) tot += ssq[(size_t)(g * 8 + hh) * MALL + row];
        const float r = rsqrtf(tot * (1.f / 512.f) + EPSV);
        bf16_t* ptr = mix + row * 3072 + 1024 + c0; const bf16x8 v = *(const bf16x8*)ptr;
        const f32x4 w0 = *(const f32x4*)(nw + c0), w1 = *(const f32x4*)(nw + c0 + 4);
        float t[8];
#pragma unroll
        for (int e = 0; e < 8; ++e) t[e] = bf2f((bf16_t)v[e]) * r * (e < 4 ? w0[e] : w1[e - 4]);
        *(bf16x8*)ptr = pack8(t);
    }
}
__device__ __forceinline__ void phase_ln(CPARAMS& p, const float* gw, const float* bw, bf16_t* yb) {
    int tid_ = threadIdx.x; asm volatile("" : "+v"(tid_));
    const int wid = tid_ >> 6, lane = tid_ & 63;
    float* y = p.out + O_Y;
    for (int row = blockIdx.x * 8 + wid; row < MALL; row += gridDim.x * 8) {
        float* rp = y + (size_t)row * DM;
        f32x4 v[8]; float s = 0.f;
#pragma unroll
        for (int j = 0; j < 8; ++j) { v[j] = *(const f32x4*)(rp + j * 256 + lane * 4); s += v[j][0] + v[j][1] + v[j][2] + v[j][3]; }
        const float mu = wave_sum(s) * (1.f / DM);
        float q = 0.f;
#pragma unroll
        for (int j = 0; j < 8; ++j) { v[j] = v[j] - mu; q += v[j][0] * v[j][0] + v[j][1] * v[j][1] + v[j][2] * v[j][2] + v[j][3] * v[j][3]; }
        const float rs = rsqrtf(wave_sum(q) * (1.f / DM) + EPSV);
#pragma unroll
        for (int j = 0; j < 8; ++j) { const int c = j * 256 + lane * 4; const f32x4 gg = *(const f32x4*)(gw + c), bb = *(const f32x4*)(bw + c);
            const f32x4 o = v[j] * rs * gg + bb; *(f32x4*)(rp + c) = o; if (yb) *(u32x2*)(yb + (size_t)row * DM + c) = pack4(o); }
    }
}
__device__ __forceinline__ void phase_post1(CPARAMS& p) {
    const int wid = threadIdx.x >> 6, lane = threadIdx.x & 63;
    const float* cqkv = (const float*)(p.ws + W_CQKV); bf16_t* cqn = (bf16_t*)(p.ws + W_CQN); bf16_t* lat = (bf16_t*)(p.ws + W_LAT); bf16_t* krb = (bf16_t*)(p.ws + W_KR);
    const float2* tab = (const float2*)(p.ws + W_ROPE);
    for (int row = blockIdx.x * 8 + wid; row < MALL; row += gridDim.x * 8) {
        const float* rp = cqkv + (size_t)row * 1088;
        const f32x4 a0 = *(const f32x4*)(rp + lane * 8), a1 = *(const f32x4*)(rp + lane * 8 + 4), c0 = *(const f32x4*)(rp + 512 + lane * 8), c1 = *(const f32x4*)(rp + 512 + lane * 8 + 4);
        const float kv = rp[1024 + lane];
        float sa = 0.f, sc = 0.f;
#pragma unroll
        for (int e = 0; e < 4; ++e) { sa += a0[e] * a0[e] + a1[e] * a1[e]; sc += c0[e] * c0[e] + c1[e] * c1[e]; }
        const float ra = rsqrtf(wave_sum(sa) * (1.f / 512.f) + EPSV), rc = rsqrtf(wave_sum(sc) * (1.f / 512.f) + EPSV);
        const f32x4 qw0 = *(const f32x4*)(p.in[I_QNW] + lane * 8), qw1 = *(const f32x4*)(p.in[I_QNW] + lane * 8 + 4), kw0 = *(const f32x4*)(p.in[I_KVNW] + lane * 8), kw1 = *(const f32x4*)(p.in[I_KVNW] + lane * 8 + 4);
        const f32x4 qa = a0 * ra * qw0, qb = a1 * ra * qw1, la = c0 * rc * kw0, lb = c1 * rc * kw1;
        { const float t[8] = {qa[0], qa[1], qa[2], qa[3], qb[0], qb[1], qb[2], qb[3]}; *(bf16x8*)(cqn + (size_t)row * 512 + lane * 8) = pack8(t); }
        const int lr = latrow_of(row);
        { const float t[8] = {la[0], la[1], la[2], la[3], lb[0], lb[1], lb[2], lb[3]}; *(bf16x8*)(lat + (size_t)lr * 512 + lane * 8) = pack8(t); }
        float* clo = row < NP ? p.out + O_CLP + (size_t)row * 512 : p.out + O_CLS + (size_t)(row - NP) * 512;
        *(f32x4*)(clo + lane * 8) = la; *(f32x4*)(clo + lane * 8 + 4) = lb;
        const float other = __shfl_xor(kv, 32);
        const int i = lane & 31, pos = pos_of(row); const float2 cs = tab[(size_t)pos * 32 + i];
        const float o = lane < 32 ? kv * cs.x - other * cs.y : other * cs.y + kv * cs.x;
        float* cko = row < NP ? p.out + O_CKP + (size_t)row * 64 : p.out + O_CKS + (size_t)(row - NP) * 64;
        cko[lane] = o;
        krb[(size_t)lr * 64 + 4 * (i >> 1) + (i & 1) + (lane >= 32 ? 2 : 0)] = f2bf(o);
    }
    const size_t gtid = (size_t)blockIdx.x * 512 + threadIdx.x, gstride = (size_t)gridDim.x * 512;
    { const size_t n8 = (size_t)8 * PAST * 512 / 8;
      for (size_t i = gtid; i < n8; i += gstride) { const size_t e = i * 8, b = e / ((size_t)PAST * 512), rem = e % ((size_t)PAST * 512); const float* s = p.in[I_CLAT] + e;
        const f32x4 a = *(const f32x4*)s, c = *(const f32x4*)(s + 4); const float t[8] = {a[0], a[1], a[2], a[3], c[0], c[1], c[2], c[3]};
        *(bf16x8*)(lat + ((size_t)NP + b * LS) * 512 + rem) = pack8(t); } }
    { const size_t n = (size_t)8 * PAST * 64;
      for (size_t e = gtid; e < n; e += gstride) { const size_t b = e / ((size_t)PAST * 64), rem = e % ((size_t)PAST * 64), t = rem >> 6; const int j = (int)(rem & 63), i = j & 31;
        krb[((size_t)NP + b * LS + t) * 64 + 4 * (i >> 1) + (i & 1) + (j >= 32 ? 2 : 0)] = f2bf(p.in[I_CKR][e]); } }
}

__device__ __forceinline__ CPARAMS& get_params() {
    const unsigned long long v = (unsigned long long)__builtin_amdgcn_kernarg_segment_ptr(); unsigned lo = (unsigned)v, hi = (unsigned)(v >> 32);
    asm volatile("" : "+s"(lo), "+s"(hi));
    lo = __builtin_amdgcn_readfirstlane(lo); hi = __builtin_amdgcn_readfirstlane(hi);
    return *(CPARAMS*)(((unsigned long long)hi << 32) | lo);
}
#ifndef PROBE_STOP
#define PROBE_STOP 0
#endif
__device__ __forceinline__ void phase_dump(CPARAMS& p) {
    const unsigned short* w = (const unsigned short*)p.ws; float* y = p.out + O_Y; const size_t n = (size_t)MALL * DM;
#ifdef PROBE_THRASH
    { const f32x4* xs = (const f32x4*)p.in[I_XP] + (size_t)((blockIdx.x >> 3) & 31) * (NP * (size_t)DM / 4 / 32); f32x4 a = {0.f, 0.f, 0.f, 0.f};
      for (size_t i = threadIdx.x; i < NP * (size_t)DM / 4 / 32; i += 512) a += xs[i];
      if (a[0] + a[1] + a[2] + a[3] == 1.2345e30f) y[0] = 1.f;
      __syncthreads(); __threadfence(); }
    cg::this_grid().sync(); __threadfence();
#endif
    for (size_t i = (size_t)blockIdx.x * 512 + threadIdx.x; i < n; i += (size_t)gridDim.x * 512) {
        unsigned h = 0x12345u;
#pragma unroll
        for (int r = 0; r < 8; ++r) { const size_t o = (size_t)r * n + i; const unsigned v = (o * 2 < W_END) ? w[o] : 0u; h = (h ^ v) * 0x9E3779B1u; }
        h ^= h >> 15; y[i] = (float)((h >> 8) & 127u);
    }
}
#define PROBE_AT(k) do { if (PROBE_STOP == (k)) { CPARAMS& pq = get_params(); phase_dump(pq); return; } } while (0)
__global__ void __launch_bounds__(512) fwd_megakernel(Params p_unused) {
    extern __shared__ __attribute__((aligned(16))) char lds[];
    cg::grid_group grid = cg::this_grid();
#define GSYNC() do { __threadfence(); grid.sync(); __threadfence(); } while (0)
    { CPARAMS& p = get_params(); phase_prep(p, lds); }
    GSYNC();
    PROBE_AT(1);
    { CPARAMS& p = get_params(); pg8::Gemm g; g.A = (const bf16_t*)(p.ws + W_XB); g.Bt = (const bf16_t*)(p.ws + W_BT0); g.M = MALL; g.N = NIN0P; g.K = DM; g.lda = DM;
      pg8::StaticOrder S; S.init(MALL, NIN0P, (int)gridDim.x, (int)blockIdx.x); EpiInProj0 E{p.ws, p.out, p.in[I_DTB]};
      pg8::gemm_phase<EpiInProj0, pg8::StaticOrder>((PG8_LAS unsigned char*)lds, g, S, E); }
    GSYNC();
    PROBE_AT(2);
    { CPARAMS& p = get_params(); phase_index(p, lds); }
    GSYNC();
    PROBE_AT(3);
#ifndef PROBE_SKIP_DSA
    { CPARAMS& p = get_params(); phase_attn_dsa(p, lds); }
#endif
#ifndef PROBE_SKIP_SSD
    { CPARAMS& p = get_params(); phase_ssd(p, lds); }
#endif
    GSYNC();
    PROBE_AT(4);
    { CPARAMS& p = get_params(); phase_bnorm(p); }
    GSYNC();
    PROBE_AT(5);
    { CPARAMS& p = get_params(); FResid f{p.in[I_XP], p.in[I_XS], p.out + O_Y}; run_gemm(lds, (const bf16_t*)(p.ws + W_MIX), 3072, (const bf16_t*)(p.ws + W_BTOUT0), MALL, DM, 3072, f); }
    GSYNC();
    PROBE_AT(6);
    { CPARAMS& p = get_params(); phase_ln(p, p.in[I_LN0G], p.in[I_LN0B], (bf16_t*)(p.ws + W_XB)); }
    GSYNC();
    PROBE_AT(7);
    { CPARAMS& p = get_params(); FInProj1 f{p.ws}; run_gemm(lds, (const bf16_t*)(p.ws + W_XB), DM, (const bf16_t*)(p.ws + W_BT1), MALL, NIN1P, DM, f); }
    GSYNC();
    PROBE_AT(8);
    { CPARAMS& p = get_params(); phase_post1(p); }
    GSYNC();
    PROBE_AT(9);
    { CPARAMS& p = get_params(); FQUp f{p.ws}; run_gemm(lds, (const bf16_t*)(p.ws + W_CQN), 512, (const bf16_t*)(p.ws + W_BTUQ), MALL, 3072, 512, f); }
    { CPARAMS& p = get_params(); FKvUp f{p.ws}; run_gemm(lds, (const bf16_t*)(p.ws + W_LAT), 512, (const bf16_t*)(p.ws + W_BTUKV), LATROWS, 4096, 512, f); }
    GSYNC();
    PROBE_AT(10);
    { CPARAMS& p = get_params(); phase_attn_mla(p, lds); }
    GSYNC();
    PROBE_AT(11);
    { CPARAMS& p = get_params(); FResid f{p.out + O_Y, p.out + O_Y + (size_t)NP * DM, p.out + O_Y}; run_gemm(lds, (const bf16_t*)(p.ws + W_Q2), 3072, (const bf16_t*)(p.ws + W_BTOUT1), MALL, DM, DM, f); }
    GSYNC();
    PROBE_AT(12);
    { CPARAMS& p = get_params(); phase_ln(p, p.in[I_LN1G], p.in[I_LN1B], nullptr); }
}

extern "C" void kernel_launch(void* const* d_in, const int* in_sizes, int n_in, void* d_out, int out_size, void* d_ws, size_t ws_size, hipStream_t stream) {
    static int grid_blocks = 0;
    if (!grid_blocks) {
        if (n_in != N_IN || (size_t)out_size != O_END || ws_size < W_END) { fprintf(stderr, "kernel_launch: unexpected shapes n_in %d out %d ws %zu\n", n_in, out_size, ws_size); return; }
        if (hipFuncSetAttribute((const void*)fwd_megakernel, hipFuncAttributeMaxDynamicSharedMemorySize, LDS_BYTES) != hipSuccess) { fprintf(stderr, "kernel_launch: LDS attribute failed\n"); return; }
        int dev = 0, cus = 0, per_cu = 0;
        hipGetDevice(&dev); hipDeviceGetAttribute(&cus, hipDeviceAttributeMultiprocessorCount, dev);
        hipOccupancyMaxActiveBlocksPerMultiprocessor(&per_cu, fwd_megakernel, 512, LDS_BYTES);
        if (per_cu < 1) { fprintf(stderr, "kernel_launch: occupancy 0\n"); return; }
        grid_blocks = cus;
    }
    Params p{};
    for (int i = 0; i < N_IN; ++i) p.in[i] = (const float*)d_in[i];
    p.out = (float*)d_out; p.ws = (char*)d_ws;
    void* args[] = {&p};
    hipError_t e = hipLaunchCooperativeKernel((const void*)fwd_megakernel, dim3(grid_blocks), dim3(512), args, LDS_BYTES, stream);
    if (e != hipSuccess) fprintf(stderr, "cooperative launch failed: %s (grid %d)\n", hipGetErrorString(e), grid_blocks);
}
```

```cpp
#include <hip/hip_runtime.h>
#include <hip/hip_cooperative_groups.h>
#include <cstdio>
#include <cstdint>
namespace cg = cooperative_groups;

#define LAS __attribute__((address_space(3)))
typedef unsigned short bf16_t;
typedef short bf16x8 __attribute__((ext_vector_type(8)));
typedef short s16x4 __attribute__((ext_vector_type(4)));
typedef float f32x4 __attribute__((ext_vector_type(4)));
typedef float f32x8 __attribute__((ext_vector_type(8)));
typedef float f32x16 __attribute__((ext_vector_type(16)));
typedef unsigned u32x4 __attribute__((ext_vector_type(4)));
typedef unsigned u32x2 __attribute__((ext_vector_type(2)));
typedef unsigned long long u64;

constexpr int DM = 2048, NP = 32768, NS = 512, MALL = NP + NS  , TP = 4096, TS = 64, PAST = 1024, LS = PAST + TS  ;
constexpr int NIN0 = 10352, NIN0P = 10496, NIN1 = 3136, NIN1P = 3328;
constexpr int LATROWS = NP + 8 * LS;
constexpr float ALPHA_RES = 1.4142135623730951f;
constexpr float LOG2E = 1.4426950408889634f;
constexpr float EPSV = 1e-5f;

enum { I_XP = 0, I_XS, I_CAK, I_CAV, I_CAKI, I_SCONV, I_SSSM, I_CLAT, I_CKR, I_T5, I_WIN0, I_WOUT0, I_CONVW, I_CONVB, I_DTB, I_ALOG, I_DSKIP,
       I_SNORM, I_LN0G, I_LN0B, I_WIN1, I_QNW, I_KVNW, I_WUQ, I_WUKV, I_WOUT1, I_LN1G, I_LN1B, N_IN };

constexpr size_t O_Y = 0;
constexpr size_t O_AKP = (size_t)MALL * DM;
constexpr size_t O_AKS = O_AKP + (size_t)NP * 1024;
constexpr size_t O_AVP = O_AKS + (size_t)NS * 1024;
constexpr size_t O_AVS = O_AVP + (size_t)NP * 1024;
constexpr size_t O_KIP = O_AVS + (size_t)NS * 1024;
constexpr size_t O_KIS = O_KIP + (size_t)NP * 64;
constexpr size_t O_BCP = O_KIS + (size_t)NS * 64;
constexpr size_t O_BCS = O_BCP + (size_t)8 * 3 * 3072;
constexpr size_t O_BSP = O_BCS + (size_t)8 * 3 * 3072;
constexpr size_t O_BSS = O_BSP + (size_t)8 * 32 * 64 * 128;
constexpr size_t O_CLP = O_BSS + (size_t)8 * 32 * 64 * 128;
constexpr size_t O_CLS = O_CLP + (size_t)NP * 512;
constexpr size_t O_CKP = O_CLS + (size_t)NS * 512;
constexpr size_t O_CKS = O_CKP + (size_t)NP * 64;
constexpr size_t O_END = O_CKS + (size_t)NS * 64;

constexpr size_t MiB = 1ull << 20;
constexpr size_t W_BT0 = 0;
constexpr size_t W_BTOUT0 = 41 * MiB;
constexpr size_t W_BT1 = 53 * MiB;
constexpr size_t W_BTUQ = 66 * MiB;
constexpr size_t W_BTUKV = 69 * MiB;
constexpr size_t W_BTOUT1 = 73 * MiB;
constexpr size_t W_ROPE = 81 * MiB;
constexpr size_t W_KIDXP = 82 * MiB;
constexpr size_t W_KIDXS = 86 * MiB;
constexpr size_t W_IW = 88 * MiB;
constexpr size_t W_DT = 91 * MiB;
constexpr size_t W_MASKP = 96 * MiB;
constexpr size_t W_MASKS = 112 * MiB;
constexpr size_t W_SSQ = 113 * MiB;
constexpr size_t W_BAR = 118 * MiB;
constexpr size_t W_XB = 120 * MiB;
constexpr size_t W_MIX = 250 * MiB;
constexpr size_t W_KP = 445 * MiB;
constexpr size_t W_KS = 509 * MiB;
constexpr size_t W_VP = 526 * MiB;
constexpr size_t W_VS = 590 * MiB;
constexpr size_t W_SG = 607 * MiB;
constexpr size_t W_IQ = 672 * MiB;
constexpr size_t W_XBC = 737 * MiB;
constexpr size_t W_KVALL = 120 * MiB;
constexpr size_t W_CQKV = 445 * MiB;
constexpr size_t W_CQN = 584 * MiB;
constexpr size_t W_LAT = 617 * MiB;
constexpr size_t W_KR = 658 * MiB;
constexpr size_t W_Q2 = 664 * MiB;
constexpr size_t W_SGATE = 860 * MiB;
constexpr size_t W_XACT = W_XB;
constexpr size_t W_BCACT = 932 * MiB;
constexpr size_t W_END = 997 * MiB;

struct Params { const float* in[N_IN]; float* out; char* ws; };
#define CPARAMS const __attribute__((address_space(4))) Params

constexpr int LDS_BYTES = 131072 + 32768;
#define KRSWZ(row, colB) ((row) * 128 + ((colB) ^ ((((row) >> 1) & 7) << 4)))

typedef __bf16 bf16x2_t __attribute__((ext_vector_type(2)));
typedef float f32x2_t __attribute__((ext_vector_type(2)));
__device__ __forceinline__ unsigned cvtpk(float lo, float hi) { const f32x2_t v = {lo, hi}; const bf16x2_t r = __builtin_convertvector(v, bf16x2_t); return __builtin_bit_cast(unsigned, r); }
__device__ __forceinline__ bf16_t f2bf(float f) { return (bf16_t)(cvtpk(f, f) & 0xffffu); }
__device__ __forceinline__ float bf2f(bf16_t b) { return __uint_as_float(((unsigned)b) << 16); }
__device__ __forceinline__ float silu_f(float v) { return v / (1.f + __expf(-v)); }
__device__ __forceinline__ bf16x8 pack8(const float* x) { u32x4 w = {cvtpk(x[0], x[1]), cvtpk(x[2], x[3]), cvtpk(x[4], x[5]), cvtpk(x[6], x[7])}; return *reinterpret_cast<bf16x8*>(&w); }
__device__ __forceinline__ u32x2 pack4(f32x4 v) { u32x2 w = {cvtpk(v[0], v[1]), cvtpk(v[2], v[3])}; return w; }
__device__ __forceinline__ float wave_sum(float v) {
#pragma unroll
  for (int o = 32; o > 0; o >>= 1) v += __shfl_xor(v, o);
  return v;
}
__device__ __forceinline__ int wave_sum_i(int v) {
#pragma unroll
  for (int o = 32; o > 0; o >>= 1) v += __shfl_xor(v, o);
  return v;
}
__device__ __forceinline__ float row16_sum(float v) {
    v += __builtin_bit_cast(float, __builtin_amdgcn_update_dpp(0, __builtin_bit_cast(int, v), 0xB1, 0xf, 0xf, true));
    v += __builtin_bit_cast(float, __builtin_amdgcn_update_dpp(0, __builtin_bit_cast(int, v), 0x4E, 0xf, 0xf, true));
    v += __builtin_bit_cast(float, __builtin_amdgcn_update_dpp(0, __builtin_bit_cast(int, v), 0x141, 0xf, 0xf, true));
    v += __builtin_bit_cast(float, __builtin_amdgcn_update_dpp(0, __builtin_bit_cast(int, v), 0x140, 0xf, 0xf, true));
    return v;
}
__device__ __forceinline__ float wave_scan_incl(float v, int lane) {
    v += __builtin_bit_cast(float, __builtin_amdgcn_update_dpp(0, __builtin_bit_cast(int, v), 0x111, 0xf, 0xf, false));
    v += __builtin_bit_cast(float, __builtin_amdgcn_update_dpp(0, __builtin_bit_cast(int, v), 0x112, 0xf, 0xf, false));
    v += __builtin_bit_cast(float, __builtin_amdgcn_update_dpp(0, __builtin_bit_cast(int, v), 0x114, 0xf, 0xf, false));
    v += __builtin_bit_cast(float, __builtin_amdgcn_update_dpp(0, __builtin_bit_cast(int, v), 0x118, 0xf, 0xf, false));
    const float t0 = __builtin_bit_cast(float, __builtin_amdgcn_readlane(__builtin_bit_cast(int, v), 15));
    const float t1 = __builtin_bit_cast(float, __builtin_amdgcn_readlane(__builtin_bit_cast(int, v), 31));
    const float t2 = __builtin_bit_cast(float, __builtin_amdgcn_readlane(__builtin_bit_cast(int, v), 47));
    float add = 0.f; if (lane >= 16) add = t0; if (lane >= 32) add = t0 + t1; if (lane >= 48) add = (t0 + t1) + t2;
    return v + add;
}
__device__ __forceinline__ int opaque_tid() { int t = threadIdx.x; asm volatile("" : "+v"(t)); return t; }
__device__ __forceinline__ int wave_sum_dpp(int v) {
    v += __builtin_amdgcn_update_dpp(0, v, 0xB1, 0xf, 0xf, true);
    v += __builtin_amdgcn_update_dpp(0, v, 0x4E, 0xf, 0xf, true);
    v += __builtin_amdgcn_update_dpp(0, v, 0x141, 0xf, 0xf, true);
    v += __builtin_amdgcn_update_dpp(0, v, 0x140, 0xf, 0xf, true);
    return __builtin_amdgcn_readlane(v, 0) + __builtin_amdgcn_readlane(v, 16) + __builtin_amdgcn_readlane(v, 32) + __builtin_amdgcn_readlane(v, 48);
}
__device__ __forceinline__ int latrow_of(int row) { if (row < NP) return row; const int r = row - NP; return NP + (r >> 6) * LS + PAST + (r & 63); }
__device__ __forceinline__ int pos_of(int row) { return row < NP ? (row & (TP - 1)) : PAST + ((row - NP) & 63); }
namespace pg8 {
#define PG8_LAS __attribute__((address_space(3)))
constexpr int BM = 256, BK = 64, HALF = 128, HTB = HALF * BK * 2  , STAGE_BYTES = 8 * HTB, NXCD = 8, WGM = 8;

__host__ __device__ __forceinline__ int lds_byte(int r, int c) { const int st = (r >> 4) * 2 + (c >> 5), rr = r & 15, cc = c & 31, ob = rr * 64 + cc * 2; return st * 1024 + (ob ^ (((ob >> 9) & 1) << 5)); }
__host__ __device__ __forceinline__ void stage_rc(int b, int& R, int& C) { const int st = b / 1024, sb = b % 1024, swz = sb ^ (((sb >> 9) & 1) << 5); R = (st >> 1) * 16 + swz / 64; C = (st & 1) * 32 + (swz % 64) / 2; }
__host__ __device__ __forceinline__ int perm32(int rho) { const int n = rho >> 4, i = rho & 15; return 8 * (i >> 2) + 4 * n + (i & 3); }

struct Unit { int pm, pn; };
struct Gemm { const bf16_t* A; const bf16_t* Bt; int M, N, K, lda; };

struct StaticOrder {
    int nM, nN, nwg, G, c;
    __host__ __device__ void init(int M, int N, int G_, int c_) { nM = M / BM; nN = N / BM; nwg = nM * nN; G = G_; c = c_; }
    __host__ __device__ bool next(int i, Unit& u) const {
        const long L = (long)i * G + c; if (L >= nwg) return false;
        int wgid = (int)L; { const int q = nwg / NXCD, r = nwg % NXCD, xcd = wgid % NXCD, off = wgid / NXCD; wgid = (xcd < r ? xcd * (q + 1) : r * (q + 1) + (xcd - r) * q) + off; }
        const int nig = WGM * nN, gid = wgid / nig, fm = gid * WGM, gsz = (nM - fm) < WGM ? (nM - fm) : WGM;
        u.pm = fm + ((wgid % nig) % gsz); u.pn = (wgid % nig) / gsz; return true;
    }
    __device__ __forceinline__ void a_ready(const Unit&) const {}
    __device__ __forceinline__ void done(const Unit&) const {}
};

template <class Epi, class Sched>
__device__ __forceinline__ void gemm_phase(PG8_LAS unsigned char* lds, const Gemm g, const Sched& S, const Epi& E) {
    constexpr bool STAMP = false; unsigned long long* stamps = nullptr;
    int tid_ = threadIdx.x; asm volatile("" : "+v"(tid_));
    const int tid = tid_, wid = __builtin_amdgcn_readfirstlane(tid >> 6), lane = tid & 63, wr = wid >> 2, wc = wid & 3, fr = lane & 15, fq = lane >> 4;
    const int K = g.K, nt = K / BK;
    int ts_lo = 0, ts_hi = 0, nts = 0; const unsigned long long rt_entry = STAMP ? (unsigned long long)wall_clock64() : 0ull;
#define PG8_STAMP() do { if (STAMP && wid == 0 && nts < 64) { const unsigned long long _c = (unsigned long long)clock64(); \
        ts_lo = (lane == nts) ? (int)(unsigned)_c : ts_lo; ts_hi = (lane == nts) ? (int)(unsigned)(_c >> 32) : ts_hi; ++nts; } } while (0)
    PG8_STAMP();
    unsigned voffA[2], voffB[2];
#pragma unroll
    for (int i = 0; i < 2; ++i) { int R, C; stage_rc(tid * 16 + i * 8192, R, C); const int Rb = Epi::PERM ? ((R & ~31) + perm32(R & 31)) : R;
        voffA[i] = (unsigned)(R * g.lda + C) * 2u; voffB[i] = (unsigned)(Rb * K + C) * 2u; }
    const size_t kstep = (size_t)(BK * 2);
    const size_t hstep = (size_t)HALF * K * 2; const size_t hstepA = (size_t)HALF * g.lda * 2;
    const size_t tstep = 2 * hstep; const size_t tstepA = 2 * hstepA;
    const unsigned ldsw = (unsigned)wid * 1024u;
    const int aoff = lds_byte(wr * 64 + fr, fq * 8), boff = lds_byte(wc * 32 + fr, fq * 8);
#define PG8_SA(b, h) (((b) * 2 + (h)) * HTB)
#define PG8_SB(b, h) ((4 + (b) * 2 + (h)) * HTB)
#define PG8_STAGE(bufoff, gbase, voff) do { _Pragma("unroll") for (int _i = 0; _i < 2; ++_i) \
        __builtin_amdgcn_global_load_lds((const unsigned*)((const char*)(gbase) + (voff)[_i]), (PG8_LAS unsigned*)(lds + (bufoff) + ldsw + _i * 8192), 16, 0, 0); } while (0)
#define PG8_LDA(dst, b, h) do { _Pragma("unroll") for (int m = 0; m < 4; ++m) _Pragma("unroll") for (int k = 0; k < 2; ++k) dst[m][k] = *(const PG8_LAS bf16x8*)(lds + PG8_SA(b, h) + aoff + m * 2048 + k * 1024); } while (0)
#define PG8_LDB(dst, b, h) do { _Pragma("unroll") for (int n = 0; n < 2; ++n) _Pragma("unroll") for (int k = 0; k < 2; ++k) dst[n][k] = *(const PG8_LAS bf16x8*)(lds + PG8_SB(b, h) + boff + n * 2048 + k * 1024); } while (0)
#define PG8_MMA(ai, bj, At, Bt) do { __builtin_amdgcn_s_setprio(1); _Pragma("unroll") for (int m = 0; m < 4; ++m) _Pragma("unroll") for (int n = 0; n < 2; ++n) _Pragma("unroll") for (int k = 0; k < 2; ++k) \
        acc[ai][bj][m][n] = __builtin_amdgcn_mfma_f32_16x16x32_bf16(Bt[n][k], At[m][k], acc[ai][bj][m][n], 0, 0, 0); __builtin_amdgcn_s_setprio(0); } while (0)
#define PG8_WAIT_V(n) asm volatile("s_waitcnt vmcnt(" #n ")" ::: "memory")
#define PG8_WAIT_L(n) asm volatile("s_waitcnt lgkmcnt(" #n ")" ::: "memory")
#define PG8_BAR __builtin_amdgcn_s_barrier()
#define PG8_SCHED __builtin_amdgcn_sched_barrier(0)
    Unit cur, nxt; int ui = 0;
    if (!S.next(0, cur)) return;
    f32x4 acc[2][2][4][2];
#pragma unroll
    for (int a = 0; a < 2; ++a)
#pragma unroll
        for (int b = 0; b < 2; ++b)
#pragma unroll
            for (int m = 0; m < 4; ++m)
#pragma unroll
                for (int n = 0; n < 2; ++n) acc[a][b][m][n] = (f32x4){0.f, 0.f, 0.f, 0.f};
    bf16x8 At[4][2], B0[2][2], B1[2][2];
    const char* cA = (const char*)g.A + (size_t)cur.pm * tstepA; const char* cB = (const char*)g.Bt + (size_t)cur.pn * tstep;
    S.a_ready(cur);
    PG8_STAGE(PG8_SB(0, 0), cB, voffB); PG8_STAGE(PG8_SA(0, 0), cA, voffA); PG8_STAGE(PG8_SB(0, 1), cB + hstep, voffB); PG8_STAGE(PG8_SA(0, 1), cA + hstepA, voffA);
    if (wr == 1) PG8_BAR;
    PG8_WAIT_V(4); PG8_BAR;
    PG8_STAGE(PG8_SB(1, 0), cB + kstep, voffB); PG8_STAGE(PG8_SA(1, 0), cA + kstep, voffA); PG8_STAGE(PG8_SB(1, 1), cB + hstep + kstep, voffB);
    PG8_WAIT_V(6); PG8_BAR;
    PG8_STAMP();
    for (;;) {
        const bool has_next = S.next(ui + 1, nxt);
        const char* nA = has_next ? (const char*)g.A + (size_t)nxt.pm * tstepA : cA; const char* nB = has_next ? (const char*)g.Bt + (size_t)nxt.pn * tstep : cB;
        for (int t = 0; t < nt; t += 2) {
            const bool last = (t == nt - 2);
            const char* a1 = cA + (size_t)(t + 1) * kstep;
            const char* a2 = last ? nA : cA + (size_t)(t + 2) * kstep; const char* b2 = last ? nB : cB + (size_t)(t + 2) * kstep;
            const char* a3 = a2 + kstep; const char* b3 = b2 + kstep;
            if (last && has_next) S.a_ready(nxt);
            PG8_LDB(B0, 0, 0); PG8_SCHED; PG8_LDA(At, 0, 0); PG8_STAGE(PG8_SA(1, 1), a1 + hstepA, voffA);
            PG8_WAIT_L(8); PG8_BAR; PG8_WAIT_L(0); PG8_MMA(0, 0, At, B0); PG8_BAR; PG8_SCHED;
            PG8_LDB(B1, 0, 1); PG8_STAGE(PG8_SB(0, 0), b2, voffB);
            PG8_BAR; PG8_WAIT_L(0); PG8_MMA(0, 1, At, B1); PG8_BAR;
            PG8_LDA(At, 0, 1); PG8_STAGE(PG8_SA(0, 0), a2, voffA);
            PG8_BAR; PG8_WAIT_L(0); PG8_MMA(1, 0, At, B0); PG8_BAR; PG8_SCHED;
            PG8_STAGE(PG8_SB(0, 1), b2 + hstep, voffB);
            PG8_WAIT_V(6); PG8_BAR; PG8_MMA(1, 1, At, B1); PG8_BAR;
            PG8_LDB(B0, 1, 0); PG8_SCHED; PG8_LDA(At, 1, 0); PG8_STAGE(PG8_SA(0, 1), a2 + hstepA, voffA);
            PG8_WAIT_L(8); PG8_BAR; PG8_WAIT_L(0); PG8_MMA(0, 0, At, B0); PG8_BAR; PG8_SCHED;
            PG8_LDB(B1, 1, 1); PG8_STAGE(PG8_SB(1, 0), b3, voffB);
            PG8_BAR; PG8_WAIT_L(0); PG8_MMA(0, 1, At, B1); PG8_BAR;
            PG8_LDA(At, 1, 1); PG8_STAGE(PG8_SA(1, 0), a3, voffA);
            PG8_BAR; PG8_WAIT_L(0); PG8_MMA(1, 0, At, B0); PG8_BAR; PG8_SCHED;
            PG8_STAGE(PG8_SB(1, 1), b3 + hstep, voffB);
            PG8_WAIT_V(6); PG8_BAR; PG8_MMA(1, 1, At, B1); PG8_BAR;
        }
        PG8_STAMP();
        if constexpr (!Epi::AFTER_DRAIN) { E(acc, cur, wr, wc, fr, fq); S.done(cur); }
        PG8_STAMP();
        if (!has_next) break;
#pragma unroll
        for (int a = 0; a < 2; ++a)
#pragma unroll
            for (int b = 0; b < 2; ++b)
#pragma unroll
                for (int m = 0; m < 4; ++m)
#pragma unroll
                    for (int n = 0; n < 2; ++n) acc[a][b][m][n] = (f32x4){0.f, 0.f, 0.f, 0.f};
        cur = nxt; cA = nA; cB = nB; ++ui;
    }
    PG8_WAIT_V(0);
    if (wr == 0) PG8_BAR;
    PG8_BAR;
    if constexpr (Epi::AFTER_DRAIN) { E.fused(acc, cur, wr, wc, fr, fq, lds, wid, lane); S.done(cur); }
    PG8_STAMP();
    if (STAMP && wid == 0) { stamps[lane] = lane < nts ? (((unsigned long long)(unsigned)ts_hi << 32) | (unsigned)ts_lo) : 0ull;
        if (lane == 62) stamps[62] = rt_entry; if (lane == 63) stamps[63] = (unsigned long long)wall_clock64(); }
#undef PG8_STAMP
#undef PG8_SA
#undef PG8_SB
#undef PG8_STAGE
#undef PG8_LDA
#undef PG8_LDB
#undef PG8_MMA
#undef PG8_WAIT_V
#undef PG8_WAIT_L
#undef PG8_BAR
#undef PG8_SCHED
}
}


template <class F> struct EpiGen {
    static constexpr bool PERM = false, AFTER_DRAIN = false;
    F f;
    __device__ __forceinline__ void operator()(const f32x4 (&acc)[2][2][4][2], const pg8::Unit& u, int wr, int wc, int fr, int fq) const {
        int row0 = u.pm * 256 + wr * 64 + fr, col0 = u.pn * 256 + wc * 32 + 4 * fq;
        asm volatile("" : "+v"(row0), "+v"(col0));
#pragma unroll
        for (int ai = 0; ai < 2; ++ai)
#pragma unroll
            for (int m = 0; m < 4; ++m) {
                const int row = row0 + ai * 128 + m * 16;
#pragma unroll
                for (int bj = 0; bj < 2; ++bj)
#pragma unroll
                    for (int n = 0; n < 2; ++n) f(row, col0 + bj * 128 + n * 16, acc[ai][bj][m][n], u.pn);
            }
    }
};

#define EPI_ITER(...) do { int row0_ = row0, col0_ = col0; asm volatile("" : "+v"(row0_), "+v"(col0_)); _Pragma("unroll") for (int ai = 0; ai < 2; ++ai) _Pragma("unroll") for (int m = 0; m < 4; ++m) { const int row = row0_ + ai * 128 + m * 16; \
    _Pragma("unroll") for (int bj = 0; bj < 2; ++bj) _Pragma("unroll") for (int n = 0; n < 2; ++n) { const int col = col0_ + bj * 128 + n * 16; const f32x4 v = acc[ai][bj][m][n]; __VA_ARGS__ } } } while (0)
struct EpiInProj0 {
    static constexpr bool PERM = false, AFTER_DRAIN = false;
    char* ws; float* out; const float* dtb;
    __device__ __forceinline__ void operator()(const f32x4 (&acc)[2][2][4][2], const pg8::Unit& u, int wr, int wc, int fr, int fq) const {
        int row0 = u.pm * 256 + wr * 64 + fr, col0 = u.pn * 256 + wc * 32 + 4 * fq; const int pn = u.pn;
        asm volatile("" : "+v"(row0), "+v"(col0));
        if (pn < 4) {
            EPI_ITER({ *(u32x2*)((bf16_t*)(ws + W_MIX) + (size_t)row * 3072 + col) = pack4(v); });
        } else if (pn < 12) {
            const bool isv = pn >= 8; const int cs = isv ? 2048 : 1024;
            bf16_t* kp = (bf16_t*)(ws + (isv ? W_VP : W_KP)); bf16_t* ks = (bf16_t*)(ws + (isv ? W_VS : W_KS)); float* op = out + (isv ? O_AVP : O_AKP); float* os = out + (isv ? O_AVS : O_AKS);
            EPI_ITER({ const int c = col - cs; bf16_t* kb; float* o;
                if (row < NP) { kb = kp + (size_t)row * 1024 + c; o = op + (size_t)row * 1024 + c; }
                else { const int r = row - NP; kb = ks + ((size_t)(r >> 6) * LS + PAST + (r & 63)) * 1024 + c; o = os + (size_t)r * 1024 + c; }
                *(u32x2*)kb = pack4(v); *(f32x4*)o = v; });
        } else if (pn < 16) {
            EPI_ITER({ f32x4 s = {silu_f(v[0]), silu_f(v[1]), silu_f(v[2]), silu_f(v[3])}; *(u32x2*)((bf16_t*)(ws + W_SG) + (size_t)row * 1024 + (col - 3072)) = pack4(s); });
        } else if (pn < 20) {
            EPI_ITER({ *(u32x2*)((bf16_t*)(ws + W_IQ) + (size_t)row * 1024 + (col - 4096)) = pack4(v); });
        } else if (pn < 28) {
            EPI_ITER({ f32x4 s = {silu_f(v[0]), silu_f(v[1]), silu_f(v[2]), silu_f(v[3])}; *(u32x2*)((bf16_t*)(ws + W_MIX) + (size_t)row * 3072 + 1024 + (col - 5120)) = pack4(s); });
        } else if (pn < 40) {
            EPI_ITER({ const int c = col - 7168;
                *(u32x2*)((bf16_t*)(ws + W_XBC) + (size_t)row * 3072 + c) = pack4(v);
                if (row < NP) { const int t = row & (TP - 1); if (t >= TP - 3) *(f32x4*)(out + O_BCP + ((size_t)(row >> 12) * 3 + (t - (TP - 3))) * 3072 + c) = v; }
                else { const int r = row - NP, t = r & 63; if (t >= TS - 3) *(f32x4*)(out + O_BCS + ((size_t)(r >> 6) * 3 + (t - (TS - 3))) * 3072 + c) = v; } });
        } else {
            int r0 = row0, c0 = col0; asm volatile("" : "+v"(r0), "+v"(c0));
#pragma unroll
            for (int n = 0; n < 2; ++n) {
                const int c = c0 - 10240 + n * 16;
                if (c < 64) {
#pragma unroll
                    for (int ai = 0; ai < 2; ++ai)
#pragma unroll
                        for (int m = 0; m < 4; ++m) { const int row = r0 + ai * 128 + m * 16; const f32x4 v = acc[ai][0][m][n]; bf16_t* kb; float* o;
                            if (row < NP) { kb = (bf16_t*)(ws + W_KIDXP) + (size_t)row * 64 + c; o = out + O_KIP + (size_t)row * 64 + c; }
                            else { const int r = row - NP; kb = (bf16_t*)(ws + W_KIDXS) + ((size_t)(r >> 6) * LS + PAST + (r & 63)) * 64 + c; o = out + O_KIS + (size_t)r * 64 + c; }
                            *(u32x2*)kb = pack4(v); *(f32x4*)o = v; }
                } else if (c < 80) {
#pragma unroll
                    for (int ai = 0; ai < 2; ++ai)
#pragma unroll
                        for (int m = 0; m < 4; ++m) { const int row = r0 + ai * 128 + m * 16; *(f32x4*)((float*)(ws + W_IW) + (size_t)row * 16 + (c - 64)) = acc[ai][0][m][n] * 0.03125f; }
                } else if (c < 112) {
                    const f32x4 db = *(const f32x4*)(dtb + (c - 80));
#pragma unroll
                    for (int ai = 0; ai < 2; ++ai)
#pragma unroll
                        for (int m = 0; m < 4; ++m) { const int row = r0 + ai * 128 + m * 16; const f32x4 v = acc[ai][0][m][n] + db; f32x4 d;
#pragma unroll
                            for (int j = 0; j < 4; ++j) d[j] = v[j] > 20.f ? v[j] : log1pf(__expf(v[j]));
                            *(f32x4*)((float*)(ws + W_DT) + (size_t)row * 32 + (c - 80)) = d; }
                }
            }
        }
    }
};

struct FResid {
    const float* r0; const float* r1; float* y;
    __device__ __forceinline__ void operator()(int row, int col, f32x4 v, int) const {
        const float* rp = row < NP ? r0 + (size_t)row * DM + col : r1 + (size_t)(row - NP) * DM + col;
        const f32x4 x = *(const f32x4*)rp;
        *(f32x4*)(y + (size_t)row * DM + col) = v + x * ALPHA_RES;
    }
};

struct FInProj1 {
    char* ws;
    __device__ __forceinline__ void operator()(int row, int col, f32x4 v, int pn) const {
        if (pn < 4) *(f32x4*)((float*)(ws + W_CQKV) + (size_t)row * 1088 + col) = v;
        else if (pn < 12) { f32x4 s = {silu_f(v[0]), silu_f(v[1]), silu_f(v[2]), silu_f(v[3])}; *(u32x2*)((bf16_t*)(ws + W_SGATE) + (size_t)row * 2048 + (col - 1024)) = pack4(s); }
        else { const int c = col - 3072; if (c < 64) *(f32x4*)((float*)(ws + W_CQKV) + (size_t)row * 1088 + 1024 + c) = v; }
    }
};

struct FQUp {
    char* ws;
    __device__ __forceinline__ void operator()(int row, int col, f32x4 v, int pn) const {
        if (pn >= 8) {
            const int jj = (col - 2048) & 63, i0 = (jj >> 2) * 2, pos = pos_of(row);
            const float2* tab = (const float2*)(ws + W_ROPE) + (size_t)pos * 32 + i0;
            const float2 c0 = tab[0], c1 = tab[1];
            f32x4 o; o[0] = v[0] * c0.x - v[2] * c0.y; o[2] = v[0] * c0.y + v[2] * c0.x; o[1] = v[1] * c1.x - v[3] * c1.y; o[3] = v[1] * c1.y + v[3] * c1.x; v = o;
        }
        *(u32x2*)((bf16_t*)(ws + W_Q2) + (size_t)row * 3072 + col) = pack4(v);
    }
};
struct FKvUp { char* ws; __device__ __forceinline__ void operator()(int row, int col, f32x4 v, int) const { *(u32x2*)((bf16_t*)(ws + W_KVALL) + (size_t)row * 4096 + col) = pack4(v); } };

template <class F> __device__ __forceinline__ void run_gemm(char* lds, const bf16_t* A, int lda, const bf16_t* Bt, int M, int N, int K, const F& f, const bool rev = false) {
    pg8::Gemm g; g.A = A; g.Bt = Bt; g.M = M; g.N = N; g.K = K; g.lda = lda;
    pg8::StaticOrder S; S.init(M, N, (int)gridDim.x, rev ? (int)(gridDim.x - 1 - blockIdx.x) : (int)blockIdx.x);
    EpiGen<F> E{f};
    pg8::gemm_phase<EpiGen<F>, pg8::StaticOrder>((PG8_LAS unsigned char*)lds, g, S, E);
}

__device__ __forceinline__ int orig_col(int w, int n) {
    switch (w) {
    case 0: if (n < 5120) return n; if (n < 7168) return 5200 + (n - 5120); if (n < 10240) return 7248 + (n - 7168); if (n < 10304) return 5120 + (n - 10240);
            if (n < 10320) return 5184 + (n - 10304); if (n < 10352) return n; return -1;
    case 2: if (n < 1024) return n; if (n < 3072) return 1088 + (n - 1024); if (n < 3136) return 1024 + (n - 3072); return -1;
    case 3: if (n < 2048) return (n >> 7) * 192 + (n & 127);
            { const int j = n - 2048, h = j >> 6, jj = j & 63, g4 = jj >> 2, e = jj & 3; return h * 192 + 128 + (e >> 1) * 32 + 2 * g4 + (e & 1); }
    case 4: if (n < 2048) return (n >> 7) * 256 + (n & 127); { const int j = n - 2048; return (j >> 7) * 256 + 128 + (j & 127); }
    default: return n;
    }
}
__device__ __forceinline__ void phase_prep(CPARAMS& p, char* lds) {
    const int tid = opaque_tid();
    {
        bf16_t* tile = (bf16_t*)lds;
        int base = 0;
#pragma unroll 1
        for (int w = 0; w < 6; ++w) {
            int K, N, NPd; const float* W; bf16_t* Bt;
            switch (w) {
            case 0: K = 2048; N = NIN0; NPd = NIN0P; W = p.in[I_WIN0]; Bt = (bf16_t*)(p.ws + W_BT0); break;
            case 1: K = 3072; N = 2048; NPd = 2048; W = p.in[I_WOUT0]; Bt = (bf16_t*)(p.ws + W_BTOUT0); break;
            case 2: K = 2048; N = NIN1; NPd = NIN1P; W = p.in[I_WIN1]; Bt = (bf16_t*)(p.ws + W_BT1); break;
            case 3: K = 512; N = 3072; NPd = 3072; W = p.in[I_WUQ]; Bt = (bf16_t*)(p.ws + W_BTUQ); break;
            case 4: K = 512; N = 4096; NPd = 4096; W = p.in[I_WUKV]; Bt = (bf16_t*)(p.ws + W_BTUKV); break;
            default: K = 2048; N = 2048; NPd = 2048; W = p.in[I_WOUT1]; Bt = (bf16_t*)(p.ws + W_BTOUT1); break;
            }
            const int nkt = K / 64, nnt = NPd / 64, ntiles = nkt * nnt;
            int first = (int)blockIdx.x - (base % (int)gridDim.x); if (first < 0) first += gridDim.x;
#pragma unroll 1
            for (int tix = first; tix < ntiles; tix += gridDim.x) {
                const int kt = tix % nkt, nt = tix / nkt;
                const int nl = tid & 63, n = nt * 64 + nl, oc = orig_col(w, n);
#pragma unroll
                for (int i = 0; i < 8; ++i) {
                    const int kl = i * 8 + (tid >> 6), k = kt * 64 + kl;
                    const float v = oc >= 0 ? W[(size_t)k * N + oc] : 0.f;
                    tile[nl * 66 + kl] = f2bf(v);
                }
                __syncthreads();
                { const int nr = tid >> 3, ks = (tid & 7) * 8; const unsigned* src = (const unsigned*)(tile + nr * 66 + ks);
                  u32x4 o = {src[0], src[1], src[2], src[3]};
                  *(u32x4*)(Bt + (size_t)(nt * 64 + nr) * K + kt * 64 + ks) = o; }
                __syncthreads();
            }
            base += ntiles;
        }
    }
    const size_t gtid = (size_t)blockIdx.x * 512 + tid, gstride = (size_t)gridDim.x * 512;
    { bf16_t* xb = (bf16_t*)(p.ws + W_XB); const size_t n8p = (size_t)NP * DM / 8, n8 = (size_t)MALL * DM / 8;
      for (size_t i0 = gtid; i0 < n8; i0 += 4 * gstride) {
        f32x4 a[4], b[4];
#pragma unroll
        for (int u = 0; u < 4; ++u) { const size_t i = i0 + u * gstride; if (i < n8) { const float* s = i < n8p ? p.in[I_XP] + i * 8 : p.in[I_XS] + (i - n8p) * 8; a[u] = *(const f32x4*)s; b[u] = *(const f32x4*)(s + 4); } }
#pragma unroll
        for (int u = 0; u < 4; ++u) { const size_t i = i0 + u * gstride; if (i < n8) { const float t[8] = {a[u][0], a[u][1], a[u][2], a[u][3], b[u][0], b[u][1], b[u][2], b[u][3]}; *(bf16x8*)(xb + i * 8) = pack8(t); } }
      } }
    { const size_t n8 = (size_t)8 * PAST * 1024 / 8;
      for (size_t i = gtid; i < 2 * n8; i += gstride) { const bool isv = i >= n8; const size_t j = isv ? i - n8 : i; const float* s = p.in[isv ? I_CAV : I_CAK] + j * 8;
        const size_t e = j * 8, b = e / ((size_t)PAST * 1024), rem = e % ((size_t)PAST * 1024);
        const f32x4 a = *(const f32x4*)s, c = *(const f32x4*)(s + 4); const float t[8] = {a[0], a[1], a[2], a[3], c[0], c[1], c[2], c[3]};
        *(bf16x8*)((bf16_t*)(p.ws + (isv ? W_VS : W_KS)) + b * (size_t)LS * 1024 + rem) = pack8(t); }
      const size_t m8 = (size_t)8 * PAST * 64 / 8;
      for (size_t i = gtid; i < m8; i += gstride) { const float* s = p.in[I_CAKI] + i * 8; const size_t e = i * 8, b = e / ((size_t)PAST * 64), rem = e % ((size_t)PAST * 64);
        const f32x4 a = *(const f32x4*)s, c = *(const f32x4*)(s + 4); const float t[8] = {a[0], a[1], a[2], a[3], c[0], c[1], c[2], c[3]};
        *(bf16x8*)((bf16_t*)(p.ws + W_KIDXS) + b * (size_t)LS * 64 + rem) = pack8(t); } }
    { float2* tab = (float2*)(p.ws + W_ROPE);
      for (size_t i = gtid; i < (size_t)4096 * 32; i += gstride) { const int pos = (int)(i >> 5), f = (int)(i & 31);
        const float inv = powf(10000.f, -(float)f / 32.f), ang = (float)pos * inv; float s, c; sincosf(ang, &s, &c); tab[i] = make_float2(c, s); } }
}

__device__ __forceinline__ void phase_index(CPARAMS& p, char* lds) {
    const int tid = opaque_tid(), wid = tid >> 6, lane = tid & 63, r32 = lane & 31, hi = lane >> 5;
    unsigned* sk = (unsigned*)lds;
    const int NU = 4096 + 64;
#pragma unroll 1
    for (int idx = blockIdx.x; idx < NU; idx += gridDim.x) {
        int b, t0, n, nblk_tot, rowg; const bf16_t* ki; u64* mrow; int ldm; bool sample;
        if (idx < 4096) { const int k = idx >> 8, w = idx & 255; b = k >> 1; const int j = (k & 1) ? 511 - w : w; t0 = j * 8; n = ((t0 >> 6) + 1) * 64; nblk_tot = ((t0 >> 8) + 1) * 4;
            rowg = b * TP + t0; ki = (const bf16_t*)(p.ws + W_KIDXP) + (size_t)b * TP * 64; mrow = (u64*)(p.ws + W_MASKP) + (size_t)rowg * 64; ldm = 64; sample = false; }
        else { const int s = idx - 4096; b = s >> 3; t0 = (s & 7) * 8; n = LS; nblk_tot = 17; rowg = NP + b * 64 + t0;
            ki = (const bf16_t*)(p.ws + W_KIDXS) + (size_t)b * LS * 64; mrow = (u64*)(p.ws + W_MASKS) + (size_t)(b * 64 + t0) * 32; ldm = 32; sample = true; }
        (void)sample;
        if (n <= 256) {
            if (lane < nblk_tot) mrow[(size_t)wid * ldm + lane] = (lane * 64 < n) ? ~0ull : 0ull;
            continue;
        }
        {
            const int pr = wid >> 1, par = wid & 1;
            const int qsel = (r32 >> 2) & 1, head = (r32 & 3) + 4 * (r32 >> 3);
            const bf16_t* qp = (const bf16_t*)(p.ws + W_IQ) + (size_t)(rowg + 2 * pr + qsel) * 1024 + head * 64 + hi * 8;
            bf16x8 qa[4];
#pragma unroll
            for (int s = 0; s < 4; ++s) qa[s] = *(const bf16x8*)(qp + s * 16);
            const float* wp = (const float*)(p.ws + W_IW) + (size_t)(rowg + 2 * pr + hi) * 16;
            float wv[16];
#pragma unroll
            for (int s = 0; s < 4; ++s) { const f32x4 t = *(const f32x4*)(wp + s * 4); wv[s * 4] = t[0]; wv[s * 4 + 1] = t[1]; wv[s * 4 + 2] = t[2]; wv[s * 4 + 3] = t[3]; }
            unsigned* dst = sk + (2 * pr + hi) * 4096 + par * 32 + r32;
            char* kst = lds + 131072;
            const int skey = tid >> 3, scolB = (tid & 7) * 16, ntile = n >> 6, ngrp = (ntile + 3) >> 2;
            const bf16_t* ksrc = ki + (size_t)skey * 64 + (scolB >> 1);
            bf16x8 pre[4];
#pragma unroll
            for (int u = 0; u < 4; ++u) pre[u] = *(const bf16x8*)(ksrc + (size_t)(u < ntile ? u : 0) * 64 * 64);
#pragma unroll 1
            for (int g = 0; g < ngrp; ++g) {
                __syncthreads();
#pragma unroll
                for (int u = 0; u < 4; ++u) *(bf16x8*)(kst + u * 8192 + KRSWZ(skey, scolB)) = pre[u];
#pragma unroll
                for (int u = 0; u < 4; ++u) { const int t = (g + 1) * 4 + u; pre[u] = *(const bf16x8*)(ksrc + (size_t)(t < ntile ? t : 0) * 64 * 64); }
                __syncthreads();
#pragma unroll
                for (int u = 0; u < 4; ++u) { const int t = g * 4 + u;
                    if (t < ntile) {
                        f32x16 acc = {};
#pragma unroll
                        for (int s = 0; s < 4; ++s) { const bf16x8 kf = *(const bf16x8*)(kst + u * 8192 + KRSWZ(par * 32 + r32, (s * 16 + hi * 8) * 2)); acc = __builtin_amdgcn_mfma_f32_32x32x16_bf16(qa[s], kf, acc, 0, 0, 0); }
                        float sc = 0.f;
#pragma unroll
                        for (int r = 0; r < 16; ++r) sc = fmaf(wv[r], fmaxf(acc[r], 0.f), sc);
                        sc += 0.f;
                        const unsigned uu = __float_as_uint(sc);
                        dst[t * 64] = (uu & 0x80000000u) ? ~uu : (uu | 0x80000000u);
                    } }
            }
        }
        __syncthreads();
        {
            const unsigned* k = sk + wid * 4096;
            u32x4 kv[16];
#pragma unroll
            for (int j = 0; j < 16; ++j) kv[j] = (j * 256 < n && j * 256 + lane * 4 < n) ? *(const u32x4*)(k + j * 256 + lane * 4) : (u32x4){0u, 0u, 0u, 0u};
            unsigned prefix = 0;
#pragma unroll 1
            for (int bit = 31; bit >= 0; --bit) {
                const unsigned cand = prefix | (1u << bit);
                int cnt = 0;
#pragma unroll
                for (int j = 0; j < 16; ++j) if (j * 256 < n) cnt += (kv[j][0] >= cand) + (kv[j][1] >= cand) + (kv[j][2] >= cand) + (kv[j][3] >= cand);
                cnt = wave_sum_dpp(cnt);
                if (cnt >= 256) { prefix = cand; if (cnt == 256) break; }
            }
            int cgt = 0;
#pragma unroll
            for (int j = 0; j < 16; ++j) if (j * 256 < n) cgt += (kv[j][0] > prefix) + (kv[j][1] > prefix) + (kv[j][2] > prefix) + (kv[j][3] > prefix);
            cgt = wave_sum_dpp(cgt);
            const int need = 256 - cgt; int running = 0;
            u64* mr = mrow + (size_t)wid * ldm;
            const u64 lt = (1ull << lane) - 1ull;
#pragma unroll 1
            for (int blk = 0; blk < nblk_tot; ++blk) {
                u64 word = 0ull;
                if (blk * 64 < n) {
                    const unsigned v = k[blk * 64 + lane];
                    const u64 eqm = __ballot(v == prefix);
                    const int rank = running + __popcll(eqm & lt);
                    const bool sel = (v > prefix) || (v == prefix && rank < need);
                    word = __ballot(sel); running += __popcll(eqm);
                }
                if (lane == 0) mr[blk] = word;
            }
        }
        __syncthreads();
    }
}

#define KSWZ(row, colB) ((row) * 256 + ((colB) ^ (((row) & 7) << 4)))
__device__ __forceinline__ int crow(int r, int hi) { return (r & 3) + 8 * (r >> 2) + 4 * hi; }
__device__ __forceinline__ int v_st(int k, int c) { const int kk = (k & ~0xC) | ((k & 4) << 1) | ((k & 8) >> 1); return ((kk >> 3) * 4 + (c >> 5)) * 512 + ((kk & 7) * 32 + (c & 31)) * 2; }
__device__ __forceinline__ int v_rd_base(int lane) { return ((lane & 3) << 3) | (((lane >> 2) & 3) << 6) | (((lane >> 4) & 1) << 5) | (((lane >> 5) & 1) << 8); }
constexpr int v_rd_off(int d0, int ks, int half) { return d0 * 512 + ks * 4096 + half * 2048; }
template <int OFF> __device__ __forceinline__ s16x4 tr_read(int vb) { s16x4 r; asm volatile("ds_read_b64_tr_b16 %0, %1 offset:%2" : "=&v"(r) : "v"(vb), "i"(OFF) : "memory"); return r; }
template <int D0> __device__ __forceinline__ void pv_one(f32x16& od, int vb, bf16x8 pa0, bf16x8 pa1, bf16x8 pa2, bf16x8 pa3) {
    const s16x4 l0 = tr_read<v_rd_off(D0, 0, 0)>(vb), h0 = tr_read<v_rd_off(D0, 0, 1)>(vb), l1 = tr_read<v_rd_off(D0, 1, 0)>(vb), h1 = tr_read<v_rd_off(D0, 1, 1)>(vb);
    const s16x4 l2 = tr_read<v_rd_off(D0, 2, 0)>(vb), h2 = tr_read<v_rd_off(D0, 2, 1)>(vb), l3 = tr_read<v_rd_off(D0, 3, 0)>(vb), h3 = tr_read<v_rd_off(D0, 3, 1)>(vb);
    asm volatile("s_waitcnt lgkmcnt(0)" ::: "memory"); __builtin_amdgcn_sched_barrier(0);
#define PKV(L, H) (bf16x8){L[0], L[1], L[2], L[3], H[0], H[1], H[2], H[3]}
    od = __builtin_amdgcn_mfma_f32_32x32x16_bf16(pa0, PKV(l0, h0), od, 0, 0, 0);
    od = __builtin_amdgcn_mfma_f32_32x32x16_bf16(pa1, PKV(l1, h1), od, 0, 0, 0);
    od = __builtin_amdgcn_mfma_f32_32x32x16_bf16(pa2, PKV(l2, h2), od, 0, 0, 0);
    od = __builtin_amdgcn_mfma_f32_32x32x16_bf16(pa3, PKV(l3, h3), od, 0, 0, 0);
#undef PKV
}

struct AttnUnit {
    const bf16_t* Q; const bf16_t* Qr; const bf16_t* K; const bf16_t* V; const bf16_t* Kr; bf16_t* O; const bf16_t* G; const u64* M;
    int ldq, ldqr, ldk, ldo, ldg, ldm, nvalid, qpos0, NT, head;
};
constexpr int AT_V = 0, AT_K = 32768, AT_KR = 65536, AT_WS = 81920, AT_TB = 81920 + 2048;

template <int MODE>
__device__ __forceinline__ void attn_unit(const AttnUnit& u, char* lds, const float* t5, const float Cs  , const bool dry = false) {
    const int tid = opaque_tid(), wid = __builtin_amdgcn_readfirstlane(tid >> 6), lane = tid & 63, r32 = lane & 31, hi = lane >> 5;
    float* wsf = (float*)(lds + AT_WS) + wid * 64; float* al_l = wsf; float* li_l = wsf + 32;
    float* tb = (float*)(lds + AT_TB);
    const int rowb = wid * 32 + r32, rowc = rowb < u.nvalid ? rowb : u.nvalid - 1;
    const int wrow0 = (wid * 32 < u.nvalid) ? wid * 32 : u.nvalid - 1;
    const int qc_w = (u.qpos0 + wrow0) >> 6;
    const int qpos = u.qpos0 + rowc;
    constexpr int NQ = MODE == 1 ? 12 : 8;
    bf16x8 qr[NQ];
    { const bf16_t* Qw = u.Q + (size_t)rowc * u.ldq + hi * 8;
#pragma unroll
      for (int d0 = 0; d0 < 8; ++d0) qr[d0] = *(const bf16x8*)(Qw + d0 * 16);
      if constexpr (MODE == 1) { const bf16_t* Qw2 = u.Qr + (size_t)rowc * u.ldqr + hi * 8;
#pragma unroll
        for (int d0 = 0; d0 < 4; ++d0) qr[8 + d0] = *(const bf16x8*)(Qw2 + d0 * 16); } }
    if constexpr (MODE == 0) {
        if (tid < 155) { const int rel = tid - 63, nn = rel < 0 ? -rel : rel;
            const int bk = (rel < 0 ? 16 : 0) + (nn < 8 ? nn : 8 + (nn >= 12) + (nn >= 16) + (nn >= 23) + (nn >= 32) + (nn >= 46) + (nn >= 64) + (nn >= 91));
            tb[tid] = t5[bk * 8 + u.head] * LOG2E; }
    }
    float m_reg = -1e29f, l_reg = 0.f; f32x16 o[4];
#pragma unroll
    for (int d = 0; d < 4; ++d) o[d] = (f32x16){};
    const int vb0 = (int)(uintptr_t)(lds + AT_V) + v_rd_base(lane);
    int koff[2], voff[2], kroff = 0;
#pragma unroll
    for (int i = 0; i < 2; ++i) { const int X = (i * 8 + wid) * 1024 + lane * 16;
        { const int row = X >> 8, colB = (X & 255) ^ ((row & 7) << 4); koff[i] = row * u.ldk + (colB >> 1); }
        { const int sub = X >> 9, y = X & 511, kk = (sub >> 2) * 8 + (y >> 6), k = (kk & ~0xC) | ((kk & 4) << 1) | ((kk & 8) >> 1), c = (sub & 3) * 32 + ((y & 63) >> 1); voff[i] = k * u.ldk + c; } }
    if constexpr (MODE == 1) { const int X = wid * 1024 + lane * 16, row = X >> 7, colB = (X & 127) ^ (((row >> 1) & 7) << 4); kroff = row * 64 + (colB >> 1); }
    LAS char* ldl = (LAS char*)lds;
#define AT_ISSUE(b, k0) do { const bf16_t* kb_ = u.K + (size_t)(k0) * u.ldk; const bf16_t* vb_ = u.V + (size_t)(k0) * u.ldk; \
        _Pragma("unroll") for (int i_ = 0; i_ < 2; ++i_) { \
            __builtin_amdgcn_global_load_lds((const unsigned*)(kb_ + koff[i_]), (LAS unsigned*)(ldl + AT_K + (b) * 16384 + (i_ * 8 + wid) * 1024), 16, 0, 0); \
            __builtin_amdgcn_global_load_lds((const unsigned*)(vb_ + voff[i_]), (LAS unsigned*)(ldl + AT_V + (b) * 16384 + (i_ * 8 + wid) * 1024), 16, 0, 0); } \
        if constexpr (MODE == 1) __builtin_amdgcn_global_load_lds((const unsigned*)(u.Kr + (size_t)(k0) * 64 + kroff), (LAS unsigned*)(ldl + AT_KR + (b) * 8192 + wid * 1024), 16, 0, 0); } while (0)
    AT_ISSUE(0, 0);
    asm volatile("s_waitcnt vmcnt(0)" ::: "memory");
    __syncthreads();
#pragma unroll 1
    for (int j = 0; j < u.NT; ++j) {
        const int cur = j & 1;
        if (j + 1 < u.NT) AT_ISSUE(cur ^ 1, (j + 1) * 64);
        if (j <= qc_w) {
            u64 mw = 0;
            if constexpr (MODE == 0) mw = u.M[(size_t)rowc * u.ldm + j];
            f32x16 p0 = {}, p1 = {};
            const char* Ks = lds + AT_K + cur * 16384;
#pragma unroll
            for (int d0 = 0; d0 < 8; ++d0) { const int cb = (d0 * 16 + hi * 8) * 2;
                const bf16x8 b0 = *(const bf16x8*)(Ks + KSWZ(r32, cb)), b1 = *(const bf16x8*)(Ks + KSWZ(32 + r32, cb));
                p0 = __builtin_amdgcn_mfma_f32_32x32x16_bf16(b0, qr[d0], p0, 0, 0, 0); p1 = __builtin_amdgcn_mfma_f32_32x32x16_bf16(b1, qr[d0], p1, 0, 0, 0);
                if ((d0 & 3) == 3) __builtin_amdgcn_sched_barrier(0); }
            if constexpr (MODE == 1) { const char* Krs = lds + AT_KR + cur * 8192;
#pragma unroll
                for (int d0 = 0; d0 < 4; ++d0) { const int cb = (d0 * 16 + hi * 8) * 2;
                    const bf16x8 b0 = *(const bf16x8*)(Krs + KRSWZ(r32, cb)), b1 = *(const bf16x8*)(Krs + KRSWZ(32 + r32, cb));
                    p0 = __builtin_amdgcn_mfma_f32_32x32x16_bf16(b0, qr[8 + d0], p0, 0, 0, 0); p1 = __builtin_amdgcn_mfma_f32_32x32x16_bf16(b1, qr[8 + d0], p1, 0, 0, 0); } }
            if constexpr (MODE == 0) {
                const unsigned mlo = (unsigned)mw >> (4 * hi), mhi = (unsigned)(mw >> 32) >> (4 * hi);
                const int kb = j * 64;
                const bool far = (u.qpos0 + wrow0) - (kb + 63) >= 91;
                if (far) { const float bb = tb[154];
#pragma unroll
                    for (int r = 0; r < 16; ++r) { const int c0 = crow(r, 0);
                        p0[r] = ((mlo >> c0) & 1u) ? fmaf(p0[r], Cs, bb) : -1e30f; p1[r] = ((mhi >> c0) & 1u) ? fmaf(p1[r], Cs, bb) : -1e30f; }
                } else { const int rel0 = qpos - kb - 4 * hi;
#pragma unroll
                    for (int r = 0; r < 16; ++r) { const int c0 = crow(r, 0);
                        int i0 = rel0 - c0; i0 = i0 < -63 ? -63 : (i0 > 91 ? 91 : i0); int i1 = rel0 - c0 - 32; i1 = i1 < -63 ? -63 : (i1 > 91 ? 91 : i1);
                        p0[r] = ((mlo >> c0) & 1u) ? fmaf(p0[r], Cs, tb[i0 + 63]) : -1e30f; p1[r] = ((mhi >> c0) & 1u) ? fmaf(p1[r], Cs, tb[i1 + 63]) : -1e30f; }
                }
            }
            float pmax = p0[0];
#pragma unroll
            for (int r = 1; r < 16; ++r) pmax = fmaxf(pmax, p0[r]);
#pragma unroll
            for (int r = 0; r < 16; ++r) pmax = fmaxf(pmax, p1[r]);
            { auto rr = __builtin_amdgcn_permlane32_swap(__float_as_uint(pmax), __float_as_uint(pmax), false, false); pmax = fmaxf(__uint_as_float(rr[0]), __uint_as_float(rr[1])); }
            const float sc_ = MODE == 1 ? Cs : 1.f;
            const float mn = fmaxf(m_reg, pmax), alpha = __builtin_amdgcn_exp2f((m_reg - mn) * sc_), mns = -mn * sc_;
            m_reg = mn;
            float ps = 0.f;
#pragma unroll
            for (int r = 0; r < 16; ++r) { p0[r] = __builtin_amdgcn_exp2f(fmaf(p0[r], sc_, mns)); p1[r] = __builtin_amdgcn_exp2f(fmaf(p1[r], sc_, mns)); ps += p0[r] + p1[r]; }
            { auto rr = __builtin_amdgcn_permlane32_swap(__float_as_uint(ps), __float_as_uint(ps), false, false); ps = __uint_as_float(rr[0]) + __uint_as_float(rr[1]); }
            l_reg = l_reg * alpha + ps;
            if (__any(alpha < 1.f)) {
                if (hi == 0) al_l[r32] = alpha;
                asm volatile("s_waitcnt lgkmcnt(0)" ::: "memory");
#pragma unroll
                for (int r = 0; r < 16; ++r) { const float a = al_l[crow(r, hi)];
#pragma unroll
                    for (int d = 0; d < 4; ++d) o[d][r] *= a; }
            }
            bf16x8 pa0, pa1, pa2, pa3;
#define PK4(P, BASE, OUT) do { unsigned a0 = cvtpk(P[BASE + 0], P[BASE + 1]), a1 = cvtpk(P[BASE + 2], P[BASE + 3]);   \
    unsigned b0 = cvtpk(P[BASE + 4], P[BASE + 5]), b1 = cvtpk(P[BASE + 6], P[BASE + 7]);                              \
    auto r0 = __builtin_amdgcn_permlane32_swap(a0, b0, false, false); auto r1 = __builtin_amdgcn_permlane32_swap(a1, b1, false, false); \
    u32x4 w = {r0[0], r1[0], r0[1], r1[1]}; OUT = *reinterpret_cast<bf16x8*>(&w); } while (0)
            PK4(p0, 0, pa0); PK4(p0, 8, pa1); PK4(p1, 0, pa2); PK4(p1, 8, pa3);
#undef PK4
            const int vb = vb0 + cur * 16384;
            pv_one<0>(o[0], vb, pa0, pa1, pa2, pa3); pv_one<1>(o[1], vb, pa0, pa1, pa2, pa3); pv_one<2>(o[2], vb, pa0, pa1, pa2, pa3); pv_one<3>(o[3], vb, pa0, pa1, pa2, pa3);
        }
        asm volatile("s_waitcnt vmcnt(0)" ::: "memory");
        __syncthreads();
    }
#undef AT_ISSUE
    if (hi == 0) li_l[r32] = l_reg;
    asm volatile("s_waitcnt lgkmcnt(0)" ::: "memory");
#pragma unroll
    for (int r = 0; r < 16; ++r) {
        const int orow = wid * 32 + crow(r, hi);
        const float rl = __builtin_amdgcn_rcpf(li_l[crow(r, hi)]);
        if (orow < u.nvalid && !dry) {
#pragma unroll
            for (int d0 = 0; d0 < 4; ++d0) { const int c = d0 * 32 + r32;
                const float g = bf2f(u.G[(size_t)orow * u.ldg + c]);
                u.O[(size_t)orow * u.ldo + c] = f2bf(o[d0][r] * rl * g); }
        }
    }
    __syncthreads();
}

__device__ __forceinline__ void phase_attn_dsa(CPARAMS& p, char* lds, const bool dry = false) {
    const float Cs = 0.08838834764831845f * LOG2E;
    const int NU = 1024 + 64;
#pragma unroll 1
    for (int idx = blockIdx.x; idx < NU; idx += gridDim.x) {
        AttnUnit u;
        bf16_t* mix = (bf16_t*)(p.ws + W_MIX);
        if (idx < 1024) { const int k = idx >> 8, w = idx & 255, h = w & 7, qb0 = (w >> 3) & 15, b = (w >> 7) + 2 * k, qb = (k & 1) ? 15 - qb0 : qb0;
            const size_t row0 = (size_t)b * TP + qb * 256;
            u.Q = mix + row0 * 3072 + h * 128; u.O = mix + row0 * 3072 + h * 128; u.G = (const bf16_t*)(p.ws + W_SG) + row0 * 1024 + h * 128;
            u.K = (const bf16_t*)(p.ws + W_KP) + (size_t)b * TP * 1024 + h * 128; u.V = (const bf16_t*)(p.ws + W_VP) + (size_t)b * TP * 1024 + h * 128;
            u.M = (const u64*)(p.ws + W_MASKP) + row0 * 64; u.ldm = 64; u.nvalid = 256; u.qpos0 = qb * 256; u.NT = 4 * (qb + 1); u.head = h;
        } else { const int s = idx - 1024, b = s >> 3, h = s & 7; const size_t row0 = (size_t)NP + b * 64;
            u.Q = mix + row0 * 3072 + h * 128; u.O = mix + row0 * 3072 + h * 128; u.G = (const bf16_t*)(p.ws + W_SG) + row0 * 1024 + h * 128;
            u.K = (const bf16_t*)(p.ws + W_KS) + (size_t)b * LS * 1024 + h * 128; u.V = (const bf16_t*)(p.ws + W_VS) + (size_t)b * LS * 1024 + h * 128;
            u.M = (const u64*)(p.ws + W_MASKS) + (size_t)b * 64 * 32; u.ldm = 32; u.nvalid = 64; u.qpos0 = PAST; u.NT = 17; u.head = h; }
        u.Qr = nullptr; u.Kr = nullptr; u.ldq = 3072; u.ldqr = 0; u.ldk = 1024; u.ldo = 3072; u.ldg = 1024;
        attn_unit<0>(u, lds, p.in[I_T5], Cs, dry);
    }
}
__device__ __forceinline__ void phase_attn_mla(CPARAMS& p, char* lds, const bool dry = false) {
    const float Cs = 0.07216878364870323f * LOG2E;
    const int NU = 2048 + 128;
#pragma unroll 1
    for (int idx = blockIdx.x; idx < NU; idx += gridDim.x) {
        AttnUnit u;
        bf16_t* q2 = (bf16_t*)(p.ws + W_Q2); const bf16_t* kv = (const bf16_t*)(p.ws + W_KVALL); const bf16_t* kr = (const bf16_t*)(p.ws + W_KR);
        size_t row0, lrow0; int h;
        if (idx < 2048) { const int k = idx >> 8, w = idx & 255, qb0 = (w >> 4) & 15, b = k, qb = (k & 1) ? 15 - qb0 : qb0; h = w & 15;
            row0 = (size_t)b * TP + qb * 256; lrow0 = (size_t)b * TP; u.nvalid = 256; u.qpos0 = qb * 256; u.NT = 4 * (qb + 1);
        } else { const int s = idx - 2048, b = s >> 4; h = s & 15; row0 = (size_t)NP + b * 64; lrow0 = (size_t)NP + (size_t)b * LS; u.nvalid = 64; u.qpos0 = PAST; u.NT = 17; }
        u.Q = q2 + row0 * 3072 + h * 128; u.Qr = q2 + row0 * 3072 + 2048 + h * 64; u.O = q2 + row0 * 3072 + h * 128; u.G = (const bf16_t*)(p.ws + W_SGATE) + row0 * 2048 + h * 128;
        u.K = kv + lrow0 * 4096 + h * 128; u.V = kv + lrow0 * 4096 + 2048 + h * 128; u.Kr = kr + lrow0 * 64; u.M = nullptr;
        u.ldq = 3072; u.ldqr = 3072; u.ldk = 4096; u.ldo = 3072; u.ldg = 2048; u.ldm = 0; u.head = h;
        attn_unit<1>(u, lds, nullptr, Cs, dry);
    }
}

__device__ __forceinline__ void phase_conv(CPARAMS& p) {
    const int tid = opaque_tid();
    if (tid < 384) {
        const int ch = tid * 8;
        float cw[4][8], cb[8];
        { const float* cwp = p.in[I_CONVW] + ch; const float* cbp = p.in[I_CONVB] + ch;
#pragma unroll
          for (int j = 0; j < 4; ++j) { const f32x4 a = *(const f32x4*)(cwp + j * 3072), bq = *(const f32x4*)(cwp + j * 3072 + 4);
              cw[j][0] = a[0]; cw[j][1] = a[1]; cw[j][2] = a[2]; cw[j][3] = a[3]; cw[j][4] = bq[0]; cw[j][5] = bq[1]; cw[j][6] = bq[2]; cw[j][7] = bq[3]; }
          const f32x4 a = *(const f32x4*)cbp, bq = *(const f32x4*)(cbp + 4); cb[0] = a[0]; cb[1] = a[1]; cb[2] = a[2]; cb[3] = a[3]; cb[4] = bq[0]; cb[5] = bq[1]; cb[6] = bq[2]; cb[7] = bq[3]; }
        const bf16_t* xbc = (const bf16_t*)(p.ws + W_XBC);
        bf16_t* dst = ch < 2048 ? (bf16_t*)(p.ws + W_XACT) + ch : (bf16_t*)(p.ws + W_BCACT) + (ch - 2048);
        const int dstride = ch < 2048 ? 2048 : 1024;
#pragma unroll 1
        for (int unit = blockIdx.x; unit < MALL / 64; unit += gridDim.x) {
            const size_t row0 = (size_t)unit * 64;
            float w[3][8];
            const bool seqstart = row0 >= NP || (row0 & (TP - 1)) == 0;
            if (seqstart) {
                if (row0 >= NP) { const float* sp = p.in[I_SCONV] + ((row0 - NP) >> 6) * 3 * 3072 + ch;
#pragma unroll
                    for (int j = 0; j < 3; ++j) { const f32x4 a = *(const f32x4*)(sp + j * 3072), bq = *(const f32x4*)(sp + j * 3072 + 4);
                        w[j][0] = a[0]; w[j][1] = a[1]; w[j][2] = a[2]; w[j][3] = a[3]; w[j][4] = bq[0]; w[j][5] = bq[1]; w[j][6] = bq[2]; w[j][7] = bq[3]; } }
                else {
#pragma unroll
                    for (int j = 0; j < 3; ++j)
#pragma unroll
                        for (int e = 0; e < 8; ++e) w[j][e] = 0.f; }
            } else {
#pragma unroll
                for (int j = 0; j < 3; ++j) { const bf16x8 r = *(const bf16x8*)(xbc + (row0 - 3 + j) * 3072 + ch);
#pragma unroll
                    for (int e = 0; e < 8; ++e) w[j][e] = bf2f((bf16_t)r[e]); }
            }
#pragma unroll 1
            for (int r0 = 0; r0 < 64; r0 += 8) {
                bf16x8 raw[8];
#pragma unroll
                for (int r = 0; r < 8; ++r) raw[r] = *(const bf16x8*)(xbc + (row0 + r0 + r) * 3072 + ch);
#pragma unroll
                for (int r = 0; r < 8; ++r) { float o[8];
#pragma unroll
                    for (int e = 0; e < 8; ++e) { const float cur = bf2f((bf16_t)raw[r][e]);
                        o[e] = silu_f(cb[e] + cw[0][e] * w[0][e] + cw[1][e] * w[1][e] + cw[2][e] * w[2][e] + cw[3][e] * cur);
                        w[0][e] = w[1][e]; w[1][e] = w[2][e]; w[2][e] = cur; }
                    *(bf16x8*)(dst + (row0 + r0 + r) * dstride) = pack8(o); }
            }
        }
    }
}

constexpr int SD_XT = 0, SD_BS = 9216, SD_BTT = 26624, SD_CS = 45056, SD_CS2 = 62464, SD_WS = 79872, SD_H0 = 89088, SD_F = 106496;
__device__ __forceinline__ void phase_ssd(CPARAMS& p, char* lds, const bool dry = false) {
    const int tid = opaque_tid(), wid = tid >> 6, lane = tid & 63, l16 = lane & 15, lq = lane >> 4;
    bf16_t* XT = (bf16_t*)(lds + SD_XT); bf16_t* Bs = (bf16_t*)(lds + SD_BS); bf16_t* BTt = (bf16_t*)(lds + SD_BTT); bf16_t* Cs = (bf16_t*)(lds + SD_CS);
    bf16_t* Cs2 = (bf16_t*)(lds + SD_CS2); bf16_t* Ws = (bf16_t*)(lds + SD_WS); bf16_t* H0 = (bf16_t*)(lds + SD_H0);
    float* s_acum = (float*)(lds + SD_F); float* s_dt = s_acum + 64; float* s_ea = s_acum + 128; float* s_tail = s_acum + 192; float* s_ssq = s_acum + 256;
    const bf16_t* xbc = (const bf16_t*)(p.ws + W_XBC); bf16_t* mix = (bf16_t*)(p.ws + W_MIX);
    const float* dtbuf = (const float*)(p.ws + W_DT); float* ssqg = (float*)(p.ws + W_SSQ);
#pragma unroll 1
    for (int idx = blockIdx.x; idx < 512; idx += gridDim.x) {
        const bool sample = idx >= 256; const int bh = idx & 255, b = bh >> 5, h = bh & 31, g = h >> 3;
        const size_t row0 = sample ? (size_t)NP + b * 64 : (size_t)b * TP; const int nch = sample ? 1 : 64;
        const float a_h = -__expf(p.in[I_ALOG][h]), d_h = p.in[I_DSKIP][h];
        f32x4 hacc[4];
        const int pt = wid >> 1;
#pragma unroll
        for (int j = 0; j < 4; ++j) { const int nt = (wid & 1) * 4 + j;
#pragma unroll
            for (int i = 0; i < 4; ++i) { const int pp = pt * 16 + 4 * lq + i, nn = nt * 16 + l16;
                hacc[j][i] = sample ? p.in[I_SSSM][(((size_t)b * 32 + h) * 64 + pp) * 128 + nn] : 0.f;
                H0[pp * 136 + nn] = f2bf(hacc[j][i]); } }
        const int cg8 = tid % 40, rb = tid / 40; const bool ldr = tid < 320;
        const bf16_t* asrc = cg8 < 8 ? (const bf16_t*)(p.ws + W_XACT) + h * 64 + cg8 * 8 : (const bf16_t*)(p.ws + W_BCACT) + (cg8 < 24 ? g * 128 + (cg8 - 8) * 8 : 512 + g * 128 + (cg8 - 24) * 8);
        const size_t astride = cg8 < 8 ? 2048 : 1024;
        bf16x8 av[8];
#pragma unroll
        for (int r = 0; r < 8; ++r) av[r] = ldr ? *(const bf16x8*)(asrc + (row0 + rb * 8 + r) * astride) : (bf16x8){0, 0, 0, 0, 0, 0, 0, 0};
        float dt_next = (wid == 0) ? dtbuf[(row0 + lane) * 32 + h] : 0.f;
        bf16_t szv[2][4];
#pragma unroll
        for (int q = 0; q < 2; ++q) { const int id = wid * 2 + q, mt = id >> 2, nt = id & 3;
#pragma unroll
            for (int i = 0; i < 4; ++i) szv[q][i] = mix[(row0 + mt * 16 + 4 * lq + i) * 3072 + 1024 + h * 64 + nt * 16 + l16]; }
#pragma unroll 1
        for (int c = 0; c < nch; ++c) {
            const size_t crow0 = row0 + (size_t)c * 64;
            if (wid == 0) {
                if (c > 0 && !dry) ssqg[(size_t)h * MALL + (crow0 - 64 + lane)] = (s_ssq[lane] + s_ssq[64 + lane]) + (s_ssq[128 + lane] + s_ssq[192 + lane]);
                const float dtv = dt_next; float ac = dtv * a_h;
                if (c + 1 < nch) dt_next = dtbuf[(crow0 + 64 + lane) * 32 + h];
                ac = wave_scan_incl(ac, lane);
                const float a63 = __builtin_bit_cast(float, __builtin_amdgcn_readlane(__builtin_bit_cast(int, ac), 63));
                s_acum[lane] = ac; s_dt[lane] = dtv; s_ea[lane] = __expf(ac); s_tail[lane] = __expf(a63 - ac) * dtv;
            }
            __syncthreads();
            if (ldr) {
                const int t0l = rb * 8;
#pragma unroll
                for (int hf = 0; hf < 2; ++hf) {
                    float vout[8][4];
#pragma unroll
                    for (int r = 0; r < 8; ++r)
#pragma unroll
                        for (int e = 0; e < 4; ++e) vout[r][e] = bf2f((bf16_t)av[r][hf * 4 + e]);
                    if (cg8 < 8) {
#pragma unroll
                        for (int e = 0; e < 4; ++e) { float t[8];
#pragma unroll
                            for (int r = 0; r < 8; ++r) t[r] = vout[r][e];
                            *(bf16x8*)(XT + (cg8 * 8 + hf * 4 + e) * 72 + t0l) = pack8(t); }
                    } else if (cg8 < 24) {
                        const int n0 = (cg8 - 8) * 8 + hf * 4;
#pragma unroll
                        for (int r = 0; r < 8; ++r) { const f32x4 q = {vout[r][0], vout[r][1], vout[r][2], vout[r][3]}; *(u32x2*)(Bs + (t0l + r) * 136 + n0) = pack4(q); }
                        float tl8[8];
#pragma unroll
                        for (int r = 0; r < 8; ++r) tl8[r] = s_tail[t0l + r];
#pragma unroll
                        for (int e = 0; e < 4; ++e) { float t[8];
#pragma unroll
                            for (int r = 0; r < 8; ++r) t[r] = vout[r][e] * tl8[r];
                            *(bf16x8*)(BTt + (n0 + e) * 72 + t0l) = pack8(t); }
                    } else {
                        const int n0 = (cg8 - 24) * 8 + hf * 4;
#pragma unroll
                        for (int r = 0; r < 8; ++r) { const f32x4 q = {vout[r][0], vout[r][1], vout[r][2], vout[r][3]}; *(u32x2*)(Cs + (t0l + r) * 136 + n0) = pack4(q);
                            const float ea = s_ea[t0l + r]; *(u32x2*)(Cs2 + (t0l + r) * 136 + n0) = pack4(q * ea); }
                    }
                }
                if (c + 1 < nch) {
#pragma unroll
                    for (int r = 0; r < 8; ++r) av[r] = *(const bf16x8*)(asrc + (crow0 + 64 + rb * 8 + r) * astride);
                }
            }
            __syncthreads();
#pragma unroll
            for (int q = 0; q < 2; ++q) { const int id = wid * 2 + q, mt = id >> 2, nt = id & 3;
                f32x4 acc = {0.f, 0.f, 0.f, 0.f};
                if (nt <= mt) {
#pragma unroll
                    for (int ks = 0; ks < 4; ++ks) { const bf16x8 af = *(const bf16x8*)(Cs + (mt * 16 + l16) * 136 + ks * 32 + lq * 8), bf = *(const bf16x8*)(Bs + (nt * 16 + l16) * 136 + ks * 32 + lq * 8);
                        acc = __builtin_amdgcn_mfma_f32_16x16x32_bf16(af, bf, acc, 0, 0, 0); }
                }
                const int s = nt * 16 + l16; const float as = s_acum[s], dts = s_dt[s];
#pragma unroll
                for (int i = 0; i < 4; ++i) { const int t = mt * 16 + 4 * lq + i; const float w = (s <= t) ? acc[i] * __expf(s_acum[t] - as) * dts : 0.f; Ws[t * 72 + s] = f2bf(w); }
            }
            __syncthreads();
#pragma unroll
            for (int q = 0; q < 2; ++q) { const int id = wid * 2 + q, mt = id >> 2, nt = id & 3;
                f32x4 acc = {0.f, 0.f, 0.f, 0.f};
#pragma unroll
                for (int ks = 0; ks < 2; ++ks) { const bf16x8 af = *(const bf16x8*)(Ws + (mt * 16 + l16) * 72 + ks * 32 + lq * 8), bf = *(const bf16x8*)(XT + (nt * 16 + l16) * 72 + ks * 32 + lq * 8);
                    acc = __builtin_amdgcn_mfma_f32_16x16x32_bf16(af, bf, acc, 0, 0, 0); }
#pragma unroll
                for (int ks = 0; ks < 4; ++ks) { const bf16x8 af = *(const bf16x8*)(Cs2 + (mt * 16 + l16) * 136 + ks * 32 + lq * 8), bf = *(const bf16x8*)(H0 + (nt * 16 + l16) * 136 + ks * 32 + lq * 8);
                    acc = __builtin_amdgcn_mfma_f32_16x16x32_bf16(af, bf, acc, 0, 0, 0); }
                const int pp = nt * 16 + l16;
#pragma unroll
                for (int i = 0; i < 4; ++i) { const int t = mt * 16 + 4 * lq + i;
                    const float xv = bf2f(XT[pp * 72 + t]);
                    const float yg = (acc[i] + d_h * xv) * bf2f(szv[q][i]);
                    if (!dry) mix[(crow0 + t) * 3072 + 1024 + h * 64 + pp] = f2bf(yg);
                    float sq = yg * yg;
                    sq = row16_sum(sq);
                    if (l16 == 0) s_ssq[nt * 64 + t] = sq; }
            }
            if (c + 1 < nch) {
#pragma unroll
                for (int q = 0; q < 2; ++q) { const int id = wid * 2 + q, mt = id >> 2, nt = id & 3;
#pragma unroll
                    for (int i = 0; i < 4; ++i) szv[q][i] = mix[(crow0 + 64 + mt * 16 + 4 * lq + i) * 3072 + 1024 + h * 64 + nt * 16 + l16]; } }
            const float e63 = s_ea[63];
            __syncthreads();
#pragma unroll
            for (int j = 0; j < 4; ++j) { const int nt = (wid & 1) * 4 + j;
                f32x4 acc = hacc[j] * e63;
#pragma unroll
                for (int ks = 0; ks < 2; ++ks) { const bf16x8 af = *(const bf16x8*)(XT + (pt * 16 + l16) * 72 + ks * 32 + lq * 8), bf = *(const bf16x8*)(BTt + (nt * 16 + l16) * 72 + ks * 32 + lq * 8);
                    acc = __builtin_amdgcn_mfma_f32_16x16x32_bf16(af, bf, acc, 0, 0, 0); }
                hacc[j] = acc;
#pragma unroll
                for (int i = 0; i < 4; ++i) H0[(pt * 16 + 4 * lq + i) * 136 + nt * 16 + l16] = f2bf(acc[i]);
            }
        }
        __syncthreads();
        if (wid == 0 && !dry) ssqg[(size_t)h * MALL + (row0 + (size_t)(nch - 1) * 64 + lane)] = (s_ssq[lane] + s_ssq[64 + lane]) + (s_ssq[128 + lane] + s_ssq[192 + lane]);
        if (!dry) { float* ho = p.out + (sample ? O_BSS : O_BSP) + ((size_t)b * 32 + h) * 64 * 128;
#pragma unroll
          for (int j = 0; j < 4; ++j) { const int nt = (wid & 1) * 4 + j;
#pragma unroll
              for (int i = 0; i < 4; ++i) ho[(size_t)(pt * 16 + 4 * lq + i) * 128 + nt * 16 + l16] = hacc[j][i]; } }
        __syncthreads();
    }
}

__device__ __forceinline__ void phase_bnorm(CPARAMS& p) {
    bf16_t* mix = (bf16_t*)(p.ws + W_MIX); const float* ssq = (const float*)(p.ws + W_SSQ); const float* nw = p.in[I_SNORM];
    const size_t n = (size_t)MALL * 256, stride = (size_t)gridDim.x * 512;
    const int tidb = opaque_tid();
    for (size_t i0 = (size_t)blockIdx.x * 512 + tidb; i0 < n; i0 += 4 * stride) {
        bf16x8 v[4]; float tot[4];
#pragma unroll
        for (int u = 0; u < 4; ++u) { const size_t i = i0 + u * stride; tot[u] = 0.f; v[u] = (bf16x8){0, 0, 0, 0, 0, 0, 0, 0};
            if (i < n) { const size_t row = i >> 8; const int c0 = (int)(i & 255) * 8, g = c0 >> 9;
                v[u] = *(const bf16x8*)(mix + row * 3072 + 1024 + c0);
#pragma unroll
                for (int hh = 0; hh < 8; ++hh) tot[u] += ssq[(size_t)(g * 8 + hh) * MALL + row]; } }
#pragma unroll
        for (int u = 0; u < 4; ++u) { const size_t i = i0 + u * stride;
            if (i < n) { const size_t row = i >> 8; const int c0 = (int)(i & 255) * 8;
                const float r = rsqrtf(tot[u] * (1.f / 512.f) + EPSV);
                const f32x4 w0 = *(const f32x4*)(nw + c0), w1 = *(const f32x4*)(nw + c0 + 4);
                float t[8];
#pragma unroll
                for (int e2 = 0; e2 < 8; ++e2) t[e2] = bf2f((bf16_t)v[u][e2]) * r * (e2 < 4 ? w0[e2] : w1[e2 - 4]);
                *(bf16x8*)(mix + row * 3072 + 1024 + c0) = pack8(t); } }
    }
}
__device__ __forceinline__ void phase_ln(CPARAMS& p, const float* gw, const float* bw, bf16_t* yb, const bool dry = false) {
    int tid_ = threadIdx.x; asm volatile("" : "+v"(tid_));
    const int wid = tid_ >> 6, lane = tid_ & 63;
    float* y = p.out + O_Y;
    for (int row = blockIdx.x * 8 + wid; row < MALL; row += gridDim.x * 8) {
        float* rp = y + (size_t)row * DM;
        f32x4 v[8]; float s = 0.f;
#pragma unroll
        for (int j = 0; j < 8; ++j) { v[j] = *(const f32x4*)(rp + j * 256 + lane * 4); s += v[j][0] + v[j][1] + v[j][2] + v[j][3]; }
        const float mu = wave_sum(s) * (1.f / DM);
        float q = 0.f;
#pragma unroll
        for (int j = 0; j < 8; ++j) { v[j] = v[j] - mu; q += v[j][0] * v[j][0] + v[j][1] * v[j][1] + v[j][2] * v[j][2] + v[j][3] * v[j][3]; }
        const float rs = rsqrtf(wave_sum(q) * (1.f / DM) + EPSV);
#pragma unroll
        for (int j = 0; j < 8; ++j) { const int c = j * 256 + lane * 4; const f32x4 gg = *(const f32x4*)(gw + c), bb = *(const f32x4*)(bw + c);
            const f32x4 o = v[j] * rs * gg + bb; if (!dry) { *(f32x4*)(rp + c) = o; if (yb) *(u32x2*)(yb + (size_t)row * DM + c) = pack4(o); } else if (o[0] == 1.2345e30f) rp[c] = 0.f; }
    }
}
__device__ __forceinline__ void phase_post1(CPARAMS& p) {
    const int tidp = opaque_tid(); const int wid = tidp >> 6, lane = tidp & 63;
    const float* cqkv = (const float*)(p.ws + W_CQKV); bf16_t* cqn = (bf16_t*)(p.ws + W_CQN); bf16_t* lat = (bf16_t*)(p.ws + W_LAT); bf16_t* krb = (bf16_t*)(p.ws + W_KR);
    const float2* tab = (const float2*)(p.ws + W_ROPE);
    for (int row = blockIdx.x * 8 + wid; row < MALL; row += gridDim.x * 8) {
        const float* rp = cqkv + (size_t)row * 1088;
        const f32x4 a0 = *(const f32x4*)(rp + lane * 8), a1 = *(const f32x4*)(rp + lane * 8 + 4), c0 = *(const f32x4*)(rp + 512 + lane * 8), c1 = *(const f32x4*)(rp + 512 + lane * 8 + 4);
        const float kv = rp[1024 + lane];
        float sa = 0.f, sc = 0.f;
#pragma unroll
        for (int e = 0; e < 4; ++e) { sa += a0[e] * a0[e] + a1[e] * a1[e]; sc += c0[e] * c0[e] + c1[e] * c1[e]; }
        const float ra = rsqrtf(wave_sum(sa) * (1.f / 512.f) + EPSV), rc = rsqrtf(wave_sum(sc) * (1.f / 512.f) + EPSV);
        const f32x4 qw0 = *(const f32x4*)(p.in[I_QNW] + lane * 8), qw1 = *(const f32x4*)(p.in[I_QNW] + lane * 8 + 4), kw0 = *(const f32x4*)(p.in[I_KVNW] + lane * 8), kw1 = *(const f32x4*)(p.in[I_KVNW] + lane * 8 + 4);
        const f32x4 qa = a0 * ra * qw0, qb = a1 * ra * qw1, la = c0 * rc * kw0, lb = c1 * rc * kw1;
        { const float t[8] = {qa[0], qa[1], qa[2], qa[3], qb[0], qb[1], qb[2], qb[3]}; *(bf16x8*)(cqn + (size_t)row * 512 + lane * 8) = pack8(t); }
        const int lr = latrow_of(row);
        { const float t[8] = {la[0], la[1], la[2], la[3], lb[0], lb[1], lb[2], lb[3]}; *(bf16x8*)(lat + (size_t)lr * 512 + lane * 8) = pack8(t); }
        float* clo = row < NP ? p.out + O_CLP + (size_t)row * 512 : p.out + O_CLS + (size_t)(row - NP) * 512;
        *(f32x4*)(clo + lane * 8) = la; *(f32x4*)(clo + lane * 8 + 4) = lb;
        const float other = __shfl_xor(kv, 32);
        const int i = lane & 31, pos = pos_of(row); const float2 cs = tab[(size_t)pos * 32 + i];
        const float o = lane < 32 ? kv * cs.x - other * cs.y : other * cs.y + kv * cs.x;
        float* cko = row < NP ? p.out + O_CKP + (size_t)row * 64 : p.out + O_CKS + (size_t)(row - NP) * 64;
        cko[lane] = o;
        krb[(size_t)lr * 64 + 4 * (i >> 1) + (i & 1) + (lane >= 32 ? 2 : 0)] = f2bf(o);
    }
    const size_t gtid = (size_t)blockIdx.x * 512 + tidp, gstride = (size_t)gridDim.x * 512;
    { const size_t n8 = (size_t)8 * PAST * 512 / 8;
      for (size_t i = gtid; i < n8; i += gstride) { const size_t e = i * 8, b = e / ((size_t)PAST * 512), rem = e % ((size_t)PAST * 512); const float* s = p.in[I_CLAT] + e;
        const f32x4 a = *(const f32x4*)s, c = *(const f32x4*)(s + 4); const float t[8] = {a[0], a[1], a[2], a[3], c[0], c[1], c[2], c[3]};
        *(bf16x8*)(lat + ((size_t)NP + b * LS) * 512 + rem) = pack8(t); } }
    { const size_t n = (size_t)8 * PAST * 64;
      for (size_t e = gtid; e < n; e += gstride) { const size_t b = e / ((size_t)PAST * 64), rem = e % ((size_t)PAST * 64), t = rem >> 6; const int j = (int)(rem & 63), i = j & 31;
        krb[((size_t)NP + b * LS + t) * 64 + 4 * (i >> 1) + (i & 1) + (j >= 32 ? 2 : 0)] = f2bf(p.in[I_CKR][e]); } }
}

__device__ __forceinline__ CPARAMS& get_params() {
    const unsigned long long v = (unsigned long long)__builtin_amdgcn_kernarg_segment_ptr(); unsigned lo = (unsigned)v, hi = (unsigned)(v >> 32);
    asm volatile("" : "+s"(lo), "+s"(hi));
    lo = __builtin_amdgcn_readfirstlane(lo); hi = __builtin_amdgcn_readfirstlane(hi);
    return *(CPARAMS*)(((unsigned long long)hi << 32) | lo);
}
#ifndef PROBE_STOP
#define PROBE_STOP 0
#endif
__device__ __forceinline__ void phase_dump(CPARAMS& p) {
    const unsigned short* w = (const unsigned short*)p.ws; float* y = p.out + O_Y; const size_t n = (size_t)MALL * DM;
#ifdef PROBE_THRASH
    { const f32x4* xs = (const f32x4*)p.in[I_XP] + (size_t)((blockIdx.x >> 3) & 31) * (NP * (size_t)DM / 4 / 32); f32x4 a = {0.f, 0.f, 0.f, 0.f};
      for (size_t i = threadIdx.x; i < NP * (size_t)DM / 4 / 32; i += 512) a += xs[i];
      if (a[0] + a[1] + a[2] + a[3] == 1.2345e30f) y[0] = 1.f;
      __syncthreads(); __threadfence(); }
    cg::this_grid().sync(); __threadfence();
#endif
    for (size_t i = (size_t)blockIdx.x * 512 + threadIdx.x; i < n; i += (size_t)gridDim.x * 512) {
        unsigned h = 0x12345u;
#pragma unroll
        for (int r = 0; r < 8; ++r) { const size_t o = (size_t)r * n + i; const unsigned v = (o * 2 < W_END) ? w[o] : 0u; h = (h ^ v) * 0x9E3779B1u; }
        h ^= h >> 15; y[i] = (float)((h >> 8) & 127u);
    }
}
#define PROBE_AT(k) do { if (PROBE_STOP == (k)) { CPARAMS& pq = get_params(); phase_dump(pq); return; } } while (0)
__global__ void __launch_bounds__(512) fwd_megakernel(Params p_unused) {
    extern __shared__ __attribute__((aligned(16))) char lds[];
    cg::grid_group grid = cg::this_grid();
#ifndef TIME_X2
#define TIME_X2 0
#endif
    const bool dryflag = get_params().ws != nullptr;
    unsigned nbar = 0;
#define GSYNC_CG() do { __builtin_amdgcn_fence(__ATOMIC_RELEASE, "agent"); asm volatile("s_waitcnt vmcnt(0)" ::: "memory"); grid.sync(); __builtin_amdgcn_fence(__ATOMIC_ACQUIRE, "agent"); } while (0)
#define GSYNC() do { ++nbar; asm volatile("s_waitcnt vmcnt(0)" ::: "memory"); __syncthreads(); \
        if (threadIdx.x == 0) { unsigned* ctr_ = (unsigned*)(get_params().ws + W_BAR); const unsigned tgt_ = nbar * gridDim.x; \
            __builtin_amdgcn_fence(__ATOMIC_RELEASE, "agent"); asm volatile("s_waitcnt vmcnt(0)" ::: "memory"); \
            __hip_atomic_fetch_add(ctr_, 1u, __ATOMIC_RELAXED, __HIP_MEMORY_SCOPE_AGENT); \
            while (__hip_atomic_load(ctr_, __ATOMIC_RELAXED, __HIP_MEMORY_SCOPE_AGENT) < tgt_) __builtin_amdgcn_s_sleep(2); \
            __builtin_amdgcn_fence(__ATOMIC_ACQUIRE, "agent"); asm volatile("s_waitcnt vmcnt(0)" ::: "memory"); } \
        __syncthreads(); } while (0)
    if (TIME_X2 == 1) { CPARAMS& p = get_params(); phase_prep(p, lds); __syncthreads(); }
    { CPARAMS& p = get_params(); phase_prep(p, lds); }
    GSYNC_CG();
    PROBE_AT(1);
    if (TIME_X2 == 2)
    { CPARAMS& p = get_params(); pg8::Gemm g; g.A = (const bf16_t*)(p.ws + W_XB); g.Bt = (const bf16_t*)(p.ws + W_BT0); g.M = MALL; g.N = NIN0P; g.K = DM; g.lda = DM;
      pg8::StaticOrder S; S.init(MALL, NIN0P, (int)gridDim.x, (int)blockIdx.x); EpiInProj0 E{p.ws, p.out, p.in[I_DTB]};
      pg8::gemm_phase<EpiInProj0, pg8::StaticOrder>((PG8_LAS unsigned char*)lds, g, S, E); }
    { CPARAMS& p = get_params(); pg8::Gemm g; g.A = (const bf16_t*)(p.ws + W_XB); g.Bt = (const bf16_t*)(p.ws + W_BT0); g.M = MALL; g.N = NIN0P; g.K = DM; g.lda = DM;
      pg8::StaticOrder S; S.init(MALL, NIN0P, (int)gridDim.x, (int)blockIdx.x); EpiInProj0 E{p.ws, p.out, p.in[I_DTB]};
      pg8::gemm_phase<EpiInProj0, pg8::StaticOrder>((PG8_LAS unsigned char*)lds, g, S, E); }
    GSYNC();
    PROBE_AT(2);
    if (TIME_X2 == 3) { CPARAMS& p = get_params(); phase_index(p, lds); }
    if (TIME_X2 == 12) { CPARAMS& p = get_params(); phase_conv(p); }
    { CPARAMS& p = get_params(); phase_conv(p); }
    { CPARAMS& p = get_params(); phase_index(p, lds); }
    GSYNC();
    PROBE_AT(3);
    if (TIME_X2 == 4) { CPARAMS& p = get_params(); phase_attn_dsa(p, lds, dryflag); }
    if (TIME_X2 == 5) { CPARAMS& p = get_params(); phase_ssd(p, lds, dryflag); }
#ifndef PROBE_SKIP_DSA
    { CPARAMS& p = get_params(); phase_attn_dsa(p, lds); }
#endif
#ifndef PROBE_SKIP_SSD
    { CPARAMS& p = get_params(); phase_ssd(p, lds); }
#endif
    GSYNC();
    PROBE_AT(4);
    { CPARAMS& p = get_params(); phase_bnorm(p); }
    GSYNC();
    PROBE_AT(5);
    if (TIME_X2 == 6)
    { CPARAMS& p = get_params(); FResid f{p.in[I_XP], p.in[I_XS], p.out + O_Y}; run_gemm(lds, (const bf16_t*)(p.ws + W_MIX), 3072, (const bf16_t*)(p.ws + W_BTOUT0), MALL, DM, 3072, f); }
    { CPARAMS& p = get_params(); FResid f{p.in[I_XP], p.in[I_XS], p.out + O_Y}; run_gemm(lds, (const bf16_t*)(p.ws + W_MIX), 3072, (const bf16_t*)(p.ws + W_BTOUT0), MALL, DM, 3072, f); }
    GSYNC();
    PROBE_AT(6);
    if (TIME_X2 == 7) { CPARAMS& p = get_params(); phase_ln(p, p.in[I_LN0G], p.in[I_LN0B], (bf16_t*)(p.ws + W_XB), dryflag); }
    { CPARAMS& p = get_params(); phase_ln(p, p.in[I_LN0G], p.in[I_LN0B], (bf16_t*)(p.ws + W_XB)); }
    GSYNC();
    PROBE_AT(7);
    if (TIME_X2 == 8)
    { CPARAMS& p = get_params(); FInProj1 f{p.ws}; run_gemm(lds, (const bf16_t*)(p.ws + W_XB), DM, (const bf16_t*)(p.ws + W_BT1), MALL, NIN1P, DM, f); }
    { CPARAMS& p = get_params(); FInProj1 f{p.ws}; run_gemm(lds, (const bf16_t*)(p.ws + W_XB), DM, (const bf16_t*)(p.ws + W_BT1), MALL, NIN1P, DM, f); }
    GSYNC();
    PROBE_AT(8);
    if (TIME_X2 == 9) { CPARAMS& p = get_params(); phase_post1(p); }
    { CPARAMS& p = get_params(); phase_post1(p); }
    GSYNC();
    PROBE_AT(9);
    if (TIME_X2 == 10)
    { CPARAMS& p = get_params(); FQUp f{p.ws}; run_gemm(lds, (const bf16_t*)(p.ws + W_CQN), 512, (const bf16_t*)(p.ws + W_BTUQ), MALL, 3072, 512, f); }
    { CPARAMS& p = get_params(); FQUp f{p.ws}; run_gemm(lds, (const bf16_t*)(p.ws + W_CQN), 512, (const bf16_t*)(p.ws + W_BTUQ), MALL, 3072, 512, f); }
    { CPARAMS& p = get_params(); FKvUp f{p.ws}; run_gemm(lds, (const bf16_t*)(p.ws + W_LAT), 512, (const bf16_t*)(p.ws + W_BTUKV), LATROWS, 4096, 512, f, true); }
    GSYNC();
    PROBE_AT(10);
    if (TIME_X2 == 11) { CPARAMS& p = get_params(); phase_attn_mla(p, lds, dryflag); }
    { CPARAMS& p = get_params(); phase_attn_mla(p, lds); }
    GSYNC();
    PROBE_AT(11);
    { CPARAMS& p = get_params(); FResid f{p.out + O_Y, p.out + O_Y + (size_t)NP * DM, p.out + O_Y}; run_gemm(lds, (const bf16_t*)(p.ws + W_Q2), 3072, (const bf16_t*)(p.ws + W_BTOUT1), MALL, DM, DM, f); }
    GSYNC();
    PROBE_AT(12);
    { CPARAMS& p = get_params(); phase_ln(p, p.in[I_LN1G], p.in[I_LN1B], nullptr); }
}

extern "C" void kernel_launch(void* const* d_in, const int* in_sizes, int n_in, void* d_out, int out_size, void* d_ws, size_t ws_size, hipStream_t stream) {
    static int grid_blocks = 0;
    if (!grid_blocks) {
        if (n_in != N_IN || (size_t)out_size != O_END || ws_size < W_END) { fprintf(stderr, "kernel_launch: unexpected shapes n_in %d out %d ws %zu\n", n_in, out_size, ws_size); return; }
        if (hipFuncSetAttribute((const void*)fwd_megakernel, hipFuncAttributeMaxDynamicSharedMemorySize, LDS_BYTES) != hipSuccess) { fprintf(stderr, "kernel_launch: LDS attribute failed\n"); return; }
        int dev = 0, cus = 0, per_cu = 0;
        hipGetDevice(&dev); hipDeviceGetAttribute(&cus, hipDeviceAttributeMultiprocessorCount, dev);
        hipOccupancyMaxActiveBlocksPerMultiprocessor(&per_cu, fwd_megakernel, 512, LDS_BYTES);
        if (per_cu < 1) { fprintf(stderr, "kernel_launch: occupancy 0\n"); return; }
        grid_blocks = cus;
    }
    if (hipMemsetAsync((char*)d_ws + W_BAR, 0, 256, stream) != hipSuccess) { fprintf(stderr, "kernel_launch: memset failed\n"); return; }
    Params p{};
    for (int i = 0; i < N_IN; ++i) p.in[i] = (const float*)d_in[i];
    p.out = (float*)d_out; p.ws = (char*)d_ws;
    void* args[] = {&p};
    hipError_t e = hipLaunchCooperativeKernel((const void*)fwd_megakernel, dim3(grid_blocks), dim3(512), args, LDS_BYTES, stream);
    if (e != hipSuccess) fprintf(stderr, "cooperative launch failed: %s (grid %d)\n", hipGetErrorString(e), grid_blocks);
}
```

```cpp
#include <hip/hip_runtime.h>
#include <hip/hip_cooperative_groups.h>
#include <cstdio>
#include <cstdint>
namespace cg = cooperative_groups;

#define LAS __attribute__((address_space(3)))
typedef unsigned short bf16_t;
typedef short bf16x8 __attribute__((ext_vector_type(8)));
typedef short s16x4 __attribute__((ext_vector_type(4)));
typedef float f32x4 __attribute__((ext_vector_type(4)));
typedef float f32x8 __attribute__((ext_vector_type(8)));
typedef float f32x16 __attribute__((ext_vector_type(16)));
typedef unsigned u32x4 __attribute__((ext_vector_type(4)));
typedef unsigned u32x2 __attribute__((ext_vector_type(2)));
typedef unsigned long long u64;

constexpr int DM = 2048, NP = 32768, NS = 512, MALL = NP + NS  , TP = 4096, TS = 64, PAST = 1024, LS = PAST + TS  ;
constexpr int NIN0 = 10352, NIN0P = 10496, NIN1 = 3136, NIN1P = 3328;
constexpr int LATROWS = NP + 8 * LS;
constexpr float ALPHA_RES = 1.4142135623730951f;
constexpr float LOG2E = 1.4426950408889634f;
constexpr float EPSV = 1e-5f;

enum { I_XP = 0, I_XS, I_CAK, I_CAV, I_CAKI, I_SCONV, I_SSSM, I_CLAT, I_CKR, I_T5, I_WIN0, I_WOUT0, I_CONVW, I_CONVB, I_DTB, I_ALOG, I_DSKIP,
       I_SNORM, I_LN0G, I_LN0B, I_WIN1, I_QNW, I_KVNW, I_WUQ, I_WUKV, I_WOUT1, I_LN1G, I_LN1B, N_IN };

constexpr size_t O_Y = 0;
constexpr size_t O_AKP = (size_t)MALL * DM;
constexpr size_t O_AKS = O_AKP + (size_t)NP * 1024;
constexpr size_t O_AVP = O_AKS + (size_t)NS * 1024;
constexpr size_t O_AVS = O_AVP + (size_t)NP * 1024;
constexpr size_t O_KIP = O_AVS + (size_t)NS * 1024;
constexpr size_t O_KIS = O_KIP + (size_t)NP * 64;
constexpr size_t O_BCP = O_KIS + (size_t)NS * 64;
constexpr size_t O_BCS = O_BCP + (size_t)8 * 3 * 3072;
constexpr size_t O_BSP = O_BCS + (size_t)8 * 3 * 3072;
constexpr size_t O_BSS = O_BSP + (size_t)8 * 32 * 64 * 128;
constexpr size_t O_CLP = O_BSS + (size_t)8 * 32 * 64 * 128;
constexpr size_t O_CLS = O_CLP + (size_t)NP * 512;
constexpr size_t O_CKP = O_CLS + (size_t)NS * 512;
constexpr size_t O_CKS = O_CKP + (size_t)NP * 64;
constexpr size_t O_END = O_CKS + (size_t)NS * 64;

constexpr size_t MiB = 1ull << 20;
constexpr size_t W_BT0 = 0;
constexpr size_t W_BTOUT0 = 41 * MiB;
constexpr size_t W_BT1 = 53 * MiB;
constexpr size_t W_BTUQ = 66 * MiB;
constexpr size_t W_BTUKV = 69 * MiB;
constexpr size_t W_BTOUT1 = 73 * MiB;
constexpr size_t W_ROPE = 81 * MiB;
constexpr size_t W_KIDXP = 82 * MiB;
constexpr size_t W_KIDXS = 86 * MiB;
constexpr size_t W_IW = 88 * MiB;
constexpr size_t W_DT = 91 * MiB;
constexpr size_t W_MASKP = 96 * MiB;
constexpr size_t W_MASKS = 112 * MiB;
constexpr size_t W_SSQ = 113 * MiB;
constexpr size_t W_BAR = 118 * MiB;
constexpr size_t W_XB = 120 * MiB;
constexpr size_t W_MIX = 250 * MiB;
constexpr size_t W_KP = 445 * MiB;
constexpr size_t W_KS = 509 * MiB;
constexpr size_t W_VP = 526 * MiB;
constexpr size_t W_VS = 590 * MiB;
constexpr size_t W_SG = 607 * MiB;
constexpr size_t W_IQ = 672 * MiB;
constexpr size_t W_XBC = 737 * MiB;
constexpr size_t W_KVALL = 120 * MiB;
constexpr size_t W_CQKV = 445 * MiB;
constexpr size_t W_CQN = 584 * MiB;
constexpr size_t W_LAT = 617 * MiB;
constexpr size_t W_KR = 658 * MiB;
constexpr size_t W_Q2 = 664 * MiB;
constexpr size_t W_SGATE = 860 * MiB;
constexpr size_t W_XACT = W_XB;
constexpr size_t W_BCACT = 932 * MiB;
constexpr size_t W_END = 997 * MiB;

struct Params { const float* in[N_IN]; float* out; char* ws; };
#define CPARAMS const __attribute__((address_space(4))) Params

constexpr int LDS_BYTES = 131072 + 32768;
#define KRSWZ(row, colB) ((row) * 128 + ((colB) ^ ((((row) >> 1) & 7) << 4)))

typedef __bf16 bf16x2_t __attribute__((ext_vector_type(2)));
typedef float f32x2_t __attribute__((ext_vector_type(2)));
__device__ __forceinline__ unsigned cvtpk(float lo, float hi) { const f32x2_t v = {lo, hi}; const bf16x2_t r = __builtin_convertvector(v, bf16x2_t); return __builtin_bit_cast(unsigned, r); }
__device__ __forceinline__ bf16_t f2bf(float f) { return (bf16_t)(cvtpk(f, f) & 0xffffu); }
__device__ __forceinline__ float bf2f(bf16_t b) { return __uint_as_float(((unsigned)b) << 16); }
__device__ __forceinline__ float silu_f(float v) { return v / (1.f + __expf(-v)); }
__device__ __forceinline__ bf16x8 pack8(const float* x) { u32x4 w = {cvtpk(x[0], x[1]), cvtpk(x[2], x[3]), cvtpk(x[4], x[5]), cvtpk(x[6], x[7])}; return *reinterpret_cast<bf16x8*>(&w); }
__device__ __forceinline__ u32x2 pack4(f32x4 v) { u32x2 w = {cvtpk(v[0], v[1]), cvtpk(v[2], v[3])}; return w; }
__device__ __forceinline__ float wave_sum(float v) {
#pragma unroll
  for (int o = 32; o > 0; o >>= 1) v += __shfl_xor(v, o);
  return v;
}
__device__ __forceinline__ int wave_sum_i(int v) {
#pragma unroll
  for (int o = 32; o > 0; o >>= 1) v += __shfl_xor(v, o);
  return v;
}
__device__ __forceinline__ float row16_sum(float v) {
    v += __builtin_bit_cast(float, __builtin_amdgcn_update_dpp(0, __builtin_bit_cast(int, v), 0xB1, 0xf, 0xf, true));
    v += __builtin_bit_cast(float, __builtin_amdgcn_update_dpp(0, __builtin_bit_cast(int, v), 0x4E, 0xf, 0xf, true));
    v += __builtin_bit_cast(float, __builtin_amdgcn_update_dpp(0, __builtin_bit_cast(int, v), 0x141, 0xf, 0xf, true));
    v += __builtin_bit_cast(float, __builtin_amdgcn_update_dpp(0, __builtin_bit_cast(int, v), 0x140, 0xf, 0xf, true));
    return v;
}
__device__ __forceinline__ float wave_scan_incl(float v, int lane) {
    v += __builtin_bit_cast(float, __builtin_amdgcn_update_dpp(0, __builtin_bit_cast(int, v), 0x111, 0xf, 0xf, false));
    v += __builtin_bit_cast(float, __builtin_amdgcn_update_dpp(0, __builtin_bit_cast(int, v), 0x112, 0xf, 0xf, false));
    v += __builtin_bit_cast(float, __builtin_amdgcn_update_dpp(0, __builtin_bit_cast(int, v), 0x114, 0xf, 0xf, false));
    v += __builtin_bit_cast(float, __builtin_amdgcn_update_dpp(0, __builtin_bit_cast(int, v), 0x118, 0xf, 0xf, false));
    const float t0 = __builtin_bit_cast(float, __builtin_amdgcn_readlane(__builtin_bit_cast(int, v), 15));
    const float t1 = __builtin_bit_cast(float, __builtin_amdgcn_readlane(__builtin_bit_cast(int, v), 31));
    const float t2 = __builtin_bit_cast(float, __builtin_amdgcn_readlane(__builtin_bit_cast(int, v), 47));
    float add = 0.f; if (lane >= 16) add = t0; if (lane >= 32) add = t0 + t1; if (lane >= 48) add = (t0 + t1) + t2;
    return v + add;
}
__device__ __forceinline__ int opaque_tid() { int t = threadIdx.x; asm volatile("" : "+v"(t)); return t; }
__device__ __forceinline__ int wave_sum_dpp(int v) {
    v += __builtin_amdgcn_update_dpp(0, v, 0xB1, 0xf, 0xf, true);
    v += __builtin_amdgcn_update_dpp(0, v, 0x4E, 0xf, 0xf, true);
    v += __builtin_amdgcn_update_dpp(0, v, 0x141, 0xf, 0xf, true);
    v += __builtin_amdgcn_update_dpp(0, v, 0x140, 0xf, 0xf, true);
    return __builtin_amdgcn_readlane(v, 0) + __builtin_amdgcn_readlane(v, 16) + __builtin_amdgcn_readlane(v, 32) + __builtin_amdgcn_readlane(v, 48);
}
__device__ __forceinline__ int latrow_of(int row) { if (row < NP) return row; const int r = row - NP; return NP + (r >> 6) * LS + PAST + (r & 63); }
__device__ __forceinline__ int pos_of(int row) { return row < NP ? (row & (TP - 1)) : PAST + ((row - NP) & 63); }
namespace pg8 {
#define PG8_LAS __attribute__((address_space(3)))
constexpr int BM = 256, BK = 64, HALF = 128, HTB = HALF * BK * 2  , STAGE_BYTES = 8 * HTB, NXCD = 8, WGM = 8;

__host__ __device__ __forceinline__ int lds_byte(int r, int c) { const int st = (r >> 4) * 2 + (c >> 5), rr = r & 15, cc = c & 31, ob = rr * 64 + cc * 2; return st * 1024 + (ob ^ (((ob >> 9) & 1) << 5)); }
__host__ __device__ __forceinline__ void stage_rc(int b, int& R, int& C) { const int st = b / 1024, sb = b % 1024, swz = sb ^ (((sb >> 9) & 1) << 5); R = (st >> 1) * 16 + swz / 64; C = (st & 1) * 32 + (swz % 64) / 2; }
__host__ __device__ __forceinline__ int perm32(int rho) { const int n = rho >> 4, i = rho & 15; return 8 * (i >> 2) + 4 * n + (i & 3); }

struct Unit { int pm, pn; };
struct Gemm { const bf16_t* A; const bf16_t* Bt; int M, N, K, lda; };

struct StaticOrder {
    int nM, nN, nwg, G, c;
    __host__ __device__ void init(int M, int N, int G_, int c_) { nM = M / BM; nN = N / BM; nwg = nM * nN; G = G_; c = c_; }
    __host__ __device__ bool next(int i, Unit& u) const {
        const long L = (long)i * G + c; if (L >= nwg) return false;
        int wgid = (int)L; { const int q = nwg / NXCD, r = nwg % NXCD, xcd = wgid % NXCD, off = wgid / NXCD; wgid = (xcd < r ? xcd * (q + 1) : r * (q + 1) + (xcd - r) * q) + off; }
        const int nig = WGM * nN, gid = wgid / nig, fm = gid * WGM, gsz = (nM - fm) < WGM ? (nM - fm) : WGM;
        u.pm = fm + ((wgid % nig) % gsz); u.pn = (wgid % nig) / gsz; return true;
    }
    __device__ __forceinline__ void a_ready(const Unit&) const {}
    __device__ __forceinline__ void done(const Unit&) const {}
};

template <class Epi, class Sched>
__device__ __forceinline__ void gemm_phase(PG8_LAS unsigned char* lds, const Gemm g, const Sched& S, const Epi& E) {
    constexpr bool STAMP = false; unsigned long long* stamps = nullptr;
    int tid_ = threadIdx.x; asm volatile("" : "+v"(tid_));
    const int tid = tid_, wid = __builtin_amdgcn_readfirstlane(tid >> 6), lane = tid & 63, wr = wid >> 2, wc = wid & 3, fr = lane & 15, fq = lane >> 4;
    const int K = g.K, nt = K / BK;
    int ts_lo = 0, ts_hi = 0, nts = 0; const unsigned long long rt_entry = STAMP ? (unsigned long long)wall_clock64() : 0ull;
#define PG8_STAMP() do { if (STAMP && wid == 0 && nts < 64) { const unsigned long long _c = (unsigned long long)clock64(); \
        ts_lo = (lane == nts) ? (int)(unsigned)_c : ts_lo; ts_hi = (lane == nts) ? (int)(unsigned)(_c >> 32) : ts_hi; ++nts; } } while (0)
    PG8_STAMP();
    unsigned voffA[2], voffB[2];
#pragma unroll
    for (int i = 0; i < 2; ++i) { int R, C; stage_rc(tid * 16 + i * 8192, R, C); const int Rb = Epi::PERM ? ((R & ~31) + perm32(R & 31)) : R;
        voffA[i] = (unsigned)(R * g.lda + C) * 2u; voffB[i] = (unsigned)(Rb * K + C) * 2u; }
    const size_t kstep = (size_t)(BK * 2);
    const size_t hstep = (size_t)HALF * K * 2; const size_t hstepA = (size_t)HALF * g.lda * 2;
    const size_t tstep = 2 * hstep; const size_t tstepA = 2 * hstepA;
    const unsigned ldsw = (unsigned)wid * 1024u;
    const int aoff = lds_byte(wr * 64 + fr, fq * 8), boff = lds_byte(wc * 32 + fr, fq * 8);
#define PG8_SA(b, h) (((b) * 2 + (h)) * HTB)
#define PG8_SB(b, h) ((4 + (b) * 2 + (h)) * HTB)
#define PG8_STAGE(bufoff, gbase, voff) do { _Pragma("unroll") for (int _i = 0; _i < 2; ++_i) \
        __builtin_amdgcn_global_load_lds((const unsigned*)((const char*)(gbase) + (voff)[_i]), (PG8_LAS unsigned*)(lds + (bufoff) + ldsw + _i * 8192), 16, 0, 0); } while (0)
#define PG8_LDA(dst, b, h) do { _Pragma("unroll") for (int m = 0; m < 4; ++m) _Pragma("unroll") for (int k = 0; k < 2; ++k) dst[m][k] = *(const PG8_LAS bf16x8*)(lds + PG8_SA(b, h) + aoff + m * 2048 + k * 1024); } while (0)
#define PG8_LDB(dst, b, h) do { _Pragma("unroll") for (int n = 0; n < 2; ++n) _Pragma("unroll") for (int k = 0; k < 2; ++k) dst[n][k] = *(const PG8_LAS bf16x8*)(lds + PG8_SB(b, h) + boff + n * 2048 + k * 1024); } while (0)
#define PG8_MMA(ai, bj, At, Bt) do { __builtin_amdgcn_s_setprio(1); _Pragma("unroll") for (int m = 0; m < 4; ++m) _Pragma("unroll") for (int n = 0; n < 2; ++n) _Pragma("unroll") for (int k = 0; k < 2; ++k) \
        acc[ai][bj][m][n] = __builtin_amdgcn_mfma_f32_16x16x32_bf16(Bt[n][k], At[m][k], acc[ai][bj][m][n], 0, 0, 0); __builtin_amdgcn_s_setprio(0); } while (0)
#define PG8_WAIT_V(n) asm volatile("s_waitcnt vmcnt(" #n ")" ::: "memory")
#define PG8_WAIT_L(n) asm volatile("s_waitcnt lgkmcnt(" #n ")" ::: "memory")
#define PG8_BAR __builtin_amdgcn_s_barrier()
#define PG8_SCHED __builtin_amdgcn_sched_barrier(0)
    Unit cur, nxt; int ui = 0;
    if (!S.next(0, cur)) return;
    f32x4 acc[2][2][4][2];
#pragma unroll
    for (int a = 0; a < 2; ++a)
#pragma unroll
        for (int b = 0; b < 2; ++b)
#pragma unroll
            for (int m = 0; m < 4; ++m)
#pragma unroll
                for (int n = 0; n < 2; ++n) acc[a][b][m][n] = (f32x4){0.f, 0.f, 0.f, 0.f};
    bf16x8 At[4][2], B0[2][2], B1[2][2];
    const char* cA = (const char*)g.A + (size_t)cur.pm * tstepA; const char* cB = (const char*)g.Bt + (size_t)cur.pn * tstep;
    S.a_ready(cur);
    PG8_STAGE(PG8_SB(0, 0), cB, voffB); PG8_STAGE(PG8_SA(0, 0), cA, voffA); PG8_STAGE(PG8_SB(0, 1), cB + hstep, voffB); PG8_STAGE(PG8_SA(0, 1), cA + hstepA, voffA);
    if (wr == 1) PG8_BAR;
    PG8_WAIT_V(4); PG8_BAR;
    PG8_STAGE(PG8_SB(1, 0), cB + kstep, voffB); PG8_STAGE(PG8_SA(1, 0), cA + kstep, voffA); PG8_STAGE(PG8_SB(1, 1), cB + hstep + kstep, voffB);
    PG8_WAIT_V(6); PG8_BAR;
    PG8_STAMP();
    for (;;) {
        const bool has_next = S.next(ui + 1, nxt);
        const char* nA = has_next ? (const char*)g.A + (size_t)nxt.pm * tstepA : cA; const char* nB = has_next ? (const char*)g.Bt + (size_t)nxt.pn * tstep : cB;
        for (int t = 0; t < nt; t += 2) {
            const bool last = (t == nt - 2);
            const char* a1 = cA + (size_t)(t + 1) * kstep;
            const char* a2 = last ? nA : cA + (size_t)(t + 2) * kstep; const char* b2 = last ? nB : cB + (size_t)(t + 2) * kstep;
            const char* a3 = a2 + kstep; const char* b3 = b2 + kstep;
            if (last && has_next) S.a_ready(nxt);
            PG8_LDB(B0, 0, 0); PG8_SCHED; PG8_LDA(At, 0, 0); PG8_STAGE(PG8_SA(1, 1), a1 + hstepA, voffA);
            PG8_WAIT_L(8); PG8_BAR; PG8_WAIT_L(0); PG8_MMA(0, 0, At, B0); PG8_BAR; PG8_SCHED;
            PG8_LDB(B1, 0, 1); PG8_STAGE(PG8_SB(0, 0), b2, voffB);
            PG8_BAR; PG8_WAIT_L(0); PG8_MMA(0, 1, At, B1); PG8_BAR;
            PG8_LDA(At, 0, 1); PG8_STAGE(PG8_SA(0, 0), a2, voffA);
            PG8_BAR; PG8_WAIT_L(0); PG8_MMA(1, 0, At, B0); PG8_BAR; PG8_SCHED;
            PG8_STAGE(PG8_SB(0, 1), b2 + hstep, voffB);
            PG8_WAIT_V(6); PG8_BAR; PG8_MMA(1, 1, At, B1); PG8_BAR;
            PG8_LDB(B0, 1, 0); PG8_SCHED; PG8_LDA(At, 1, 0); PG8_STAGE(PG8_SA(0, 1), a2 + hstepA, voffA);
            PG8_WAIT_L(8); PG8_BAR; PG8_WAIT_L(0); PG8_MMA(0, 0, At, B0); PG8_BAR; PG8_SCHED;
            PG8_LDB(B1, 1, 1); PG8_STAGE(PG8_SB(1, 0), b3, voffB);
            PG8_BAR; PG8_WAIT_L(0); PG8_MMA(0, 1, At, B1); PG8_BAR;
            PG8_LDA(At, 1, 1); PG8_STAGE(PG8_SA(1, 0), a3, voffA);
            PG8_BAR; PG8_WAIT_L(0); PG8_MMA(1, 0, At, B0); PG8_BAR; PG8_SCHED;
            PG8_STAGE(PG8_SB(1, 1), b3 + hstep, voffB);
            PG8_WAIT_V(6); PG8_BAR; PG8_MMA(1, 1, At, B1); PG8_BAR;
        }
        PG8_STAMP();
        if constexpr (!Epi::AFTER_DRAIN) { E(acc, cur, wr, wc, fr, fq); S.done(cur); }
        PG8_STAMP();
        if (!has_next) break;
#pragma unroll
        for (int a = 0; a < 2; ++a)
#pragma unroll
            for (int b = 0; b < 2; ++b)
#pragma unroll
                for (int m = 0; m < 4; ++m)
#pragma unroll
                    for (int n = 0; n < 2; ++n) acc[a][b][m][n] = (f32x4){0.f, 0.f, 0.f, 0.f};
        cur = nxt; cA = nA; cB = nB; ++ui;
    }
    PG8_WAIT_V(0);
    if (wr == 0) PG8_BAR;
    PG8_BAR;
    if constexpr (Epi::AFTER_DRAIN) { E.fused(acc, cur, wr, wc, fr, fq, lds, wid, lane); S.done(cur); }
    PG8_STAMP();
    if (STAMP && wid == 0) { stamps[lane] = lane < nts ? (((unsigned long long)(unsigned)ts_hi << 32) | (unsigned)ts_lo) : 0ull;
        if (lane == 62) stamps[62] = rt_entry; if (lane == 63) stamps[63] = (unsigned long long)wall_clock64(); }
#undef PG8_STAMP
#undef PG8_SA
#undef PG8_SB
#undef PG8_STAGE
#undef PG8_LDA
#undef PG8_LDB
#undef PG8_MMA
#undef PG8_WAIT_V
#undef PG8_WAIT_L
#undef PG8_BAR
#undef PG8_SCHED
}
}


template <class F> struct EpiGen {
    static constexpr bool PERM = false, AFTER_DRAIN = false;
    F f;
    __device__ __forceinline__ void operator()(const f32x4 (&acc)[2][2][4][2], const pg8::Unit& u, int wr, int wc, int fr, int fq) const {
        int row0 = u.pm * 256 + wr * 64 + fr, col0 = u.pn * 256 + wc * 32 + 4 * fq;
        asm volatile("" : "+v"(row0), "+v"(col0));
#pragma unroll
        for (int ai = 0; ai < 2; ++ai)
#pragma unroll
            for (int m = 0; m < 4; ++m) {
                const int row = row0 + ai * 128 + m * 16;
#pragma unroll
                for (int bj = 0; bj < 2; ++bj)
#pragma unroll
                    for (int n = 0; n < 2; ++n) f(row, col0 + bj * 128 + n * 16, acc[ai][bj][m][n], u.pn);
            }
    }
};

#define EPI_ITER(...) do { int row0_ = row0, col0_ = col0; asm volatile("" : "+v"(row0_), "+v"(col0_)); _Pragma("unroll") for (int ai = 0; ai < 2; ++ai) _Pragma("unroll") for (int m = 0; m < 4; ++m) { const int row = row0_ + ai * 128 + m * 16; \
    _Pragma("unroll") for (int bj = 0; bj < 2; ++bj) _Pragma("unroll") for (int n = 0; n < 2; ++n) { const int col = col0_ + bj * 128 + n * 16; const f32x4 v = acc[ai][bj][m][n]; __VA_ARGS__ } } } while (0)
struct EpiInProj0 {
    static constexpr bool PERM = false, AFTER_DRAIN = false;
    char* ws; float* out; const float* dtb;
    __device__ __forceinline__ void operator()(const f32x4 (&acc)[2][2][4][2], const pg8::Unit& u, int wr, int wc, int fr, int fq) const {
        int row0 = u.pm * 256 + wr * 64 + fr, col0 = u.pn * 256 + wc * 32 + 4 * fq; const int pn = u.pn;
        asm volatile("" : "+v"(row0), "+v"(col0));
        if (pn < 4) {
            EPI_ITER({ *(u32x2*)((bf16_t*)(ws + W_MIX) + (size_t)row * 3072 + col) = pack4(v); });
        } else if (pn < 12) {
            const bool isv = pn >= 8; const int cs = isv ? 2048 : 1024;
            bf16_t* kp = (bf16_t*)(ws + (isv ? W_VP : W_KP)); bf16_t* ks = (bf16_t*)(ws + (isv ? W_VS : W_KS)); float* op = out + (isv ? O_AVP : O_AKP); float* os = out + (isv ? O_AVS : O_AKS);
            EPI_ITER({ const int c = col - cs; bf16_t* kb; float* o;
                if (row < NP) { kb = kp + (size_t)row * 1024 + c; o = op + (size_t)row * 1024 + c; }
                else { const int r = row - NP; kb = ks + ((size_t)(r >> 6) * LS + PAST + (r & 63)) * 1024 + c; o = os + (size_t)r * 1024 + c; }
                *(u32x2*)kb = pack4(v); *(f32x4*)o = v; });
        } else if (pn < 16) {
            EPI_ITER({ f32x4 s = {silu_f(v[0]), silu_f(v[1]), silu_f(v[2]), silu_f(v[3])}; *(u32x2*)((bf16_t*)(ws + W_SG) + (size_t)row * 1024 + (col - 3072)) = pack4(s); });
        } else if (pn < 20) {
            EPI_ITER({ *(u32x2*)((bf16_t*)(ws + W_IQ) + (size_t)row * 1024 + (col - 4096)) = pack4(v); });
        } else if (pn < 28) {
            EPI_ITER({ f32x4 s = {silu_f(v[0]), silu_f(v[1]), silu_f(v[2]), silu_f(v[3])}; *(u32x2*)((bf16_t*)(ws + W_MIX) + (size_t)row * 3072 + 1024 + (col - 5120)) = pack4(s); });
        } else if (pn < 40) {
            EPI_ITER({ const int c = col - 7168;
                *(u32x2*)((bf16_t*)(ws + W_XBC) + (size_t)row * 3072 + c) = pack4(v);
                if (row < NP) { const int t = row & (TP - 1); if (t >= TP - 3) *(f32x4*)(out + O_BCP + ((size_t)(row >> 12) * 3 + (t - (TP - 3))) * 3072 + c) = v; }
                else { const int r = row - NP, t = r & 63; if (t >= TS - 3) *(f32x4*)(out + O_BCS + ((size_t)(r >> 6) * 3 + (t - (TS - 3))) * 3072 + c) = v; } });
        } else {
            int r0 = row0, c0 = col0; asm volatile("" : "+v"(r0), "+v"(c0));
#pragma unroll
            for (int n = 0; n < 2; ++n) {
                const int c = c0 - 10240 + n * 16;
                if (c < 64) {
#pragma unroll
                    for (int ai = 0; ai < 2; ++ai)
#pragma unroll
                        for (int m = 0; m < 4; ++m) { const int row = r0 + ai * 128 + m * 16; const f32x4 v = acc[ai][0][m][n]; bf16_t* kb; float* o;
                            if (row < NP) { kb = (bf16_t*)(ws + W_KIDXP) + (size_t)row * 64 + c; o = out + O_KIP + (size_t)row * 64 + c; }
                            else { const int r = row - NP; kb = (bf16_t*)(ws + W_KIDXS) + ((size_t)(r >> 6) * LS + PAST + (r & 63)) * 64 + c; o = out + O_KIS + (size_t)r * 64 + c; }
                            *(u32x2*)kb = pack4(v); *(f32x4*)o = v; }
                } else if (c < 80) {
#pragma unroll
                    for (int ai = 0; ai < 2; ++ai)
#pragma unroll
                        for (int m = 0; m < 4; ++m) { const int row = r0 + ai * 128 + m * 16; *(f32x4*)((float*)(ws + W_IW) + (size_t)row * 16 + (c - 64)) = acc[ai][0][m][n] * 0.03125f; }
                } else if (c < 112) {
                    const f32x4 db = *(const f32x4*)(dtb + (c - 80));
#pragma unroll
                    for (int ai = 0; ai < 2; ++ai)
#pragma unroll
                        for (int m = 0; m < 4; ++m) { const int row = r0 + ai * 128 + m * 16; const f32x4 v = acc[ai][0][m][n] + db; f32x4 d;
#pragma unroll
                            for (int j = 0; j < 4; ++j) d[j] = v[j] > 20.f ? v[j] : log1pf(__expf(v[j]));
                            *(f32x4*)((float*)(ws + W_DT) + (size_t)row * 32 + (c - 80)) = d; }
                }
            }
        }
    }
};

struct FResid {
    const float* r0; const float* r1; float* y;
    __device__ __forceinline__ void operator()(int row, int col, f32x4 v, int) const {
        const float* rp = row < NP ? r0 + (size_t)row * DM + col : r1 + (size_t)(row - NP) * DM + col;
        const f32x4 x = *(const f32x4*)rp;
        *(f32x4*)(y + (size_t)row * DM + col) = v + x * ALPHA_RES;
    }
};

struct FInProj1 {
    char* ws;
    __device__ __forceinline__ void operator()(int row, int col, f32x4 v, int pn) const {
        if (pn < 4) *(f32x4*)((float*)(ws + W_CQKV) + (size_t)row * 1088 + col) = v;
        else if (pn < 12) { f32x4 s = {silu_f(v[0]), silu_f(v[1]), silu_f(v[2]), silu_f(v[3])}; *(u32x2*)((bf16_t*)(ws + W_SGATE) + (size_t)row * 2048 + (col - 1024)) = pack4(s); }
        else { const int c = col - 3072; if (c < 64) *(f32x4*)((float*)(ws + W_CQKV) + (size_t)row * 1088 + 1024 + c) = v; }
    }
};

struct FQUp {
    char* ws;
    __device__ __forceinline__ void operator()(int row, int col, f32x4 v, int pn) const {
        if (pn >= 8) {
            const int jj = (col - 2048) & 63, i0 = (jj >> 2) * 2, pos = pos_of(row);
            const float2* tab = (const float2*)(ws + W_ROPE) + (size_t)pos * 32 + i0;
            const float2 c0 = tab[0], c1 = tab[1];
            f32x4 o; o[0] = v[0] * c0.x - v[2] * c0.y; o[2] = v[0] * c0.y + v[2] * c0.x; o[1] = v[1] * c1.x - v[3] * c1.y; o[3] = v[1] * c1.y + v[3] * c1.x; v = o;
        }
        *(u32x2*)((bf16_t*)(ws + W_Q2) + (size_t)row * 3072 + col) = pack4(v);
    }
};
struct FKvUp { char* ws; __device__ __forceinline__ void operator()(int row, int col, f32x4 v, int) const { *(u32x2*)((bf16_t*)(ws + W_KVALL) + (size_t)row * 4096 + col) = pack4(v); } };

template <class F> __device__ __forceinline__ void run_gemm(char* lds, const bf16_t* A, int lda, const bf16_t* Bt, int M, int N, int K, const F& f, const bool rev = false) {
    pg8::Gemm g; g.A = A; g.Bt = Bt; g.M = M; g.N = N; g.K = K; g.lda = lda;
    pg8::StaticOrder S; S.init(M, N, (int)gridDim.x, rev ? (int)(gridDim.x - 1 - blockIdx.x) : (int)blockIdx.x);
    EpiGen<F> E{f};
    pg8::gemm_phase<EpiGen<F>, pg8::StaticOrder>((PG8_LAS unsigned char*)lds, g, S, E);
}

__device__ __forceinline__ int orig_col(int w, int n) {
    switch (w) {
    case 0: if (n < 5120) return n; if (n < 7168) return 5200 + (n - 5120); if (n < 10240) return 7248 + (n - 7168); if (n < 10304) return 5120 + (n - 10240);
            if (n < 10320) return 5184 + (n - 10304); if (n < 10352) return n; return -1;
    case 2: if (n < 1024) return n; if (n < 3072) return 1088 + (n - 1024); if (n < 3136) return 1024 + (n - 3072); return -1;
    case 3: if (n < 2048) return (n >> 7) * 192 + (n & 127);
            { const int j = n - 2048, h = j >> 6, jj = j & 63, g4 = jj >> 2, e = jj & 3; return h * 192 + 128 + (e >> 1) * 32 + 2 * g4 + (e & 1); }
    case 4: if (n < 2048) return (n >> 7) * 256 + (n & 127); { const int j = n - 2048; return (j >> 7) * 256 + 128 + (j & 127); }
    default: return n;
    }
}
__device__ __forceinline__ void phase_prep(CPARAMS& p, char* lds) {
    const int tid = opaque_tid();
    {
        bf16_t* tile = (bf16_t*)lds;
        int base = 0;
#pragma unroll 1
        for (int w = 0; w < 6; ++w) {
            int K, N, NPd; const float* W; bf16_t* Bt;
            switch (w) {
            case 0: K = 2048; N = NIN0; NPd = NIN0P; W = p.in[I_WIN0]; Bt = (bf16_t*)(p.ws + W_BT0); break;
            case 1: K = 3072; N = 2048; NPd = 2048; W = p.in[I_WOUT0]; Bt = (bf16_t*)(p.ws + W_BTOUT0); break;
            case 2: K = 2048; N = NIN1; NPd = NIN1P; W = p.in[I_WIN1]; Bt = (bf16_t*)(p.ws + W_BT1); break;
            case 3: K = 512; N = 3072; NPd = 3072; W = p.in[I_WUQ]; Bt = (bf16_t*)(p.ws + W_BTUQ); break;
            case 4: K = 512; N = 4096; NPd = 4096; W = p.in[I_WUKV]; Bt = (bf16_t*)(p.ws + W_BTUKV); break;
            default: K = 2048; N = 2048; NPd = 2048; W = p.in[I_WOUT1]; Bt = (bf16_t*)(p.ws + W_BTOUT1); break;
            }
            const int nkt = K / 64, nnt = NPd / 64, ntiles = nkt * nnt;
            int first = (int)blockIdx.x - (base % (int)gridDim.x); if (first < 0) first += gridDim.x;
#pragma unroll 1
            for (int tix = first; tix < ntiles; tix += gridDim.x) {
                const int kt = tix % nkt, nt = tix / nkt;
                const int nl = tid & 63, n = nt * 64 + nl, oc = orig_col(w, n);
#pragma unroll
                for (int i = 0; i < 8; ++i) {
                    const int kl = i * 8 + (tid >> 6), k = kt * 64 + kl;
                    const float v = oc >= 0 ? W[(size_t)k * N + oc] : 0.f;
                    tile[nl * 66 + kl] = f2bf(v);
                }
                __syncthreads();
                { const int nr = tid >> 3, ks = (tid & 7) * 8; const unsigned* src = (const unsigned*)(tile + nr * 66 + ks);
                  u32x4 o = {src[0], src[1], src[2], src[3]};
                  *(u32x4*)(Bt + (size_t)(nt * 64 + nr) * K + kt * 64 + ks) = o; }
                __syncthreads();
            }
            base += ntiles;
        }
    }
    const size_t gtid = (size_t)blockIdx.x * 512 + tid, gstride = (size_t)gridDim.x * 512;
    { bf16_t* xb = (bf16_t*)(p.ws + W_XB); const size_t n8p = (size_t)NP * DM / 8, n8 = (size_t)MALL * DM / 8;
      for (size_t i0 = gtid; i0 < n8; i0 += 4 * gstride) {
        f32x4 a[4], b[4];
#pragma unroll
        for (int u = 0; u < 4; ++u) { const size_t i = i0 + u * gstride; if (i < n8) { const float* s = i < n8p ? p.in[I_XP] + i * 8 : p.in[I_XS] + (i - n8p) * 8; a[u] = *(const f32x4*)s; b[u] = *(const f32x4*)(s + 4); } }
#pragma unroll
        for (int u = 0; u < 4; ++u) { const size_t i = i0 + u * gstride; if (i < n8) { const float t[8] = {a[u][0], a[u][1], a[u][2], a[u][3], b[u][0], b[u][1], b[u][2], b[u][3]}; *(bf16x8*)(xb + i * 8) = pack8(t); } }
      } }
    { const size_t n8 = (size_t)8 * PAST * 1024 / 8;
      for (size_t i = gtid; i < 2 * n8; i += gstride) { const bool isv = i >= n8; const size_t j = isv ? i - n8 : i; const float* s = p.in[isv ? I_CAV : I_CAK] + j * 8;
        const size_t e = j * 8, b = e / ((size_t)PAST * 1024), rem = e % ((size_t)PAST * 1024);
        const f32x4 a = *(const f32x4*)s, c = *(const f32x4*)(s + 4); const float t[8] = {a[0], a[1], a[2], a[3], c[0], c[1], c[2], c[3]};
        *(bf16x8*)((bf16_t*)(p.ws + (isv ? W_VS : W_KS)) + b * (size_t)LS * 1024 + rem) = pack8(t); }
      const size_t m8 = (size_t)8 * PAST * 64 / 8;
      for (size_t i = gtid; i < m8; i += gstride) { const float* s = p.in[I_CAKI] + i * 8; const size_t e = i * 8, b = e / ((size_t)PAST * 64), rem = e % ((size_t)PAST * 64);
        const f32x4 a = *(const f32x4*)s, c = *(const f32x4*)(s + 4); const float t[8] = {a[0], a[1], a[2], a[3], c[0], c[1], c[2], c[3]};
        *(bf16x8*)((bf16_t*)(p.ws + W_KIDXS) + b * (size_t)LS * 64 + rem) = pack8(t); } }
    { float2* tab = (float2*)(p.ws + W_ROPE);
      for (size_t i = gtid; i < (size_t)4096 * 32; i += gstride) { const int pos = (int)(i >> 5), f = (int)(i & 31);
        const float inv = powf(10000.f, -(float)f / 32.f), ang = (float)pos * inv; float s, c; sincosf(ang, &s, &c); tab[i] = make_float2(c, s); } }
}

__device__ __forceinline__ void phase_index(CPARAMS& p, char* lds) {
    const int tid = opaque_tid(), wid = tid >> 6, lane = tid & 63, r32 = lane & 31, hi = lane >> 5;
    unsigned* sk = (unsigned*)lds;
    const int NU = 4096 + 64;
#pragma unroll 1
    for (int idx = blockIdx.x; idx < NU; idx += gridDim.x) {
        int b, t0, n, nblk_tot, rowg; const bf16_t* ki; u64* mrow; int ldm; bool sample;
        if (idx < 4096) { const int k = idx >> 8, w = idx & 255; b = k >> 1; const int j = (k & 1) ? 511 - w : w; t0 = j * 8; n = ((t0 >> 6) + 1) * 64; nblk_tot = ((t0 >> 8) + 1) * 4;
            rowg = b * TP + t0; ki = (const bf16_t*)(p.ws + W_KIDXP) + (size_t)b * TP * 64; mrow = (u64*)(p.ws + W_MASKP) + (size_t)rowg * 64; ldm = 64; sample = false; }
        else { const int s = idx - 4096; b = s >> 3; t0 = (s & 7) * 8; n = LS; nblk_tot = 17; rowg = NP + b * 64 + t0;
            ki = (const bf16_t*)(p.ws + W_KIDXS) + (size_t)b * LS * 64; mrow = (u64*)(p.ws + W_MASKS) + (size_t)(b * 64 + t0) * 32; ldm = 32; sample = true; }
        (void)sample;
        if (n <= 256) {
            if (lane < nblk_tot) mrow[(size_t)wid * ldm + lane] = (lane * 64 < n) ? ~0ull : 0ull;
            continue;
        }
        {
            const int pr = wid >> 1, par = wid & 1;
            const int qsel = (r32 >> 2) & 1, head = (r32 & 3) + 4 * (r32 >> 3);
            const bf16_t* qp = (const bf16_t*)(p.ws + W_IQ) + (size_t)(rowg + 2 * pr + qsel) * 1024 + head * 64 + hi * 8;
            bf16x8 qa[4];
#pragma unroll
            for (int s = 0; s < 4; ++s) qa[s] = *(const bf16x8*)(qp + s * 16);
            const float* wp = (const float*)(p.ws + W_IW) + (size_t)(rowg + 2 * pr + hi) * 16;
            float wv[16];
#pragma unroll
            for (int s = 0; s < 4; ++s) { const f32x4 t = *(const f32x4*)(wp + s * 4); wv[s * 4] = t[0]; wv[s * 4 + 1] = t[1]; wv[s * 4 + 2] = t[2]; wv[s * 4 + 3] = t[3]; }
            unsigned* dst = sk + (2 * pr + hi) * 4096 + par * 32 + r32;
            char* kst = lds + 131072;
            const int skey = tid >> 3, scolB = (tid & 7) * 16, ntile = n >> 6, ngrp = (ntile + 3) >> 2;
            const bf16_t* ksrc = ki + (size_t)skey * 64 + (scolB >> 1);
            bf16x8 pre[3][4];
#pragma unroll
            for (int sl = 0; sl < 3; ++sl)
#pragma unroll
                for (int u = 0; u < 4; ++u) { const int t = sl * 4 + u; pre[sl][u] = *(const bf16x8*)(ksrc + (size_t)(t < ntile ? t : 0) * 64 * 64); }
#define IDX_GROUP(SL, G) do { const int g_ = (G); \
                __syncthreads(); \
                _Pragma("unroll") for (int u = 0; u < 4; ++u) *(bf16x8*)(kst + u * 8192 + KRSWZ(skey, scolB)) = pre[SL][u]; \
                _Pragma("unroll") for (int u = 0; u < 4; ++u) { const int t = (g_ + 3) * 4 + u; pre[SL][u] = *(const bf16x8*)(ksrc + (size_t)(t < ntile ? t : 0) * 64 * 64); } \
                __syncthreads(); \
                _Pragma("unroll") for (int u = 0; u < 4; ++u) { const int t = g_ * 4 + u; \
                    if (t < ntile) { f32x16 acc = {}; \
                        _Pragma("unroll") for (int s = 0; s < 4; ++s) { const bf16x8 kf = *(const bf16x8*)(kst + u * 8192 + KRSWZ(par * 32 + r32, (s * 16 + hi * 8) * 2)); acc = __builtin_amdgcn_mfma_f32_32x32x16_bf16(qa[s], kf, acc, 0, 0, 0); } \
                        float sc = 0.f; \
                        _Pragma("unroll") for (int r = 0; r < 16; ++r) sc = fmaf(wv[r], fmaxf(acc[r], 0.f), sc); \
                        sc += 0.f; \
                        const unsigned uu = __float_as_uint(sc); \
                        dst[t * 64] = (uu & 0x80000000u) ? ~uu : (uu | 0x80000000u); } } } while (0)
#pragma unroll 1
            for (int g0 = 0; g0 < ngrp; g0 += 3) {
                IDX_GROUP(0, g0);
                if (g0 + 1 < ngrp) IDX_GROUP(1, g0 + 1);
                if (g0 + 2 < ngrp) IDX_GROUP(2, g0 + 2);
            }
#undef IDX_GROUP
        }
        __syncthreads();
        {
            const unsigned* k = sk + wid * 4096;
            u32x4 kv[16];
#pragma unroll
            for (int j = 0; j < 16; ++j) kv[j] = (j * 256 < n && j * 256 + lane * 4 < n) ? *(const u32x4*)(k + j * 256 + lane * 4) : (u32x4){0u, 0u, 0u, 0u};
            unsigned prefix = 0;
#pragma unroll 1
            for (int bit = 31; bit >= 0; --bit) {
                const unsigned cand = prefix | (1u << bit);
                int cnt = 0;
#pragma unroll
                for (int j = 0; j < 16; ++j) if (j * 256 < n) cnt += (kv[j][0] >= cand) + (kv[j][1] >= cand) + (kv[j][2] >= cand) + (kv[j][3] >= cand);
                cnt = wave_sum_dpp(cnt);
                if (cnt >= 256) { prefix = cand; if (cnt == 256) break; }
            }
            int cgt = 0;
#pragma unroll
            for (int j = 0; j < 16; ++j) if (j * 256 < n) cgt += (kv[j][0] > prefix) + (kv[j][1] > prefix) + (kv[j][2] > prefix) + (kv[j][3] > prefix);
            cgt = wave_sum_dpp(cgt);
            const int need = 256 - cgt; int running = 0;
            u64* mr = mrow + (size_t)wid * ldm;
            const u64 lt = (1ull << lane) - 1ull;
#pragma unroll 1
            for (int blk = 0; blk < nblk_tot; ++blk) {
                u64 word = 0ull;
                if (blk * 64 < n) {
                    const unsigned v = k[blk * 64 + lane];
                    const u64 eqm = __ballot(v == prefix);
                    const int rank = running + __popcll(eqm & lt);
                    const bool sel = (v > prefix) || (v == prefix && rank < need);
                    word = __ballot(sel); running += __popcll(eqm);
                }
                if (lane == 0) mr[blk] = word;
            }
        }
        __syncthreads();
    }
}

#define KSWZ(row, colB) ((row) * 256 + ((colB) ^ (((row) & 7) << 4)))
__device__ __forceinline__ int crow(int r, int hi) { return (r & 3) + 8 * (r >> 2) + 4 * hi; }
__device__ __forceinline__ int v_st(int k, int c) { const int kk = (k & ~0xC) | ((k & 4) << 1) | ((k & 8) >> 1); return ((kk >> 3) * 4 + (c >> 5)) * 512 + ((kk & 7) * 32 + (c & 31)) * 2; }
__device__ __forceinline__ int v_rd_base(int lane) { return ((lane & 3) << 3) | (((lane >> 2) & 3) << 6) | (((lane >> 4) & 1) << 5) | (((lane >> 5) & 1) << 8); }
constexpr int v_rd_off(int d0, int ks, int half) { return d0 * 512 + ks * 4096 + half * 2048; }
template <int OFF> __device__ __forceinline__ s16x4 tr_read(int vb) { s16x4 r; asm volatile("ds_read_b64_tr_b16 %0, %1 offset:%2" : "=&v"(r) : "v"(vb), "i"(OFF) : "memory"); return r; }
template <int D0> __device__ __forceinline__ void pv_one(f32x16& od, int vb, bf16x8 pa0, bf16x8 pa1, bf16x8 pa2, bf16x8 pa3) {
    const s16x4 l0 = tr_read<v_rd_off(D0, 0, 0)>(vb), h0 = tr_read<v_rd_off(D0, 0, 1)>(vb), l1 = tr_read<v_rd_off(D0, 1, 0)>(vb), h1 = tr_read<v_rd_off(D0, 1, 1)>(vb);
    const s16x4 l2 = tr_read<v_rd_off(D0, 2, 0)>(vb), h2 = tr_read<v_rd_off(D0, 2, 1)>(vb), l3 = tr_read<v_rd_off(D0, 3, 0)>(vb), h3 = tr_read<v_rd_off(D0, 3, 1)>(vb);
    asm volatile("s_waitcnt lgkmcnt(0)" ::: "memory"); __builtin_amdgcn_sched_barrier(0);
#define PKV(L, H) (bf16x8){L[0], L[1], L[2], L[3], H[0], H[1], H[2], H[3]}
    od = __builtin_amdgcn_mfma_f32_32x32x16_bf16(pa0, PKV(l0, h0), od, 0, 0, 0);
    od = __builtin_amdgcn_mfma_f32_32x32x16_bf16(pa1, PKV(l1, h1), od, 0, 0, 0);
    od = __builtin_amdgcn_mfma_f32_32x32x16_bf16(pa2, PKV(l2, h2), od, 0, 0, 0);
    od = __builtin_amdgcn_mfma_f32_32x32x16_bf16(pa3, PKV(l3, h3), od, 0, 0, 0);
#undef PKV
}

struct AttnUnit {
    const bf16_t* Q; const bf16_t* Qr; const bf16_t* K; const bf16_t* V; const bf16_t* Kr; bf16_t* O; const bf16_t* G; const u64* M;
    int ldq, ldqr, ldk, ldo, ldg, ldm, nvalid, qpos0, NT, head;
};
constexpr int AT_V = 0, AT_K = 32768, AT_KR = 65536, AT_WS = 81920, AT_TB = 81920 + 2048;

template <int MODE>
__device__ __forceinline__ void attn_unit(const AttnUnit& u, char* lds, const float* t5, const float Cs  , const bool dry = false) {
    const int tid = opaque_tid(), wid = __builtin_amdgcn_readfirstlane(tid >> 6), lane = tid & 63, r32 = lane & 31, hi = lane >> 5;
    float* wsf = (float*)(lds + AT_WS) + wid * 64; float* al_l = wsf; float* li_l = wsf + 32;
    float* tb = (float*)(lds + AT_TB);
    const int rowb = wid * 32 + r32, rowc = rowb < u.nvalid ? rowb : u.nvalid - 1;
    const int wrow0 = (wid * 32 < u.nvalid) ? wid * 32 : u.nvalid - 1;
    const int qc_w = (u.qpos0 + wrow0) >> 6;
    const int qpos = u.qpos0 + rowc;
    constexpr int NQ = MODE == 1 ? 12 : 8;
    bf16x8 qr[NQ];
    { const bf16_t* Qw = u.Q + (size_t)rowc * u.ldq + hi * 8;
#pragma unroll
      for (int d0 = 0; d0 < 8; ++d0) qr[d0] = *(const bf16x8*)(Qw + d0 * 16);
      if constexpr (MODE == 1) { const bf16_t* Qw2 = u.Qr + (size_t)rowc * u.ldqr + hi * 8;
#pragma unroll
        for (int d0 = 0; d0 < 4; ++d0) qr[8 + d0] = *(const bf16x8*)(Qw2 + d0 * 16); } }
    if constexpr (MODE == 0) {
        if (tid < 155) { const int rel = tid - 63, nn = rel < 0 ? -rel : rel;
            const int bk = (rel < 0 ? 16 : 0) + (nn < 8 ? nn : 8 + (nn >= 12) + (nn >= 16) + (nn >= 23) + (nn >= 32) + (nn >= 46) + (nn >= 64) + (nn >= 91));
            tb[tid] = t5[bk * 8 + u.head] * LOG2E; }
    }
    float m_reg = -1e29f, l_reg = 0.f; f32x16 o[4];
#pragma unroll
    for (int d = 0; d < 4; ++d) o[d] = (f32x16){};
    const int vb0 = (int)(uintptr_t)(lds + AT_V) + v_rd_base(lane);
    int koff[2], voff[2], kroff = 0;
#pragma unroll
    for (int i = 0; i < 2; ++i) { const int X = (i * 8 + wid) * 1024 + lane * 16;
        { const int row = X >> 8, colB = (X & 255) ^ ((row & 7) << 4); koff[i] = row * u.ldk + (colB >> 1); }
        { const int sub = X >> 9, y = X & 511, kk = (sub >> 2) * 8 + (y >> 6), k = (kk & ~0xC) | ((kk & 4) << 1) | ((kk & 8) >> 1), c = (sub & 3) * 32 + ((y & 63) >> 1); voff[i] = k * u.ldk + c; } }
    if constexpr (MODE == 1) { const int X = wid * 1024 + lane * 16, row = X >> 7, colB = (X & 127) ^ (((row >> 1) & 7) << 4); kroff = row * 64 + (colB >> 1); }
    LAS char* ldl = (LAS char*)lds;
#define AT_ISSUE(b, k0) do { const bf16_t* kb_ = u.K + (size_t)(k0) * u.ldk; const bf16_t* vb_ = u.V + (size_t)(k0) * u.ldk; \
        _Pragma("unroll") for (int i_ = 0; i_ < 2; ++i_) { \
            __builtin_amdgcn_global_load_lds((const unsigned*)(kb_ + koff[i_]), (LAS unsigned*)(ldl + AT_K + (b) * 16384 + (i_ * 8 + wid) * 1024), 16, 0, 0); \
            __builtin_amdgcn_global_load_lds((const unsigned*)(vb_ + voff[i_]), (LAS unsigned*)(ldl + AT_V + (b) * 16384 + (i_ * 8 + wid) * 1024), 16, 0, 0); } \
        if constexpr (MODE == 1) __builtin_amdgcn_global_load_lds((const unsigned*)(u.Kr + (size_t)(k0) * 64 + kroff), (LAS unsigned*)(ldl + AT_KR + (b) * 8192 + wid * 1024), 16, 0, 0); } while (0)
    AT_ISSUE(0, 0);
    asm volatile("s_waitcnt vmcnt(0)" ::: "memory");
    __syncthreads();
#pragma unroll 1
    for (int j = 0; j < u.NT; ++j) {
        const int cur = j & 1;
        if (j + 1 < u.NT) AT_ISSUE(cur ^ 1, (j + 1) * 64);
        if (j <= qc_w && wid * 32 < u.nvalid) {
            u64 mw = 0;
            if constexpr (MODE == 0) mw = u.M[(size_t)rowc * u.ldm + j];
            f32x16 p0 = {}, p1 = {};
            const char* Ks = lds + AT_K + cur * 16384;
#pragma unroll
            for (int d0 = 0; d0 < 8; ++d0) { const int cb = (d0 * 16 + hi * 8) * 2;
                const bf16x8 b0 = *(const bf16x8*)(Ks + KSWZ(r32, cb)), b1 = *(const bf16x8*)(Ks + KSWZ(32 + r32, cb));
                p0 = __builtin_amdgcn_mfma_f32_32x32x16_bf16(b0, qr[d0], p0, 0, 0, 0); p1 = __builtin_amdgcn_mfma_f32_32x32x16_bf16(b1, qr[d0], p1, 0, 0, 0);
                if ((d0 & 3) == 3) __builtin_amdgcn_sched_barrier(0); }
            if constexpr (MODE == 1) { const char* Krs = lds + AT_KR + cur * 8192;
#pragma unroll
                for (int d0 = 0; d0 < 4; ++d0) { const int cb = (d0 * 16 + hi * 8) * 2;
                    const bf16x8 b0 = *(const bf16x8*)(Krs + KRSWZ(r32, cb)), b1 = *(const bf16x8*)(Krs + KRSWZ(32 + r32, cb));
                    p0 = __builtin_amdgcn_mfma_f32_32x32x16_bf16(b0, qr[8 + d0], p0, 0, 0, 0); p1 = __builtin_amdgcn_mfma_f32_32x32x16_bf16(b1, qr[8 + d0], p1, 0, 0, 0); } }
            if constexpr (MODE == 0) {
                const unsigned mlo = (unsigned)mw >> (4 * hi), mhi = (unsigned)(mw >> 32) >> (4 * hi);
                const int kb = j * 64;
                const bool far = (u.qpos0 + wrow0) - (kb + 63) >= 91;
                if (far) { const float bb = tb[154];
#pragma unroll
                    for (int r = 0; r < 16; ++r) { const int c0 = crow(r, 0);
                        p0[r] = ((mlo >> c0) & 1u) ? fmaf(p0[r], Cs, bb) : -1e30f; p1[r] = ((mhi >> c0) & 1u) ? fmaf(p1[r], Cs, bb) : -1e30f; }
                } else { const int rel0 = qpos - kb - 4 * hi;
#pragma unroll
                    for (int r = 0; r < 16; ++r) { const int c0 = crow(r, 0);
                        int i0 = rel0 - c0; i0 = i0 < -63 ? -63 : (i0 > 91 ? 91 : i0); int i1 = rel0 - c0 - 32; i1 = i1 < -63 ? -63 : (i1 > 91 ? 91 : i1);
                        p0[r] = ((mlo >> c0) & 1u) ? fmaf(p0[r], Cs, tb[i0 + 63]) : -1e30f; p1[r] = ((mhi >> c0) & 1u) ? fmaf(p1[r], Cs, tb[i1 + 63]) : -1e30f; }
                }
            }
            float pmax = p0[0];
#pragma unroll
            for (int r = 1; r < 16; ++r) pmax = fmaxf(pmax, p0[r]);
#pragma unroll
            for (int r = 0; r < 16; ++r) pmax = fmaxf(pmax, p1[r]);
            { auto rr = __builtin_amdgcn_permlane32_swap(__float_as_uint(pmax), __float_as_uint(pmax), false, false); pmax = fmaxf(__uint_as_float(rr[0]), __uint_as_float(rr[1])); }
            const float sc_ = MODE == 1 ? Cs : 1.f;
            const float mn = fmaxf(m_reg, pmax), alpha = __builtin_amdgcn_exp2f((m_reg - mn) * sc_), mns = -mn * sc_;
            m_reg = mn;
            float ps = 0.f;
#pragma unroll
            for (int r = 0; r < 16; ++r) { p0[r] = __builtin_amdgcn_exp2f(fmaf(p0[r], sc_, mns)); p1[r] = __builtin_amdgcn_exp2f(fmaf(p1[r], sc_, mns)); ps += p0[r] + p1[r]; }
            { auto rr = __builtin_amdgcn_permlane32_swap(__float_as_uint(ps), __float_as_uint(ps), false, false); ps = __uint_as_float(rr[0]) + __uint_as_float(rr[1]); }
            l_reg = l_reg * alpha + ps;
            if (__any(alpha < 1.f)) {
                if (hi == 0) al_l[r32] = alpha;
                asm volatile("s_waitcnt lgkmcnt(0)" ::: "memory");
#pragma unroll
                for (int r = 0; r < 16; ++r) { const float a = al_l[crow(r, hi)];
#pragma unroll
                    for (int d = 0; d < 4; ++d) o[d][r] *= a; }
            }
            bf16x8 pa0, pa1, pa2, pa3;
#define PK4(P, BASE, OUT) do { unsigned a0 = cvtpk(P[BASE + 0], P[BASE + 1]), a1 = cvtpk(P[BASE + 2], P[BASE + 3]);   \
    unsigned b0 = cvtpk(P[BASE + 4], P[BASE + 5]), b1 = cvtpk(P[BASE + 6], P[BASE + 7]);                              \
    auto r0 = __builtin_amdgcn_permlane32_swap(a0, b0, false, false); auto r1 = __builtin_amdgcn_permlane32_swap(a1, b1, false, false); \
    u32x4 w = {r0[0], r1[0], r0[1], r1[1]}; OUT = *reinterpret_cast<bf16x8*>(&w); } while (0)
            PK4(p0, 0, pa0); PK4(p0, 8, pa1); PK4(p1, 0, pa2); PK4(p1, 8, pa3);
#undef PK4
            const int vb = vb0 + cur * 16384;
            pv_one<0>(o[0], vb, pa0, pa1, pa2, pa3); pv_one<1>(o[1], vb, pa0, pa1, pa2, pa3); pv_one<2>(o[2], vb, pa0, pa1, pa2, pa3); pv_one<3>(o[3], vb, pa0, pa1, pa2, pa3);
        }
        asm volatile("s_waitcnt vmcnt(0)" ::: "memory");
        __syncthreads();
    }
#undef AT_ISSUE
    if (hi == 0) li_l[r32] = l_reg;
    asm volatile("s_waitcnt lgkmcnt(0)" ::: "memory");
#pragma unroll
    for (int r = 0; r < 16; ++r) {
        const int orow = wid * 32 + crow(r, hi);
        const float rl = __builtin_amdgcn_rcpf(li_l[crow(r, hi)]);
        if (orow < u.nvalid && !dry) {
#pragma unroll
            for (int d0 = 0; d0 < 4; ++d0) { const int c = d0 * 32 + r32;
                const float g = bf2f(u.G[(size_t)orow * u.ldg + c]);
                u.O[(size_t)orow * u.ldo + c] = f2bf(o[d0][r] * rl * g); }
        }
    }
    __syncthreads();
}

__device__ __forceinline__ void phase_attn_dsa(CPARAMS& p, char* lds, const bool dry = false) {
    const float Cs = 0.08838834764831845f * LOG2E;
    const int NU = 1024 + 64;
#pragma unroll 1
    for (int idx = blockIdx.x; idx < NU; idx += gridDim.x) {
        AttnUnit u;
        bf16_t* mix = (bf16_t*)(p.ws + W_MIX);
        if (idx < 1024) { const int k = idx >> 8, w = idx & 255, h = w & 7, qb0 = (w >> 3) & 15, b = (w >> 7) + 2 * k, qb = (k & 1) ? 15 - qb0 : qb0;
            const size_t row0 = (size_t)b * TP + qb * 256;
            u.Q = mix + row0 * 3072 + h * 128; u.O = mix + row0 * 3072 + h * 128; u.G = (const bf16_t*)(p.ws + W_SG) + row0 * 1024 + h * 128;
            u.K = (const bf16_t*)(p.ws + W_KP) + (size_t)b * TP * 1024 + h * 128; u.V = (const bf16_t*)(p.ws + W_VP) + (size_t)b * TP * 1024 + h * 128;
            u.M = (const u64*)(p.ws + W_MASKP) + row0 * 64; u.ldm = 64; u.nvalid = 256; u.qpos0 = qb * 256; u.NT = 4 * (qb + 1); u.head = h;
        } else { const int s = idx - 1024, b = s >> 3, h = s & 7; const size_t row0 = (size_t)NP + b * 64;
            u.Q = mix + row0 * 3072 + h * 128; u.O = mix + row0 * 3072 + h * 128; u.G = (const bf16_t*)(p.ws + W_SG) + row0 * 1024 + h * 128;
            u.K = (const bf16_t*)(p.ws + W_KS) + (size_t)b * LS * 1024 + h * 128; u.V = (const bf16_t*)(p.ws + W_VS) + (size_t)b * LS * 1024 + h * 128;
            u.M = (const u64*)(p.ws + W_MASKS) + (size_t)b * 64 * 32; u.ldm = 32; u.nvalid = 64; u.qpos0 = PAST; u.NT = 17; u.head = h; }
        u.Qr = nullptr; u.Kr = nullptr; u.ldq = 3072; u.ldqr = 0; u.ldk = 1024; u.ldo = 3072; u.ldg = 1024;
        attn_unit<0>(u, lds, p.in[I_T5], Cs, dry);
    }
}
__device__ __forceinline__ void phase_attn_mla(CPARAMS& p, char* lds, const bool dry = false) {
    const float Cs = 0.07216878364870323f * LOG2E;
    const int NU = 2048 + 128;
#pragma unroll 1
    for (int idx = blockIdx.x; idx < NU; idx += gridDim.x) {
        AttnUnit u;
        bf16_t* q2 = (bf16_t*)(p.ws + W_Q2); const bf16_t* kv = (const bf16_t*)(p.ws + W_KVALL); const bf16_t* kr = (const bf16_t*)(p.ws + W_KR);
        size_t row0, lrow0; int h;
        if (idx < 2048) { const int k = idx >> 8, w = idx & 255, qb0 = (w >> 4) & 15, b = k, qb = (k & 1) ? 15 - qb0 : qb0; h = w & 15;
            row0 = (size_t)b * TP + qb * 256; lrow0 = (size_t)b * TP; u.nvalid = 256; u.qpos0 = qb * 256; u.NT = 4 * (qb + 1);
        } else { const int s = idx - 2048, b = s >> 4; h = s & 15; row0 = (size_t)NP + b * 64; lrow0 = (size_t)NP + (size_t)b * LS; u.nvalid = 64; u.qpos0 = PAST; u.NT = 17; }
        u.Q = q2 + row0 * 3072 + h * 128; u.Qr = q2 + row0 * 3072 + 2048 + h * 64; u.O = q2 + row0 * 3072 + h * 128; u.G = (const bf16_t*)(p.ws + W_SGATE) + row0 * 2048 + h * 128;
        u.K = kv + lrow0 * 4096 + h * 128; u.V = kv + lrow0 * 4096 + 2048 + h * 128; u.Kr = kr + lrow0 * 64; u.M = nullptr;
        u.ldq = 3072; u.ldqr = 3072; u.ldk = 4096; u.ldo = 3072; u.ldg = 2048; u.ldm = 0; u.head = h;
        attn_unit<1>(u, lds, nullptr, Cs, dry);
    }
}

__device__ __forceinline__ void phase_conv(CPARAMS& p) {
    const int tid = opaque_tid();
    if (tid < 384) {
        const int ch = tid * 8;
        float cw[4][8], cb[8];
        { const float* cwp = p.in[I_CONVW] + ch; const float* cbp = p.in[I_CONVB] + ch;
#pragma unroll
          for (int j = 0; j < 4; ++j) { const f32x4 a = *(const f32x4*)(cwp + j * 3072), bq = *(const f32x4*)(cwp + j * 3072 + 4);
              cw[j][0] = a[0]; cw[j][1] = a[1]; cw[j][2] = a[2]; cw[j][3] = a[3]; cw[j][4] = bq[0]; cw[j][5] = bq[1]; cw[j][6] = bq[2]; cw[j][7] = bq[3]; }
          const f32x4 a = *(const f32x4*)cbp, bq = *(const f32x4*)(cbp + 4); cb[0] = a[0]; cb[1] = a[1]; cb[2] = a[2]; cb[3] = a[3]; cb[4] = bq[0]; cb[5] = bq[1]; cb[6] = bq[2]; cb[7] = bq[3]; }
        const bf16_t* xbc = (const bf16_t*)(p.ws + W_XBC);
        bf16_t* dst = ch < 2048 ? (bf16_t*)(p.ws + W_XACT) + ch : (bf16_t*)(p.ws + W_BCACT) + (ch - 2048);
        const int dstride = ch < 2048 ? 2048 : 1024;
#pragma unroll 1
        for (int unit = blockIdx.x; unit < MALL / 64; unit += gridDim.x) {
            const size_t row0 = (size_t)unit * 64;
            float w[3][8];
            const bool seqstart = row0 >= NP || (row0 & (TP - 1)) == 0;
            if (seqstart) {
                if (row0 >= NP) { const float* sp = p.in[I_SCONV] + ((row0 - NP) >> 6) * 3 * 3072 + ch;
#pragma unroll
                    for (int j = 0; j < 3; ++j) { const f32x4 a = *(const f32x4*)(sp + j * 3072), bq = *(const f32x4*)(sp + j * 3072 + 4);
                        w[j][0] = a[0]; w[j][1] = a[1]; w[j][2] = a[2]; w[j][3] = a[3]; w[j][4] = bq[0]; w[j][5] = bq[1]; w[j][6] = bq[2]; w[j][7] = bq[3]; } }
                else {
#pragma unroll
                    for (int j = 0; j < 3; ++j)
#pragma unroll
                        for (int e = 0; e < 8; ++e) w[j][e] = 0.f; }
            } else {
#pragma unroll
                for (int j = 0; j < 3; ++j) { const bf16x8 r = *(const bf16x8*)(xbc + (row0 - 3 + j) * 3072 + ch);
#pragma unroll
                    for (int e = 0; e < 8; ++e) w[j][e] = bf2f((bf16_t)r[e]); }
            }
#pragma unroll 1
            for (int r0 = 0; r0 < 64; r0 += 8) {
                bf16x8 raw[8];
#pragma unroll
                for (int r = 0; r < 8; ++r) raw[r] = *(const bf16x8*)(xbc + (row0 + r0 + r) * 3072 + ch);
#pragma unroll
                for (int r = 0; r < 8; ++r) { float o[8];
#pragma unroll
                    for (int e = 0; e < 8; ++e) { const float cur = bf2f((bf16_t)raw[r][e]);
                        o[e] = silu_f(cb[e] + cw[0][e] * w[0][e] + cw[1][e] * w[1][e] + cw[2][e] * w[2][e] + cw[3][e] * cur);
                        w[0][e] = w[1][e]; w[1][e] = w[2][e]; w[2][e] = cur; }
                    *(bf16x8*)(dst + (row0 + r0 + r) * dstride) = pack8(o); }
            }
        }
    }
}

constexpr int SD_XT = 0, SD_BS = 9216, SD_BTT = 26624, SD_CS = 45056, SD_CS2 = 62464, SD_WS = 79872, SD_H0 = 89088, SD_F = 106496;
__device__ __forceinline__ void phase_ssd(CPARAMS& p, char* lds, const bool dry = false) {
    const int tid = opaque_tid(), wid = tid >> 6, lane = tid & 63, l16 = lane & 15, lq = lane >> 4;
    bf16_t* XT = (bf16_t*)(lds + SD_XT); bf16_t* Bs = (bf16_t*)(lds + SD_BS); bf16_t* BTt = (bf16_t*)(lds + SD_BTT); bf16_t* Cs = (bf16_t*)(lds + SD_CS);
    bf16_t* Cs2 = (bf16_t*)(lds + SD_CS2); bf16_t* Ws = (bf16_t*)(lds + SD_WS); bf16_t* H0 = (bf16_t*)(lds + SD_H0);
    float* s_acum = (float*)(lds + SD_F); float* s_dt = s_acum + 64; float* s_ea = s_acum + 128; float* s_tail = s_acum + 192; float* s_ssq = s_acum + 256;
    const bf16_t* xbc = (const bf16_t*)(p.ws + W_XBC); bf16_t* mix = (bf16_t*)(p.ws + W_MIX);
    const float* dtbuf = (const float*)(p.ws + W_DT); float* ssqg = (float*)(p.ws + W_SSQ);
#pragma unroll 1
    for (int idx = blockIdx.x; idx < 512; idx += gridDim.x) {
        const bool sample = idx >= 256; const int bh = idx & 255, b = bh >> 5, h = bh & 31, g = h >> 3;
        const size_t row0 = sample ? (size_t)NP + b * 64 : (size_t)b * TP; const int nch = sample ? 1 : 64;
        const float a_h = -__expf(p.in[I_ALOG][h]), d_h = p.in[I_DSKIP][h];
        f32x4 hacc[4];
        const int pt = wid >> 1;
#pragma unroll
        for (int j = 0; j < 4; ++j) { const int nt = (wid & 1) * 4 + j;
#pragma unroll
            for (int i = 0; i < 4; ++i) { const int pp = pt * 16 + 4 * lq + i, nn = nt * 16 + l16;
                hacc[j][i] = sample ? p.in[I_SSSM][(((size_t)b * 32 + h) * 64 + pp) * 128 + nn] : 0.f;
                H0[pp * 136 + nn] = f2bf(hacc[j][i]); } }
        const int cg8 = tid % 40, rb = tid / 40; const bool ldr = tid < 320;
        const bf16_t* asrc = cg8 < 8 ? (const bf16_t*)(p.ws + W_XACT) + h * 64 + cg8 * 8 : (const bf16_t*)(p.ws + W_BCACT) + (cg8 < 24 ? g * 128 + (cg8 - 8) * 8 : 512 + g * 128 + (cg8 - 24) * 8);
        const size_t astride = cg8 < 8 ? 2048 : 1024;
        bf16x8 av[8];
#pragma unroll
        for (int r = 0; r < 8; ++r) av[r] = ldr ? *(const bf16x8*)(asrc + (row0 + rb * 8 + r) * astride) : (bf16x8){0, 0, 0, 0, 0, 0, 0, 0};
        float dt_next = (wid == 0) ? dtbuf[(row0 + lane) * 32 + h] : 0.f;
        bf16_t szv[2][4];
#pragma unroll
        for (int q = 0; q < 2; ++q) { const int id = wid * 2 + q, mt = id >> 2, nt = id & 3;
#pragma unroll
            for (int i = 0; i < 4; ++i) szv[q][i] = mix[(row0 + mt * 16 + 4 * lq + i) * 3072 + 1024 + h * 64 + nt * 16 + l16]; }
#pragma unroll 1
        for (int c = 0; c < nch; ++c) {
            const size_t crow0 = row0 + (size_t)c * 64;
            if (wid == 0) {
                if (c > 0 && !dry) ssqg[(size_t)h * MALL + (crow0 - 64 + lane)] = (s_ssq[lane] + s_ssq[64 + lane]) + (s_ssq[128 + lane] + s_ssq[192 + lane]);
                const float dtv = dt_next; float ac = dtv * a_h;
                if (c + 1 < nch) dt_next = dtbuf[(crow0 + 64 + lane) * 32 + h];
                ac = wave_scan_incl(ac, lane);
                const float a63 = __builtin_bit_cast(float, __builtin_amdgcn_readlane(__builtin_bit_cast(int, ac), 63));
                s_acum[lane] = ac; s_dt[lane] = dtv; s_ea[lane] = __expf(ac); s_tail[lane] = __expf(a63 - ac) * dtv;
            }
            __syncthreads();
            if (ldr) {
                const int t0l = rb * 8;
#pragma unroll
                for (int hf = 0; hf < 2; ++hf) {
                    float vout[8][4];
#pragma unroll
                    for (int r = 0; r < 8; ++r)
#pragma unroll
                        for (int e = 0; e < 4; ++e) vout[r][e] = bf2f((bf16_t)av[r][hf * 4 + e]);
                    if (cg8 < 8) {
#pragma unroll
                        for (int e = 0; e < 4; ++e) { float t[8];
#pragma unroll
                            for (int r = 0; r < 8; ++r) t[r] = vout[r][e];
                            *(bf16x8*)(XT + (cg8 * 8 + hf * 4 + e) * 72 + t0l) = pack8(t); }
                    } else if (cg8 < 24) {
                        const int n0 = (cg8 - 8) * 8 + hf * 4;
#pragma unroll
                        for (int r = 0; r < 8; ++r) { const f32x4 q = {vout[r][0], vout[r][1], vout[r][2], vout[r][3]}; *(u32x2*)(Bs + (t0l + r) * 136 + n0) = pack4(q); }
                        float tl8[8];
#pragma unroll
                        for (int r = 0; r < 8; ++r) tl8[r] = s_tail[t0l + r];
#pragma unroll
                        for (int e = 0; e < 4; ++e) { float t[8];
#pragma unroll
                            for (int r = 0; r < 8; ++r) t[r] = vout[r][e] * tl8[r];
                            *(bf16x8*)(BTt + (n0 + e) * 72 + t0l) = pack8(t); }
                    } else {
                        const int n0 = (cg8 - 24) * 8 + hf * 4;
#pragma unroll
                        for (int r = 0; r < 8; ++r) { const f32x4 q = {vout[r][0], vout[r][1], vout[r][2], vout[r][3]}; *(u32x2*)(Cs + (t0l + r) * 136 + n0) = pack4(q);
                            const float ea = s_ea[t0l + r]; *(u32x2*)(Cs2 + (t0l + r) * 136 + n0) = pack4(q * ea); }
                    }
                }
                if (c + 1 < nch) {
#pragma unroll
                    for (int r = 0; r < 8; ++r) av[r] = *(const bf16x8*)(asrc + (crow0 + 64 + rb * 8 + r) * astride);
                }
            }
            __syncthreads();
#pragma unroll
            for (int q = 0; q < 2; ++q) { const int id = wid * 2 + q, mt = id >> 2, nt = id & 3;
                f32x4 acc = {0.f, 0.f, 0.f, 0.f};
                if (nt <= mt) {
#pragma unroll
                    for (int ks = 0; ks < 4; ++ks) { const bf16x8 af = *(const bf16x8*)(Cs + (mt * 16 + l16) * 136 + ks * 32 + lq * 8), bf = *(const bf16x8*)(Bs + (nt * 16 + l16) * 136 + ks * 32 + lq * 8);
                        acc = __builtin_amdgcn_mfma_f32_16x16x32_bf16(af, bf, acc, 0, 0, 0); }
                }
                const int s = nt * 16 + l16; const float as = s_acum[s], dts = s_dt[s];
#pragma unroll
                for (int i = 0; i < 4; ++i) { const int t = mt * 16 + 4 * lq + i; const float w = (s <= t) ? acc[i] * __expf(s_acum[t] - as) * dts : 0.f; Ws[t * 72 + s] = f2bf(w); }
            }
            __syncthreads();
#pragma unroll
            for (int q = 0; q < 2; ++q) { const int id = wid * 2 + q, mt = id >> 2, nt = id & 3;
                f32x4 acc = {0.f, 0.f, 0.f, 0.f};
#pragma unroll
                for (int ks = 0; ks < 2; ++ks) { const bf16x8 af = *(const bf16x8*)(Ws + (mt * 16 + l16) * 72 + ks * 32 + lq * 8), bf = *(const bf16x8*)(XT + (nt * 16 + l16) * 72 + ks * 32 + lq * 8);
                    acc = __builtin_amdgcn_mfma_f32_16x16x32_bf16(af, bf, acc, 0, 0, 0); }
#pragma unroll
                for (int ks = 0; ks < 4; ++ks) { const bf16x8 af = *(const bf16x8*)(Cs2 + (mt * 16 + l16) * 136 + ks * 32 + lq * 8), bf = *(const bf16x8*)(H0 + (nt * 16 + l16) * 136 + ks * 32 + lq * 8);
                    acc = __builtin_amdgcn_mfma_f32_16x16x32_bf16(af, bf, acc, 0, 0, 0); }
                const int pp = nt * 16 + l16;
#pragma unroll
                for (int i = 0; i < 4; ++i) { const int t = mt * 16 + 4 * lq + i;
                    const float xv = bf2f(XT[pp * 72 + t]);
                    const float yg = (acc[i] + d_h * xv) * bf2f(szv[q][i]);
                    if (!dry) mix[(crow0 + t) * 3072 + 1024 + h * 64 + pp] = f2bf(yg);
                    float sq = yg * yg;
                    sq = row16_sum(sq);
                    if (l16 == 0) s_ssq[nt * 64 + t] = sq; }
            }
            if (c + 1 < nch) {
#pragma unroll
                for (int q = 0; q < 2; ++q) { const int id = wid * 2 + q, mt = id >> 2, nt = id & 3;
#pragma unroll
                    for (int i = 0; i < 4; ++i) szv[q][i] = mix[(crow0 + 64 + mt * 16 + 4 * lq + i) * 3072 + 1024 + h * 64 + nt * 16 + l16]; } }
            const float e63 = s_ea[63];
            __syncthreads();
#pragma unroll
            for (int j = 0; j < 4; ++j) { const int nt = (wid & 1) * 4 + j;
                f32x4 acc = hacc[j] * e63;
#pragma unroll
                for (int ks = 0; ks < 2; ++ks) { const bf16x8 af = *(const bf16x8*)(XT + (pt * 16 + l16) * 72 + ks * 32 + lq * 8), bf = *(const bf16x8*)(BTt + (nt * 16 + l16) * 72 + ks * 32 + lq * 8);
                    acc = __builtin_amdgcn_mfma_f32_16x16x32_bf16(af, bf, acc, 0, 0, 0); }
                hacc[j] = acc;
#pragma unroll
                for (int i = 0; i < 4; ++i) H0[(pt * 16 + 4 * lq + i) * 136 + nt * 16 + l16] = f2bf(acc[i]);
            }
        }
        __syncthreads();
        if (wid == 0 && !dry) ssqg[(size_t)h * MALL + (row0 + (size_t)(nch - 1) * 64 + lane)] = (s_ssq[lane] + s_ssq[64 + lane]) + (s_ssq[128 + lane] + s_ssq[192 + lane]);
        if (!dry) { float* ho = p.out + (sample ? O_BSS : O_BSP) + ((size_t)b * 32 + h) * 64 * 128;
#pragma unroll
          for (int j = 0; j < 4; ++j) { const int nt = (wid & 1) * 4 + j;
#pragma unroll
              for (int i = 0; i < 4; ++i) ho[(size_t)(pt * 16 + 4 * lq + i) * 128 + nt * 16 + l16] = hacc[j][i]; } }
        __syncthreads();
    }
}

__device__ __forceinline__ void phase_bnorm(CPARAMS& p) {
    bf16_t* mix = (bf16_t*)(p.ws + W_MIX); const float* ssq = (const float*)(p.ws + W_SSQ); const float* nw = p.in[I_SNORM];
    const size_t n = (size_t)MALL * 256, stride = (size_t)gridDim.x * 512;
    const int tidb = opaque_tid();
    for (size_t i0 = (size_t)blockIdx.x * 512 + tidb; i0 < n; i0 += 4 * stride) {
        bf16x8 v[4]; float tot[4];
#pragma unroll
        for (int u = 0; u < 4; ++u) { const size_t i = i0 + u * stride; tot[u] = 0.f; v[u] = (bf16x8){0, 0, 0, 0, 0, 0, 0, 0};
            if (i < n) { const size_t row = i >> 8; const int c0 = (int)(i & 255) * 8, g = c0 >> 9;
                v[u] = *(const bf16x8*)(mix + row * 3072 + 1024 + c0);
#pragma unroll
                for (int hh = 0; hh < 8; ++hh) tot[u] += ssq[(size_t)(g * 8 + hh) * MALL + row]; } }
#pragma unroll
        for (int u = 0; u < 4; ++u) { const size_t i = i0 + u * stride;
            if (i < n) { const size_t row = i >> 8; const int c0 = (int)(i & 255) * 8;
                const float r = rsqrtf(tot[u] * (1.f / 512.f) + EPSV);
                const f32x4 w0 = *(const f32x4*)(nw + c0), w1 = *(const f32x4*)(nw + c0 + 4);
                float t[8];
#pragma unroll
                for (int e2 = 0; e2 < 8; ++e2) t[e2] = bf2f((bf16_t)v[u][e2]) * r * (e2 < 4 ? w0[e2] : w1[e2 - 4]);
                *(bf16x8*)(mix + row * 3072 + 1024 + c0) = pack8(t); } }
    }
}
__device__ __forceinline__ void phase_ln(CPARAMS& p, const float* gw, const float* bw, bf16_t* yb, const bool dry = false) {
    int tid_ = threadIdx.x; asm volatile("" : "+v"(tid_));
    const int wid = tid_ >> 6, lane = tid_ & 63;
    float* y = p.out + O_Y;
    for (int row = blockIdx.x * 8 + wid; row < MALL; row += gridDim.x * 8) {
        float* rp = y + (size_t)row * DM;
        f32x4 v[8]; float s = 0.f;
#pragma unroll
        for (int j = 0; j < 8; ++j) { v[j] = *(const f32x4*)(rp + j * 256 + lane * 4); s += v[j][0] + v[j][1] + v[j][2] + v[j][3]; }
        const float mu = wave_sum(s) * (1.f / DM);
        float q = 0.f;
#pragma unroll
        for (int j = 0; j < 8; ++j) { v[j] = v[j] - mu; q += v[j][0] * v[j][0] + v[j][1] * v[j][1] + v[j][2] * v[j][2] + v[j][3] * v[j][3]; }
        const float rs = rsqrtf(wave_sum(q) * (1.f / DM) + EPSV);
#pragma unroll
        for (int j = 0; j < 8; ++j) { const int c = j * 256 + lane * 4; const f32x4 gg = *(const f32x4*)(gw + c), bb = *(const f32x4*)(bw + c);
            const f32x4 o = v[j] * rs * gg + bb; if (!dry) { *(f32x4*)(rp + c) = o; if (yb) *(u32x2*)(yb + (size_t)row * DM + c) = pack4(o); } else if (o[0] == 1.2345e30f) rp[c] = 0.f; }
    }
}
__device__ __forceinline__ void phase_post1(CPARAMS& p) {
    const int tidp = opaque_tid(); const int wid = tidp >> 6, lane = tidp & 63;
    const float* cqkv = (const float*)(p.ws + W_CQKV); bf16_t* cqn = (bf16_t*)(p.ws + W_CQN); bf16_t* lat = (bf16_t*)(p.ws + W_LAT); bf16_t* krb = (bf16_t*)(p.ws + W_KR);
    const float2* tab = (const float2*)(p.ws + W_ROPE);
    for (int row = blockIdx.x * 8 + wid; row < MALL; row += gridDim.x * 8) {
        const float* rp = cqkv + (size_t)row * 1088;
        const f32x4 a0 = *(const f32x4*)(rp + lane * 8), a1 = *(const f32x4*)(rp + lane * 8 + 4), c0 = *(const f32x4*)(rp + 512 + lane * 8), c1 = *(const f32x4*)(rp + 512 + lane * 8 + 4);
        const float kv = rp[1024 + lane];
        float sa = 0.f, sc = 0.f;
#pragma unroll
        for (int e = 0; e < 4; ++e) { sa += a0[e] * a0[e] + a1[e] * a1[e]; sc += c0[e] * c0[e] + c1[e] * c1[e]; }
        const float ra = rsqrtf(wave_sum(sa) * (1.f / 512.f) + EPSV), rc = rsqrtf(wave_sum(sc) * (1.f / 512.f) + EPSV);
        const f32x4 qw0 = *(const f32x4*)(p.in[I_QNW] + lane * 8), qw1 = *(const f32x4*)(p.in[I_QNW] + lane * 8 + 4), kw0 = *(const f32x4*)(p.in[I_KVNW] + lane * 8), kw1 = *(const f32x4*)(p.in[I_KVNW] + lane * 8 + 4);
        const f32x4 qa = a0 * ra * qw0, qb = a1 * ra * qw1, la = c0 * rc * kw0, lb = c1 * rc * kw1;
        { const float t[8] = {qa[0], qa[1], qa[2], qa[3], qb[0], qb[1], qb[2], qb[3]}; *(bf16x8*)(cqn + (size_t)row * 512 + lane * 8) = pack8(t); }
        const int lr = latrow_of(row);
        { const float t[8] = {la[0], la[1], la[2], la[3], lb[0], lb[1], lb[2], lb[3]}; *(bf16x8*)(lat + (size_t)lr * 512 + lane * 8) = pack8(t); }
        float* clo = row < NP ? p.out + O_CLP + (size_t)row * 512 : p.out + O_CLS + (size_t)(row - NP) * 512;
        *(f32x4*)(clo + lane * 8) = la; *(f32x4*)(clo + lane * 8 + 4) = lb;
        const float other = __shfl_xor(kv, 32);
        const int i = lane & 31, pos = pos_of(row); const float2 cs = tab[(size_t)pos * 32 + i];
        const float o = lane < 32 ? kv * cs.x - other * cs.y : other * cs.y + kv * cs.x;
        float* cko = row < NP ? p.out + O_CKP + (size_t)row * 64 : p.out + O_CKS + (size_t)(row - NP) * 64;
        cko[lane] = o;
        krb[(size_t)lr * 64 + 4 * (i >> 1) + (i & 1) + (lane >= 32 ? 2 : 0)] = f2bf(o);
    }
    const size_t gtid = (size_t)blockIdx.x * 512 + tidp, gstride = (size_t)gridDim.x * 512;
    { const size_t n8 = (size_t)8 * PAST * 512 / 8;
      for (size_t i = gtid; i < n8; i += gstride) { const size_t e = i * 8, b = e / ((size_t)PAST * 512), rem = e % ((size_t)PAST * 512); const float* s = p.in[I_CLAT] + e;
        const f32x4 a = *(const f32x4*)s, c = *(const f32x4*)(s + 4); const float t[8] = {a[0], a[1], a[2], a[3], c[0], c[1], c[2], c[3]};
        *(bf16x8*)(lat + ((size_t)NP + b * LS) * 512 + rem) = pack8(t); } }
    { const size_t n = (size_t)8 * PAST * 64;
      for (size_t e = gtid; e < n; e += gstride) { const size_t b = e / ((size_t)PAST * 64), rem = e % ((size_t)PAST * 64), t = rem >> 6; const int j = (int)(rem & 63), i = j & 31;
        krb[((size_t)NP + b * LS + t) * 64 + 4 * (i >> 1) + (i & 1) + (j >= 32 ? 2 : 0)] = f2bf(p.in[I_CKR][e]); } }
}

__device__ __forceinline__ CPARAMS& get_params() {
    const unsigned long long v = (unsigned long long)__builtin_amdgcn_kernarg_segment_ptr(); unsigned lo = (unsigned)v, hi = (unsigned)(v >> 32);
    asm volatile("" : "+s"(lo), "+s"(hi));
    lo = __builtin_amdgcn_readfirstlane(lo); hi = __builtin_amdgcn_readfirstlane(hi);
    return *(CPARAMS*)(((unsigned long long)hi << 32) | lo);
}
#ifndef PROBE_STOP
#define PROBE_STOP 0
#endif
__device__ __forceinline__ void phase_dump(CPARAMS& p) {
    const unsigned short* w = (const unsigned short*)p.ws; float* y = p.out + O_Y; const size_t n = (size_t)MALL * DM;
#ifdef PROBE_THRASH
    { const f32x4* xs = (const f32x4*)p.in[I_XP] + (size_t)((blockIdx.x >> 3) & 31) * (NP * (size_t)DM / 4 / 32); f32x4 a = {0.f, 0.f, 0.f, 0.f};
      for (size_t i = threadIdx.x; i < NP * (size_t)DM / 4 / 32; i += 512) a += xs[i];
      if (a[0] + a[1] + a[2] + a[3] == 1.2345e30f) y[0] = 1.f;
      __syncthreads(); __threadfence(); }
    cg::this_grid().sync(); __threadfence();
#endif
    for (size_t i = (size_t)blockIdx.x * 512 + threadIdx.x; i < n; i += (size_t)gridDim.x * 512) {
        unsigned h = 0x12345u;
#pragma unroll
        for (int r = 0; r < 8; ++r) { const size_t o = (size_t)r * n + i; const unsigned v = (o * 2 < W_END) ? w[o] : 0u; h = (h ^ v) * 0x9E3779B1u; }
        h ^= h >> 15; y[i] = (float)((h >> 8) & 127u);
    }
}
#define PROBE_AT(k) do { if (PROBE_STOP == (k)) { CPARAMS& pq = get_params(); phase_dump(pq); return; } } while (0)
__global__ void __launch_bounds__(512) fwd_megakernel(Params p_unused) {
    extern __shared__ __attribute__((aligned(16))) char lds[];
    cg::grid_group grid = cg::this_grid();
#ifndef TIME_X2
#define TIME_X2 0
#endif
    const bool dryflag = get_params().ws != nullptr;
    unsigned nbar = 0;
#define GSYNC_CG() do { __builtin_amdgcn_fence(__ATOMIC_RELEASE, "agent"); asm volatile("s_waitcnt vmcnt(0)" ::: "memory"); grid.sync(); __builtin_amdgcn_fence(__ATOMIC_ACQUIRE, "agent"); } while (0)
#define GSYNC() do { ++nbar; asm volatile("s_waitcnt vmcnt(0)" ::: "memory"); __syncthreads(); \
        if (threadIdx.x == 0) { unsigned* ctr_ = (unsigned*)(get_params().ws + W_BAR); const unsigned tgt_ = nbar * gridDim.x; \
            __builtin_amdgcn_fence(__ATOMIC_RELEASE, "agent"); asm volatile("s_waitcnt vmcnt(0)" ::: "memory"); \
            __hip_atomic_fetch_add(ctr_, 1u, __ATOMIC_RELAXED, __HIP_MEMORY_SCOPE_AGENT); \
            while (__hip_atomic_load(ctr_, __ATOMIC_RELAXED, __HIP_MEMORY_SCOPE_AGENT) < tgt_) __builtin_amdgcn_s_sleep(1); \
            __builtin_amdgcn_fence(__ATOMIC_ACQUIRE, "agent"); asm volatile("s_waitcnt vmcnt(0)" ::: "memory"); } \
        __syncthreads(); } while (0)
    if (TIME_X2 == 1) { CPARAMS& p = get_params(); phase_prep(p, lds); __syncthreads(); }
    { CPARAMS& p = get_params(); phase_prep(p, lds); }
    if (__builtin_expect(get_params().ws == nullptr, 0)) GSYNC_CG();
    GSYNC();
    PROBE_AT(1);
    if (TIME_X2 == 2)
    { CPARAMS& p = get_params(); pg8::Gemm g; g.A = (const bf16_t*)(p.ws + W_XB); g.Bt = (const bf16_t*)(p.ws + W_BT0); g.M = MALL; g.N = NIN0P; g.K = DM; g.lda = DM;
      pg8::StaticOrder S; S.init(MALL, NIN0P, (int)gridDim.x, (int)blockIdx.x); EpiInProj0 E{p.ws, p.out, p.in[I_DTB]};
      pg8::gemm_phase<EpiInProj0, pg8::StaticOrder>((PG8_LAS unsigned char*)lds, g, S, E); }
    { CPARAMS& p = get_params(); pg8::Gemm g; g.A = (const bf16_t*)(p.ws + W_XB); g.Bt = (const bf16_t*)(p.ws + W_BT0); g.M = MALL; g.N = NIN0P; g.K = DM; g.lda = DM;
      pg8::StaticOrder S; S.init(MALL, NIN0P, (int)gridDim.x, (int)blockIdx.x); EpiInProj0 E{p.ws, p.out, p.in[I_DTB]};
      pg8::gemm_phase<EpiInProj0, pg8::StaticOrder>((PG8_LAS unsigned char*)lds, g, S, E); }
    GSYNC();
    PROBE_AT(2);
    if (TIME_X2 == 3) { CPARAMS& p = get_params(); phase_index(p, lds); }
    if (TIME_X2 == 12) { CPARAMS& p = get_params(); phase_conv(p); }
    { CPARAMS& p = get_params(); phase_conv(p); }
    { CPARAMS& p = get_params(); phase_index(p, lds); }
    GSYNC();
    PROBE_AT(3);
    if (TIME_X2 == 4) { CPARAMS& p = get_params(); phase_attn_dsa(p, lds, dryflag); }
    if (TIME_X2 == 5) { CPARAMS& p = get_params(); phase_ssd(p, lds, dryflag); }
#ifndef PROBE_SKIP_DSA
    { CPARAMS& p = get_params(); phase_attn_dsa(p, lds); }
#endif
#ifndef PROBE_SKIP_SSD
    { CPARAMS& p = get_params(); phase_ssd(p, lds); }
#endif
    GSYNC();
    PROBE_AT(4);
    { CPARAMS& p = get_params(); phase_bnorm(p); }
    GSYNC();
    PROBE_AT(5);
    if (TIME_X2 == 6)
    { CPARAMS& p = get_params(); FResid f{p.in[I_XP], p.in[I_XS], p.out + O_Y}; run_gemm(lds, (const bf16_t*)(p.ws + W_MIX), 3072, (const bf16_t*)(p.ws + W_BTOUT0), MALL, DM, 3072, f); }
    { CPARAMS& p = get_params(); FResid f{p.in[I_XP], p.in[I_XS], p.out + O_Y}; run_gemm(lds, (const bf16_t*)(p.ws + W_MIX), 3072, (const bf16_t*)(p.ws + W_BTOUT0), MALL, DM, 3072, f); }
    GSYNC();
    PROBE_AT(6);
    if (TIME_X2 == 7) { CPARAMS& p = get_params(); phase_ln(p, p.in[I_LN0G], p.in[I_LN0B], (bf16_t*)(p.ws + W_XB), dryflag); }
    { CPARAMS& p = get_params(); phase_ln(p, p.in[I_LN0G], p.in[I_LN0B], (bf16_t*)(p.ws + W_XB)); }
    GSYNC();
    PROBE_AT(7);
    if (TIME_X2 == 8)
    { CPARAMS& p = get_params(); FInProj1 f{p.ws}; run_gemm(lds, (const bf16_t*)(p.ws + W_XB), DM, (const bf16_t*)(p.ws + W_BT1), MALL, NIN1P, DM, f); }
    { CPARAMS& p = get_params(); FInProj1 f{p.ws}; run_gemm(lds, (const bf16_t*)(p.ws + W_XB), DM, (const bf16_t*)(p.ws + W_BT1), MALL, NIN1P, DM, f); }
    GSYNC();
    PROBE_AT(8);
    if (TIME_X2 == 9) { CPARAMS& p = get_params(); phase_post1(p); }
    { CPARAMS& p = get_params(); phase_post1(p); }
    GSYNC();
    PROBE_AT(9);
    if (TIME_X2 == 10)
    { CPARAMS& p = get_params(); FQUp f{p.ws}; run_gemm(lds, (const bf16_t*)(p.ws + W_CQN), 512, (const bf16_t*)(p.ws + W_BTUQ), MALL, 3072, 512, f); }
    { CPARAMS& p = get_params(); FQUp f{p.ws}; run_gemm(lds, (const bf16_t*)(p.ws + W_CQN), 512, (const bf16_t*)(p.ws + W_BTUQ), MALL, 3072, 512, f); }
    { CPARAMS& p = get_params(); FKvUp f{p.ws}; run_gemm(lds, (const bf16_t*)(p.ws + W_LAT), 512, (const bf16_t*)(p.ws + W_BTUKV), LATROWS, 4096, 512, f, true); }
    GSYNC();
    PROBE_AT(10);
    if (TIME_X2 == 11) { CPARAMS& p = get_params(); phase_attn_mla(p, lds, dryflag); }
    { CPARAMS& p = get_params(); phase_attn_mla(p, lds); }
    GSYNC();
    PROBE_AT(11);
    { CPARAMS& p = get_params(); FResid f{p.out + O_Y, p.out + O_Y + (size_t)NP * DM, p.out + O_Y}; run_gemm(lds, (const bf16_t*)(p.ws + W_Q2), 3072, (const bf16_t*)(p.ws + W_BTOUT1), MALL, DM, DM, f); }
    GSYNC();
    PROBE_AT(12);
    { CPARAMS& p = get_params(); phase_ln(p, p.in[I_LN1G], p.in[I_LN1B], nullptr); }
}

extern "C" void kernel_launch(void* const* d_in, const int* in_sizes, int n_in, void* d_out, int out_size, void* d_ws, size_t ws_size, hipStream_t stream) {
    static int grid_blocks = 0;
    if (!grid_blocks) {
        if (n_in != N_IN || (size_t)out_size != O_END || ws_size < W_END) { fprintf(stderr, "kernel_launch: unexpected shapes n_in %d out %d ws %zu\n", n_in, out_size, ws_size); return; }
        if (hipFuncSetAttribute((const void*)fwd_megakernel, hipFuncAttributeMaxDynamicSharedMemorySize, LDS_BYTES) != hipSuccess) { fprintf(stderr, "kernel_launch: LDS attribute failed\n"); return; }
        int dev = 0, cus = 0, per_cu = 0;
        hipGetDevice(&dev); hipDeviceGetAttribute(&cus, hipDeviceAttributeMultiprocessorCount, dev);
        hipOccupancyMaxActiveBlocksPerMultiprocessor(&per_cu, fwd_megakernel, 512, LDS_BYTES);
        if (per_cu < 1) { fprintf(stderr, "kernel_launch: occupancy 0\n"); return; }
        grid_blocks = cus;
    }
    if (hipMemsetAsync((char*)d_ws + W_BAR, 0, 256, stream) != hipSuccess) { fprintf(stderr, "kernel_launch: memset failed\n"); return; }
    Params p{};
    for (int i = 0; i < N_IN; ++i) p.in[i] = (const float*)d_in[i];
    p.out = (float*)d_out; p.ws = (char*)d_ws;
    void* args[] = {&p};
    hipError_t e = hipLaunchCooperativeKernel((const void*)fwd_megakernel, dim3(grid_blocks), dim3(512), args, LDS_BYTES, stream);
    if (e != hipSuccess) fprintf(stderr, "cooperative launch failed: %s (grid %d)\n", hipGetErrorString(e), grid_blocks);
}
```

```cpp
#include <hip/hip_runtime.h>
#include <hip/hip_cooperative_groups.h>
#include <cstdio>
#include <cstdint>
namespace cg = cooperative_groups;

#define LAS __attribute__((address_space(3)))
typedef unsigned short bf16_t;
typedef short bf16x8 __attribute__((ext_vector_type(8)));
typedef short s16x4 __attribute__((ext_vector_type(4)));
typedef float f32x4 __attribute__((ext_vector_type(4)));
typedef float f32x8 __attribute__((ext_vector_type(8)));
typedef float f32x16 __attribute__((ext_vector_type(16)));
typedef unsigned u32x4 __attribute__((ext_vector_type(4)));
typedef unsigned u32x2 __attribute__((ext_vector_type(2)));
typedef unsigned long long u64;

constexpr int DM = 2048, NP = 32768, NS = 512, MALL = NP + NS  , TP = 4096, TS = 64, PAST = 1024, LS = PAST + TS  ;
constexpr int NIN0 = 10352, NIN0P = 10496, NIN1 = 3136, NIN1P = 3328;
constexpr int LATROWS = NP + 8 * LS;
constexpr float ALPHA_RES = 1.4142135623730951f;
constexpr float LOG2E = 1.4426950408889634f;
constexpr float EPSV = 1e-5f;

enum { I_XP = 0, I_XS, I_CAK, I_CAV, I_CAKI, I_SCONV, I_SSSM, I_CLAT, I_CKR, I_T5, I_WIN0, I_WOUT0, I_CONVW, I_CONVB, I_DTB, I_ALOG, I_DSKIP,
       I_SNORM, I_LN0G, I_LN0B, I_WIN1, I_QNW, I_KVNW, I_WUQ, I_WUKV, I_WOUT1, I_LN1G, I_LN1B, N_IN };

constexpr size_t O_Y = 0;
constexpr size_t O_AKP = (size_t)MALL * DM;
constexpr size_t O_AKS = O_AKP + (size_t)NP * 1024;
constexpr size_t O_AVP = O_AKS + (size_t)NS * 1024;
constexpr size_t O_AVS = O_AVP + (size_t)NP * 1024;
constexpr size_t O_KIP = O_AVS + (size_t)NS * 1024;
constexpr size_t O_KIS = O_KIP + (size_t)NP * 64;
constexpr size_t O_BCP = O_KIS + (size_t)NS * 64;
constexpr size_t O_BCS = O_BCP + (size_t)8 * 3 * 3072;
constexpr size_t O_BSP = O_BCS + (size_t)8 * 3 * 3072;
constexpr size_t O_BSS = O_BSP + (size_t)8 * 32 * 64 * 128;
constexpr size_t O_CLP = O_BSS + (size_t)8 * 32 * 64 * 128;
constexpr size_t O_CLS = O_CLP + (size_t)NP * 512;
constexpr size_t O_CKP = O_CLS + (size_t)NS * 512;
constexpr size_t O_CKS = O_CKP + (size_t)NP * 64;
constexpr size_t O_END = O_CKS + (size_t)NS * 64;

constexpr size_t MiB = 1ull << 20;
constexpr size_t W_BT0 = 0;
constexpr size_t W_BTOUT0 = 41 * MiB;
constexpr size_t W_BT1 = 53 * MiB;
constexpr size_t W_BTUQ = 66 * MiB;
constexpr size_t W_BTUKV = 69 * MiB;
constexpr size_t W_BTOUT1 = 73 * MiB;
constexpr size_t W_ROPE = 81 * MiB;
constexpr size_t W_KIDXP = 82 * MiB;
constexpr size_t W_KIDXS = 86 * MiB;
constexpr size_t W_IW = 88 * MiB;
constexpr size_t W_DT = 91 * MiB;
constexpr size_t W_MASKP = 96 * MiB;
constexpr size_t W_MASKS = 112 * MiB;
constexpr size_t W_SSQ = 113 * MiB;
constexpr size_t W_BAR = 118 * MiB;
constexpr size_t W_XB = 120 * MiB;
constexpr size_t W_MIX = 250 * MiB;
constexpr size_t W_KP = 445 * MiB;
constexpr size_t W_KS = 509 * MiB;
constexpr size_t W_VP = 526 * MiB;
constexpr size_t W_VS = 590 * MiB;
constexpr size_t W_SG = 607 * MiB;
constexpr size_t W_IQ = 672 * MiB;
constexpr size_t W_XBC = 737 * MiB;
constexpr size_t W_KVALL = 120 * MiB;
constexpr size_t W_CQKV = 445 * MiB;
constexpr size_t W_CQN = 584 * MiB;
constexpr size_t W_LAT = 617 * MiB;
constexpr size_t W_KR = 658 * MiB;
constexpr size_t W_Q2 = 664 * MiB;
constexpr size_t W_SGATE = 860 * MiB;
constexpr size_t W_XACT = W_XB;
constexpr size_t W_BCACT = 932 * MiB;
constexpr size_t W_END = 997 * MiB;

struct Params { const float* in[N_IN]; float* out; char* ws; };
#define CPARAMS const __attribute__((address_space(4))) Params

constexpr int LDS_BYTES = 131072 + 32768;
#define KRSWZ(row, colB) ((row) * 128 + ((colB) ^ ((((row) >> 1) & 7) << 4)))

typedef __bf16 bf16x2_t __attribute__((ext_vector_type(2)));
typedef float f32x2_t __attribute__((ext_vector_type(2)));
__device__ __forceinline__ unsigned cvtpk(float lo, float hi) { const f32x2_t v = {lo, hi}; const bf16x2_t r = __builtin_convertvector(v, bf16x2_t); return __builtin_bit_cast(unsigned, r); }
__device__ __forceinline__ bf16_t f2bf(float f) { return (bf16_t)(cvtpk(f, f) & 0xffffu); }
__device__ __forceinline__ float bf2f(bf16_t b) { return __uint_as_float(((unsigned)b) << 16); }
__device__ __forceinline__ float silu_f(float v) { return v / (1.f + __expf(-v)); }
__device__ __forceinline__ bf16x8 pack8(const float* x) { u32x4 w = {cvtpk(x[0], x[1]), cvtpk(x[2], x[3]), cvtpk(x[4], x[5]), cvtpk(x[6], x[7])}; return *reinterpret_cast<bf16x8*>(&w); }
__device__ __forceinline__ u32x2 pack4(f32x4 v) { u32x2 w = {cvtpk(v[0], v[1]), cvtpk(v[2], v[3])}; return w; }
__device__ __forceinline__ float wave_sum(float v) {
#pragma unroll
  for (int o = 32; o > 0; o >>= 1) v += __shfl_xor(v, o);
  return v;
}
__device__ __forceinline__ int wave_sum_i(int v) {
#pragma unroll
  for (int o = 32; o > 0; o >>= 1) v += __shfl_xor(v, o);
  return v;
}
__device__ __forceinline__ float row16_sum(float v) {
    v += __builtin_bit_cast(float, __builtin_amdgcn_update_dpp(0, __builtin_bit_cast(int, v), 0xB1, 0xf, 0xf, true));
    v += __builtin_bit_cast(float, __builtin_amdgcn_update_dpp(0, __builtin_bit_cast(int, v), 0x4E, 0xf, 0xf, true));
    v += __builtin_bit_cast(float, __builtin_amdgcn_update_dpp(0, __builtin_bit_cast(int, v), 0x141, 0xf, 0xf, true));
    v += __builtin_bit_cast(float, __builtin_amdgcn_update_dpp(0, __builtin_bit_cast(int, v), 0x140, 0xf, 0xf, true));
    return v;
}
__device__ __forceinline__ float wave_scan_incl(float v, int lane) {
    v += __builtin_bit_cast(float, __builtin_amdgcn_update_dpp(0, __builtin_bit_cast(int, v), 0x111, 0xf, 0xf, false));
    v += __builtin_bit_cast(float, __builtin_amdgcn_update_dpp(0, __builtin_bit_cast(int, v), 0x112, 0xf, 0xf, false));
    v += __builtin_bit_cast(float, __builtin_amdgcn_update_dpp(0, __builtin_bit_cast(int, v), 0x114, 0xf, 0xf, false));
    v += __builtin_bit_cast(float, __builtin_amdgcn_update_dpp(0, __builtin_bit_cast(int, v), 0x118, 0xf, 0xf, false));
    const float t0 = __builtin_bit_cast(float, __builtin_amdgcn_readlane(__builtin_bit_cast(int, v), 15));
    const float t1 = __builtin_bit_cast(float, __builtin_amdgcn_readlane(__builtin_bit_cast(int, v), 31));
    const float t2 = __builtin_bit_cast(float, __builtin_amdgcn_readlane(__builtin_bit_cast(int, v), 47));
    float add = 0.f; if (lane >= 16) add = t0; if (lane >= 32) add = t0 + t1; if (lane >= 48) add = (t0 + t1) + t2;
    return v + add;
}
__device__ __forceinline__ int opaque_tid() { int t = threadIdx.x; asm volatile("" : "+v"(t)); return t; }
__device__ __forceinline__ int wave_sum_dpp(int v) {
    v += __builtin_amdgcn_update_dpp(0, v, 0xB1, 0xf, 0xf, true);
    v += __builtin_amdgcn_update_dpp(0, v, 0x4E, 0xf, 0xf, true);
    v += __builtin_amdgcn_update_dpp(0, v, 0x141, 0xf, 0xf, true);
    v += __builtin_amdgcn_update_dpp(0, v, 0x140, 0xf, 0xf, true);
    return __builtin_amdgcn_readlane(v, 0) + __builtin_amdgcn_readlane(v, 16) + __builtin_amdgcn_readlane(v, 32) + __builtin_amdgcn_readlane(v, 48);
}
__device__ __forceinline__ int latrow_of(int row) { if (row < NP) return row; const int r = row - NP; return NP + (r >> 6) * LS + PAST + (r & 63); }
__device__ __forceinline__ int pos_of(int row) { return row < NP ? (row & (TP - 1)) : PAST + ((row - NP) & 63); }
namespace pg8 {
#define PG8_LAS __attribute__((address_space(3)))
constexpr int BM = 256, BK = 64, HALF = 128, HTB = HALF * BK * 2  , STAGE_BYTES = 8 * HTB, NXCD = 8, WGM = 8;

__host__ __device__ __forceinline__ int lds_byte(int r, int c) { const int st = (r >> 4) * 2 + (c >> 5), rr = r & 15, cc = c & 31, ob = rr * 64 + cc * 2; return st * 1024 + (ob ^ (((ob >> 9) & 1) << 5)); }
__host__ __device__ __forceinline__ void stage_rc(int b, int& R, int& C) { const int st = b / 1024, sb = b % 1024, swz = sb ^ (((sb >> 9) & 1) << 5); R = (st >> 1) * 16 + swz / 64; C = (st & 1) * 32 + (swz % 64) / 2; }
__host__ __device__ __forceinline__ int perm32(int rho) { const int n = rho >> 4, i = rho & 15; return 8 * (i >> 2) + 4 * n + (i & 3); }

struct Unit { int pm, pn; };
struct Gemm { const bf16_t* A; const bf16_t* Bt; int M, N, K, lda; };

struct StaticOrder {
    int nM, nN, nwg, G, c;
    __host__ __device__ void init(int M, int N, int G_, int c_) { nM = M / BM; nN = N / BM; nwg = nM * nN; G = G_; c = c_; }
    __host__ __device__ bool next(int i, Unit& u) const {
        const long L = (long)i * G + c; if (L >= nwg) return false;
        int wgid = (int)L; { const int q = nwg / NXCD, r = nwg % NXCD, xcd = wgid % NXCD, off = wgid / NXCD; wgid = (xcd < r ? xcd * (q + 1) : r * (q + 1) + (xcd - r) * q) + off; }
        const int nig = WGM * nN, gid = wgid / nig, fm = gid * WGM, gsz = (nM - fm) < WGM ? (nM - fm) : WGM;
        u.pm = fm + ((wgid % nig) % gsz); u.pn = (wgid % nig) / gsz; return true;
    }
    __device__ __forceinline__ void a_ready(const Unit&) const {}
    __device__ __forceinline__ void done(const Unit&) const {}
};

template <class Epi, class Sched>
__device__ __forceinline__ void gemm_phase(PG8_LAS unsigned char* lds, const Gemm g, const Sched& S, const Epi& E) {
    constexpr bool STAMP = false; unsigned long long* stamps = nullptr;
    int tid_ = threadIdx.x; asm volatile("" : "+v"(tid_));
    const int tid = tid_, wid = __builtin_amdgcn_readfirstlane(tid >> 6), lane = tid & 63, wr = wid >> 2, wc = wid & 3, fr = lane & 15, fq = lane >> 4;
    const int K = g.K, nt = K / BK;
    int ts_lo = 0, ts_hi = 0, nts = 0; const unsigned long long rt_entry = STAMP ? (unsigned long long)wall_clock64() : 0ull;
#define PG8_STAMP() do { if (STAMP && wid == 0 && nts < 64) { const unsigned long long _c = (unsigned long long)clock64(); \
        ts_lo = (lane == nts) ? (int)(unsigned)_c : ts_lo; ts_hi = (lane == nts) ? (int)(unsigned)(_c >> 32) : ts_hi; ++nts; } } while (0)
    PG8_STAMP();
    unsigned voffA[2], voffB[2];
#pragma unroll
    for (int i = 0; i < 2; ++i) { int R, C; stage_rc(tid * 16 + i * 8192, R, C); const int Rb = Epi::PERM ? ((R & ~31) + perm32(R & 31)) : R;
        voffA[i] = (unsigned)(R * g.lda + C) * 2u; voffB[i] = (unsigned)(Rb * K + C) * 2u; }
    const size_t kstep = (size_t)(BK * 2);
    const size_t hstep = (size_t)HALF * K * 2; const size_t hstepA = (size_t)HALF * g.lda * 2;
    const size_t tstep = 2 * hstep; const size_t tstepA = 2 * hstepA;
    const unsigned ldsw = (unsigned)wid * 1024u;
    const int aoff = lds_byte(wr * 64 + fr, fq * 8), boff = lds_byte(wc * 32 + fr, fq * 8);
#define PG8_SA(b, h) (((b) * 2 + (h)) * HTB)
#define PG8_SB(b, h) ((4 + (b) * 2 + (h)) * HTB)
#define PG8_STAGE(bufoff, gbase, voff) do { _Pragma("unroll") for (int _i = 0; _i < 2; ++_i) \
        __builtin_amdgcn_global_load_lds((const unsigned*)((const char*)(gbase) + (voff)[_i]), (PG8_LAS unsigned*)(lds + (bufoff) + ldsw + _i * 8192), 16, 0, 0); } while (0)
#define PG8_LDA(dst, b, h) do { _Pragma("unroll") for (int m = 0; m < 4; ++m) _Pragma("unroll") for (int k = 0; k < 2; ++k) dst[m][k] = *(const PG8_LAS bf16x8*)(lds + PG8_SA(b, h) + aoff + m * 2048 + k * 1024); } while (0)
#define PG8_LDB(dst, b, h) do { _Pragma("unroll") for (int n = 0; n < 2; ++n) _Pragma("unroll") for (int k = 0; k < 2; ++k) dst[n][k] = *(const PG8_LAS bf16x8*)(lds + PG8_SB(b, h) + boff + n * 2048 + k * 1024); } while (0)
#define PG8_MMA(ai, bj, At, Bt) do { __builtin_amdgcn_s_setprio(1); _Pragma("unroll") for (int m = 0; m < 4; ++m) _Pragma("unroll") for (int n = 0; n < 2; ++n) _Pragma("unroll") for (int k = 0; k < 2; ++k) \
        acc[ai][bj][m][n] = __builtin_amdgcn_mfma_f32_16x16x32_bf16(Bt[n][k], At[m][k], acc[ai][bj][m][n], 0, 0, 0); __builtin_amdgcn_s_setprio(0); } while (0)
#define PG8_WAIT_V(n) asm volatile("s_waitcnt vmcnt(" #n ")" ::: "memory")
#define PG8_WAIT_L(n) asm volatile("s_waitcnt lgkmcnt(" #n ")" ::: "memory")
#define PG8_BAR __builtin_amdgcn_s_barrier()
#define PG8_SCHED __builtin_amdgcn_sched_barrier(0)
    Unit cur, nxt; int ui = 0;
    if (!S.next(0, cur)) return;
    f32x4 acc[2][2][4][2];
#pragma unroll
    for (int a = 0; a < 2; ++a)
#pragma unroll
        for (int b = 0; b < 2; ++b)
#pragma unroll
            for (int m = 0; m < 4; ++m)
#pragma unroll
                for (int n = 0; n < 2; ++n) acc[a][b][m][n] = (f32x4){0.f, 0.f, 0.f, 0.f};
    bf16x8 At[4][2], B0[2][2], B1[2][2];
    const char* cA = (const char*)g.A + (size_t)cur.pm * tstepA; const char* cB = (const char*)g.Bt + (size_t)cur.pn * tstep;
    S.a_ready(cur);
    PG8_STAGE(PG8_SB(0, 0), cB, voffB); PG8_STAGE(PG8_SA(0, 0), cA, voffA); PG8_STAGE(PG8_SB(0, 1), cB + hstep, voffB); PG8_STAGE(PG8_SA(0, 1), cA + hstepA, voffA);
    if (wr == 1) PG8_BAR;
    PG8_WAIT_V(4); PG8_BAR;
    PG8_STAGE(PG8_SB(1, 0), cB + kstep, voffB); PG8_STAGE(PG8_SA(1, 0), cA + kstep, voffA); PG8_STAGE(PG8_SB(1, 1), cB + hstep + kstep, voffB);
    PG8_WAIT_V(6); PG8_BAR;
    PG8_STAMP();
    for (;;) {
        const bool has_next = S.next(ui + 1, nxt);
        const char* nA = has_next ? (const char*)g.A + (size_t)nxt.pm * tstepA : cA; const char* nB = has_next ? (const char*)g.Bt + (size_t)nxt.pn * tstep : cB;
        for (int t = 0; t < nt; t += 2) {
            const bool last = (t == nt - 2);
            const char* a1 = cA + (size_t)(t + 1) * kstep;
            const char* a2 = last ? nA : cA + (size_t)(t + 2) * kstep; const char* b2 = last ? nB : cB + (size_t)(t + 2) * kstep;
            const char* a3 = a2 + kstep; const char* b3 = b2 + kstep;
            if (last && has_next) S.a_ready(nxt);
            PG8_LDB(B0, 0, 0); PG8_SCHED; PG8_LDA(At, 0, 0); PG8_STAGE(PG8_SA(1, 1), a1 + hstepA, voffA);
            PG8_WAIT_L(8); PG8_BAR; PG8_WAIT_L(0); PG8_MMA(0, 0, At, B0); PG8_BAR; PG8_SCHED;
            PG8_LDB(B1, 0, 1); PG8_STAGE(PG8_SB(0, 0), b2, voffB);
            PG8_BAR; PG8_WAIT_L(0); PG8_MMA(0, 1, At, B1); PG8_BAR;
            PG8_LDA(At, 0, 1); PG8_STAGE(PG8_SA(0, 0), a2, voffA);
            PG8_BAR; PG8_WAIT_L(0); PG8_MMA(1, 0, At, B0); PG8_BAR; PG8_SCHED;
            PG8_STAGE(PG8_SB(0, 1), b2 + hstep, voffB);
            PG8_WAIT_V(6); PG8_BAR; PG8_MMA(1, 1, At, B1); PG8_BAR;
            PG8_LDB(B0, 1, 0); PG8_SCHED; PG8_LDA(At, 1, 0); PG8_STAGE(PG8_SA(0, 1), a2 + hstepA, voffA);
            PG8_WAIT_L(8); PG8_BAR; PG8_WAIT_L(0); PG8_MMA(0, 0, At, B0); PG8_BAR; PG8_SCHED;
            PG8_LDB(B1, 1, 1); PG8_STAGE(PG8_SB(1, 0), b3, voffB);
            PG8_BAR; PG8_WAIT_L(0); PG8_MMA(0, 1, At, B1); PG8_BAR;
            PG8_LDA(At, 1, 1); PG8_STAGE(PG8_SA(1, 0), a3, voffA);
            PG8_BAR; PG8_WAIT_L(0); PG8_MMA(1, 0, At, B0); PG8_BAR; PG8_SCHED;
            PG8_STAGE(PG8_SB(1, 1), b3 + hstep, voffB);
            PG8_WAIT_V(6); PG8_BAR; PG8_MMA(1, 1, At, B1); PG8_BAR;
        }
        PG8_STAMP();
        if constexpr (!Epi::AFTER_DRAIN) { E(acc, cur, wr, wc, fr, fq); S.done(cur); }
        PG8_STAMP();
        if (!has_next) break;
#pragma unroll
        for (int a = 0; a < 2; ++a)
#pragma unroll
            for (int b = 0; b < 2; ++b)
#pragma unroll
                for (int m = 0; m < 4; ++m)
#pragma unroll
                    for (int n = 0; n < 2; ++n) acc[a][b][m][n] = (f32x4){0.f, 0.f, 0.f, 0.f};
        cur = nxt; cA = nA; cB = nB; ++ui;
    }
    PG8_WAIT_V(0);
    if (wr == 0) PG8_BAR;
    PG8_BAR;
    if constexpr (Epi::AFTER_DRAIN) { E.fused(acc, cur, wr, wc, fr, fq, lds, wid, lane); S.done(cur); }
    PG8_STAMP();
    if (STAMP && wid == 0) { stamps[lane] = lane < nts ? (((unsigned long long)(unsigned)ts_hi << 32) | (unsigned)ts_lo) : 0ull;
        if (lane == 62) stamps[62] = rt_entry; if (lane == 63) stamps[63] = (unsigned long long)wall_clock64(); }
#undef PG8_STAMP
#undef PG8_SA
#undef PG8_SB
#undef PG8_STAGE
#undef PG8_LDA
#undef PG8_LDB
#undef PG8_MMA
#undef PG8_WAIT_V
#undef PG8_WAIT_L
#undef PG8_BAR
#undef PG8_SCHED
}
}


template <class F> struct EpiGen {
    static constexpr bool PERM = false, AFTER_DRAIN = false;
    F f;
    __device__ __forceinline__ void operator()(const f32x4 (&acc)[2][2][4][2], const pg8::Unit& u, int wr, int wc, int fr, int fq) const {
        int row0 = u.pm * 256 + wr * 64 + fr, col0 = u.pn * 256 + wc * 32 + 4 * fq;
        asm volatile("" : "+v"(row0), "+v"(col0));
#pragma unroll
        for (int ai = 0; ai < 2; ++ai)
#pragma unroll
            for (int m = 0; m < 4; ++m) {
                const int row = row0 + ai * 128 + m * 16;
#pragma unroll
                for (int bj = 0; bj < 2; ++bj)
#pragma unroll
                    for (int n = 0; n < 2; ++n) f(row, col0 + bj * 128 + n * 16, acc[ai][bj][m][n], u.pn);
            }
    }
};

#define EPI_ITER(...) do { int row0_ = row0, col0_ = col0; asm volatile("" : "+v"(row0_), "+v"(col0_)); _Pragma("unroll") for (int ai = 0; ai < 2; ++ai) _Pragma("unroll") for (int m = 0; m < 4; ++m) { const int row = row0_ + ai * 128 + m * 16; \
    _Pragma("unroll") for (int bj = 0; bj < 2; ++bj) _Pragma("unroll") for (int n = 0; n < 2; ++n) { const int col = col0_ + bj * 128 + n * 16; const f32x4 v = acc[ai][bj][m][n]; __VA_ARGS__ } } } while (0)
struct EpiInProj0 {
    static constexpr bool PERM = false, AFTER_DRAIN = false;
    char* ws; float* out; const float* dtb;
    __device__ __forceinline__ void operator()(const f32x4 (&acc)[2][2][4][2], const pg8::Unit& u, int wr, int wc, int fr, int fq) const {
        int row0 = u.pm * 256 + wr * 64 + fr, col0 = u.pn * 256 + wc * 32 + 4 * fq; const int pn = u.pn;
        asm volatile("" : "+v"(row0), "+v"(col0));
        if (pn < 4) {
            EPI_ITER({ *(u32x2*)((bf16_t*)(ws + W_MIX) + (size_t)row * 3072 + col) = pack4(v); });
        } else if (pn < 12) {
            const bool isv = pn >= 8; const int cs = isv ? 2048 : 1024;
            bf16_t* kp = (bf16_t*)(ws + (isv ? W_VP : W_KP)); bf16_t* ks = (bf16_t*)(ws + (isv ? W_VS : W_KS)); float* op = out + (isv ? O_AVP : O_AKP); float* os = out + (isv ? O_AVS : O_AKS);
            EPI_ITER({ const int c = col - cs; bf16_t* kb; float* o;
                if (row < NP) { kb = kp + (size_t)row * 1024 + c; o = op + (size_t)row * 1024 + c; }
                else { const int r = row - NP; kb = ks + ((size_t)(r >> 6) * LS + PAST + (r & 63)) * 1024 + c; o = os + (size_t)r * 1024 + c; }
                *(u32x2*)kb = pack4(v); *(f32x4*)o = v; });
        } else if (pn < 16) {
            EPI_ITER({ f32x4 s = {silu_f(v[0]), silu_f(v[1]), silu_f(v[2]), silu_f(v[3])}; *(u32x2*)((bf16_t*)(ws + W_SG) + (size_t)row * 1024 + (col - 3072)) = pack4(s); });
        } else if (pn < 20) {
            EPI_ITER({ *(u32x2*)((bf16_t*)(ws + W_IQ) + (size_t)row * 1024 + (col - 4096)) = pack4(v); });
        } else if (pn < 28) {
            EPI_ITER({ f32x4 s = {silu_f(v[0]), silu_f(v[1]), silu_f(v[2]), silu_f(v[3])}; *(u32x2*)((bf16_t*)(ws + W_MIX) + (size_t)row * 3072 + 1024 + (col - 5120)) = pack4(s); });
        } else if (pn < 40) {
            EPI_ITER({ const int c = col - 7168;
                *(u32x2*)((bf16_t*)(ws + W_XBC) + (size_t)row * 3072 + c) = pack4(v);
                if (row < NP) { const int t = row & (TP - 1); if (t >= TP - 3) *(f32x4*)(out + O_BCP + ((size_t)(row >> 12) * 3 + (t - (TP - 3))) * 3072 + c) = v; }
                else { const int r = row - NP, t = r & 63; if (t >= TS - 3) *(f32x4*)(out + O_BCS + ((size_t)(r >> 6) * 3 + (t - (TS - 3))) * 3072 + c) = v; } });
        } else {
            int r0 = row0, c0 = col0; asm volatile("" : "+v"(r0), "+v"(c0));
#pragma unroll
            for (int n = 0; n < 2; ++n) {
                const int c = c0 - 10240 + n * 16;
                if (c < 64) {
#pragma unroll
                    for (int ai = 0; ai < 2; ++ai)
#pragma unroll
                        for (int m = 0; m < 4; ++m) { const int row = r0 + ai * 128 + m * 16; const f32x4 v = acc[ai][0][m][n]; bf16_t* kb; float* o;
                            if (row < NP) { kb = (bf16_t*)(ws + W_KIDXP) + (size_t)row * 64 + c; o = out + O_KIP + (size_t)row * 64 + c; }
                            else { const int r = row - NP; kb = (bf16_t*)(ws + W_KIDXS) + ((size_t)(r >> 6) * LS + PAST + (r & 63)) * 64 + c; o = out + O_KIS + (size_t)r * 64 + c; }
                            *(u32x2*)kb = pack4(v); *(f32x4*)o = v; }
                } else if (c < 80) {
#pragma unroll
                    for (int ai = 0; ai < 2; ++ai)
#pragma unroll
                        for (int m = 0; m < 4; ++m) { const int row = r0 + ai * 128 + m * 16; *(f32x4*)((float*)(ws + W_IW) + (size_t)row * 16 + (c - 64)) = acc[ai][0][m][n] * 0.03125f; }
                } else if (c < 112) {
                    const f32x4 db = *(const f32x4*)(dtb + (c - 80));
#pragma unroll
                    for (int ai = 0; ai < 2; ++ai)
#pragma unroll
                        for (int m = 0; m < 4; ++m) { const int row = r0 + ai * 128 + m * 16; const f32x4 v = acc[ai][0][m][n] + db; f32x4 d;
#pragma unroll
                            for (int j = 0; j < 4; ++j) d[j] = v[j] > 20.f ? v[j] : log1pf(__expf(v[j]));
                            *(f32x4*)((float*)(ws + W_DT) + (size_t)row * 32 + (c - 80)) = d; }
                }
            }
        }
    }
};

struct FResid {
    const float* r0; const float* r1; float* y;
    __device__ __forceinline__ void operator()(int row, int col, f32x4 v, int) const {
        const float* rp = row < NP ? r0 + (size_t)row * DM + col : r1 + (size_t)(row - NP) * DM + col;
        const f32x4 x = *(const f32x4*)rp;
        *(f32x4*)(y + (size_t)row * DM + col) = v + x * ALPHA_RES;
    }
};

struct FInProj1 {
    char* ws;
    __device__ __forceinline__ void operator()(int row, int col, f32x4 v, int pn) const {
        if (pn < 4) *(f32x4*)((float*)(ws + W_CQKV) + (size_t)row * 1088 + col) = v;
        else if (pn < 12) { f32x4 s = {silu_f(v[0]), silu_f(v[1]), silu_f(v[2]), silu_f(v[3])}; *(u32x2*)((bf16_t*)(ws + W_SGATE) + (size_t)row * 2048 + (col - 1024)) = pack4(s); }
        else { const int c = col - 3072; if (c < 64) *(f32x4*)((float*)(ws + W_CQKV) + (size_t)row * 1088 + 1024 + c) = v; }
    }
};

struct FQUp {
    char* ws;
    __device__ __forceinline__ void operator()(int row, int col, f32x4 v, int pn) const {
        if (pn >= 8) {
            const int jj = (col - 2048) & 63, i0 = (jj >> 2) * 2, pos = pos_of(row);
            const float2* tab = (const float2*)(ws + W_ROPE) + (size_t)pos * 32 + i0;
            const float2 c0 = tab[0], c1 = tab[1];
            f32x4 o; o[0] = v[0] * c0.x - v[2] * c0.y; o[2] = v[0] * c0.y + v[2] * c0.x; o[1] = v[1] * c1.x - v[3] * c1.y; o[3] = v[1] * c1.y + v[3] * c1.x; v = o;
        }
        *(u32x2*)((bf16_t*)(ws + W_Q2) + (size_t)row * 3072 + col) = pack4(v);
    }
};
struct FKvUp { char* ws; __device__ __forceinline__ void operator()(int row, int col, f32x4 v, int) const { *(u32x2*)((bf16_t*)(ws + W_KVALL) + (size_t)row * 4096 + col) = pack4(v); } };

template <class F> __device__ __forceinline__ void run_gemm(char* lds, const bf16_t* A, int lda, const bf16_t* Bt, int M, int N, int K, const F& f, const bool rev = false) {
    pg8::Gemm g; g.A = A; g.Bt = Bt; g.M = M; g.N = N; g.K = K; g.lda = lda;
    pg8::StaticOrder S; S.init(M, N, (int)gridDim.x, rev ? (int)(gridDim.x - 1 - blockIdx.x) : (int)blockIdx.x);
    EpiGen<F> E{f};
    pg8::gemm_phase<EpiGen<F>, pg8::StaticOrder>((PG8_LAS unsigned char*)lds, g, S, E);
}

__device__ __forceinline__ int orig_col(int w, int n) {
    switch (w) {
    case 0: if (n < 5120) return n; if (n < 7168) return 5200 + (n - 5120); if (n < 10240) return 7248 + (n - 7168); if (n < 10304) return 5120 + (n - 10240);
            if (n < 10320) return 5184 + (n - 10304); if (n < 10352) return n; return -1;
    case 2: if (n < 1024) return n; if (n < 3072) return 1088 + (n - 1024); if (n < 3136) return 1024 + (n - 3072); return -1;
    case 3: if (n < 2048) return (n >> 7) * 192 + (n & 127);
            { const int j = n - 2048, h = j >> 6, jj = j & 63, g4 = jj >> 2, e = jj & 3; return h * 192 + 128 + (e >> 1) * 32 + 2 * g4 + (e & 1); }
    case 4: if (n < 2048) return (n >> 7) * 256 + (n & 127); { const int j = n - 2048; return (j >> 7) * 256 + 128 + (j & 127); }
    default: return n;
    }
}
__device__ __forceinline__ void phase_prep(CPARAMS& p, char* lds) {
    const int tid = opaque_tid();
    {
        bf16_t* tile = (bf16_t*)lds;
        int base = 0;
#pragma unroll 1
        for (int w = 0; w < 6; ++w) {
            int K, N, NPd; const float* W; bf16_t* Bt;
            switch (w) {
            case 0: K = 2048; N = NIN0; NPd = NIN0P; W = p.in[I_WIN0]; Bt = (bf16_t*)(p.ws + W_BT0); break;
            case 1: K = 3072; N = 2048; NPd = 2048; W = p.in[I_WOUT0]; Bt = (bf16_t*)(p.ws + W_BTOUT0); break;
            case 2: K = 2048; N = NIN1; NPd = NIN1P; W = p.in[I_WIN1]; Bt = (bf16_t*)(p.ws + W_BT1); break;
            case 3: K = 512; N = 3072; NPd = 3072; W = p.in[I_WUQ]; Bt = (bf16_t*)(p.ws + W_BTUQ); break;
            case 4: K = 512; N = 4096; NPd = 4096; W = p.in[I_WUKV]; Bt = (bf16_t*)(p.ws + W_BTUKV); break;
            default: K = 2048; N = 2048; NPd = 2048; W = p.in[I_WOUT1]; Bt = (bf16_t*)(p.ws + W_BTOUT1); break;
            }
            const int nkt = K / 64, nnt = NPd / 64, ntiles = nkt * nnt;
            int first = (int)blockIdx.x - (base % (int)gridDim.x); if (first < 0) first += gridDim.x;
#pragma unroll 1
            for (int tix = first; tix < ntiles; tix += gridDim.x) {
                const int kt = tix % nkt, nt = tix / nkt;
                const int nl = tid & 63, n = nt * 64 + nl, oc = orig_col(w, n);
#pragma unroll
                for (int i = 0; i < 8; ++i) {
                    const int kl = i * 8 + (tid >> 6), k = kt * 64 + kl;
                    const float v = oc >= 0 ? W[(size_t)k * N + oc] : 0.f;
                    tile[nl * 66 + kl] = f2bf(v);
                }
                __syncthreads();
                { const int nr = tid >> 3, ks = (tid & 7) * 8; const unsigned* src = (const unsigned*)(tile + nr * 66 + ks);
                  u32x4 o = {src[0], src[1], src[2], src[3]};
                  *(u32x4*)(Bt + (size_t)(nt * 64 + nr) * K + kt * 64 + ks) = o; }
                __syncthreads();
            }
            base += ntiles;
        }
    }
    const size_t gtid = (size_t)blockIdx.x * 512 + tid, gstride = (size_t)gridDim.x * 512;
    { bf16_t* xb = (bf16_t*)(p.ws + W_XB); const size_t n8p = (size_t)NP * DM / 8, n8 = (size_t)MALL * DM / 8;
      for (size_t i0 = gtid; i0 < n8; i0 += 4 * gstride) {
        f32x4 a[4], b[4];
#pragma unroll
        for (int u = 0; u < 4; ++u) { const size_t i = i0 + u * gstride; if (i < n8) { const float* s = i < n8p ? p.in[I_XP] + i * 8 : p.in[I_XS] + (i - n8p) * 8; a[u] = *(const f32x4*)s; b[u] = *(const f32x4*)(s + 4); } }
#pragma unroll
        for (int u = 0; u < 4; ++u) { const size_t i = i0 + u * gstride; if (i < n8) { const float t[8] = {a[u][0], a[u][1], a[u][2], a[u][3], b[u][0], b[u][1], b[u][2], b[u][3]}; *(bf16x8*)(xb + i * 8) = pack8(t); } }
      } }
    { const size_t n8 = (size_t)8 * PAST * 1024 / 8;
      for (size_t i = gtid; i < 2 * n8; i += gstride) { const bool isv = i >= n8; const size_t j = isv ? i - n8 : i; const float* s = p.in[isv ? I_CAV : I_CAK] + j * 8;
        const size_t e = j * 8, b = e / ((size_t)PAST * 1024), rem = e % ((size_t)PAST * 1024);
        const f32x4 a = *(const f32x4*)s, c = *(const f32x4*)(s + 4); const float t[8] = {a[0], a[1], a[2], a[3], c[0], c[1], c[2], c[3]};
        *(bf16x8*)((bf16_t*)(p.ws + (isv ? W_VS : W_KS)) + b * (size_t)LS * 1024 + rem) = pack8(t); }
      const size_t m8 = (size_t)8 * PAST * 64 / 8;
      for (size_t i = gtid; i < m8; i += gstride) { const float* s = p.in[I_CAKI] + i * 8; const size_t e = i * 8, b = e / ((size_t)PAST * 64), rem = e % ((size_t)PAST * 64);
        const f32x4 a = *(const f32x4*)s, c = *(const f32x4*)(s + 4); const float t[8] = {a[0], a[1], a[2], a[3], c[0], c[1], c[2], c[3]};
        *(bf16x8*)((bf16_t*)(p.ws + W_KIDXS) + b * (size_t)LS * 64 + rem) = pack8(t); } }
    { float2* tab = (float2*)(p.ws + W_ROPE);
      for (size_t i = gtid; i < (size_t)4096 * 32; i += gstride) { const int pos = (int)(i >> 5), f = (int)(i & 31);
        const float inv = powf(10000.f, -(float)f / 32.f), ang = (float)pos * inv; float s, c; sincosf(ang, &s, &c); tab[i] = make_float2(c, s); } }
}

__device__ __forceinline__ void phase_index(CPARAMS& p, char* lds) {
    const int tid = opaque_tid(), wid = tid >> 6, lane = tid & 63, r32 = lane & 31, hi = lane >> 5;
    unsigned* sk = (unsigned*)lds;
    const int NU = 4096 + 64;
#pragma unroll 1
    for (int idx = blockIdx.x; idx < NU; idx += gridDim.x) {
        int b, t0, n, nblk_tot, rowg; const bf16_t* ki; u64* mrow; int ldm; bool sample;
        if (idx < 4096) { const int k = idx >> 8, w = idx & 255; b = k >> 1; const int j = (k & 1) ? 511 - w : w; t0 = j * 8; n = ((t0 >> 6) + 1) * 64; nblk_tot = ((t0 >> 8) + 1) * 4;
            rowg = b * TP + t0; ki = (const bf16_t*)(p.ws + W_KIDXP) + (size_t)b * TP * 64; mrow = (u64*)(p.ws + W_MASKP) + (size_t)rowg * 64; ldm = 64; sample = false; }
        else { const int s = idx - 4096; b = s >> 3; t0 = (s & 7) * 8; n = LS; nblk_tot = 17; rowg = NP + b * 64 + t0;
            ki = (const bf16_t*)(p.ws + W_KIDXS) + (size_t)b * LS * 64; mrow = (u64*)(p.ws + W_MASKS) + (size_t)(b * 64 + t0) * 32; ldm = 32; sample = true; }
        (void)sample;
        if (n <= 256) {
            if (lane < nblk_tot) mrow[(size_t)wid * ldm + lane] = (lane * 64 < n) ? ~0ull : 0ull;
            continue;
        }
        {
            const int pr = wid >> 1, par = wid & 1;
            const int qsel = (r32 >> 2) & 1, head = (r32 & 3) + 4 * (r32 >> 3);
            const bf16_t* qp = (const bf16_t*)(p.ws + W_IQ) + (size_t)(rowg + 2 * pr + qsel) * 1024 + head * 64 + hi * 8;
            bf16x8 qa[4];
#pragma unroll
            for (int s = 0; s < 4; ++s) qa[s] = *(const bf16x8*)(qp + s * 16);
            const float* wp = (const float*)(p.ws + W_IW) + (size_t)(rowg + 2 * pr + hi) * 16;
            float wv[16];
#pragma unroll
            for (int s = 0; s < 4; ++s) { const f32x4 t = *(const f32x4*)(wp + s * 4); wv[s * 4] = t[0]; wv[s * 4 + 1] = t[1]; wv[s * 4 + 2] = t[2]; wv[s * 4 + 3] = t[3]; }
            unsigned* dst = sk + (2 * pr + hi) * 4096 + par * 32 + r32;
            char* kst = lds + 131072;
            const int skey = tid >> 3, scolB = (tid & 7) * 16, ntile = n >> 6, ngrp = (ntile + 3) >> 2;
            const bf16_t* ksrc = ki + (size_t)skey * 64 + (scolB >> 1);
            bf16x8 pre[3][4];
#pragma unroll
            for (int sl = 0; sl < 3; ++sl)
#pragma unroll
                for (int u = 0; u < 4; ++u) { const int t = sl * 4 + u; pre[sl][u] = *(const bf16x8*)(ksrc + (size_t)(t < ntile ? t : 0) * 64 * 64); }
#define IDX_GROUP(SL, G) do { const int g_ = (G); \
                __syncthreads(); \
                _Pragma("unroll") for (int u = 0; u < 4; ++u) *(bf16x8*)(kst + u * 8192 + KRSWZ(skey, scolB)) = pre[SL][u]; \
                _Pragma("unroll") for (int u = 0; u < 4; ++u) { const int t = (g_ + 3) * 4 + u; pre[SL][u] = *(const bf16x8*)(ksrc + (size_t)(t < ntile ? t : 0) * 64 * 64); } \
                __syncthreads(); \
                _Pragma("unroll") for (int u = 0; u < 4; ++u) { const int t = g_ * 4 + u; \
                    if (t < ntile) { f32x16 acc = {}; \
                        _Pragma("unroll") for (int s = 0; s < 4; ++s) { const bf16x8 kf = *(const bf16x8*)(kst + u * 8192 + KRSWZ(par * 32 + r32, (s * 16 + hi * 8) * 2)); acc = __builtin_amdgcn_mfma_f32_32x32x16_bf16(qa[s], kf, acc, 0, 0, 0); } \
                        float sc = 0.f; \
                        _Pragma("unroll") for (int r = 0; r < 16; ++r) sc = fmaf(wv[r], fmaxf(acc[r], 0.f), sc); \
                        sc += 0.f; \
                        const unsigned uu = __float_as_uint(sc); \
                        dst[t * 64] = (uu & 0x80000000u) ? ~uu : (uu | 0x80000000u); } } } while (0)
#pragma unroll 1
            for (int g0 = 0; g0 < ngrp; g0 += 3) {
                IDX_GROUP(0, g0);
                if (g0 + 1 < ngrp) IDX_GROUP(1, g0 + 1);
                if (g0 + 2 < ngrp) IDX_GROUP(2, g0 + 2);
            }
#undef IDX_GROUP
        }
        __syncthreads();
        {
            const unsigned* k = sk + wid * 4096;
            u32x4 kv[16];
#pragma unroll
            for (int j = 0; j < 16; ++j) kv[j] = (j * 256 < n && j * 256 + lane * 4 < n) ? *(const u32x4*)(k + j * 256 + lane * 4) : (u32x4){0u, 0u, 0u, 0u};
            unsigned prefix = 0;
#pragma unroll 1
            for (int bit = 31; bit >= 0; --bit) {
                const unsigned cand = prefix | (1u << bit);
                int cnt = 0;
#pragma unroll
                for (int j = 0; j < 16; ++j) if (j * 256 < n) cnt += (kv[j][0] >= cand) + (kv[j][1] >= cand) + (kv[j][2] >= cand) + (kv[j][3] >= cand);
                cnt = wave_sum_dpp(cnt);
                if (cnt >= 256) { prefix = cand; if (cnt == 256) break; }
            }
            int cgt = 0;
#pragma unroll
            for (int j = 0; j < 16; ++j) if (j * 256 < n) cgt += (kv[j][0] > prefix) + (kv[j][1] > prefix) + (kv[j][2] > prefix) + (kv[j][3] > prefix);
            cgt = wave_sum_dpp(cgt);
            const int need = 256 - cgt; int running = 0;
            u64* mr = mrow + (size_t)wid * ldm;
            const u64 lt = (1ull << lane) - 1ull;
#pragma unroll 1
            for (int blk = 0; blk < nblk_tot; ++blk) {
                u64 word = 0ull;
                if (blk * 64 < n) {
                    const unsigned v = k[blk * 64 + lane];
                    const u64 eqm = __ballot(v == prefix);
                    const int rank = running + __popcll(eqm & lt);
                    const bool sel = (v > prefix) || (v == prefix && rank < need);
                    word = __ballot(sel); running += __popcll(eqm);
                }
                if (lane == 0) mr[blk] = word;
            }
        }
        __syncthreads();
    }
}

#define KSWZ(row, colB) ((row) * 256 + ((colB) ^ (((row) & 7) << 4)))
__device__ __forceinline__ int crow(int r, int hi) { return (r & 3) + 8 * (r >> 2) + 4 * hi; }
__device__ __forceinline__ int v_st(int k, int c) { const int kk = (k & ~0xC) | ((k & 4) << 1) | ((k & 8) >> 1); return ((kk >> 3) * 4 + (c >> 5)) * 512 + ((kk & 7) * 32 + (c & 31)) * 2; }
__device__ __forceinline__ int v_rd_base(int lane) { return ((lane & 3) << 3) | (((lane >> 2) & 3) << 6) | (((lane >> 4) & 1) << 5) | (((lane >> 5) & 1) << 8); }
constexpr int v_rd_off(int d0, int ks, int half) { return d0 * 512 + ks * 4096 + half * 2048; }
template <int OFF> __device__ __forceinline__ s16x4 tr_read(int vb) { s16x4 r; asm volatile("ds_read_b64_tr_b16 %0, %1 offset:%2" : "=&v"(r) : "v"(vb), "i"(OFF) : "memory"); return r; }
template <int D0> __device__ __forceinline__ void pv_one(f32x16& od, int vb, bf16x8 pa0, bf16x8 pa1, bf16x8 pa2, bf16x8 pa3) {
    const s16x4 l0 = tr_read<v_rd_off(D0, 0, 0)>(vb), h0 = tr_read<v_rd_off(D0, 0, 1)>(vb), l1 = tr_read<v_rd_off(D0, 1, 0)>(vb), h1 = tr_read<v_rd_off(D0, 1, 1)>(vb);
    const s16x4 l2 = tr_read<v_rd_off(D0, 2, 0)>(vb), h2 = tr_read<v_rd_off(D0, 2, 1)>(vb), l3 = tr_read<v_rd_off(D0, 3, 0)>(vb), h3 = tr_read<v_rd_off(D0, 3, 1)>(vb);
    asm volatile("s_waitcnt lgkmcnt(0)" ::: "memory"); __builtin_amdgcn_sched_barrier(0);
#define PKV(L, H) (bf16x8){L[0], L[1], L[2], L[3], H[0], H[1], H[2], H[3]}
    od = __builtin_amdgcn_mfma_f32_32x32x16_bf16(pa0, PKV(l0, h0), od, 0, 0, 0);
    od = __builtin_amdgcn_mfma_f32_32x32x16_bf16(pa1, PKV(l1, h1), od, 0, 0, 0);
    od = __builtin_amdgcn_mfma_f32_32x32x16_bf16(pa2, PKV(l2, h2), od, 0, 0, 0);
    od = __builtin_amdgcn_mfma_f32_32x32x16_bf16(pa3, PKV(l3, h3), od, 0, 0, 0);
#undef PKV
}

struct AttnUnit {
    const bf16_t* Q; const bf16_t* Qr; const bf16_t* K; const bf16_t* V; const bf16_t* Kr; bf16_t* O; const bf16_t* G; const u64* M;
    int ldq, ldqr, ldk, ldo, ldg, ldm, nvalid, qpos0, NT, head;
};
constexpr int AT_V = 0, AT_K = 32768, AT_KR = 65536, AT_WS = 81920, AT_TB = 81920 + 2048;

template <int MODE>
__device__ __forceinline__ void attn_unit(const AttnUnit& u, char* lds, const float* t5, const float Cs  , const bool dry = false) {
    const int tid = opaque_tid(), wid = __builtin_amdgcn_readfirstlane(tid >> 6), lane = tid & 63, r32 = lane & 31, hi = lane >> 5;
    float* wsf = (float*)(lds + AT_WS) + wid * 64; float* al_l = wsf; float* li_l = wsf + 32;
    float* tb = (float*)(lds + AT_TB);
    const int rowb = wid * 32 + r32, rowc = rowb < u.nvalid ? rowb : u.nvalid - 1;
    const int wrow0 = (wid * 32 < u.nvalid) ? wid * 32 : u.nvalid - 1;
    const int qc_w = (u.qpos0 + wrow0) >> 6;
    const int qpos = u.qpos0 + rowc;
    constexpr int NQ = MODE == 1 ? 12 : 8;
    bf16x8 qr[NQ];
    { const bf16_t* Qw = u.Q + (size_t)rowc * u.ldq + hi * 8;
#pragma unroll
      for (int d0 = 0; d0 < 8; ++d0) qr[d0] = *(const bf16x8*)(Qw + d0 * 16);
      if constexpr (MODE == 1) { const bf16_t* Qw2 = u.Qr + (size_t)rowc * u.ldqr + hi * 8;
#pragma unroll
        for (int d0 = 0; d0 < 4; ++d0) qr[8 + d0] = *(const bf16x8*)(Qw2 + d0 * 16); } }
    if constexpr (MODE == 0) {
        if (tid < 155) { const int rel = tid - 63, nn = rel < 0 ? -rel : rel;
            const int bk = (rel < 0 ? 16 : 0) + (nn < 8 ? nn : 8 + (nn >= 12) + (nn >= 16) + (nn >= 23) + (nn >= 32) + (nn >= 46) + (nn >= 64) + (nn >= 91));
            tb[tid] = t5[bk * 8 + u.head] * LOG2E; }
    }
    float m_reg = -1e29f, l_reg = 0.f; f32x16 o[4];
#pragma unroll
    for (int d = 0; d < 4; ++d) o[d] = (f32x16){};
    const int vb0 = (int)(uintptr_t)(lds + AT_V) + v_rd_base(lane);
    int koff[2], voff[2], kroff = 0;
#pragma unroll
    for (int i = 0; i < 2; ++i) { const int X = (i * 8 + wid) * 1024 + lane * 16;
        { const int row = X >> 8, colB = (X & 255) ^ ((row & 7) << 4); koff[i] = row * u.ldk + (colB >> 1); }
        { const int sub = X >> 9, y = X & 511, kk = (sub >> 2) * 8 + (y >> 6), k = (kk & ~0xC) | ((kk & 4) << 1) | ((kk & 8) >> 1), c = (sub & 3) * 32 + ((y & 63) >> 1); voff[i] = k * u.ldk + c; } }
    if constexpr (MODE == 1) { const int X = wid * 1024 + lane * 16, row = X >> 7, colB = (X & 127) ^ (((row >> 1) & 7) << 4); kroff = row * 64 + (colB >> 1); }
    LAS char* ldl = (LAS char*)lds;
#define AT_ISSUE(b, k0) do { const bf16_t* kb_ = u.K + (size_t)(k0) * u.ldk; const bf16_t* vb_ = u.V + (size_t)(k0) * u.ldk; \
        _Pragma("unroll") for (int i_ = 0; i_ < 2; ++i_) { \
            __builtin_amdgcn_global_load_lds((const unsigned*)(kb_ + koff[i_]), (LAS unsigned*)(ldl + AT_K + (b) * 16384 + (i_ * 8 + wid) * 1024), 16, 0, 0); \
            __builtin_amdgcn_global_load_lds((const unsigned*)(vb_ + voff[i_]), (LAS unsigned*)(ldl + AT_V + (b) * 16384 + (i_ * 8 + wid) * 1024), 16, 0, 0); } \
        if constexpr (MODE == 1) __builtin_amdgcn_global_load_lds((const unsigned*)(u.Kr + (size_t)(k0) * 64 + kroff), (LAS unsigned*)(ldl + AT_KR + (b) * 8192 + wid * 1024), 16, 0, 0); } while (0)
    AT_ISSUE(0, 0);
    asm volatile("s_waitcnt vmcnt(0)" ::: "memory");
    __syncthreads();
#pragma unroll 1
    for (int j = 0; j < u.NT; ++j) {
        const int cur = j & 1;
        if (j + 1 < u.NT) AT_ISSUE(cur ^ 1, (j + 1) * 64);
        if (j <= qc_w && wid * 32 < u.nvalid) {
            u64 mw = 0;
            if constexpr (MODE == 0) mw = u.M[(size_t)rowc * u.ldm + j];
            f32x16 p0 = {}, p1 = {};
            const char* Ks = lds + AT_K + cur * 16384;
#pragma unroll
            for (int d0 = 0; d0 < 8; ++d0) { const int cb = (d0 * 16 + hi * 8) * 2;
                const bf16x8 b0 = *(const bf16x8*)(Ks + KSWZ(r32, cb)), b1 = *(const bf16x8*)(Ks + KSWZ(32 + r32, cb));
                p0 = __builtin_amdgcn_mfma_f32_32x32x16_bf16(b0, qr[d0], p0, 0, 0, 0); p1 = __builtin_amdgcn_mfma_f32_32x32x16_bf16(b1, qr[d0], p1, 0, 0, 0);
                if ((d0 & 3) == 3) __builtin_amdgcn_sched_barrier(0); }
            if constexpr (MODE == 1) { const char* Krs = lds + AT_KR + cur * 8192;
#pragma unroll
                for (int d0 = 0; d0 < 4; ++d0) { const int cb = (d0 * 16 + hi * 8) * 2;
                    const bf16x8 b0 = *(const bf16x8*)(Krs + KRSWZ(r32, cb)), b1 = *(const bf16x8*)(Krs + KRSWZ(32 + r32, cb));
                    p0 = __builtin_amdgcn_mfma_f32_32x32x16_bf16(b0, qr[8 + d0], p0, 0, 0, 0); p1 = __builtin_amdgcn_mfma_f32_32x32x16_bf16(b1, qr[8 + d0], p1, 0, 0, 0); } }
            if constexpr (MODE == 0) {
                const unsigned mlo = (unsigned)mw >> (4 * hi), mhi = (unsigned)(mw >> 32) >> (4 * hi);
                const int kb = j * 64;
                const bool far = (u.qpos0 + wrow0) - (kb + 63) >= 91;
                if (far) { const float bb = tb[154];
#pragma unroll
                    for (int r = 0; r < 16; ++r) { const int c0 = crow(r, 0);
                        p0[r] = ((mlo >> c0) & 1u) ? fmaf(p0[r], Cs, bb) : -1e30f; p1[r] = ((mhi >> c0) & 1u) ? fmaf(p1[r], Cs, bb) : -1e30f; }
                } else { const int rel0 = qpos - kb - 4 * hi;
#pragma unroll
                    for (int r = 0; r < 16; ++r) { const int c0 = crow(r, 0);
                        int i0 = rel0 - c0; i0 = i0 < -63 ? -63 : (i0 > 91 ? 91 : i0); int i1 = rel0 - c0 - 32; i1 = i1 < -63 ? -63 : (i1 > 91 ? 91 : i1);
                        p0[r] = ((mlo >> c0) & 1u) ? fmaf(p0[r], Cs, tb[i0 + 63]) : -1e30f; p1[r] = ((mhi >> c0) & 1u) ? fmaf(p1[r], Cs, tb[i1 + 63]) : -1e30f; }
                }
            }
            float pmax = p0[0];
#pragma unroll
            for (int r = 1; r < 16; ++r) pmax = fmaxf(pmax, p0[r]);
#pragma unroll
            for (int r = 0; r < 16; ++r) pmax = fmaxf(pmax, p1[r]);
            { auto rr = __builtin_amdgcn_permlane32_swap(__float_as_uint(pmax), __float_as_uint(pmax), false, false); pmax = fmaxf(__uint_as_float(rr[0]), __uint_as_float(rr[1])); }
            const float sc_ = MODE == 1 ? Cs : 1.f;
            float mn = m_reg, alpha = 1.f;
            const bool grow = !__all((pmax - m_reg) * sc_ <= 11.5f);
            if (grow) { mn = fmaxf(m_reg, pmax); alpha = __builtin_amdgcn_exp2f((m_reg - mn) * sc_); m_reg = mn; }
            const float mns = -mn * sc_;
            float ps = 0.f;
#pragma unroll
            for (int r = 0; r < 16; ++r) { p0[r] = __builtin_amdgcn_exp2f(fmaf(p0[r], sc_, mns)); p1[r] = __builtin_amdgcn_exp2f(fmaf(p1[r], sc_, mns)); ps += p0[r] + p1[r]; }
            { auto rr = __builtin_amdgcn_permlane32_swap(__float_as_uint(ps), __float_as_uint(ps), false, false); ps = __uint_as_float(rr[0]) + __uint_as_float(rr[1]); }
            l_reg = l_reg * alpha + ps;
            if (grow) {
                if (hi == 0) al_l[r32] = alpha;
                asm volatile("s_waitcnt lgkmcnt(0)" ::: "memory");
#pragma unroll
                for (int r = 0; r < 16; ++r) { const float a = al_l[crow(r, hi)];
#pragma unroll
                    for (int d = 0; d < 4; ++d) o[d][r] *= a; }
            }
            bf16x8 pa0, pa1, pa2, pa3;
#define PK4(P, BASE, OUT) do { unsigned a0 = cvtpk(P[BASE + 0], P[BASE + 1]), a1 = cvtpk(P[BASE + 2], P[BASE + 3]);   \
    unsigned b0 = cvtpk(P[BASE + 4], P[BASE + 5]), b1 = cvtpk(P[BASE + 6], P[BASE + 7]);                              \
    auto r0 = __builtin_amdgcn_permlane32_swap(a0, b0, false, false); auto r1 = __builtin_amdgcn_permlane32_swap(a1, b1, false, false); \
    u32x4 w = {r0[0], r1[0], r0[1], r1[1]}; OUT = *reinterpret_cast<bf16x8*>(&w); } while (0)
            PK4(p0, 0, pa0); PK4(p0, 8, pa1); PK4(p1, 0, pa2); PK4(p1, 8, pa3);
#undef PK4
            const int vb = vb0 + cur * 16384;
            pv_one<0>(o[0], vb, pa0, pa1, pa2, pa3); pv_one<1>(o[1], vb, pa0, pa1, pa2, pa3); pv_one<2>(o[2], vb, pa0, pa1, pa2, pa3); pv_one<3>(o[3], vb, pa0, pa1, pa2, pa3);
        }
        asm volatile("s_waitcnt vmcnt(0)" ::: "memory");
        __syncthreads();
    }
#undef AT_ISSUE
    if (hi == 0) li_l[r32] = l_reg;
    asm volatile("s_waitcnt lgkmcnt(0)" ::: "memory");
#pragma unroll
    for (int r = 0; r < 16; ++r) {
        const int orow = wid * 32 + crow(r, hi);
        const float rl = __builtin_amdgcn_rcpf(li_l[crow(r, hi)]);
        if (orow < u.nvalid && !dry) {
#pragma unroll
            for (int d0 = 0; d0 < 4; ++d0) { const int c = d0 * 32 + r32;
                const float g = bf2f(u.G[(size_t)orow * u.ldg + c]);
                u.O[(size_t)orow * u.ldo + c] = f2bf(o[d0][r] * rl * g); }
        }
    }
    __syncthreads();
}

__device__ __forceinline__ void phase_attn_dsa(CPARAMS& p, char* lds, const bool dry = false) {
    const float Cs = 0.08838834764831845f * LOG2E;
    const int NU = 1024 + 64;
#pragma unroll 1
    for (int idx = blockIdx.x; idx < NU; idx += gridDim.x) {
        AttnUnit u;
        bf16_t* mix = (bf16_t*)(p.ws + W_MIX);
        if (idx < 1024) { const int k = idx >> 8, w = idx & 255, h = w & 7, qb0 = (w >> 3) & 15, b = (w >> 7) + 2 * k, qb = (k & 1) ? 15 - qb0 : qb0;
            const size_t row0 = (size_t)b * TP + qb * 256;
            u.Q = mix + row0 * 3072 + h * 128; u.O = mix + row0 * 3072 + h * 128; u.G = (const bf16_t*)(p.ws + W_SG) + row0 * 1024 + h * 128;
            u.K = (const bf16_t*)(p.ws + W_KP) + (size_t)b * TP * 1024 + h * 128; u.V = (const bf16_t*)(p.ws + W_VP) + (size_t)b * TP * 1024 + h * 128;
            u.M = (const u64*)(p.ws + W_MASKP) + row0 * 64; u.ldm = 64; u.nvalid = 256; u.qpos0 = qb * 256; u.NT = 4 * (qb + 1); u.head = h;
        } else { const int s = idx - 1024, b = s >> 3, h = s & 7; const size_t row0 = (size_t)NP + b * 64;
            u.Q = mix + row0 * 3072 + h * 128; u.O = mix + row0 * 3072 + h * 128; u.G = (const bf16_t*)(p.ws + W_SG) + row0 * 1024 + h * 128;
            u.K = (const bf16_t*)(p.ws + W_KS) + (size_t)b * LS * 1024 + h * 128; u.V = (const bf16_t*)(p.ws + W_VS) + (size_t)b * LS * 1024 + h * 128;
            u.M = (const u64*)(p.ws + W_MASKS) + (size_t)b * 64 * 32; u.ldm = 32; u.nvalid = 64; u.qpos0 = PAST; u.NT = 17; u.head = h; }
        u.Qr = nullptr; u.Kr = nullptr; u.ldq = 3072; u.ldqr = 0; u.ldk = 1024; u.ldo = 3072; u.ldg = 1024;
        attn_unit<0>(u, lds, p.in[I_T5], Cs, dry);
    }
}
__device__ __forceinline__ void phase_attn_mla(CPARAMS& p, char* lds, const bool dry = false) {
    const float Cs = 0.07216878364870323f * LOG2E;
    const int NU = 2048 + 128;
#pragma unroll 1
    for (int idx = blockIdx.x; idx < NU; idx += gridDim.x) {
        AttnUnit u;
        bf16_t* q2 = (bf16_t*)(p.ws + W_Q2); const bf16_t* kv = (const bf16_t*)(p.ws + W_KVALL); const bf16_t* kr = (const bf16_t*)(p.ws + W_KR);
        size_t row0, lrow0; int h;
        if (idx < 2048) { const int k = idx >> 8, w = idx & 255, qb0 = (w >> 4) & 15, b = k, qb = (k & 1) ? 15 - qb0 : qb0; h = w & 15;
            row0 = (size_t)b * TP + qb * 256; lrow0 = (size_t)b * TP; u.nvalid = 256; u.qpos0 = qb * 256; u.NT = 4 * (qb + 1);
        } else { const int s = idx - 2048, b = s >> 4; h = s & 15; row0 = (size_t)NP + b * 64; lrow0 = (size_t)NP + (size_t)b * LS; u.nvalid = 64; u.qpos0 = PAST; u.NT = 17; }
        u.Q = q2 + row0 * 3072 + h * 128; u.Qr = q2 + row0 * 3072 + 2048 + h * 64; u.O = q2 + row0 * 3072 + h * 128; u.G = (const bf16_t*)(p.ws + W_SGATE) + row0 * 2048 + h * 128;
        u.K = kv + lrow0 * 4096 + h * 128; u.V = kv + lrow0 * 4096 + 2048 + h * 128; u.Kr = kr + lrow0 * 64; u.M = nullptr;
        u.ldq = 3072; u.ldqr = 3072; u.ldk = 4096; u.ldo = 3072; u.ldg = 2048; u.ldm = 0; u.head = h;
        attn_unit<1>(u, lds, nullptr, Cs, dry);
    }
}

__device__ __forceinline__ void phase_conv(CPARAMS& p) {
    const int tid = opaque_tid();
    if (tid < 384) {
        const int ch = tid * 8;
        float cw[4][8], cb[8];
        { const float* cwp = p.in[I_CONVW] + ch; const float* cbp = p.in[I_CONVB] + ch;
#pragma unroll
          for (int j = 0; j < 4; ++j) { const f32x4 a = *(const f32x4*)(cwp + j * 3072), bq = *(const f32x4*)(cwp + j * 3072 + 4);
              cw[j][0] = a[0]; cw[j][1] = a[1]; cw[j][2] = a[2]; cw[j][3] = a[3]; cw[j][4] = bq[0]; cw[j][5] = bq[1]; cw[j][6] = bq[2]; cw[j][7] = bq[3]; }
          const f32x4 a = *(const f32x4*)cbp, bq = *(const f32x4*)(cbp + 4); cb[0] = a[0]; cb[1] = a[1]; cb[2] = a[2]; cb[3] = a[3]; cb[4] = bq[0]; cb[5] = bq[1]; cb[6] = bq[2]; cb[7] = bq[3]; }
        const bf16_t* xbc = (const bf16_t*)(p.ws + W_XBC);
        bf16_t* dst = ch < 2048 ? (bf16_t*)(p.ws + W_XACT) + ch : (bf16_t*)(p.ws + W_BCACT) + (ch - 2048);
        const int dstride = ch < 2048 ? 2048 : 1024;
#pragma unroll 1
        for (int unit = blockIdx.x; unit < MALL / 64; unit += gridDim.x) {
            const size_t row0 = (size_t)unit * 64;
            float w[3][8];
            const bool seqstart = row0 >= NP || (row0 & (TP - 1)) == 0;
            if (seqstart) {
                if (row0 >= NP) { const float* sp = p.in[I_SCONV] + ((row0 - NP) >> 6) * 3 * 3072 + ch;
#pragma unroll
                    for (int j = 0; j < 3; ++j) { const f32x4 a = *(const f32x4*)(sp + j * 3072), bq = *(const f32x4*)(sp + j * 3072 + 4);
                        w[j][0] = a[0]; w[j][1] = a[1]; w[j][2] = a[2]; w[j][3] = a[3]; w[j][4] = bq[0]; w[j][5] = bq[1]; w[j][6] = bq[2]; w[j][7] = bq[3]; } }
                else {
#pragma unroll
                    for (int j = 0; j < 3; ++j)
#pragma unroll
                        for (int e = 0; e < 8; ++e) w[j][e] = 0.f; }
            } else {
#pragma unroll
                for (int j = 0; j < 3; ++j) { const bf16x8 r = *(const bf16x8*)(xbc + (row0 - 3 + j) * 3072 + ch);
#pragma unroll
                    for (int e = 0; e < 8; ++e) w[j][e] = bf2f((bf16_t)r[e]); }
            }
#pragma unroll 1
            for (int r0 = 0; r0 < 64; r0 += 8) {
                bf16x8 raw[8];
#pragma unroll
                for (int r = 0; r < 8; ++r) raw[r] = *(const bf16x8*)(xbc + (row0 + r0 + r) * 3072 + ch);
#pragma unroll
                for (int r = 0; r < 8; ++r) { float o[8];
#pragma unroll
                    for (int e = 0; e < 8; ++e) { const float cur = bf2f((bf16_t)raw[r][e]);
                        o[e] = silu_f(cb[e] + cw[0][e] * w[0][e] + cw[1][e] * w[1][e] + cw[2][e] * w[2][e] + cw[3][e] * cur);
                        w[0][e] = w[1][e]; w[1][e] = w[2][e]; w[2][e] = cur; }
                    *(bf16x8*)(dst + (row0 + r0 + r) * dstride) = pack8(o); }
            }
        }
    }
}

constexpr int SD_XT = 0, SD_BS = 9216, SD_BTT = 26624, SD_CS = 45056, SD_CS2 = 62464, SD_WS = 79872, SD_H0 = 89088, SD_F = 106496;
__device__ __forceinline__ void phase_ssd(CPARAMS& p, char* lds, const bool dry = false) {
    const int tid = opaque_tid(), wid = tid >> 6, lane = tid & 63, l16 = lane & 15, lq = lane >> 4;
    bf16_t* XT = (bf16_t*)(lds + SD_XT); bf16_t* Bs = (bf16_t*)(lds + SD_BS); bf16_t* BTt = (bf16_t*)(lds + SD_BTT); bf16_t* Cs = (bf16_t*)(lds + SD_CS);
    bf16_t* Cs2 = (bf16_t*)(lds + SD_CS2); bf16_t* Ws = (bf16_t*)(lds + SD_WS); bf16_t* H0 = (bf16_t*)(lds + SD_H0);
    float* s_acum = (float*)(lds + SD_F); float* s_dt = s_acum + 64; float* s_ea = s_acum + 128; float* s_tail = s_acum + 192; float* s_ssq = s_acum + 256;
    const bf16_t* xbc = (const bf16_t*)(p.ws + W_XBC); bf16_t* mix = (bf16_t*)(p.ws + W_MIX);
    const float* dtbuf = (const float*)(p.ws + W_DT); float* ssqg = (float*)(p.ws + W_SSQ);
#pragma unroll 1
    for (int idx = blockIdx.x; idx < 512; idx += gridDim.x) {
        const bool sample = idx >= 256; const int bh = idx & 255, b = bh >> 5, h = bh & 31, g = h >> 3;
        const size_t row0 = sample ? (size_t)NP + b * 64 : (size_t)b * TP; const int nch = sample ? 1 : 64;
        const float a_h = -__expf(p.in[I_ALOG][h]), d_h = p.in[I_DSKIP][h];
        f32x4 hacc[4];
        const int pt = wid >> 1;
#pragma unroll
        for (int j = 0; j < 4; ++j) { const int nt = (wid & 1) * 4 + j;
#pragma unroll
            for (int i = 0; i < 4; ++i) { const int pp = pt * 16 + 4 * lq + i, nn = nt * 16 + l16;
                hacc[j][i] = sample ? p.in[I_SSSM][(((size_t)b * 32 + h) * 64 + pp) * 128 + nn] : 0.f;
                H0[pp * 136 + nn] = f2bf(hacc[j][i]); } }
        const int cg8 = tid % 40, rb = tid / 40; const bool ldr = tid < 320;
        const bf16_t* asrc = cg8 < 8 ? (const bf16_t*)(p.ws + W_XACT) + h * 64 + cg8 * 8 : (const bf16_t*)(p.ws + W_BCACT) + (cg8 < 24 ? g * 128 + (cg8 - 8) * 8 : 512 + g * 128 + (cg8 - 24) * 8);
        const size_t astride = cg8 < 8 ? 2048 : 1024;
        bf16x8 av[8];
#pragma unroll
        for (int r = 0; r < 8; ++r) av[r] = ldr ? *(const bf16x8*)(asrc + (row0 + rb * 8 + r) * astride) : (bf16x8){0, 0, 0, 0, 0, 0, 0, 0};
        float dt_next = (wid == 0) ? dtbuf[(row0 + lane) * 32 + h] : 0.f;
        bf16_t szv[2][4];
#pragma unroll
        for (int q = 0; q < 2; ++q) { const int id = wid * 2 + q, mt = id >> 2, nt = id & 3;
#pragma unroll
            for (int i = 0; i < 4; ++i) szv[q][i] = mix[(row0 + mt * 16 + 4 * lq + i) * 3072 + 1024 + h * 64 + nt * 16 + l16]; }
#pragma unroll 1
        for (int c = 0; c < nch; ++c) {
            const size_t crow0 = row0 + (size_t)c * 64;
            if (wid == 0) {
                if (c > 0 && !dry) ssqg[(size_t)h * MALL + (crow0 - 64 + lane)] = (s_ssq[lane] + s_ssq[64 + lane]) + (s_ssq[128 + lane] + s_ssq[192 + lane]);
                const float dtv = dt_next; float ac = dtv * a_h;
                if (c + 1 < nch) dt_next = dtbuf[(crow0 + 64 + lane) * 32 + h];
                ac = wave_scan_incl(ac, lane);
                const float a63 = __builtin_bit_cast(float, __builtin_amdgcn_readlane(__builtin_bit_cast(int, ac), 63));
                s_acum[lane] = ac; s_dt[lane] = dtv; s_ea[lane] = __expf(ac); s_tail[lane] = __expf(a63 - ac) * dtv;
            }
            __syncthreads();
            if (ldr) {
                const int t0l = rb * 8;
#pragma unroll
                for (int hf = 0; hf < 2; ++hf) {
                    float vout[8][4];
#pragma unroll
                    for (int r = 0; r < 8; ++r)
#pragma unroll
                        for (int e = 0; e < 4; ++e) vout[r][e] = bf2f((bf16_t)av[r][hf * 4 + e]);
                    if (cg8 < 8) {
#pragma unroll
                        for (int e = 0; e < 4; ++e) { float t[8];
#pragma unroll
                            for (int r = 0; r < 8; ++r) t[r] = vout[r][e];
                            *(bf16x8*)(XT + (cg8 * 8 + hf * 4 + e) * 72 + t0l) = pack8(t); }
                    } else if (cg8 < 24) {
                        const int n0 = (cg8 - 8) * 8 + hf * 4;
#pragma unroll
                        for (int r = 0; r < 8; ++r) { const f32x4 q = {vout[r][0], vout[r][1], vout[r][2], vout[r][3]}; *(u32x2*)(Bs + (t0l + r) * 136 + n0) = pack4(q); }
                        float tl8[8];
#pragma unroll
                        for (int r = 0; r < 8; ++r) tl8[r] = s_tail[t0l + r];
#pragma unroll
                        for (int e = 0; e < 4; ++e) { float t[8];
#pragma unroll
                            for (int r = 0; r < 8; ++r) t[r] = vout[r][e] * tl8[r];
                            *(bf16x8*)(BTt + (n0 + e) * 72 + t0l) = pack8(t); }
                    } else {
                        const int n0 = (cg8 - 24) * 8 + hf * 4;
#pragma unroll
                        for (int r = 0; r < 8; ++r) { const f32x4 q = {vout[r][0], vout[r][1], vout[r][2], vout[r][3]}; *(u32x2*)(Cs + (t0l + r) * 136 + n0) = pack4(q);
                            const float ea = s_ea[t0l + r]; *(u32x2*)(Cs2 + (t0l + r) * 136 + n0) = pack4(q * ea); }
                    }
                }
                if (c + 1 < nch) {
#pragma unroll
                    for (int r = 0; r < 8; ++r) av[r] = *(const bf16x8*)(asrc + (crow0 + 64 + rb * 8 + r) * astride);
                }
            }
            __syncthreads();
#pragma unroll
            for (int q = 0; q < 2; ++q) { const int id = wid * 2 + q, mt = id >> 2, nt = id & 3;
                f32x4 acc = {0.f, 0.f, 0.f, 0.f};
                if (nt <= mt) {
#pragma unroll
                    for (int ks = 0; ks < 4; ++ks) { const bf16x8 af = *(const bf16x8*)(Cs + (mt * 16 + l16) * 136 + ks * 32 + lq * 8), bf = *(const bf16x8*)(Bs + (nt * 16 + l16) * 136 + ks * 32 + lq * 8);
                        acc = __builtin_amdgcn_mfma_f32_16x16x32_bf16(af, bf, acc, 0, 0, 0); }
                }
                const int s = nt * 16 + l16; const float as = s_acum[s], dts = s_dt[s];
#pragma unroll
                for (int i = 0; i < 4; ++i) { const int t = mt * 16 + 4 * lq + i; const float w = (s <= t) ? acc[i] * __expf(s_acum[t] - as) * dts : 0.f; Ws[t * 72 + s] = f2bf(w); }
            }
            __syncthreads();
#pragma unroll
            for (int q = 0; q < 2; ++q) { const int id = wid * 2 + q, mt = id >> 2, nt = id & 3;
                f32x4 acc = {0.f, 0.f, 0.f, 0.f};
#pragma unroll
                for (int ks = 0; ks < 2; ++ks) { const bf16x8 af = *(const bf16x8*)(Ws + (mt * 16 + l16) * 72 + ks * 32 + lq * 8), bf = *(const bf16x8*)(XT + (nt * 16 + l16) * 72 + ks * 32 + lq * 8);
                    acc = __builtin_amdgcn_mfma_f32_16x16x32_bf16(af, bf, acc, 0, 0, 0); }
#pragma unroll
                for (int ks = 0; ks < 4; ++ks) { const bf16x8 af = *(const bf16x8*)(Cs2 + (mt * 16 + l16) * 136 + ks * 32 + lq * 8), bf = *(const bf16x8*)(H0 + (nt * 16 + l16) * 136 + ks * 32 + lq * 8);
                    acc = __builtin_amdgcn_mfma_f32_16x16x32_bf16(af, bf, acc, 0, 0, 0); }
                const int pp = nt * 16 + l16;
#pragma unroll
                for (int i = 0; i < 4; ++i) { const int t = mt * 16 + 4 * lq + i;
                    const float xv = bf2f(XT[pp * 72 + t]);
                    const float yg = (acc[i] + d_h * xv) * bf2f(szv[q][i]);
                    if (!dry) mix[(crow0 + t) * 3072 + 1024 + h * 64 + pp] = f2bf(yg);
                    float sq = yg * yg;
                    sq = row16_sum(sq);
                    if (l16 == 0) s_ssq[nt * 64 + t] = sq; }
            }
            if (c + 1 < nch) {
#pragma unroll
                for (int q = 0; q < 2; ++q) { const int id = wid * 2 + q, mt = id >> 2, nt = id & 3;
#pragma unroll
                    for (int i = 0; i < 4; ++i) szv[q][i] = mix[(crow0 + 64 + mt * 16 + 4 * lq + i) * 3072 + 1024 + h * 64 + nt * 16 + l16]; } }
            const float e63 = s_ea[63];
            __syncthreads();
#pragma unroll
            for (int j = 0; j < 4; ++j) { const int nt = (wid & 1) * 4 + j;
                f32x4 acc = hacc[j] * e63;
#pragma unroll
                for (int ks = 0; ks < 2; ++ks) { const bf16x8 af = *(const bf16x8*)(XT + (pt * 16 + l16) * 72 + ks * 32 + lq * 8), bf = *(const bf16x8*)(BTt + (nt * 16 + l16) * 72 + ks * 32 + lq * 8);
                    acc = __builtin_amdgcn_mfma_f32_16x16x32_bf16(af, bf, acc, 0, 0, 0); }
                hacc[j] = acc;
#pragma unroll
                for (int i = 0; i < 4; ++i) H0[(pt * 16 + 4 * lq + i) * 136 + nt * 16 + l16] = f2bf(acc[i]);
            }
        }
        __syncthreads();
        if (wid == 0 && !dry) ssqg[(size_t)h * MALL + (row0 + (size_t)(nch - 1) * 64 + lane)] = (s_ssq[lane] + s_ssq[64 + lane]) + (s_ssq[128 + lane] + s_ssq[192 + lane]);
        if (!dry) { float* ho = p.out + (sample ? O_BSS : O_BSP) + ((size_t)b * 32 + h) * 64 * 128;
#pragma unroll
          for (int j = 0; j < 4; ++j) { const int nt = (wid & 1) * 4 + j;
#pragma unroll
              for (int i = 0; i < 4; ++i) ho[(size_t)(pt * 16 + 4 * lq + i) * 128 + nt * 16 + l16] = hacc[j][i]; } }
        __syncthreads();
    }
}

__device__ __forceinline__ void phase_bnorm(CPARAMS& p) {
    bf16_t* mix = (bf16_t*)(p.ws + W_MIX); const float* ssq = (const float*)(p.ws + W_SSQ); const float* nw = p.in[I_SNORM];
    const size_t n = (size_t)MALL * 256, stride = (size_t)gridDim.x * 512;
    const int tidb = opaque_tid();
    for (size_t i0 = (size_t)blockIdx.x * 512 + tidb; i0 < n; i0 += 4 * stride) {
        bf16x8 v[4]; float tot[4];
#pragma unroll
        for (int u = 0; u < 4; ++u) { const size_t i = i0 + u * stride; tot[u] = 0.f; v[u] = (bf16x8){0, 0, 0, 0, 0, 0, 0, 0};
            if (i < n) { const size_t row = i >> 8; const int c0 = (int)(i & 255) * 8, g = c0 >> 9;
                v[u] = *(const bf16x8*)(mix + row * 3072 + 1024 + c0);
#pragma unroll
                for (int hh = 0; hh < 8; ++hh) tot[u] += ssq[(size_t)(g * 8 + hh) * MALL + row]; } }
#pragma unroll
        for (int u = 0; u < 4; ++u) { const size_t i = i0 + u * stride;
            if (i < n) { const size_t row = i >> 8; const int c0 = (int)(i & 255) * 8;
                const float r = rsqrtf(tot[u] * (1.f / 512.f) + EPSV);
                const f32x4 w0 = *(const f32x4*)(nw + c0), w1 = *(const f32x4*)(nw + c0 + 4);
                float t[8];
#pragma unroll
                for (int e2 = 0; e2 < 8; ++e2) t[e2] = bf2f((bf16_t)v[u][e2]) * r * (e2 < 4 ? w0[e2] : w1[e2 - 4]);
                *(bf16x8*)(mix + row * 3072 + 1024 + c0) = pack8(t); } }
    }
}
__device__ __forceinline__ void phase_ln(CPARAMS& p, const float* gw, const float* bw, bf16_t* yb, const bool dry = false) {
    int tid_ = threadIdx.x; asm volatile("" : "+v"(tid_));
    const int wid = tid_ >> 6, lane = tid_ & 63;
    float* y = p.out + O_Y;
    for (int row = blockIdx.x * 8 + wid; row < MALL; row += gridDim.x * 8) {
        float* rp = y + (size_t)row * DM;
        f32x4 v[8]; float s = 0.f;
#pragma unroll
        for (int j = 0; j < 8; ++j) { v[j] = *(const f32x4*)(rp + j * 256 + lane * 4); s += v[j][0] + v[j][1] + v[j][2] + v[j][3]; }
        const float mu = wave_sum(s) * (1.f / DM);
        float q = 0.f;
#pragma unroll
        for (int j = 0; j < 8; ++j) { v[j] = v[j] - mu; q += v[j][0] * v[j][0] + v[j][1] * v[j][1] + v[j][2] * v[j][2] + v[j][3] * v[j][3]; }
        const float rs = rsqrtf(wave_sum(q) * (1.f / DM) + EPSV);
#pragma unroll
        for (int j = 0; j < 8; ++j) { const int c = j * 256 + lane * 4; const f32x4 gg = *(const f32x4*)(gw + c), bb = *(const f32x4*)(bw + c);
            const f32x4 o = v[j] * rs * gg + bb; if (!dry) { *(f32x4*)(rp + c) = o; if (yb) *(u32x2*)(yb + (size_t)row * DM + c) = pack4(o); } else if (o[0] == 1.2345e30f) rp[c] = 0.f; }
    }
}
__device__ __forceinline__ void phase_post1(CPARAMS& p) {
    const int tidp = opaque_tid(); const int wid = tidp >> 6, lane = tidp & 63;
    const float* cqkv = (const float*)(p.ws + W_CQKV); bf16_t* cqn = (bf16_t*)(p.ws + W_CQN); bf16_t* lat = (bf16_t*)(p.ws + W_LAT); bf16_t* krb = (bf16_t*)(p.ws + W_KR);
    const float2* tab = (const float2*)(p.ws + W_ROPE);
    for (int row = blockIdx.x * 8 + wid; row < MALL; row += gridDim.x * 8) {
        const float* rp = cqkv + (size_t)row * 1088;
        const f32x4 a0 = *(const f32x4*)(rp + lane * 8), a1 = *(const f32x4*)(rp + lane * 8 + 4), c0 = *(const f32x4*)(rp + 512 + lane * 8), c1 = *(const f32x4*)(rp + 512 + lane * 8 + 4);
        const float kv = rp[1024 + lane];
        float sa = 0.f, sc = 0.f;
#pragma unroll
        for (int e = 0; e < 4; ++e) { sa += a0[e] * a0[e] + a1[e] * a1[e]; sc += c0[e] * c0[e] + c1[e] * c1[e]; }
        const float ra = rsqrtf(wave_sum(sa) * (1.f / 512.f) + EPSV), rc = rsqrtf(wave_sum(sc) * (1.f / 512.f) + EPSV);
        const f32x4 qw0 = *(const f32x4*)(p.in[I_QNW] + lane * 8), qw1 = *(const f32x4*)(p.in[I_QNW] + lane * 8 + 4), kw0 = *(const f32x4*)(p.in[I_KVNW] + lane * 8), kw1 = *(const f32x4*)(p.in[I_KVNW] + lane * 8 + 4);
        const f32x4 qa = a0 * ra * qw0, qb = a1 * ra * qw1, la = c0 * rc * kw0, lb = c1 * rc * kw1;
        { const float t[8] = {qa[0], qa[1], qa[2], qa[3], qb[0], qb[1], qb[2], qb[3]}; *(bf16x8*)(cqn + (size_t)row * 512 + lane * 8) = pack8(t); }
        const int lr = latrow_of(row);
        { const float t[8] = {la[0], la[1], la[2], la[3], lb[0], lb[1], lb[2], lb[3]}; *(bf16x8*)(lat + (size_t)lr * 512 + lane * 8) = pack8(t); }
        float* clo = row < NP ? p.out + O_CLP + (size_t)row * 512 : p.out + O_CLS + (size_t)(row - NP) * 512;
        *(f32x4*)(clo + lane * 8) = la; *(f32x4*)(clo + lane * 8 + 4) = lb;
        const float other = __shfl_xor(kv, 32);
        const int i = lane & 31, pos = pos_of(row); const float2 cs = tab[(size_t)pos * 32 + i];
        const float o = lane < 32 ? kv * cs.x - other * cs.y : other * cs.y + kv * cs.x;
        float* cko = row < NP ? p.out + O_CKP + (size_t)row * 64 : p.out + O_CKS + (size_t)(row - NP) * 64;
        cko[lane] = o;
        krb[(size_t)lr * 64 + 4 * (i >> 1) + (i & 1) + (lane >= 32 ? 2 : 0)] = f2bf(o);
    }
    const size_t gtid = (size_t)blockIdx.x * 512 + tidp, gstride = (size_t)gridDim.x * 512;
    { const size_t n8 = (size_t)8 * PAST * 512 / 8;
      for (size_t i = gtid; i < n8; i += gstride) { const size_t e = i * 8, b = e / ((size_t)PAST * 512), rem = e % ((size_t)PAST * 512); const float* s = p.in[I_CLAT] + e;
        const f32x4 a = *(const f32x4*)s, c = *(const f32x4*)(s + 4); const float t[8] = {a[0], a[1], a[2], a[3], c[0], c[1], c[2], c[3]};
        *(bf16x8*)(lat + ((size_t)NP + b * LS) * 512 + rem) = pack8(t); } }
    { const size_t n = (size_t)8 * PAST * 64;
      for (size_t e = gtid; e < n; e += gstride) { const size_t b = e / ((size_t)PAST * 64), rem = e % ((size_t)PAST * 64), t = rem >> 6; const int j = (int)(rem & 63), i = j & 31;
        krb[((size_t)NP + b * LS + t) * 64 + 4 * (i >> 1) + (i & 1) + (j >= 32 ? 2 : 0)] = f2bf(p.in[I_CKR][e]); } }
}

__device__ __forceinline__ CPARAMS& get_params() {
    const unsigned long long v = (unsigned long long)__builtin_amdgcn_kernarg_segment_ptr(); unsigned lo = (unsigned)v, hi = (unsigned)(v >> 32);
    asm volatile("" : "+s"(lo), "+s"(hi));
    lo = __builtin_amdgcn_readfirstlane(lo); hi = __builtin_amdgcn_readfirstlane(hi);
    return *(CPARAMS*)(((unsigned long long)hi << 32) | lo);
}
#ifndef PROBE_STOP
#define PROBE_STOP 0
#endif
__device__ __forceinline__ void phase_dump(CPARAMS& p) {
    const unsigned short* w = (const unsigned short*)p.ws; float* y = p.out + O_Y; const size_t n = (size_t)MALL * DM;
#ifdef PROBE_THRASH
    { const f32x4* xs = (const f32x4*)p.in[I_XP] + (size_t)((blockIdx.x >> 3) & 31) * (NP * (size_t)DM / 4 / 32); f32x4 a = {0.f, 0.f, 0.f, 0.f};
      for (size_t i = threadIdx.x; i < NP * (size_t)DM / 4 / 32; i += 512) a += xs[i];
      if (a[0] + a[1] + a[2] + a[3] == 1.2345e30f) y[0] = 1.f;
      __syncthreads(); __threadfence(); }
    cg::this_grid().sync(); __threadfence();
#endif
    for (size_t i = (size_t)blockIdx.x * 512 + threadIdx.x; i < n; i += (size_t)gridDim.x * 512) {
        unsigned h = 0x12345u;
#pragma unroll
        for (int r = 0; r < 8; ++r) { const size_t o = (size_t)r * n + i; const unsigned v = (o * 2 < W_END) ? w[o] : 0u; h = (h ^ v) * 0x9E3779B1u; }
        h ^= h >> 15; y[i] = (float)((h >> 8) & 127u);
    }
}
#define PROBE_AT(k) do { if (PROBE_STOP == (k)) { CPARAMS& pq = get_params(); phase_dump(pq); return; } } while (0)
__global__ void __launch_bounds__(512) fwd_megakernel(Params p_unused) {
    extern __shared__ __attribute__((aligned(16))) char lds[];
    cg::grid_group grid = cg::this_grid();
#ifndef TIME_X2
#define TIME_X2 0
#endif
    const bool dryflag = get_params().ws != nullptr;
    unsigned nbar = 0;
#define GSYNC_CG() do { __builtin_amdgcn_fence(__ATOMIC_RELEASE, "agent"); asm volatile("s_waitcnt vmcnt(0)" ::: "memory"); grid.sync(); __builtin_amdgcn_fence(__ATOMIC_ACQUIRE, "agent"); } while (0)
#define GSYNC() do { ++nbar; asm volatile("s_waitcnt vmcnt(0)" ::: "memory"); __syncthreads(); \
        if (threadIdx.x == 0) { unsigned* ctr_ = (unsigned*)(get_params().ws + W_BAR); const unsigned tgt_ = nbar * gridDim.x; \
            __builtin_amdgcn_fence(__ATOMIC_RELEASE, "agent"); asm volatile("s_waitcnt vmcnt(0)" ::: "memory"); \
            __hip_atomic_fetch_add(ctr_, 1u, __ATOMIC_RELAXED, __HIP_MEMORY_SCOPE_AGENT); \
            while (__hip_atomic_load(ctr_, __ATOMIC_RELAXED, __HIP_MEMORY_SCOPE_AGENT) < tgt_) __builtin_amdgcn_s_sleep(1); \
            __builtin_amdgcn_fence(__ATOMIC_ACQUIRE, "agent"); asm volatile("s_waitcnt vmcnt(0)" ::: "memory"); } \
        __syncthreads(); } while (0)
    if (TIME_X2 == 1) { CPARAMS& p = get_params(); phase_prep(p, lds); __syncthreads(); }
    { CPARAMS& p = get_params(); phase_prep(p, lds); }
    if (__builtin_expect(get_params().ws == nullptr, 0)) GSYNC_CG();
    GSYNC();
    PROBE_AT(1);
    if (TIME_X2 == 2)
    { CPARAMS& p = get_params(); pg8::Gemm g; g.A = (const bf16_t*)(p.ws + W_XB); g.Bt = (const bf16_t*)(p.ws + W_BT0); g.M = MALL; g.N = NIN0P; g.K = DM; g.lda = DM;
      pg8::StaticOrder S; S.init(MALL, NIN0P, (int)gridDim.x, (int)blockIdx.x); EpiInProj0 E{p.ws, p.out, p.in[I_DTB]};
      pg8::gemm_phase<EpiInProj0, pg8::StaticOrder>((PG8_LAS unsigned char*)lds, g, S, E); }
    { CPARAMS& p = get_params(); pg8::Gemm g; g.A = (const bf16_t*)(p.ws + W_XB); g.Bt = (const bf16_t*)(p.ws + W_BT0); g.M = MALL; g.N = NIN0P; g.K = DM; g.lda = DM;
      pg8::StaticOrder S; S.init(MALL, NIN0P, (int)gridDim.x, (int)blockIdx.x); EpiInProj0 E{p.ws, p.out, p.in[I_DTB]};
      pg8::gemm_phase<EpiInProj0, pg8::StaticOrder>((PG8_LAS unsigned char*)lds, g, S, E); }
    GSYNC();
    PROBE_AT(2);
    if (TIME_X2 == 3) { CPARAMS& p = get_params(); phase_index(p, lds); }
    if (TIME_X2 == 12) { CPARAMS& p = get_params(); phase_conv(p); }
    { CPARAMS& p = get_params(); phase_conv(p); }
    { CPARAMS& p = get_params(); phase_index(p, lds); }
    GSYNC();
    PROBE_AT(3);
    if (TIME_X2 == 4) { CPARAMS& p = get_params(); phase_attn_dsa(p, lds, dryflag); }
    if (TIME_X2 == 5) { CPARAMS& p = get_params(); phase_ssd(p, lds, dryflag); }
#ifndef PROBE_SKIP_DSA
    { CPARAMS& p = get_params(); phase_attn_dsa(p, lds); }
#endif
#ifndef PROBE_SKIP_SSD
    { CPARAMS& p = get_params(); phase_ssd(p, lds); }
#endif
    GSYNC();
    PROBE_AT(4);
    { CPARAMS& p = get_params(); phase_bnorm(p); }
    GSYNC();
    PROBE_AT(5);
    if (TIME_X2 == 6)
    { CPARAMS& p = get_params(); FResid f{p.in[I_XP], p.in[I_XS], p.out + O_Y}; run_gemm(lds, (const bf16_t*)(p.ws + W_MIX), 3072, (const bf16_t*)(p.ws + W_BTOUT0), MALL, DM, 3072, f); }
    { CPARAMS& p = get_params(); FResid f{p.in[I_XP], p.in[I_XS], p.out + O_Y}; run_gemm(lds, (const bf16_t*)(p.ws + W_MIX), 3072, (const bf16_t*)(p.ws + W_BTOUT0), MALL, DM, 3072, f); }
    GSYNC();
    PROBE_AT(6);
    if (TIME_X2 == 7) { CPARAMS& p = get_params(); phase_ln(p, p.in[I_LN0G], p.in[I_LN0B], (bf16_t*)(p.ws + W_XB), dryflag); }
    { CPARAMS& p = get_params(); phase_ln(p, p.in[I_LN0G], p.in[I_LN0B], (bf16_t*)(p.ws + W_XB)); }
    GSYNC();
    PROBE_AT(7);
    if (TIME_X2 == 8)
    { CPARAMS& p = get_params(); FInProj1 f{p.ws}; run_gemm(lds, (const bf16_t*)(p.ws + W_XB), DM, (const bf16_t*)(p.ws + W_BT1), MALL, NIN1P, DM, f); }
    { CPARAMS& p = get_params(); FInProj1 f{p.ws}; run_gemm(lds, (const bf16_t*)(p.ws + W_XB), DM, (const bf16_t*)(p.ws + W_BT1), MALL, NIN1P, DM, f); }
    GSYNC();
    PROBE_AT(8);
    if (TIME_X2 == 9) { CPARAMS& p = get_params(); phase_post1(p); }
    { CPARAMS& p = get_params(); phase_post1(p); }
    GSYNC();
    PROBE_AT(9);
    if (TIME_X2 == 10)
    { CPARAMS& p = get_params(); FQUp f{p.ws}; run_gemm(lds, (const bf16_t*)(p.ws + W_CQN), 512, (const bf16_t*)(p.ws + W_BTUQ), MALL, 3072, 512, f); }
    { CPARAMS& p = get_params(); FQUp f{p.ws}; run_gemm(lds, (const bf16_t*)(p.ws + W_CQN), 512, (const bf16_t*)(p.ws + W_BTUQ), MALL, 3072, 512, f); }
    { CPARAMS& p = get_params(); FKvUp f{p.ws}; run_gemm(lds, (const bf16_t*)(p.ws + W_LAT), 512, (const bf16_t*)(p.ws + W_BTUKV), LATROWS, 4096, 512, f, true); }
    GSYNC();
    PROBE_AT(10);
    if (TIME_X2 == 11) { CPARAMS& p = get_params(); phase_attn_mla(p, lds, dryflag); }
    { CPARAMS& p = get_params(); phase_attn_mla(p, lds); }
    GSYNC();
    PROBE_AT(11);
    { CPARAMS& p = get_params(); FResid f{p.out + O_Y, p.out + O_Y + (size_t)NP * DM, p.out + O_Y}; run_gemm(lds, (const bf16_t*)(p.ws + W_Q2), 3072, (const bf16_t*)(p.ws + W_BTOUT1), MALL, DM, DM, f); }
    GSYNC();
    PROBE_AT(12);
    { CPARAMS& p = get_params(); phase_ln(p, p.in[I_LN1G], p.in[I_LN1B], nullptr); }
}

extern "C" void kernel_launch(void* const* d_in, const int* in_sizes, int n_in, void* d_out, int out_size, void* d_ws, size_t ws_size, hipStream_t stream) {
    static int grid_blocks = 0;
    if (!grid_blocks) {
        if (n_in != N_IN || (size_t)out_size != O_END || ws_size < W_END) { fprintf(stderr, "kernel_launch: unexpected shapes n_in %d out %d ws %zu\n", n_in, out_size, ws_size); return; }
        if (hipFuncSetAttribute((const void*)fwd_megakernel, hipFuncAttributeMaxDynamicSharedMemorySize, LDS_BYTES) != hipSuccess) { fprintf(stderr, "kernel_launch: LDS attribute failed\n"); return; }
        int dev = 0, cus = 0, per_cu = 0;
        hipGetDevice(&dev); hipDeviceGetAttribute(&cus, hipDeviceAttributeMultiprocessorCount, dev);
        hipOccupancyMaxActiveBlocksPerMultiprocessor(&per_cu, fwd_megakernel, 512, LDS_BYTES);
        if (per_cu < 1) { fprintf(stderr, "kernel_launch: occupancy 0\n"); return; }
        grid_blocks = cus;
    }
    if (hipMemsetAsync((char*)d_ws + W_BAR, 0, 256, stream) != hipSuccess) { fprintf(stderr, "kernel_launch: memset failed\n"); return; }
    Params p{};
    for (int i = 0; i < N_IN; ++i) p.in[i] = (const float*)d_in[i];
    p.out = (float*)d_out; p.ws = (char*)d_ws;
    void* args[] = {&p};
    hipError_t e = hipLaunchCooperativeKernel((const void*)fwd_megakernel, dim3(grid_blocks), dim3(512), args, LDS_BYTES, stream);
    if (e != hipSuccess) fprintf(stderr, "cooperative launch failed: %s (grid %d)\n", hipGetErrorString(e), grid_blocks);
}
```

```cpp
#include <hip/hip_runtime.h>
#include <hip/hip_cooperative_groups.h>
#include <cstdio>
#include <cstdint>
namespace cg = cooperative_groups;

#define LAS __attribute__((address_space(3)))
typedef unsigned short bf16_t;
typedef short bf16x8 __attribute__((ext_vector_type(8)));
typedef short s16x4 __attribute__((ext_vector_type(4)));
typedef float f32x4 __attribute__((ext_vector_type(4)));
typedef float f32x8 __attribute__((ext_vector_type(8)));
typedef float f32x16 __attribute__((ext_vector_type(16)));
typedef unsigned u32x4 __attribute__((ext_vector_type(4)));
typedef unsigned u32x2 __attribute__((ext_vector_type(2)));
typedef unsigned long long u64;

constexpr int DM = 2048, NP = 32768, NS = 512, MALL = NP + NS  , TP = 4096, TS = 64, PAST = 1024, LS = PAST + TS  ;
constexpr int NIN0 = 10352, NIN0P = 10496, NIN1 = 3136, NIN1P = 3328;
constexpr int LATROWS = NP + 8 * LS;
constexpr float ALPHA_RES = 1.4142135623730951f;
constexpr float LOG2E = 1.4426950408889634f;
constexpr float EPSV = 1e-5f;

enum { I_XP = 0, I_XS, I_CAK, I_CAV, I_CAKI, I_SCONV, I_SSSM, I_CLAT, I_CKR, I_T5, I_WIN0, I_WOUT0, I_CONVW, I_CONVB, I_DTB, I_ALOG, I_DSKIP,
       I_SNORM, I_LN0G, I_LN0B, I_WIN1, I_QNW, I_KVNW, I_WUQ, I_WUKV, I_WOUT1, I_LN1G, I_LN1B, N_IN };

constexpr size_t O_Y = 0;
constexpr size_t O_AKP = (size_t)MALL * DM;
constexpr size_t O_AKS = O_AKP + (size_t)NP * 1024;
constexpr size_t O_AVP = O_AKS + (size_t)NS * 1024;
constexpr size_t O_AVS = O_AVP + (size_t)NP * 1024;
constexpr size_t O_KIP = O_AVS + (size_t)NS * 1024;
constexpr size_t O_KIS = O_KIP + (size_t)NP * 64;
constexpr size_t O_BCP = O_KIS + (size_t)NS * 64;
constexpr size_t O_BCS = O_BCP + (size_t)8 * 3 * 3072;
constexpr size_t O_BSP = O_BCS + (size_t)8 * 3 * 3072;
constexpr size_t O_BSS = O_BSP + (size_t)8 * 32 * 64 * 128;
constexpr size_t O_CLP = O_BSS + (size_t)8 * 32 * 64 * 128;
constexpr size_t O_CLS = O_CLP + (size_t)NP * 512;
constexpr size_t O_CKP = O_CLS + (size_t)NS * 512;
constexpr size_t O_CKS = O_CKP + (size_t)NP * 64;
constexpr size_t O_END = O_CKS + (size_t)NS * 64;

constexpr size_t MiB = 1ull << 20;
constexpr size_t W_BT0 = 0;
constexpr size_t W_BTOUT0 = 41 * MiB;
constexpr size_t W_BT1 = 53 * MiB;
constexpr size_t W_BTUQ = 66 * MiB;
constexpr size_t W_BTUKV = 69 * MiB;
constexpr size_t W_BTOUT1 = 73 * MiB;
constexpr size_t W_ROPE = 81 * MiB;
constexpr size_t W_KIDXP = 82 * MiB;
constexpr size_t W_KIDXS = 86 * MiB;
constexpr size_t W_IW = 88 * MiB;
constexpr size_t W_DT = 91 * MiB;
constexpr size_t W_MASKP = 96 * MiB;
constexpr size_t W_MASKS = 112 * MiB;
constexpr size_t W_SSQ = 113 * MiB;
constexpr size_t W_BAR = 118 * MiB;
constexpr size_t W_XB = 120 * MiB;
constexpr size_t W_MIX = 250 * MiB;
constexpr size_t W_KP = 445 * MiB;
constexpr size_t W_KS = 509 * MiB;
constexpr size_t W_VP = 526 * MiB;
constexpr size_t W_VS = 590 * MiB;
constexpr size_t W_SG = 607 * MiB;
constexpr size_t W_IQ = 672 * MiB;
constexpr size_t W_XBC = 737 * MiB;
constexpr size_t W_KVALL = 120 * MiB;
constexpr size_t W_CQKV = 445 * MiB;
constexpr size_t W_CQN = 584 * MiB;
constexpr size_t W_LAT = 617 * MiB;
constexpr size_t W_KR = 658 * MiB;
constexpr size_t W_Q2 = 664 * MiB;
constexpr size_t W_SGATE = 860 * MiB;
constexpr size_t W_XACT = W_XB;
constexpr size_t W_BCACT = 932 * MiB;
constexpr size_t W_END = 997 * MiB;

struct Params { const float* in[N_IN]; float* out; char* ws; };
#define CPARAMS const __attribute__((address_space(4))) Params

constexpr int LDS_BYTES = 131072 + 32768;
#define KRSWZ(row, colB) ((row) * 128 + ((colB) ^ ((((row) >> 1) & 7) << 4)))

typedef __bf16 bf16x2_t __attribute__((ext_vector_type(2)));
typedef float f32x2_t __attribute__((ext_vector_type(2)));
__device__ __forceinline__ unsigned cvtpk(float lo, float hi) { const f32x2_t v = {lo, hi}; const bf16x2_t r = __builtin_convertvector(v, bf16x2_t); return __builtin_bit_cast(unsigned, r); }
__device__ __forceinline__ bf16_t f2bf(float f) { return (bf16_t)(cvtpk(f, f) & 0xffffu); }
__device__ __forceinline__ float bf2f(bf16_t b) { return __uint_as_float(((unsigned)b) << 16); }
__device__ __forceinline__ float silu_f(float v) { return v / (1.f + __expf(-v)); }
__device__ __forceinline__ bf16x8 pack8(const float* x) { u32x4 w = {cvtpk(x[0], x[1]), cvtpk(x[2], x[3]), cvtpk(x[4], x[5]), cvtpk(x[6], x[7])}; return *reinterpret_cast<bf16x8*>(&w); }
__device__ __forceinline__ u32x2 pack4(f32x4 v) { u32x2 w = {cvtpk(v[0], v[1]), cvtpk(v[2], v[3])}; return w; }
__device__ __forceinline__ float wave_sum(float v) {
#pragma unroll
  for (int o = 32; o > 0; o >>= 1) v += __shfl_xor(v, o);
  return v;
}
__device__ __forceinline__ int wave_sum_i(int v) {
#pragma unroll
  for (int o = 32; o > 0; o >>= 1) v += __shfl_xor(v, o);
  return v;
}
__device__ __forceinline__ float row16_sum(float v) {
    v += __builtin_bit_cast(float, __builtin_amdgcn_update_dpp(0, __builtin_bit_cast(int, v), 0xB1, 0xf, 0xf, true));
    v += __builtin_bit_cast(float, __builtin_amdgcn_update_dpp(0, __builtin_bit_cast(int, v), 0x4E, 0xf, 0xf, true));
    v += __builtin_bit_cast(float, __builtin_amdgcn_update_dpp(0, __builtin_bit_cast(int, v), 0x141, 0xf, 0xf, true));
    v += __builtin_bit_cast(float, __builtin_amdgcn_update_dpp(0, __builtin_bit_cast(int, v), 0x140, 0xf, 0xf, true));
    return v;
}
__device__ __forceinline__ float wave_scan_incl(float v, int lane) {
    v += __builtin_bit_cast(float, __builtin_amdgcn_update_dpp(0, __builtin_bit_cast(int, v), 0x111, 0xf, 0xf, false));
    v += __builtin_bit_cast(float, __builtin_amdgcn_update_dpp(0, __builtin_bit_cast(int, v), 0x112, 0xf, 0xf, false));
    v += __builtin_bit_cast(float, __builtin_amdgcn_update_dpp(0, __builtin_bit_cast(int, v), 0x114, 0xf, 0xf, false));
    v += __builtin_bit_cast(float, __builtin_amdgcn_update_dpp(0, __builtin_bit_cast(int, v), 0x118, 0xf, 0xf, false));
    const float t0 = __builtin_bit_cast(float, __builtin_amdgcn_readlane(__builtin_bit_cast(int, v), 15));
    const float t1 = __builtin_bit_cast(float, __builtin_amdgcn_readlane(__builtin_bit_cast(int, v), 31));
    const float t2 = __builtin_bit_cast(float, __builtin_amdgcn_readlane(__builtin_bit_cast(int, v), 47));
    float add = 0.f; if (lane >= 16) add = t0; if (lane >= 32) add = t0 + t1; if (lane >= 48) add = (t0 + t1) + t2;
    return v + add;
}
__device__ __forceinline__ int opaque_tid() { int t = threadIdx.x; asm volatile("" : "+v"(t)); return t; }
__device__ __forceinline__ int wave_sum_dpp(int v) {
    v += __builtin_amdgcn_update_dpp(0, v, 0xB1, 0xf, 0xf, true);
    v += __builtin_amdgcn_update_dpp(0, v, 0x4E, 0xf, 0xf, true);
    v += __builtin_amdgcn_update_dpp(0, v, 0x141, 0xf, 0xf, true);
    v += __builtin_amdgcn_update_dpp(0, v, 0x140, 0xf, 0xf, true);
    return __builtin_amdgcn_readlane(v, 0) + __builtin_amdgcn_readlane(v, 16) + __builtin_amdgcn_readlane(v, 32) + __builtin_amdgcn_readlane(v, 48);
}
__device__ __forceinline__ int latrow_of(int row) { if (row < NP) return row; const int r = row - NP; return NP + (r >> 6) * LS + PAST + (r & 63); }
__device__ __forceinline__ int pos_of(int row) { return row < NP ? (row & (TP - 1)) : PAST + ((row - NP) & 63); }
namespace pg8 {
#define PG8_LAS __attribute__((address_space(3)))
constexpr int BM = 256, BK = 64, HALF = 128, HTB = HALF * BK * 2  , STAGE_BYTES = 8 * HTB, NXCD = 8, WGM = 8;

__host__ __device__ __forceinline__ int lds_byte(int r, int c) { const int st = (r >> 4) * 2 + (c >> 5), rr = r & 15, cc = c & 31, ob = rr * 64 + cc * 2; return st * 1024 + (ob ^ (((ob >> 9) & 1) << 5)); }
__host__ __device__ __forceinline__ void stage_rc(int b, int& R, int& C) { const int st = b / 1024, sb = b % 1024, swz = sb ^ (((sb >> 9) & 1) << 5); R = (st >> 1) * 16 + swz / 64; C = (st & 1) * 32 + (swz % 64) / 2; }
__host__ __device__ __forceinline__ int perm32(int rho) { const int n = rho >> 4, i = rho & 15; return 8 * (i >> 2) + 4 * n + (i & 3); }

struct Unit { int pm, pn; };
struct Gemm { const bf16_t* A; const bf16_t* Bt; int M, N, K, lda; };

struct StaticOrder {
    int nM, nN, nwg, G, c;
    __host__ __device__ void init(int M, int N, int G_, int c_) { nM = M / BM; nN = N / BM; nwg = nM * nN; G = G_; c = c_; }
    __host__ __device__ bool next(int i, Unit& u) const {
        const long L = (long)i * G + c; if (L >= nwg) return false;
        int wgid = (int)L; { const int q = nwg / NXCD, r = nwg % NXCD, xcd = wgid % NXCD, off = wgid / NXCD; wgid = (xcd < r ? xcd * (q + 1) : r * (q + 1) + (xcd - r) * q) + off; }
        const int nig = WGM * nN, gid = wgid / nig, fm = gid * WGM, gsz = (nM - fm) < WGM ? (nM - fm) : WGM;
        u.pm = fm + ((wgid % nig) % gsz); u.pn = (wgid % nig) / gsz; return true;
    }
    __device__ __forceinline__ void a_ready(const Unit&) const {}
    __device__ __forceinline__ void done(const Unit&) const {}
};

template <class Epi, class Sched>
__device__ __forceinline__ void gemm_phase(PG8_LAS unsigned char* lds, const Gemm g, const Sched& S, const Epi& E) {
    constexpr bool STAMP = false; unsigned long long* stamps = nullptr;
    int tid_ = threadIdx.x; asm volatile("" : "+v"(tid_));
    const int tid = tid_, wid = __builtin_amdgcn_readfirstlane(tid >> 6), lane = tid & 63, wr = wid >> 2, wc = wid & 3, fr = lane & 15, fq = lane >> 4;
    const int K = g.K, nt = K / BK;
    int ts_lo = 0, ts_hi = 0, nts = 0; const unsigned long long rt_entry = STAMP ? (unsigned long long)wall_clock64() : 0ull;
#define PG8_STAMP() do { if (STAMP && wid == 0 && nts < 64) { const unsigned long long _c = (unsigned long long)clock64(); \
        ts_lo = (lane == nts) ? (int)(unsigned)_c : ts_lo; ts_hi = (lane == nts) ? (int)(unsigned)(_c >> 32) : ts_hi; ++nts; } } while (0)
    PG8_STAMP();
    unsigned voffA[2], voffB[2];
#pragma unroll
    for (int i = 0; i < 2; ++i) { int R, C; stage_rc(tid * 16 + i * 8192, R, C); const int Rb = Epi::PERM ? ((R & ~31) + perm32(R & 31)) : R;
        voffA[i] = (unsigned)(R * g.lda + C) * 2u; voffB[i] = (unsigned)(Rb * K + C) * 2u; }
    const size_t kstep = (size_t)(BK * 2);
    const size_t hstep = (size_t)HALF * K * 2; const size_t hstepA = (size_t)HALF * g.lda * 2;
    const size_t tstep = 2 * hstep; const size_t tstepA = 2 * hstepA;
    const unsigned ldsw = (unsigned)wid * 1024u;
    const int aoff = lds_byte(wr * 64 + fr, fq * 8), boff = lds_byte(wc * 32 + fr, fq * 8);
#define PG8_SA(b, h) (((b) * 2 + (h)) * HTB)
#define PG8_SB(b, h) ((4 + (b) * 2 + (h)) * HTB)
#define PG8_STAGE(bufoff, gbase, voff) do { _Pragma("unroll") for (int _i = 0; _i < 2; ++_i) \
        __builtin_amdgcn_global_load_lds((const unsigned*)((const char*)(gbase) + (voff)[_i]), (PG8_LAS unsigned*)(lds + (bufoff) + ldsw + _i * 8192), 16, 0, 0); } while (0)
#define PG8_LDA(dst, b, h) do { _Pragma("unroll") for (int m = 0; m < 4; ++m) _Pragma("unroll") for (int k = 0; k < 2; ++k) dst[m][k] = *(const PG8_LAS bf16x8*)(lds + PG8_SA(b, h) + aoff + m * 2048 + k * 1024); } while (0)
#define PG8_LDB(dst, b, h) do { _Pragma("unroll") for (int n = 0; n < 2; ++n) _Pragma("unroll") for (int k = 0; k < 2; ++k) dst[n][k] = *(const PG8_LAS bf16x8*)(lds + PG8_SB(b, h) + boff + n * 2048 + k * 1024); } while (0)
#define PG8_MMA(ai, bj, At, Bt) do { __builtin_amdgcn_s_setprio(1); _Pragma("unroll") for (int m = 0; m < 4; ++m) _Pragma("unroll") for (int n = 0; n < 2; ++n) _Pragma("unroll") for (int k = 0; k < 2; ++k) \
        acc[ai][bj][m][n] = __builtin_amdgcn_mfma_f32_16x16x32_bf16(Bt[n][k], At[m][k], acc[ai][bj][m][n], 0, 0, 0); __builtin_amdgcn_s_setprio(0); } while (0)
#define PG8_WAIT_V(n) asm volatile("s_waitcnt vmcnt(" #n ")" ::: "memory")
#define PG8_WAIT_L(n) asm volatile("s_waitcnt lgkmcnt(" #n ")" ::: "memory")
#define PG8_BAR __builtin_amdgcn_s_barrier()
#define PG8_SCHED __builtin_amdgcn_sched_barrier(0)
    Unit cur, nxt; int ui = 0;
    if (!S.next(0, cur)) return;
    f32x4 acc[2][2][4][2];
#pragma unroll
    for (int a = 0; a < 2; ++a)
#pragma unroll
        for (int b = 0; b < 2; ++b)
#pragma unroll
            for (int m = 0; m < 4; ++m)
#pragma unroll
                for (int n = 0; n < 2; ++n) acc[a][b][m][n] = (f32x4){0.f, 0.f, 0.f, 0.f};
    bf16x8 At[4][2], B0[2][2], B1[2][2];
    const char* cA = (const char*)g.A + (size_t)cur.pm * tstepA; const char* cB = (const char*)g.Bt + (size_t)cur.pn * tstep;
    S.a_ready(cur);
    PG8_STAGE(PG8_SB(0, 0), cB, voffB); PG8_STAGE(PG8_SA(0, 0), cA, voffA); PG8_STAGE(PG8_SB(0, 1), cB + hstep, voffB); PG8_STAGE(PG8_SA(0, 1), cA + hstepA, voffA);
    if (wr == 1) PG8_BAR;
    PG8_WAIT_V(4); PG8_BAR;
    PG8_STAGE(PG8_SB(1, 0), cB + kstep, voffB); PG8_STAGE(PG8_SA(1, 0), cA + kstep, voffA); PG8_STAGE(PG8_SB(1, 1), cB + hstep + kstep, voffB);
    PG8_WAIT_V(6); PG8_BAR;
    PG8_STAMP();
    for (;;) {
        const bool has_next = S.next(ui + 1, nxt);
        const char* nA = has_next ? (const char*)g.A + (size_t)nxt.pm * tstepA : cA; const char* nB = has_next ? (const char*)g.Bt + (size_t)nxt.pn * tstep : cB;
        for (int t = 0; t < nt; t += 2) {
            const bool last = (t == nt - 2);
            const char* a1 = cA + (size_t)(t + 1) * kstep;
            const char* a2 = last ? nA : cA + (size_t)(t + 2) * kstep; const char* b2 = last ? nB : cB + (size_t)(t + 2) * kstep;
            const char* a3 = a2 + kstep; const char* b3 = b2 + kstep;
            if (last && has_next) S.a_ready(nxt);
            PG8_LDB(B0, 0, 0); PG8_SCHED; PG8_LDA(At, 0, 0); PG8_STAGE(PG8_SA(1, 1), a1 + hstepA, voffA);
            PG8_WAIT_L(8); PG8_BAR; PG8_WAIT_L(0); PG8_MMA(0, 0, At, B0); PG8_BAR; PG8_SCHED;
            PG8_LDB(B1, 0, 1); PG8_STAGE(PG8_SB(0, 0), b2, voffB);
            PG8_BAR; PG8_WAIT_L(0); PG8_MMA(0, 1, At, B1); PG8_BAR;
            PG8_LDA(At, 0, 1); PG8_STAGE(PG8_SA(0, 0), a2, voffA);
            PG8_BAR; PG8_WAIT_L(0); PG8_MMA(1, 0, At, B0); PG8_BAR; PG8_SCHED;
            PG8_STAGE(PG8_SB(0, 1), b2 + hstep, voffB);
            PG8_WAIT_V(6); PG8_BAR; PG8_MMA(1, 1, At, B1); PG8_BAR;
            PG8_LDB(B0, 1, 0); PG8_SCHED; PG8_LDA(At, 1, 0); PG8_STAGE(PG8_SA(0, 1), a2 + hstepA, voffA);
            PG8_WAIT_L(8); PG8_BAR; PG8_WAIT_L(0); PG8_MMA(0, 0, At, B0); PG8_BAR; PG8_SCHED;
            PG8_LDB(B1, 1, 1); PG8_STAGE(PG8_SB(1, 0), b3, voffB);
            PG8_BAR; PG8_WAIT_L(0); PG8_MMA(0, 1, At, B1); PG8_BAR;
            PG8_LDA(At, 1, 1); PG8_STAGE(PG8_SA(1, 0), a3, voffA);
            PG8_BAR; PG8_WAIT_L(0); PG8_MMA(1, 0, At, B0); PG8_BAR; PG8_SCHED;
            PG8_STAGE(PG8_SB(1, 1), b3 + hstep, voffB);
            PG8_WAIT_V(6); PG8_BAR; PG8_MMA(1, 1, At, B1); PG8_BAR;
        }
        PG8_STAMP();
        if constexpr (!Epi::AFTER_DRAIN) { E(acc, cur, wr, wc, fr, fq); S.done(cur); }
        PG8_STAMP();
        if (!has_next) break;
#pragma unroll
        for (int a = 0; a < 2; ++a)
#pragma unroll
            for (int b = 0; b < 2; ++b)
#pragma unroll
                for (int m = 0; m < 4; ++m)
#pragma unroll
                    for (int n = 0; n < 2; ++n) acc[a][b][m][n] = (f32x4){0.f, 0.f, 0.f, 0.f};
        cur = nxt; cA = nA; cB = nB; ++ui;
    }
    PG8_WAIT_V(0);
    if (wr == 0) PG8_BAR;
    PG8_BAR;
    if constexpr (Epi::AFTER_DRAIN) { E.fused(acc, cur, wr, wc, fr, fq, lds, wid, lane); S.done(cur); }
    PG8_STAMP();
    if (STAMP && wid == 0) { stamps[lane] = lane < nts ? (((unsigned long long)(unsigned)ts_hi << 32) | (unsigned)ts_lo) : 0ull;
        if (lane == 62) stamps[62] = rt_entry; if (lane == 63) stamps[63] = (unsigned long long)wall_clock64(); }
#undef PG8_STAMP
#undef PG8_SA
#undef PG8_SB
#undef PG8_STAGE
#undef PG8_LDA
#undef PG8_LDB
#undef PG8_MMA
#undef PG8_WAIT_V
#undef PG8_WAIT_L
#undef PG8_BAR
#undef PG8_SCHED
}
}


template <class F> struct EpiGen {
    static constexpr bool PERM = false, AFTER_DRAIN = false;
    F f;
    __device__ __forceinline__ void operator()(const f32x4 (&acc)[2][2][4][2], const pg8::Unit& u, int wr, int wc, int fr, int fq) const {
        int row0 = u.pm * 256 + wr * 64 + fr, col0 = u.pn * 256 + wc * 32 + 4 * fq;
        asm volatile("" : "+v"(row0), "+v"(col0));
#pragma unroll
        for (int ai = 0; ai < 2; ++ai)
#pragma unroll
            for (int m = 0; m < 4; ++m) {
                const int row = row0 + ai * 128 + m * 16;
#pragma unroll
                for (int bj = 0; bj < 2; ++bj)
#pragma unroll
                    for (int n = 0; n < 2; ++n) f(row, col0 + bj * 128 + n * 16, acc[ai][bj][m][n], u.pn);
            }
    }
};

#define EPI_ITER(...) do { int row0_ = row0, col0_ = col0; asm volatile("" : "+v"(row0_), "+v"(col0_)); _Pragma("unroll") for (int ai = 0; ai < 2; ++ai) _Pragma("unroll") for (int m = 0; m < 4; ++m) { const int row = row0_ + ai * 128 + m * 16; \
    _Pragma("unroll") for (int bj = 0; bj < 2; ++bj) _Pragma("unroll") for (int n = 0; n < 2; ++n) { const int col = col0_ + bj * 128 + n * 16; const f32x4 v = acc[ai][bj][m][n]; __VA_ARGS__ } } } while (0)
struct EpiInProj0 {
    static constexpr bool PERM = false, AFTER_DRAIN = false;
    char* ws; float* out; const float* dtb;
    __device__ __forceinline__ void operator()(const f32x4 (&acc)[2][2][4][2], const pg8::Unit& u, int wr, int wc, int fr, int fq) const {
        int row0 = u.pm * 256 + wr * 64 + fr, col0 = u.pn * 256 + wc * 32 + 4 * fq; const int pn = u.pn;
        asm volatile("" : "+v"(row0), "+v"(col0));
        if (pn < 4) {
            EPI_ITER({ *(u32x2*)((bf16_t*)(ws + W_MIX) + (size_t)row * 3072 + col) = pack4(v); });
        } else if (pn < 12) {
            const bool isv = pn >= 8; const int cs = isv ? 2048 : 1024;
            bf16_t* kp = (bf16_t*)(ws + (isv ? W_VP : W_KP)); bf16_t* ks = (bf16_t*)(ws + (isv ? W_VS : W_KS)); float* op = out + (isv ? O_AVP : O_AKP); float* os = out + (isv ? O_AVS : O_AKS);
            EPI_ITER({ const int c = col - cs; bf16_t* kb; float* o;
                if (row < NP) { kb = kp + (size_t)row * 1024 + c; o = op + (size_t)row * 1024 + c; }
                else { const int r = row - NP; kb = ks + ((size_t)(r >> 6) * LS + PAST + (r & 63)) * 1024 + c; o = os + (size_t)r * 1024 + c; }
                *(u32x2*)kb = pack4(v); *(f32x4*)o = v; });
        } else if (pn < 16) {
            EPI_ITER({ f32x4 s = {silu_f(v[0]), silu_f(v[1]), silu_f(v[2]), silu_f(v[3])}; *(u32x2*)((bf16_t*)(ws + W_SG) + (size_t)row * 1024 + (col - 3072)) = pack4(s); });
        } else if (pn < 20) {
            EPI_ITER({ *(u32x2*)((bf16_t*)(ws + W_IQ) + (size_t)row * 1024 + (col - 4096)) = pack4(v); });
        } else if (pn < 28) {
            EPI_ITER({ f32x4 s = {silu_f(v[0]), silu_f(v[1]), silu_f(v[2]), silu_f(v[3])}; *(u32x2*)((bf16_t*)(ws + W_MIX) + (size_t)row * 3072 + 1024 + (col - 5120)) = pack4(s); });
        } else if (pn < 40) {
            EPI_ITER({ const int c = col - 7168;
                *(u32x2*)((bf16_t*)(ws + W_XBC) + (size_t)row * 3072 + c) = pack4(v);
                if (row < NP) { const int t = row & (TP - 1); if (t >= TP - 3) *(f32x4*)(out + O_BCP + ((size_t)(row >> 12) * 3 + (t - (TP - 3))) * 3072 + c) = v; }
                else { const int r = row - NP, t = r & 63; if (t >= TS - 3) *(f32x4*)(out + O_BCS + ((size_t)(r >> 6) * 3 + (t - (TS - 3))) * 3072 + c) = v; } });
        } else {
            int r0 = row0, c0 = col0; asm volatile("" : "+v"(r0), "+v"(c0));
#pragma unroll
            for (int n = 0; n < 2; ++n) {
                const int c = c0 - 10240 + n * 16;
                if (c < 64) {
#pragma unroll
                    for (int ai = 0; ai < 2; ++ai)
#pragma unroll
                        for (int m = 0; m < 4; ++m) { const int row = r0 + ai * 128 + m * 16; const f32x4 v = acc[ai][0][m][n]; bf16_t* kb; float* o;
                            if (row < NP) { kb = (bf16_t*)(ws + W_KIDXP) + (size_t)row * 64 + c; o = out + O_KIP + (size_t)row * 64 + c; }
                            else { const int r = row - NP; kb = (bf16_t*)(ws + W_KIDXS) + ((size_t)(r >> 6) * LS + PAST + (r & 63)) * 64 + c; o = out + O_KIS + (size_t)r * 64 + c; }
                            *(u32x2*)kb = pack4(v); *(f32x4*)o = v; }
                } else if (c < 80) {
#pragma unroll
                    for (int ai = 0; ai < 2; ++ai)
#pragma unroll
                        for (int m = 0; m < 4; ++m) { const int row = r0 + ai * 128 + m * 16; *(f32x4*)((float*)(ws + W_IW) + (size_t)row * 16 + (c - 64)) = acc[ai][0][m][n] * 0.03125f; }
                } else if (c < 112) {
                    const f32x4 db = *(const f32x4*)(dtb + (c - 80));
#pragma unroll
                    for (int ai = 0; ai < 2; ++ai)
#pragma unroll
                        for (int m = 0; m < 4; ++m) { const int row = r0 + ai * 128 + m * 16; const f32x4 v = acc[ai][0][m][n] + db; f32x4 d;
#pragma unroll
                            for (int j = 0; j < 4; ++j) d[j] = v[j] > 20.f ? v[j] : log1pf(__expf(v[j]));
                            *(f32x4*)((float*)(ws + W_DT) + (size_t)row * 32 + (c - 80)) = d; }
                }
            }
        }
    }
};

struct FResid {
    const float* r0; const float* r1; float* y;
    __device__ __forceinline__ void operator()(int row, int col, f32x4 v, int) const {
        const float* rp = row < NP ? r0 + (size_t)row * DM + col : r1 + (size_t)(row - NP) * DM + col;
        const f32x4 x = *(const f32x4*)rp;
        *(f32x4*)(y + (size_t)row * DM + col) = v + x * ALPHA_RES;
    }
};

struct FInProj1 {
    char* ws;
    __device__ __forceinline__ void operator()(int row, int col, f32x4 v, int pn) const {
        if (pn < 4) *(f32x4*)((float*)(ws + W_CQKV) + (size_t)row * 1088 + col) = v;
        else if (pn < 12) { f32x4 s = {silu_f(v[0]), silu_f(v[1]), silu_f(v[2]), silu_f(v[3])}; *(u32x2*)((bf16_t*)(ws + W_SGATE) + (size_t)row * 2048 + (col - 1024)) = pack4(s); }
        else { const int c = col - 3072; if (c < 64) *(f32x4*)((float*)(ws + W_CQKV) + (size_t)row * 1088 + 1024 + c) = v; }
    }
};

struct FQUp {
    char* ws;
    __device__ __forceinline__ void operator()(int row, int col, f32x4 v, int pn) const {
        if (pn >= 8) {
            const int jj = (col - 2048) & 63, i0 = (jj >> 2) * 2, pos = pos_of(row);
            const float2* tab = (const float2*)(ws + W_ROPE) + (size_t)pos * 32 + i0;
            const float2 c0 = tab[0], c1 = tab[1];
            f32x4 o; o[0] = v[0] * c0.x - v[2] * c0.y; o[2] = v[0] * c0.y + v[2] * c0.x; o[1] = v[1] * c1.x - v[3] * c1.y; o[3] = v[1] * c1.y + v[3] * c1.x; v = o;
        }
        *(u32x2*)((bf16_t*)(ws + W_Q2) + (size_t)row * 3072 + col) = pack4(v);
    }
};
struct FKvUp { char* ws; __device__ __forceinline__ void operator()(int row, int col, f32x4 v, int) const { *(u32x2*)((bf16_t*)(ws + W_KVALL) + (size_t)row * 4096 + col) = pack4(v); } };

template <class F> __device__ __forceinline__ void run_gemm(char* lds, const bf16_t* A, int lda, const bf16_t* Bt, int M, int N, int K, const F& f, const bool rev = false) {
    pg8::Gemm g; g.A = A; g.Bt = Bt; g.M = M; g.N = N; g.K = K; g.lda = lda;
    pg8::StaticOrder S; S.init(M, N, (int)gridDim.x, rev ? (int)(gridDim.x - 1 - blockIdx.x) : (int)blockIdx.x);
    EpiGen<F> E{f};
    pg8::gemm_phase<EpiGen<F>, pg8::StaticOrder>((PG8_LAS unsigned char*)lds, g, S, E);
}

__device__ __forceinline__ int orig_col(int w, int n) {
    switch (w) {
    case 0: if (n < 5120) return n; if (n < 7168) return 5200 + (n - 5120); if (n < 10240) return 7248 + (n - 7168); if (n < 10304) return 5120 + (n - 10240);
            if (n < 10320) return 5184 + (n - 10304); if (n < 10352) return n; return -1;
    case 2: if (n < 1024) return n; if (n < 3072) return 1088 + (n - 1024); if (n < 3136) return 1024 + (n - 3072); return -1;
    case 3: if (n < 2048) return (n >> 7) * 192 + (n & 127);
            { const int j = n - 2048, h = j >> 6, jj = j & 63, g4 = jj >> 2, e = jj & 3; return h * 192 + 128 + (e >> 1) * 32 + 2 * g4 + (e & 1); }
    case 4: if (n < 2048) return (n >> 7) * 256 + (n & 127); { const int j = n - 2048; return (j >> 7) * 256 + 128 + (j & 127); }
    default: return n;
    }
}
__device__ __forceinline__ void phase_prep(CPARAMS& p, char* lds) {
    const int tid = opaque_tid();
    {
        bf16_t* tile = (bf16_t*)lds;
        int base = 0;
#pragma unroll 1
        for (int w = 0; w < 6; ++w) {
            int K, N, NPd; const float* W; bf16_t* Bt;
            switch (w) {
            case 0: K = 2048; N = NIN0; NPd = NIN0P; W = p.in[I_WIN0]; Bt = (bf16_t*)(p.ws + W_BT0); break;
            case 1: K = 3072; N = 2048; NPd = 2048; W = p.in[I_WOUT0]; Bt = (bf16_t*)(p.ws + W_BTOUT0); break;
            case 2: K = 2048; N = NIN1; NPd = NIN1P; W = p.in[I_WIN1]; Bt = (bf16_t*)(p.ws + W_BT1); break;
            case 3: K = 512; N = 3072; NPd = 3072; W = p.in[I_WUQ]; Bt = (bf16_t*)(p.ws + W_BTUQ); break;
            case 4: K = 512; N = 4096; NPd = 4096; W = p.in[I_WUKV]; Bt = (bf16_t*)(p.ws + W_BTUKV); break;
            default: K = 2048; N = 2048; NPd = 2048; W = p.in[I_WOUT1]; Bt = (bf16_t*)(p.ws + W_BTOUT1); break;
            }
            const int nkt = K / 64, nnt = NPd / 64, ntiles = nkt * nnt;
            int first = (int)blockIdx.x - (base % (int)gridDim.x); if (first < 0) first += gridDim.x;
#pragma unroll 1
            for (int tix = first; tix < ntiles; tix += gridDim.x) {
                const int kt = tix % nkt, nt = tix / nkt;
                const int nl = tid & 63, n = nt * 64 + nl, oc = orig_col(w, n);
#pragma unroll
                for (int i = 0; i < 8; ++i) {
                    const int kl = i * 8 + (tid >> 6), k = kt * 64 + kl;
                    const float v = oc >= 0 ? W[(size_t)k * N + oc] : 0.f;
                    tile[nl * 66 + kl] = f2bf(v);
                }
                __syncthreads();
                { const int nr = tid >> 3, ks = (tid & 7) * 8; const unsigned* src = (const unsigned*)(tile + nr * 66 + ks);
                  u32x4 o = {src[0], src[1], src[2], src[3]};
                  *(u32x4*)(Bt + (size_t)(nt * 64 + nr) * K + kt * 64 + ks) = o; }
                __syncthreads();
            }
            base += ntiles;
        }
    }
    const size_t gtid = (size_t)blockIdx.x * 512 + tid, gstride = (size_t)gridDim.x * 512;
    { bf16_t* xb = (bf16_t*)(p.ws + W_XB); const size_t n8p = (size_t)NP * DM / 8, n8 = (size_t)MALL * DM / 8;
      for (size_t i0 = gtid; i0 < n8; i0 += 4 * gstride) {
        f32x4 a[4], b[4];
#pragma unroll
        for (int u = 0; u < 4; ++u) { const size_t i = i0 + u * gstride; if (i < n8) { const float* s = i < n8p ? p.in[I_XP] + i * 8 : p.in[I_XS] + (i - n8p) * 8; a[u] = *(const f32x4*)s; b[u] = *(const f32x4*)(s + 4); } }
#pragma unroll
        for (int u = 0; u < 4; ++u) { const size_t i = i0 + u * gstride; if (i < n8) { const float t[8] = {a[u][0], a[u][1], a[u][2], a[u][3], b[u][0], b[u][1], b[u][2], b[u][3]}; *(bf16x8*)(xb + i * 8) = pack8(t); } }
      } }
    { const size_t n8 = (size_t)8 * PAST * 1024 / 8;
      for (size_t i = gtid; i < 2 * n8; i += gstride) { const bool isv = i >= n8; const size_t j = isv ? i - n8 : i; const float* s = p.in[isv ? I_CAV : I_CAK] + j * 8;
        const size_t e = j * 8, b = e / ((size_t)PAST * 1024), rem = e % ((size_t)PAST * 1024);
        const f32x4 a = *(const f32x4*)s, c = *(const f32x4*)(s + 4); const float t[8] = {a[0], a[1], a[2], a[3], c[0], c[1], c[2], c[3]};
        *(bf16x8*)((bf16_t*)(p.ws + (isv ? W_VS : W_KS)) + b * (size_t)LS * 1024 + rem) = pack8(t); }
      const size_t m8 = (size_t)8 * PAST * 64 / 8;
      for (size_t i = gtid; i < m8; i += gstride) { const float* s = p.in[I_CAKI] + i * 8; const size_t e = i * 8, b = e / ((size_t)PAST * 64), rem = e % ((size_t)PAST * 64);
        const f32x4 a = *(const f32x4*)s, c = *(const f32x4*)(s + 4); const float t[8] = {a[0], a[1], a[2], a[3], c[0], c[1], c[2], c[3]};
        *(bf16x8*)((bf16_t*)(p.ws + W_KIDXS) + b * (size_t)LS * 64 + rem) = pack8(t); } }
    { float2* tab = (float2*)(p.ws + W_ROPE);
      for (size_t i = gtid; i < (size_t)4096 * 32; i += gstride) { const int pos = (int)(i >> 5), f = (int)(i & 31);
        const float inv = powf(10000.f, -(float)f / 32.f), ang = (float)pos * inv; float s, c; sincosf(ang, &s, &c); tab[i] = make_float2(c, s); } }
}

__device__ __forceinline__ void phase_index(CPARAMS& p, char* lds) {
    const int tid = opaque_tid(), wid = tid >> 6, lane = tid & 63, r32 = lane & 31, hi = lane >> 5;
    unsigned* sk = (unsigned*)lds;
    const int NU = 4096 + 64;
#pragma unroll 1
    for (int idx = blockIdx.x; idx < NU; idx += gridDim.x) {
        int b, t0, n, nblk_tot, rowg; const bf16_t* ki; u64* mrow; int ldm; bool sample;
        if (idx < 4096) { const int k = idx >> 8, w = idx & 255; b = k >> 1; const int j = (k & 1) ? 511 - w : w; t0 = j * 8; n = ((t0 >> 6) + 1) * 64; nblk_tot = ((t0 >> 8) + 1) * 4;
            rowg = b * TP + t0; ki = (const bf16_t*)(p.ws + W_KIDXP) + (size_t)b * TP * 64; mrow = (u64*)(p.ws + W_MASKP) + (size_t)rowg * 64; ldm = 64; sample = false; }
        else { const int s = idx - 4096; b = s >> 3; t0 = (s & 7) * 8; n = LS; nblk_tot = 17; rowg = NP + b * 64 + t0;
            ki = (const bf16_t*)(p.ws + W_KIDXS) + (size_t)b * LS * 64; mrow = (u64*)(p.ws + W_MASKS) + (size_t)(b * 64 + t0) * 32; ldm = 32; sample = true; }
        (void)sample;
        if (n <= 256) {
            if (lane < nblk_tot) mrow[(size_t)wid * ldm + lane] = (lane * 64 < n) ? ~0ull : 0ull;
            continue;
        }
        {
            const int pr = wid >> 1, par = wid & 1;
            const int qsel = (r32 >> 2) & 1, head = (r32 & 3) + 4 * (r32 >> 3);
            const bf16_t* qp = (const bf16_t*)(p.ws + W_IQ) + (size_t)(rowg + 2 * pr + qsel) * 1024 + head * 64 + hi * 8;
            bf16x8 qa[4];
#pragma unroll
            for (int s = 0; s < 4; ++s) qa[s] = *(const bf16x8*)(qp + s * 16);
            const float* wp = (const float*)(p.ws + W_IW) + (size_t)(rowg + 2 * pr + hi) * 16;
            float wv[16];
#pragma unroll
            for (int s = 0; s < 4; ++s) { const f32x4 t = *(const f32x4*)(wp + s * 4); wv[s * 4] = t[0]; wv[s * 4 + 1] = t[1]; wv[s * 4 + 2] = t[2]; wv[s * 4 + 3] = t[3]; }
            unsigned* dst = sk + (2 * pr + hi) * 4096 + par * 32 + r32;
            char* kst = lds + 131072;
            const int skey = tid >> 3, scolB = (tid & 7) * 16, ntile = n >> 6, ngrp = (ntile + 3) >> 2;
            const bf16_t* ksrc = ki + (size_t)skey * 64 + (scolB >> 1);
            bf16x8 pre[3][4];
#pragma unroll
            for (int sl = 0; sl < 3; ++sl)
#pragma unroll
                for (int u = 0; u < 4; ++u) { const int t = sl * 4 + u; pre[sl][u] = *(const bf16x8*)(ksrc + (size_t)(t < ntile ? t : 0) * 64 * 64); }
#define IDX_GROUP(SL, G) do { const int g_ = (G); \
                __syncthreads(); \
                _Pragma("unroll") for (int u = 0; u < 4; ++u) *(bf16x8*)(kst + u * 8192 + KRSWZ(skey, scolB)) = pre[SL][u]; \
                _Pragma("unroll") for (int u = 0; u < 4; ++u) { const int t = (g_ + 3) * 4 + u; pre[SL][u] = *(const bf16x8*)(ksrc + (size_t)(t < ntile ? t : 0) * 64 * 64); } \
                __syncthreads(); \
                _Pragma("unroll") for (int u = 0; u < 4; ++u) { const int t = g_ * 4 + u; \
                    if (t < ntile) { f32x16 acc = {}; \
                        _Pragma("unroll") for (int s = 0; s < 4; ++s) { const bf16x8 kf = *(const bf16x8*)(kst + u * 8192 + KRSWZ(par * 32 + r32, (s * 16 + hi * 8) * 2)); acc = __builtin_amdgcn_mfma_f32_32x32x16_bf16(qa[s], kf, acc, 0, 0, 0); } \
                        float sc = 0.f; \
                        _Pragma("unroll") for (int r = 0; r < 16; ++r) sc = fmaf(wv[r], fmaxf(acc[r], 0.f), sc); \
                        sc += 0.f; \
                        const unsigned uu = __float_as_uint(sc); \
                        dst[t * 64] = (uu & 0x80000000u) ? ~uu : (uu | 0x80000000u); } } } while (0)
#pragma unroll 1
            for (int g0 = 0; g0 < ngrp; g0 += 3) {
                IDX_GROUP(0, g0);
                if (g0 + 1 < ngrp) IDX_GROUP(1, g0 + 1);
                if (g0 + 2 < ngrp) IDX_GROUP(2, g0 + 2);
            }
#undef IDX_GROUP
        }
        __syncthreads();
        {
            const unsigned* k = sk + wid * 4096;
            u32x4 kv[16];
#pragma unroll
            for (int j = 0; j < 16; ++j) kv[j] = (j * 256 < n && j * 256 + lane * 4 < n) ? *(const u32x4*)(k + j * 256 + lane * 4) : (u32x4){0u, 0u, 0u, 0u};
            unsigned prefix = 0;
#pragma unroll 1
            for (int bit = 31; bit >= 0; --bit) {
                const unsigned cand = prefix | (1u << bit);
                int cnt = 0;
#pragma unroll
                for (int j = 0; j < 16; ++j) if (j * 256 < n) cnt += (kv[j][0] >= cand) + (kv[j][1] >= cand) + (kv[j][2] >= cand) + (kv[j][3] >= cand);
                cnt = wave_sum_dpp(cnt);
                if (cnt >= 256) { prefix = cand; if (cnt == 256) break; }
            }
            int cgt = 0;
#pragma unroll
            for (int j = 0; j < 16; ++j) if (j * 256 < n) cgt += (kv[j][0] > prefix) + (kv[j][1] > prefix) + (kv[j][2] > prefix) + (kv[j][3] > prefix);
            cgt = wave_sum_dpp(cgt);
            const int need = 256 - cgt; int running = 0;
            u64* mr = mrow + (size_t)wid * ldm;
            const u64 lt = (1ull << lane) - 1ull;
#pragma unroll 1
            for (int blk = 0; blk < nblk_tot; ++blk) {
                u64 word = 0ull;
                if (blk * 64 < n) {
                    const unsigned v = k[blk * 64 + lane];
                    const u64 eqm = __ballot(v == prefix);
                    const int rank = running + __popcll(eqm & lt);
                    const bool sel = (v > prefix) || (v == prefix && rank < need);
                    word = __ballot(sel); running += __popcll(eqm);
                }
                if (lane == 0) mr[blk] = word;
            }
        }
        __syncthreads();
    }
}

#define KSWZ(row, colB) ((row) * 256 + ((colB) ^ (((row) & 7) << 4)))
__device__ __forceinline__ int crow(int r, int hi) { return (r & 3) + 8 * (r >> 2) + 4 * hi; }
__device__ __forceinline__ int v_st(int k, int c) { const int kk = (k & ~0xC) | ((k & 4) << 1) | ((k & 8) >> 1); return ((kk >> 3) * 4 + (c >> 5)) * 512 + ((kk & 7) * 32 + (c & 31)) * 2; }
__device__ __forceinline__ int v_rd_base(int lane) { return ((lane & 3) << 3) | (((lane >> 2) & 3) << 6) | (((lane >> 4) & 1) << 5) | (((lane >> 5) & 1) << 8); }
constexpr int v_rd_off(int d0, int ks, int half) { return d0 * 512 + ks * 4096 + half * 2048; }
template <int OFF> __device__ __forceinline__ s16x4 tr_read(int vb) { s16x4 r; asm volatile("ds_read_b64_tr_b16 %0, %1 offset:%2" : "=&v"(r) : "v"(vb), "i"(OFF) : "memory"); return r; }
template <int D0> __device__ __forceinline__ void pv_one(f32x16& od, int vb, bf16x8 pa0, bf16x8 pa1, bf16x8 pa2, bf16x8 pa3) {
    const s16x4 l0 = tr_read<v_rd_off(D0, 0, 0)>(vb), h0 = tr_read<v_rd_off(D0, 0, 1)>(vb), l1 = tr_read<v_rd_off(D0, 1, 0)>(vb), h1 = tr_read<v_rd_off(D0, 1, 1)>(vb);
    const s16x4 l2 = tr_read<v_rd_off(D0, 2, 0)>(vb), h2 = tr_read<v_rd_off(D0, 2, 1)>(vb), l3 = tr_read<v_rd_off(D0, 3, 0)>(vb), h3 = tr_read<v_rd_off(D0, 3, 1)>(vb);
    asm volatile("s_waitcnt lgkmcnt(0)" ::: "memory"); __builtin_amdgcn_sched_barrier(0);
#define PKV(L, H) (bf16x8){L[0], L[1], L[2], L[3], H[0], H[1], H[2], H[3]}
    od = __builtin_amdgcn_mfma_f32_32x32x16_bf16(pa0, PKV(l0, h0), od, 0, 0, 0);
    od = __builtin_amdgcn_mfma_f32_32x32x16_bf16(pa1, PKV(l1, h1), od, 0, 0, 0);
    od = __builtin_amdgcn_mfma_f32_32x32x16_bf16(pa2, PKV(l2, h2), od, 0, 0, 0);
    od = __builtin_amdgcn_mfma_f32_32x32x16_bf16(pa3, PKV(l3, h3), od, 0, 0, 0);
#undef PKV
}

struct AttnUnit {
    const bf16_t* Q; const bf16_t* Qr; const bf16_t* K; const bf16_t* V; const bf16_t* Kr; bf16_t* O; const bf16_t* G; const u64* M;
    int ldq, ldqr, ldk, ldo, ldg, ldm, nvalid, qpos0, NT, head;
};
constexpr int AT_V = 0, AT_K = 32768, AT_KR = 65536, AT_WS = 81920, AT_TB = 81920 + 2048;

template <int MODE>
__device__ __forceinline__ void attn_unit(const AttnUnit& u, char* lds, const float* t5, const float Cs  , const bool dry = false) {
    const int tid = opaque_tid(), wid = __builtin_amdgcn_readfirstlane(tid >> 6), lane = tid & 63, r32 = lane & 31, hi = lane >> 5;
    float* wsf = (float*)(lds + AT_WS) + wid * 64; float* al_l = wsf; float* li_l = wsf + 32;
    float* tb = (float*)(lds + AT_TB);
    const int rowb = wid * 32 + r32, rowc = rowb < u.nvalid ? rowb : u.nvalid - 1;
    const int wrow0 = (wid * 32 < u.nvalid) ? wid * 32 : u.nvalid - 1;
    const int qc_w = (u.qpos0 + wrow0) >> 6;
    const int qpos = u.qpos0 + rowc;
    constexpr int NQ = MODE == 1 ? 12 : 8;
    bf16x8 qr[NQ];
    { const bf16_t* Qw = u.Q + (size_t)rowc * u.ldq + hi * 8;
#pragma unroll
      for (int d0 = 0; d0 < 8; ++d0) qr[d0] = *(const bf16x8*)(Qw + d0 * 16);
      if constexpr (MODE == 1) { const bf16_t* Qw2 = u.Qr + (size_t)rowc * u.ldqr + hi * 8;
#pragma unroll
        for (int d0 = 0; d0 < 4; ++d0) qr[8 + d0] = *(const bf16x8*)(Qw2 + d0 * 16); } }
    if constexpr (MODE == 0) {
        if (tid < 155) { const int rel = tid - 63, nn = rel < 0 ? -rel : rel;
            const int bk = (rel < 0 ? 16 : 0) + (nn < 8 ? nn : 8 + (nn >= 12) + (nn >= 16) + (nn >= 23) + (nn >= 32) + (nn >= 46) + (nn >= 64) + (nn >= 91));
            tb[tid] = t5[bk * 8 + u.head] * LOG2E; }
    }
    float m_reg = -1e29f, l_reg = 0.f; f32x16 o[4];
#pragma unroll
    for (int d = 0; d < 4; ++d) o[d] = (f32x16){};
    const int vb0 = (int)(uintptr_t)(lds + AT_V) + v_rd_base(lane);
    int koff[2], voff[2], kroff = 0;
#pragma unroll
    for (int i = 0; i < 2; ++i) { const int X = (i * 8 + wid) * 1024 + lane * 16;
        { const int row = X >> 8, colB = (X & 255) ^ ((row & 7) << 4); koff[i] = row * u.ldk + (colB >> 1); }
        { const int sub = X >> 9, y = X & 511, kk = (sub >> 2) * 8 + (y >> 6), k = (kk & ~0xC) | ((kk & 4) << 1) | ((kk & 8) >> 1), c = (sub & 3) * 32 + ((y & 63) >> 1); voff[i] = k * u.ldk + c; } }
    if constexpr (MODE == 1) { const int X = wid * 1024 + lane * 16, row = X >> 7, colB = (X & 127) ^ (((row >> 1) & 7) << 4); kroff = row * 64 + (colB >> 1); }
    LAS char* ldl = (LAS char*)lds;
#define AT_ISSUE(b, k0) do { const bf16_t* kb_ = u.K + (size_t)(k0) * u.ldk; const bf16_t* vb_ = u.V + (size_t)(k0) * u.ldk; \
        _Pragma("unroll") for (int i_ = 0; i_ < 2; ++i_) { \
            __builtin_amdgcn_global_load_lds((const unsigned*)(kb_ + koff[i_]), (LAS unsigned*)(ldl + AT_K + (b) * 16384 + (i_ * 8 + wid) * 1024), 16, 0, 0); \
            __builtin_amdgcn_global_load_lds((const unsigned*)(vb_ + voff[i_]), (LAS unsigned*)(ldl + AT_V + (b) * 16384 + (i_ * 8 + wid) * 1024), 16, 0, 0); } \
        if constexpr (MODE == 1) __builtin_amdgcn_global_load_lds((const unsigned*)(u.Kr + (size_t)(k0) * 64 + kroff), (LAS unsigned*)(ldl + AT_KR + (b) * 8192 + wid * 1024), 16, 0, 0); } while (0)
    AT_ISSUE(0, 0);
    asm volatile("s_waitcnt vmcnt(0)" ::: "memory");
    __syncthreads();
#pragma unroll 1
    for (int j = 0; j < u.NT; ++j) {
        const int cur = j & 1;
        if (j + 1 < u.NT) AT_ISSUE(cur ^ 1, (j + 1) * 64);
        if (j <= qc_w && wid * 32 < u.nvalid) {
            u64 mw = 0;
            if constexpr (MODE == 0) mw = u.M[(size_t)rowc * u.ldm + j];
            f32x16 p0 = {}, p1 = {};
            const char* Ks = lds + AT_K + cur * 16384;
#pragma unroll
            for (int d0 = 0; d0 < 8; ++d0) { const int cb = (d0 * 16 + hi * 8) * 2;
                const bf16x8 b0 = *(const bf16x8*)(Ks + KSWZ(r32, cb)), b1 = *(const bf16x8*)(Ks + KSWZ(32 + r32, cb));
                p0 = __builtin_amdgcn_mfma_f32_32x32x16_bf16(b0, qr[d0], p0, 0, 0, 0); p1 = __builtin_amdgcn_mfma_f32_32x32x16_bf16(b1, qr[d0], p1, 0, 0, 0);
                if ((d0 & 3) == 3) __builtin_amdgcn_sched_barrier(0); }
            if constexpr (MODE == 1) { const char* Krs = lds + AT_KR + cur * 8192;
#pragma unroll
                for (int d0 = 0; d0 < 4; ++d0) { const int cb = (d0 * 16 + hi * 8) * 2;
                    const bf16x8 b0 = *(const bf16x8*)(Krs + KRSWZ(r32, cb)), b1 = *(const bf16x8*)(Krs + KRSWZ(32 + r32, cb));
                    p0 = __builtin_amdgcn_mfma_f32_32x32x16_bf16(b0, qr[8 + d0], p0, 0, 0, 0); p1 = __builtin_amdgcn_mfma_f32_32x32x16_bf16(b1, qr[8 + d0], p1, 0, 0, 0); } }
            float esc = Cs, ebias = 0.f;
            unsigned mlo = 0u, mhi = 0u;
            if constexpr (MODE == 0) {
                mlo = (unsigned)mw >> (4 * hi); mhi = (unsigned)(mw >> 32) >> (4 * hi);
                const int kb = j * 64;
                const bool far = (u.qpos0 + wrow0) - (kb + 63) >= 91;
                if (far) ebias = tb[154];
                else { const int rel0 = qpos - kb - 4 * hi; esc = 1.f;
#pragma unroll
                    for (int r = 0; r < 16; ++r) { const int c0 = crow(r, 0);
                        int i0 = rel0 - c0; i0 = i0 < -63 ? -63 : (i0 > 91 ? 91 : i0); int i1 = rel0 - c0 - 32; i1 = i1 < -63 ? -63 : (i1 > 91 ? 91 : i1);
                        p0[r] = fmaf(p0[r], Cs, tb[i0 + 63]); p1[r] = fmaf(p1[r], Cs, tb[i1 + 63]); }
                }
            }
            float pmax = p0[0];
#pragma unroll
            for (int r = 1; r < 16; ++r) pmax = fmaxf(pmax, p0[r]);
#pragma unroll
            for (int r = 0; r < 16; ++r) pmax = fmaxf(pmax, p1[r]);
            { auto rr = __builtin_amdgcn_permlane32_swap(__float_as_uint(pmax), __float_as_uint(pmax), false, false); pmax = fmaxf(__uint_as_float(rr[0]), __uint_as_float(rr[1])); }
            const float pmax_t = fmaf(pmax, esc, ebias);
            float mn = m_reg, alpha = 1.f;
            const bool grow = !__all(pmax_t - m_reg <= 11.5f);
            if (grow) { mn = fmaxf(m_reg, pmax_t); alpha = __builtin_amdgcn_exp2f(m_reg - mn); m_reg = mn; }
            const float mns = ebias - mn;
            float ps = 0.f;
#pragma unroll
            for (int r = 0; r < 16; ++r) { p0[r] = __builtin_amdgcn_exp2f(fmaf(p0[r], esc, mns)); p1[r] = __builtin_amdgcn_exp2f(fmaf(p1[r], esc, mns)); }
            if constexpr (MODE == 0) {
#pragma unroll
                for (int r = 0; r < 16; ++r) { const int c0 = crow(r, 0);
                    p0[r] = __uint_as_float(__float_as_uint(p0[r]) & (unsigned)((int)(mlo << (31 - c0)) >> 31));
                    p1[r] = __uint_as_float(__float_as_uint(p1[r]) & (unsigned)((int)(mhi << (31 - c0)) >> 31)); }
            }
#pragma unroll
            for (int r = 0; r < 16; ++r) ps += p0[r] + p1[r];
            { auto rr = __builtin_amdgcn_permlane32_swap(__float_as_uint(ps), __float_as_uint(ps), false, false); ps = __uint_as_float(rr[0]) + __uint_as_float(rr[1]); }
            l_reg = l_reg * alpha + ps;
            if (grow) {
                if (hi == 0) al_l[r32] = alpha;
                asm volatile("s_waitcnt lgkmcnt(0)" ::: "memory");
#pragma unroll
                for (int r = 0; r < 16; ++r) { const float a = al_l[crow(r, hi)];
#pragma unroll
                    for (int d = 0; d < 4; ++d) o[d][r] *= a; }
            }
            bf16x8 pa0, pa1, pa2, pa3;
#define PK4(P, BASE, OUT) do { unsigned a0 = cvtpk(P[BASE + 0], P[BASE + 1]), a1 = cvtpk(P[BASE + 2], P[BASE + 3]);   \
    unsigned b0 = cvtpk(P[BASE + 4], P[BASE + 5]), b1 = cvtpk(P[BASE + 6], P[BASE + 7]);                              \
    auto r0 = __builtin_amdgcn_permlane32_swap(a0, b0, false, false); auto r1 = __builtin_amdgcn_permlane32_swap(a1, b1, false, false); \
    u32x4 w = {r0[0], r1[0], r0[1], r1[1]}; OUT = *reinterpret_cast<bf16x8*>(&w); } while (0)
            PK4(p0, 0, pa0); PK4(p0, 8, pa1); PK4(p1, 0, pa2); PK4(p1, 8, pa3);
#undef PK4
            const int vb = vb0 + cur * 16384;
            pv_one<0>(o[0], vb, pa0, pa1, pa2, pa3); pv_one<1>(o[1], vb, pa0, pa1, pa2, pa3); pv_one<2>(o[2], vb, pa0, pa1, pa2, pa3); pv_one<3>(o[3], vb, pa0, pa1, pa2, pa3);
        }
        asm volatile("s_waitcnt vmcnt(0)" ::: "memory");
        __syncthreads();
    }
#undef AT_ISSUE
    if (hi == 0) li_l[r32] = l_reg;
    asm volatile("s_waitcnt lgkmcnt(0)" ::: "memory");
#pragma unroll
    for (int r = 0; r < 16; ++r) {
        const int orow = wid * 32 + crow(r, hi);
        const float rl = __builtin_amdgcn_rcpf(li_l[crow(r, hi)]);
        if (orow < u.nvalid && !dry) {
#pragma unroll
            for (int d0 = 0; d0 < 4; ++d0) { const int c = d0 * 32 + r32;
                const float g = bf2f(u.G[(size_t)orow * u.ldg + c]);
                u.O[(size_t)orow * u.ldo + c] = f2bf(o[d0][r] * rl * g); }
        }
    }
    __syncthreads();
}

__device__ __forceinline__ void phase_attn_dsa(CPARAMS& p, char* lds, const bool dry = false) {
    const float Cs = 0.08838834764831845f * LOG2E;
    const int NU = 1024 + 64;
#pragma unroll 1
    for (int idx = blockIdx.x; idx < NU; idx += gridDim.x) {
        AttnUnit u;
        bf16_t* mix = (bf16_t*)(p.ws + W_MIX);
        if (idx < 1024) { const int k = idx >> 8, w = idx & 255, h = w & 7, qb0 = (w >> 3) & 15, b = (w >> 7) + 2 * k, qb = (k & 1) ? 15 - qb0 : qb0;
            const size_t row0 = (size_t)b * TP + qb * 256;
            u.Q = mix + row0 * 3072 + h * 128; u.O = mix + row0 * 3072 + h * 128; u.G = (const bf16_t*)(p.ws + W_SG) + row0 * 1024 + h * 128;
            u.K = (const bf16_t*)(p.ws + W_KP) + (size_t)b * TP * 1024 + h * 128; u.V = (const bf16_t*)(p.ws + W_VP) + (size_t)b * TP * 1024 + h * 128;
            u.M = (const u64*)(p.ws + W_MASKP) + row0 * 64; u.ldm = 64; u.nvalid = 256; u.qpos0 = qb * 256; u.NT = 4 * (qb + 1); u.head = h;
        } else { const int s = idx - 1024, b = s >> 3, h = s & 7; const size_t row0 = (size_t)NP + b * 64;
            u.Q = mix + row0 * 3072 + h * 128; u.O = mix + row0 * 3072 + h * 128; u.G = (const bf16_t*)(p.ws + W_SG) + row0 * 1024 + h * 128;
            u.K = (const bf16_t*)(p.ws + W_KS) + (size_t)b * LS * 1024 + h * 128; u.V = (const bf16_t*)(p.ws + W_VS) + (size_t)b * LS * 1024 + h * 128;
            u.M = (const u64*)(p.ws + W_MASKS) + (size_t)b * 64 * 32; u.ldm = 32; u.nvalid = 64; u.qpos0 = PAST; u.NT = 17; u.head = h; }
        u.Qr = nullptr; u.Kr = nullptr; u.ldq = 3072; u.ldqr = 0; u.ldk = 1024; u.ldo = 3072; u.ldg = 1024;
        attn_unit<0>(u, lds, p.in[I_T5], Cs, dry);
    }
}
__device__ __forceinline__ void phase_attn_mla(CPARAMS& p, char* lds, const bool dry = false) {
    const float Cs = 0.07216878364870323f * LOG2E;
    const int NU = 2048 + 128;
#pragma unroll 1
    for (int idx = blockIdx.x; idx < NU; idx += gridDim.x) {
        AttnUnit u;
        bf16_t* q2 = (bf16_t*)(p.ws + W_Q2); const bf16_t* kv = (const bf16_t*)(p.ws + W_KVALL); const bf16_t* kr = (const bf16_t*)(p.ws + W_KR);
        size_t row0, lrow0; int h;
        if (idx < 2048) { const int k = idx >> 8, w = idx & 255, qb0 = (w >> 4) & 15, b = k, qb = (k & 1) ? 15 - qb0 : qb0; h = w & 15;
            row0 = (size_t)b * TP + qb * 256; lrow0 = (size_t)b * TP; u.nvalid = 256; u.qpos0 = qb * 256; u.NT = 4 * (qb + 1);
        } else { const int s = idx - 2048, b = s >> 4; h = s & 15; row0 = (size_t)NP + b * 64; lrow0 = (size_t)NP + (size_t)b * LS; u.nvalid = 64; u.qpos0 = PAST; u.NT = 17; }
        u.Q = q2 + row0 * 3072 + h * 128; u.Qr = q2 + row0 * 3072 + 2048 + h * 64; u.O = q2 + row0 * 3072 + h * 128; u.G = (const bf16_t*)(p.ws + W_SGATE) + row0 * 2048 + h * 128;
        u.K = kv + lrow0 * 4096 + h * 128; u.V = kv + lrow0 * 4096 + 2048 + h * 128; u.Kr = kr + lrow0 * 64; u.M = nullptr;
        u.ldq = 3072; u.ldqr = 3072; u.ldk = 4096; u.ldo = 3072; u.ldg = 2048; u.ldm = 0; u.head = h;
        attn_unit<1>(u, lds, nullptr, Cs, dry);
    }
}

__device__ __forceinline__ void phase_conv(CPARAMS& p) {
    const int tid = opaque_tid();
    if (tid < 384) {
        const int ch = tid * 8;
        float cw[4][8], cb[8];
        { const float* cwp = p.in[I_CONVW] + ch; const float* cbp = p.in[I_CONVB] + ch;
#pragma unroll
          for (int j = 0; j < 4; ++j) { const f32x4 a = *(const f32x4*)(cwp + j * 3072), bq = *(const f32x4*)(cwp + j * 3072 + 4);
              cw[j][0] = a[0]; cw[j][1] = a[1]; cw[j][2] = a[2]; cw[j][3] = a[3]; cw[j][4] = bq[0]; cw[j][5] = bq[1]; cw[j][6] = bq[2]; cw[j][7] = bq[3]; }
          const f32x4 a = *(const f32x4*)cbp, bq = *(const f32x4*)(cbp + 4); cb[0] = a[0]; cb[1] = a[1]; cb[2] = a[2]; cb[3] = a[3]; cb[4] = bq[0]; cb[5] = bq[1]; cb[6] = bq[2]; cb[7] = bq[3]; }
        const bf16_t* xbc = (const bf16_t*)(p.ws + W_XBC);
        bf16_t* dst = ch < 2048 ? (bf16_t*)(p.ws + W_XACT) + ch : (bf16_t*)(p.ws + W_BCACT) + (ch - 2048);
        const int dstride = ch < 2048 ? 2048 : 1024;
#pragma unroll 1
        for (int unit = blockIdx.x; unit < MALL / 64; unit += gridDim.x) {
            const size_t row0 = (size_t)unit * 64;
            float w[3][8];
            const bool seqstart = row0 >= NP || (row0 & (TP - 1)) == 0;
            if (seqstart) {
                if (row0 >= NP) { const float* sp = p.in[I_SCONV] + ((row0 - NP) >> 6) * 3 * 3072 + ch;
#pragma unroll
                    for (int j = 0; j < 3; ++j) { const f32x4 a = *(const f32x4*)(sp + j * 3072), bq = *(const f32x4*)(sp + j * 3072 + 4);
                        w[j][0] = a[0]; w[j][1] = a[1]; w[j][2] = a[2]; w[j][3] = a[3]; w[j][4] = bq[0]; w[j][5] = bq[1]; w[j][6] = bq[2]; w[j][7] = bq[3]; } }
                else {
#pragma unroll
                    for (int j = 0; j < 3; ++j)
#pragma unroll
                        for (int e = 0; e < 8; ++e) w[j][e] = 0.f; }
            } else {
#pragma unroll
                for (int j = 0; j < 3; ++j) { const bf16x8 r = *(const bf16x8*)(xbc + (row0 - 3 + j) * 3072 + ch);
#pragma unroll
                    for (int e = 0; e < 8; ++e) w[j][e] = bf2f((bf16_t)r[e]); }
            }
#pragma unroll 1
            for (int r0 = 0; r0 < 64; r0 += 8) {
                bf16x8 raw[8];
#pragma unroll
                for (int r = 0; r < 8; ++r) raw[r] = *(const bf16x8*)(xbc + (row0 + r0 + r) * 3072 + ch);
#pragma unroll
                for (int r = 0; r < 8; ++r) { float o[8];
#pragma unroll
                    for (int e = 0; e < 8; ++e) { const float cur = bf2f((bf16_t)raw[r][e]);
                        o[e] = silu_f(cb[e] + cw[0][e] * w[0][e] + cw[1][e] * w[1][e] + cw[2][e] * w[2][e] + cw[3][e] * cur);
                        w[0][e] = w[1][e]; w[1][e] = w[2][e]; w[2][e] = cur; }
                    *(bf16x8*)(dst + (row0 + r0 + r) * dstride) = pack8(o); }
            }
        }
    }
}

constexpr int SD_XT = 0, SD_BS = 9216, SD_BTT = 26624, SD_CS = 45056, SD_CS2 = 62464, SD_WS = 79872, SD_H0 = 89088, SD_F = 106496;
__device__ __forceinline__ void phase_ssd(CPARAMS& p, char* lds, const bool dry = false) {
    const int tid = opaque_tid(), wid = tid >> 6, lane = tid & 63, l16 = lane & 15, lq = lane >> 4;
    bf16_t* XT = (bf16_t*)(lds + SD_XT); bf16_t* Bs = (bf16_t*)(lds + SD_BS); bf16_t* BTt = (bf16_t*)(lds + SD_BTT); bf16_t* Cs = (bf16_t*)(lds + SD_CS);
    bf16_t* Cs2 = (bf16_t*)(lds + SD_CS2); bf16_t* Ws = (bf16_t*)(lds + SD_WS); bf16_t* H0 = (bf16_t*)(lds + SD_H0);
    float* s_acum = (float*)(lds + SD_F); float* s_dt = s_acum + 64; float* s_ea = s_acum + 128; float* s_tail = s_acum + 192; float* s_ssq = s_acum + 256;
    const bf16_t* xbc = (const bf16_t*)(p.ws + W_XBC); bf16_t* mix = (bf16_t*)(p.ws + W_MIX);
    const float* dtbuf = (const float*)(p.ws + W_DT); float* ssqg = (float*)(p.ws + W_SSQ);
#pragma unroll 1
    for (int idx = blockIdx.x; idx < 512; idx += gridDim.x) {
        const bool sample = idx >= 256; const int bh = idx & 255, b = bh >> 5, h = bh & 31, g = h >> 3;
        const size_t row0 = sample ? (size_t)NP + b * 64 : (size_t)b * TP; const int nch = sample ? 1 : 64;
        const float a_h = -__expf(p.in[I_ALOG][h]), d_h = p.in[I_DSKIP][h];
        f32x4 hacc[4];
        const int pt = wid >> 1;
#pragma unroll
        for (int j = 0; j < 4; ++j) { const int nt = (wid & 1) * 4 + j;
#pragma unroll
            for (int i = 0; i < 4; ++i) { const int pp = pt * 16 + 4 * lq + i, nn = nt * 16 + l16;
                hacc[j][i] = sample ? p.in[I_SSSM][(((size_t)b * 32 + h) * 64 + pp) * 128 + nn] : 0.f;
                H0[pp * 136 + nn] = f2bf(hacc[j][i]); } }
        const int cg8 = tid % 40, rb = tid / 40; const bool ldr = tid < 320;
        const bf16_t* asrc = cg8 < 8 ? (const bf16_t*)(p.ws + W_XACT) + h * 64 + cg8 * 8 : (const bf16_t*)(p.ws + W_BCACT) + (cg8 < 24 ? g * 128 + (cg8 - 8) * 8 : 512 + g * 128 + (cg8 - 24) * 8);
        const size_t astride = cg8 < 8 ? 2048 : 1024;
        bf16x8 av[8];
#pragma unroll
        for (int r = 0; r < 8; ++r) av[r] = ldr ? *(const bf16x8*)(asrc + (row0 + rb * 8 + r) * astride) : (bf16x8){0, 0, 0, 0, 0, 0, 0, 0};
        float dt_next = (wid == 0) ? dtbuf[(row0 + lane) * 32 + h] : 0.f;
        bf16_t szv[2][4];
#pragma unroll
        for (int q = 0; q < 2; ++q) { const int id = wid * 2 + q, mt = id >> 2, nt = id & 3;
#pragma unroll
            for (int i = 0; i < 4; ++i) szv[q][i] = mix[(row0 + mt * 16 + 4 * lq + i) * 3072 + 1024 + h * 64 + nt * 16 + l16]; }
#pragma unroll 1
        for (int c = 0; c < nch; ++c) {
            const size_t crow0 = row0 + (size_t)c * 64;
            if (wid == 0) {
                if (c > 0 && !dry) ssqg[(size_t)h * MALL + (crow0 - 64 + lane)] = (s_ssq[lane] + s_ssq[64 + lane]) + (s_ssq[128 + lane] + s_ssq[192 + lane]);
                const float dtv = dt_next; float ac = dtv * a_h;
                if (c + 1 < nch) dt_next = dtbuf[(crow0 + 64 + lane) * 32 + h];
                ac = wave_scan_incl(ac, lane);
                const float a63 = __builtin_bit_cast(float, __builtin_amdgcn_readlane(__builtin_bit_cast(int, ac), 63));
                s_acum[lane] = ac; s_dt[lane] = dtv; s_ea[lane] = __expf(ac); s_tail[lane] = __expf(a63 - ac) * dtv;
            }
            __syncthreads();
            if (ldr) {
                const int t0l = rb * 8;
#pragma unroll
                for (int hf = 0; hf < 2; ++hf) {
                    float vout[8][4];
#pragma unroll
                    for (int r = 0; r < 8; ++r)
#pragma unroll
                        for (int e = 0; e < 4; ++e) vout[r][e] = bf2f((bf16_t)av[r][hf * 4 + e]);
                    if (cg8 < 8) {
#pragma unroll
                        for (int e = 0; e < 4; ++e) { float t[8];
#pragma unroll
                            for (int r = 0; r < 8; ++r) t[r] = vout[r][e];
                            *(bf16x8*)(XT + (cg8 * 8 + hf * 4 + e) * 72 + t0l) = pack8(t); }
                    } else if (cg8 < 24) {
                        const int n0 = (cg8 - 8) * 8 + hf * 4;
#pragma unroll
                        for (int r = 0; r < 8; ++r) { const f32x4 q = {vout[r][0], vout[r][1], vout[r][2], vout[r][3]}; *(u32x2*)(Bs + (t0l + r) * 136 + n0) = pack4(q); }
                        float tl8[8];
#pragma unroll
                        for (int r = 0; r < 8; ++r) tl8[r] = s_tail[t0l + r];
#pragma unroll
                        for (int e = 0; e < 4; ++e) { float t[8];
#pragma unroll
                            for (int r = 0; r < 8; ++r) t[r] = vout[r][e] * tl8[r];
                            *(bf16x8*)(BTt + (n0 + e) * 72 + t0l) = pack8(t); }
                    } else {
                        const int n0 = (cg8 - 24) * 8 + hf * 4;
#pragma unroll
                        for (int r = 0; r < 8; ++r) { const f32x4 q = {vout[r][0], vout[r][1], vout[r][2], vout[r][3]}; *(u32x2*)(Cs + (t0l + r) * 136 + n0) = pack4(q);
                            const float ea = s_ea[t0l + r]; *(u32x2*)(Cs2 + (t0l + r) * 136 + n0) = pack4(q * ea); }
                    }
                }
                if (c + 1 < nch) {
#pragma unroll
                    for (int r = 0; r < 8; ++r) av[r] = *(const bf16x8*)(asrc + (crow0 + 64 + rb * 8 + r) * astride);
                }
            }
            __syncthreads();
#pragma unroll
            for (int q = 0; q < 2; ++q) { const int id = wid * 2 + q, mt = id >> 2, nt = id & 3;
                f32x4 acc = {0.f, 0.f, 0.f, 0.f};
                if (nt <= mt) {
#pragma unroll
                    for (int ks = 0; ks < 4; ++ks) { const bf16x8 af = *(const bf16x8*)(Cs + (mt * 16 + l16) * 136 + ks * 32 + lq * 8), bf = *(const bf16x8*)(Bs + (nt * 16 + l16) * 136 + ks * 32 + lq * 8);
                        acc = __builtin_amdgcn_mfma_f32_16x16x32_bf16(af, bf, acc, 0, 0, 0); }
                }
                const int s = nt * 16 + l16; const float as = s_acum[s], dts = s_dt[s];
#pragma unroll
                for (int i = 0; i < 4; ++i) { const int t = mt * 16 + 4 * lq + i; const float w = (s <= t) ? acc[i] * __expf(s_acum[t] - as) * dts : 0.f; Ws[t * 72 + s] = f2bf(w); }
            }
            __syncthreads();
#pragma unroll
            for (int q = 0; q < 2; ++q) { const int id = wid * 2 + q, mt = id >> 2, nt = id & 3;
                f32x4 acc = {0.f, 0.f, 0.f, 0.f};
#pragma unroll
                for (int ks = 0; ks < 2; ++ks) { const bf16x8 af = *(const bf16x8*)(Ws + (mt * 16 + l16) * 72 + ks * 32 + lq * 8), bf = *(const bf16x8*)(XT + (nt * 16 + l16) * 72 + ks * 32 + lq * 8);
                    acc = __builtin_amdgcn_mfma_f32_16x16x32_bf16(af, bf, acc, 0, 0, 0); }
#pragma unroll
                for (int ks = 0; ks < 4; ++ks) { const bf16x8 af = *(const bf16x8*)(Cs2 + (mt * 16 + l16) * 136 + ks * 32 + lq * 8), bf = *(const bf16x8*)(H0 + (nt * 16 + l16) * 136 + ks * 32 + lq * 8);
                    acc = __builtin_amdgcn_mfma_f32_16x16x32_bf16(af, bf, acc, 0, 0, 0); }
                const int pp = nt * 16 + l16;
#pragma unroll
                for (int i = 0; i < 4; ++i) { const int t = mt * 16 + 4 * lq + i;
                    const float xv = bf2f(XT[pp * 72 + t]);
                    const float yg = (acc[i] + d_h * xv) * bf2f(szv[q][i]);
                    if (!dry) mix[(crow0 + t) * 3072 + 1024 + h * 64 + pp] = f2bf(yg);
                    float sq = yg * yg;
                    sq = row16_sum(sq);
                    if (l16 == 0) s_ssq[nt * 64 + t] = sq; }
            }
            if (c + 1 < nch) {
#pragma unroll
                for (int q = 0; q < 2; ++q) { const int id = wid * 2 + q, mt = id >> 2, nt = id & 3;
#pragma unroll
                    for (int i = 0; i < 4; ++i) szv[q][i] = mix[(crow0 + 64 + mt * 16 + 4 * lq + i) * 3072 + 1024 + h * 64 + nt * 16 + l16]; } }
            const float e63 = s_ea[63];
            __syncthreads();
#pragma unroll
            for (int j = 0; j < 4; ++j) { const int nt = (wid & 1) * 4 + j;
                f32x4 acc = hacc[j] * e63;
#pragma unroll
                for (int ks = 0; ks < 2; ++ks) { const bf16x8 af = *(const bf16x8*)(XT + (pt * 16 + l16) * 72 + ks * 32 + lq * 8), bf = *(const bf16x8*)(BTt + (nt * 16 + l16) * 72 + ks * 32 + lq * 8);
                    acc = __builtin_amdgcn_mfma_f32_16x16x32_bf16(af, bf, acc, 0, 0, 0); }
                hacc[j] = acc;
#pragma unroll
                for (int i = 0; i < 4; ++i) H0[(pt * 16 + 4 * lq + i) * 136 + nt * 16 + l16] = f2bf(acc[i]);
            }
        }
        __syncthreads();
        if (wid == 0 && !dry) ssqg[(size_t)h * MALL + (row0 + (size_t)(nch - 1) * 64 + lane)] = (s_ssq[lane] + s_ssq[64 + lane]) + (s_ssq[128 + lane] + s_ssq[192 + lane]);
        if (!dry) { float* ho = p.out + (sample ? O_BSS : O_BSP) + ((size_t)b * 32 + h) * 64 * 128;
#pragma unroll
          for (int j = 0; j < 4; ++j) { const int nt = (wid & 1) * 4 + j;
#pragma unroll
              for (int i = 0; i < 4; ++i) ho[(size_t)(pt * 16 + 4 * lq + i) * 128 + nt * 16 + l16] = hacc[j][i]; } }
        __syncthreads();
    }
}

__device__ __forceinline__ void phase_bnorm(CPARAMS& p) {
    bf16_t* mix = (bf16_t*)(p.ws + W_MIX); const float* ssq = (const float*)(p.ws + W_SSQ); const float* nw = p.in[I_SNORM];
    const size_t n = (size_t)MALL * 256, stride = (size_t)gridDim.x * 512;
    const int tidb = opaque_tid();
    for (size_t i0 = (size_t)blockIdx.x * 512 + tidb; i0 < n; i0 += 4 * stride) {
        bf16x8 v[4]; float tot[4];
#pragma unroll
        for (int u = 0; u < 4; ++u) { const size_t i = i0 + u * stride; tot[u] = 0.f; v[u] = (bf16x8){0, 0, 0, 0, 0, 0, 0, 0};
            if (i < n) { const size_t row = i >> 8; const int c0 = (int)(i & 255) * 8, g = c0 >> 9;
                v[u] = *(const bf16x8*)(mix + row * 3072 + 1024 + c0);
#pragma unroll
                for (int hh = 0; hh < 8; ++hh) tot[u] += ssq[(size_t)(g * 8 + hh) * MALL + row]; } }
#pragma unroll
        for (int u = 0; u < 4; ++u) { const size_t i = i0 + u * stride;
            if (i < n) { const size_t row = i >> 8; const int c0 = (int)(i & 255) * 8;
                const float r = rsqrtf(tot[u] * (1.f / 512.f) + EPSV);
                const f32x4 w0 = *(const f32x4*)(nw + c0), w1 = *(const f32x4*)(nw + c0 + 4);
                float t[8];
#pragma unroll
                for (int e2 = 0; e2 < 8; ++e2) t[e2] = bf2f((bf16_t)v[u][e2]) * r * (e2 < 4 ? w0[e2] : w1[e2 - 4]);
                *(bf16x8*)(mix + row * 3072 + 1024 + c0) = pack8(t); } }
    }
}
__device__ __forceinline__ void phase_ln(CPARAMS& p, const float* gw, const float* bw, bf16_t* yb, const bool dry = false) {
    int tid_ = threadIdx.x; asm volatile("" : "+v"(tid_));
    const int wid = tid_ >> 6, lane = tid_ & 63;
    float* y = p.out + O_Y;
    for (int row = blockIdx.x * 8 + wid; row < MALL; row += gridDim.x * 8) {
        float* rp = y + (size_t)row * DM;
        f32x4 v[8]; float s = 0.f;
#pragma unroll
        for (int j = 0; j < 8; ++j) { v[j] = *(const f32x4*)(rp + j * 256 + lane * 4); s += v[j][0] + v[j][1] + v[j][2] + v[j][3]; }
        const float mu = wave_sum(s) * (1.f / DM);
        float q = 0.f;
#pragma unroll
        for (int j = 0; j < 8; ++j) { v[j] = v[j] - mu; q += v[j][0] * v[j][0] + v[j][1] * v[j][1] + v[j][2] * v[j][2] + v[j][3] * v[j][3]; }
        const float rs = rsqrtf(wave_sum(q) * (1.f / DM) + EPSV);
#pragma unroll
        for (int j = 0; j < 8; ++j) { const int c = j * 256 + lane * 4; const f32x4 gg = *(const f32x4*)(gw + c), bb = *(const f32x4*)(bw + c);
            const f32x4 o = v[j] * rs * gg + bb; if (!dry) { *(f32x4*)(rp + c) = o; if (yb) *(u32x2*)(yb + (size_t)row * DM + c) = pack4(o); } else if (o[0] == 1.2345e30f) rp[c] = 0.f; }
    }
}
__device__ __forceinline__ void phase_post1(CPARAMS& p) {
    const int tidp = opaque_tid(); const int wid = tidp >> 6, lane = tidp & 63;
    const float* cqkv = (const float*)(p.ws + W_CQKV); bf16_t* cqn = (bf16_t*)(p.ws + W_CQN); bf16_t* lat = (bf16_t*)(p.ws + W_LAT); bf16_t* krb = (bf16_t*)(p.ws + W_KR);
    const float2* tab = (const float2*)(p.ws + W_ROPE);
    for (int row = blockIdx.x * 8 + wid; row < MALL; row += gridDim.x * 8) {
        const float* rp = cqkv + (size_t)row * 1088;
        const f32x4 a0 = *(const f32x4*)(rp + lane * 8), a1 = *(const f32x4*)(rp + lane * 8 + 4), c0 = *(const f32x4*)(rp + 512 + lane * 8), c1 = *(const f32x4*)(rp + 512 + lane * 8 + 4);
        const float kv = rp[1024 + lane];
        float sa = 0.f, sc = 0.f;
#pragma unroll
        for (int e = 0; e < 4; ++e) { sa += a0[e] * a0[e] + a1[e] * a1[e]; sc += c0[e] * c0[e] + c1[e] * c1[e]; }
        const float ra = rsqrtf(wave_sum(sa) * (1.f / 512.f) + EPSV), rc = rsqrtf(wave_sum(sc) * (1.f / 512.f) + EPSV);
        const f32x4 qw0 = *(const f32x4*)(p.in[I_QNW] + lane * 8), qw1 = *(const f32x4*)(p.in[I_QNW] + lane * 8 + 4), kw0 = *(const f32x4*)(p.in[I_KVNW] + lane * 8), kw1 = *(const f32x4*)(p.in[I_KVNW] + lane * 8 + 4);
        const f32x4 qa = a0 * ra * qw0, qb = a1 * ra * qw1, la = c0 * rc * kw0, lb = c1 * rc * kw1;
        { const float t[8] = {qa[0], qa[1], qa[2], qa[3], qb[0], qb[1], qb[2], qb[3]}; *(bf16x8*)(cqn + (size_t)row * 512 + lane * 8) = pack8(t); }
        const int lr = latrow_of(row);
        { const float t[8] = {la[0], la[1], la[2], la[3], lb[0], lb[1], lb[2], lb[3]}; *(bf16x8*)(lat + (size_t)lr * 512 + lane * 8) = pack8(t); }
        float* clo = row < NP ? p.out + O_CLP + (size_t)row * 512 : p.out + O_CLS + (size_t)(row - NP) * 512;
        *(f32x4*)(clo + lane * 8) = la; *(f32x4*)(clo + lane * 8 + 4) = lb;
        const float other = __shfl_xor(kv, 32);
        const int i = lane & 31, pos = pos_of(row); const float2 cs = tab[(size_t)pos * 32 + i];
        const float o = lane < 32 ? kv * cs.x - other * cs.y : other * cs.y + kv * cs.x;
        float* cko = row < NP ? p.out + O_CKP + (size_t)row * 64 : p.out + O_CKS + (size_t)(row - NP) * 64;
        cko[lane] = o;
        krb[(size_t)lr * 64 + 4 * (i >> 1) + (i & 1) + (lane >= 32 ? 2 : 0)] = f2bf(o);
    }
    const size_t gtid = (size_t)blockIdx.x * 512 + tidp, gstride = (size_t)gridDim.x * 512;
    { const size_t n8 = (size_t)8 * PAST * 512 / 8;
      for (size_t i = gtid; i < n8; i += gstride) { const size_t e = i * 8, b = e / ((size_t)PAST * 512), rem = e % ((size_t)PAST * 512); const float* s = p.in[I_CLAT] + e;
        const f32x4 a = *(const f32x4*)s, c = *(const f32x4*)(s + 4); const float t[8] = {a[0], a[1], a[2], a[3], c[0], c[1], c[2], c[3]};
        *(bf16x8*)(lat + ((size_t)NP + b * LS) * 512 + rem) = pack8(t); } }
    { const size_t n = (size_t)8 * PAST * 64;
      for (size_t e = gtid; e < n; e += gstride) { const size_t b = e / ((size_t)PAST * 64), rem = e % ((size_t)PAST * 64), t = rem >> 6; const int j = (int)(rem & 63), i = j & 31;
        krb[((size_t)NP + b * LS + t) * 64 + 4 * (i >> 1) + (i & 1) + (j >= 32 ? 2 : 0)] = f2bf(p.in[I_CKR][e]); } }
}

__device__ __forceinline__ CPARAMS& get_params() {
    const unsigned long long v = (unsigned long long)__builtin_amdgcn_kernarg_segment_ptr(); unsigned lo = (unsigned)v, hi = (unsigned)(v >> 32);
    asm volatile("" : "+s"(lo), "+s"(hi));
    lo = __builtin_amdgcn_readfirstlane(lo); hi = __builtin_amdgcn_readfirstlane(hi);
    return *(CPARAMS*)(((unsigned long long)hi << 32) | lo);
}
#ifndef PROBE_STOP
#define PROBE_STOP 0
#endif
__device__ __forceinline__ void phase_dump(CPARAMS& p) {
    const unsigned short* w = (const unsigned short*)p.ws; float* y = p.out + O_Y; const size_t n = (size_t)MALL * DM;
#ifdef PROBE_THRASH
    { const f32x4* xs = (const f32x4*)p.in[I_XP] + (size_t)((blockIdx.x >> 3) & 31) * (NP * (size_t)DM / 4 / 32); f32x4 a = {0.f, 0.f, 0.f, 0.f};
      for (size_t i = threadIdx.x; i < NP * (size_t)DM / 4 / 32; i += 512) a += xs[i];
      if (a[0] + a[1] + a[2] + a[3] == 1.2345e30f) y[0] = 1.f;
      __syncthreads(); __threadfence(); }
    cg::this_grid().sync(); __threadfence();
#endif
    for (size_t i = (size_t)blockIdx.x * 512 + threadIdx.x; i < n; i += (size_t)gridDim.x * 512) {
        unsigned h = 0x12345u;
#pragma unroll
        for (int r = 0; r < 8; ++r) { const size_t o = (size_t)r * n + i; const unsigned v = (o * 2 < W_END) ? w[o] : 0u; h = (h ^ v) * 0x9E3779B1u; }
        h ^= h >> 15; y[i] = (float)((h >> 8) & 127u);
    }
}
#define PROBE_AT(k) do { if (PROBE_STOP == (k)) { CPARAMS& pq = get_params(); phase_dump(pq); return; } } while (0)
__global__ void __launch_bounds__(512) fwd_megakernel(Params p_unused) {
    extern __shared__ __attribute__((aligned(16))) char lds[];
    cg::grid_group grid = cg::this_grid();
#ifndef TIME_X2
#define TIME_X2 0
#endif
    const bool dryflag = get_params().ws != nullptr;
    unsigned nbar = 0;
#define GSYNC_CG() do { __builtin_amdgcn_fence(__ATOMIC_RELEASE, "agent"); asm volatile("s_waitcnt vmcnt(0)" ::: "memory"); grid.sync(); __builtin_amdgcn_fence(__ATOMIC_ACQUIRE, "agent"); } while (0)
#define GSYNC() do { ++nbar; asm volatile("s_waitcnt vmcnt(0)" ::: "memory"); __syncthreads(); \
        if (threadIdx.x == 0) { unsigned* ctr_ = (unsigned*)(get_params().ws + W_BAR); const unsigned tgt_ = nbar * gridDim.x; \
            __builtin_amdgcn_fence(__ATOMIC_RELEASE, "agent"); asm volatile("s_waitcnt vmcnt(0)" ::: "memory"); \
            __hip_atomic_fetch_add(ctr_, 1u, __ATOMIC_RELAXED, __HIP_MEMORY_SCOPE_AGENT); \
            while (__hip_atomic_load(ctr_, __ATOMIC_RELAXED, __HIP_MEMORY_SCOPE_AGENT) < tgt_) __builtin_amdgcn_s_sleep(1); \
            __builtin_amdgcn_fence(__ATOMIC_ACQUIRE, "agent"); asm volatile("s_waitcnt vmcnt(0)" ::: "memory"); } \
        __syncthreads(); } while (0)
    if (TIME_X2 == 1) { CPARAMS& p = get_params(); phase_prep(p, lds); __syncthreads(); }
    { CPARAMS& p = get_params(); phase_prep(p, lds); }
    if (__builtin_expect(get_params().ws == nullptr, 0)) GSYNC_CG();
    GSYNC();
    PROBE_AT(1);
    if (TIME_X2 == 2)
    { CPARAMS& p = get_params(); pg8::Gemm g; g.A = (const bf16_t*)(p.ws + W_XB); g.Bt = (const bf16_t*)(p.ws + W_BT0); g.M = MALL; g.N = NIN0P; g.K = DM; g.lda = DM;
      pg8::StaticOrder S; S.init(MALL, NIN0P, (int)gridDim.x, (int)blockIdx.x); EpiInProj0 E{p.ws, p.out, p.in[I_DTB]};
      pg8::gemm_phase<EpiInProj0, pg8::StaticOrder>((PG8_LAS unsigned char*)lds, g, S, E); }
    { CPARAMS& p = get_params(); pg8::Gemm g; g.A = (const bf16_t*)(p.ws + W_XB); g.Bt = (const bf16_t*)(p.ws + W_BT0); g.M = MALL; g.N = NIN0P; g.K = DM; g.lda = DM;
      pg8::StaticOrder S; S.init(MALL, NIN0P, (int)gridDim.x, (int)blockIdx.x); EpiInProj0 E{p.ws, p.out, p.in[I_DTB]};
      pg8::gemm_phase<EpiInProj0, pg8::StaticOrder>((PG8_LAS unsigned char*)lds, g, S, E); }
    GSYNC();
    PROBE_AT(2);
    if (TIME_X2 == 3) { CPARAMS& p = get_params(); phase_index(p, lds); }
    if (TIME_X2 == 12) { CPARAMS& p = get_params(); phase_conv(p); }
    { CPARAMS& p = get_params(); phase_conv(p); }
    { CPARAMS& p = get_params(); phase_index(p, lds); }
    GSYNC();
    PROBE_AT(3);
    if (TIME_X2 == 4) { CPARAMS& p = get_params(); phase_attn_dsa(p, lds, dryflag); }
    if (TIME_X2 == 5) { CPARAMS& p = get_params(); phase_ssd(p, lds, dryflag); }
#ifndef PROBE_SKIP_DSA
    { CPARAMS& p = get_params(); phase_attn_dsa(p, lds); }
#endif
#ifndef PROBE_SKIP_SSD
    { CPARAMS& p = get_params(); phase_ssd(p, lds); }
#endif
    GSYNC();
    PROBE_AT(4);
    { CPARAMS& p = get_params(); phase_bnorm(p); }
    GSYNC();
    PROBE_AT(5);
    if (TIME_X2 == 6)
    { CPARAMS& p = get_params(); FResid f{p.in[I_XP], p.in[I_XS], p.out + O_Y}; run_gemm(lds, (const bf16_t*)(p.ws + W_MIX), 3072, (const bf16_t*)(p.ws + W_BTOUT0), MALL, DM, 3072, f); }
    { CPARAMS& p = get_params(); FResid f{p.in[I_XP], p.in[I_XS], p.out + O_Y}; run_gemm(lds, (const bf16_t*)(p.ws + W_MIX), 3072, (const bf16_t*)(p.ws + W_BTOUT0), MALL, DM, 3072, f); }
    GSYNC();
    PROBE_AT(6);
    if (TIME_X2 == 7) { CPARAMS& p = get_params(); phase_ln(p, p.in[I_LN0G], p.in[I_LN0B], (bf16_t*)(p.ws + W_XB), dryflag); }
    { CPARAMS& p = get_params(); phase_ln(p, p.in[I_LN0G], p.in[I_LN0B], (bf16_t*)(p.ws + W_XB)); }
    GSYNC();
    PROBE_AT(7);
    if (TIME_X2 == 8)
    { CPARAMS& p = get_params(); FInProj1 f{p.ws}; run_gemm(lds, (const bf16_t*)(p.ws + W_XB), DM, (const bf16_t*)(p.ws + W_BT1), MALL, NIN1P, DM, f); }
    { CPARAMS& p = get_params(); FInProj1 f{p.ws}; run_gemm(lds, (const bf16_t*)(p.ws + W_XB), DM, (const bf16_t*)(p.ws + W_BT1), MALL, NIN1P, DM, f); }
    GSYNC();
    PROBE_AT(8);
    if (TIME_X2 == 9) { CPARAMS& p = get_params(); phase_post1(p); }
    { CPARAMS& p = get_params(); phase_post1(p); }
    GSYNC();
    PROBE_AT(9);
    if (TIME_X2 == 10)
    { CPARAMS& p = get_params(); FQUp f{p.ws}; run_gemm(lds, (const bf16_t*)(p.ws + W_CQN), 512, (const bf16_t*)(p.ws + W_BTUQ), MALL, 3072, 512, f); }
    { CPARAMS& p = get_params(); FQUp f{p.ws}; run_gemm(lds, (const bf16_t*)(p.ws + W_CQN), 512, (const bf16_t*)(p.ws + W_BTUQ), MALL, 3072, 512, f); }
    { CPARAMS& p = get_params(); FKvUp f{p.ws}; run_gemm(lds, (const bf16_t*)(p.ws + W_LAT), 512, (const bf16_t*)(p.ws + W_BTUKV), LATROWS, 4096, 512, f, true); }
    GSYNC();
    PROBE_AT(10);
    if (TIME_X2 == 11) { CPARAMS& p = get_params(); phase_attn_mla(p, lds, dryflag); }
    { CPARAMS& p = get_params(); phase_attn_mla(p, lds); }
    GSYNC();
    PROBE_AT(11);
    { CPARAMS& p = get_params(); FResid f{p.out + O_Y, p.out + O_Y + (size_t)NP * DM, p.out + O_Y}; run_gemm(lds, (const bf16_t*)(p.ws + W_Q2), 3072, (const bf16_t*)(p.ws + W_BTOUT1), MALL, DM, DM, f); }
    GSYNC();
    PROBE_AT(12);
    { CPARAMS& p = get_params(); phase_ln(p, p.in[I_LN1G], p.in[I_LN1B], nullptr); }
}

extern "C" void kernel_launch(void* const* d_in, const int* in_sizes, int n_in, void* d_out, int out_size, void* d_ws, size_t ws_size, hipStream_t stream) {
    static int grid_blocks = 0;
    if (!grid_blocks) {
        if (n_in != N_IN || (size_t)out_size != O_END || ws_size < W_END) { fprintf(stderr, "kernel_launch: unexpected shapes n_in %d out %d ws %zu\n", n_in, out_size, ws_size); return; }
        if (hipFuncSetAttribute((const void*)fwd_megakernel, hipFuncAttributeMaxDynamicSharedMemorySize, LDS_BYTES) != hipSuccess) { fprintf(stderr, "kernel_launch: LDS attribute failed\n"); return; }
        int dev = 0, cus = 0, per_cu = 0;
        hipGetDevice(&dev); hipDeviceGetAttribute(&cus, hipDeviceAttributeMultiprocessorCount, dev);
        hipOccupancyMaxActiveBlocksPerMultiprocessor(&per_cu, fwd_megakernel, 512, LDS_BYTES);
        if (per_cu < 1) { fprintf(stderr, "kernel_launch: occupancy 0\n"); return; }
        grid_blocks = cus;
    }
    if (hipMemsetAsync((char*)d_ws + W_BAR, 0, 256, stream) != hipSuccess) { fprintf(stderr, "kernel_launch: memset failed\n"); return; }
    Params p{};
    for (int i = 0; i < N_IN; ++i) p.in[i] = (const float*)d_in[i];
    p.out = (float*)d_out; p.ws = (char*)d_ws;
    void* args[] = {&p};
    hipError_t e = hipLaunchCooperativeKernel((const void*)fwd_megakernel, dim3(grid_blocks), dim3(512), args, LDS_BYTES, stream);
    if (e != hipSuccess) fprintf(stderr, "cooperative launch failed: %s (grid %d)\n", hipGetErrorString(e), grid_blocks);
}
```

```cpp
#include <hip/hip_runtime.h>
#include <hip/hip_cooperative_groups.h>
#include <cstdio>
#include <cstdint>
namespace cg = cooperative_groups;

#define LAS __attribute__((address_space(3)))
typedef unsigned short bf16_t;
typedef short bf16x8 __attribute__((ext_vector_type(8)));
typedef short s16x4 __attribute__((ext_vector_type(4)));
typedef float f32x4 __attribute__((ext_vector_type(4)));
typedef float f32x8 __attribute__((ext_vector_type(8)));
typedef float f32x16 __attribute__((ext_vector_type(16)));
typedef unsigned u32x4 __attribute__((ext_vector_type(4)));
typedef unsigned u32x2 __attribute__((ext_vector_type(2)));
typedef unsigned long long u64;

constexpr int DM = 2048, NP = 32768, NS = 512, MALL = NP + NS  , TP = 4096, TS = 64, PAST = 1024, LS = PAST + TS  ;
constexpr int NIN0 = 10352, NIN0P = 10496, NIN1 = 3136, NIN1P = 3328;
constexpr int LATROWS = NP + 8 * LS;
constexpr float ALPHA_RES = 1.4142135623730951f;
constexpr float LOG2E = 1.4426950408889634f;
constexpr float EPSV = 1e-5f;

enum { I_XP = 0, I_XS, I_CAK, I_CAV, I_CAKI, I_SCONV, I_SSSM, I_CLAT, I_CKR, I_T5, I_WIN0, I_WOUT0, I_CONVW, I_CONVB, I_DTB, I_ALOG, I_DSKIP,
       I_SNORM, I_LN0G, I_LN0B, I_WIN1, I_QNW, I_KVNW, I_WUQ, I_WUKV, I_WOUT1, I_LN1G, I_LN1B, N_IN };

constexpr size_t O_Y = 0;
constexpr size_t O_AKP = (size_t)MALL * DM;
constexpr size_t O_AKS = O_AKP + (size_t)NP * 1024;
constexpr size_t O_AVP = O_AKS + (size_t)NS * 1024;
constexpr size_t O_AVS = O_AVP + (size_t)NP * 1024;
constexpr size_t O_KIP = O_AVS + (size_t)NS * 1024;
constexpr size_t O_KIS = O_KIP + (size_t)NP * 64;
constexpr size_t O_BCP = O_KIS + (size_t)NS * 64;
constexpr size_t O_BCS = O_BCP + (size_t)8 * 3 * 3072;
constexpr size_t O_BSP = O_BCS + (size_t)8 * 3 * 3072;
constexpr size_t O_BSS = O_BSP + (size_t)8 * 32 * 64 * 128;
constexpr size_t O_CLP = O_BSS + (size_t)8 * 32 * 64 * 128;
constexpr size_t O_CLS = O_CLP + (size_t)NP * 512;
constexpr size_t O_CKP = O_CLS + (size_t)NS * 512;
constexpr size_t O_CKS = O_CKP + (size_t)NP * 64;
constexpr size_t O_END = O_CKS + (size_t)NS * 64;

constexpr size_t MiB = 1ull << 20;
constexpr size_t W_BT0 = 0;
constexpr size_t W_BTOUT0 = 41 * MiB;
constexpr size_t W_BT1 = 53 * MiB;
constexpr size_t W_BTUQ = 66 * MiB;
constexpr size_t W_BTUKV = 69 * MiB;
constexpr size_t W_BTOUT1 = 73 * MiB;
constexpr size_t W_ROPE = 81 * MiB;
constexpr size_t W_KIDXP = 82 * MiB;
constexpr size_t W_KIDXS = 86 * MiB;
constexpr size_t W_IW = 88 * MiB;
constexpr size_t W_DT = 91 * MiB;
constexpr size_t W_MASKP = 96 * MiB;
constexpr size_t W_MASKS = 112 * MiB;
constexpr size_t W_SSQ = 113 * MiB;
constexpr size_t W_BAR = 118 * MiB;
constexpr size_t W_XB = 120 * MiB;
constexpr size_t W_MIX = 250 * MiB;
constexpr size_t W_KP = 445 * MiB;
constexpr size_t W_KS = 509 * MiB;
constexpr size_t W_VP = 526 * MiB;
constexpr size_t W_VS = 590 * MiB;
constexpr size_t W_SG = 607 * MiB;
constexpr size_t W_IQ = 672 * MiB;
constexpr size_t W_XBC = 737 * MiB;
constexpr size_t W_KVALL = 120 * MiB;
constexpr size_t W_CQKV = 445 * MiB;
constexpr size_t W_CQN = 584 * MiB;
constexpr size_t W_LAT = 617 * MiB;
constexpr size_t W_KR = 658 * MiB;
constexpr size_t W_Q2 = 664 * MiB;
constexpr size_t W_SGATE = 860 * MiB;
constexpr size_t W_XACT = W_XB;
constexpr size_t W_BCACT = 932 * MiB;
constexpr size_t W_END = 997 * MiB;

struct Params { const float* in[N_IN]; float* out; char* ws; };
#define CPARAMS const __attribute__((address_space(4))) Params

constexpr int LDS_BYTES = 131072 + 32768;
#define KRSWZ(row, colB) ((row) * 128 + ((colB) ^ ((((row) >> 1) & 7) << 4)))

typedef __bf16 bf16x2_t __attribute__((ext_vector_type(2)));
typedef float f32x2_t __attribute__((ext_vector_type(2)));
__device__ __forceinline__ unsigned cvtpk(float lo, float hi) { const f32x2_t v = {lo, hi}; const bf16x2_t r = __builtin_convertvector(v, bf16x2_t); return __builtin_bit_cast(unsigned, r); }
__device__ __forceinline__ bf16_t f2bf(float f) { return (bf16_t)(cvtpk(f, f) & 0xffffu); }
__device__ __forceinline__ float bf2f(bf16_t b) { return __uint_as_float(((unsigned)b) << 16); }
__device__ __forceinline__ float silu_f(float v) { return v / (1.f + __expf(-v)); }
__device__ __forceinline__ bf16x8 pack8(const float* x) { u32x4 w = {cvtpk(x[0], x[1]), cvtpk(x[2], x[3]), cvtpk(x[4], x[5]), cvtpk(x[6], x[7])}; return *reinterpret_cast<bf16x8*>(&w); }
__device__ __forceinline__ u32x2 pack4(f32x4 v) { u32x2 w = {cvtpk(v[0], v[1]), cvtpk(v[2], v[3])}; return w; }
__device__ __forceinline__ float wave_sum(float v) {
#pragma unroll
  for (int o = 32; o > 0; o >>= 1) v += __shfl_xor(v, o);
  return v;
}
__device__ __forceinline__ int wave_sum_i(int v) {
#pragma unroll
  for (int o = 32; o > 0; o >>= 1) v += __shfl_xor(v, o);
  return v;
}
__device__ __forceinline__ float row16_sum(float v) {
    v += __builtin_bit_cast(float, __builtin_amdgcn_update_dpp(0, __builtin_bit_cast(int, v), 0xB1, 0xf, 0xf, true));
    v += __builtin_bit_cast(float, __builtin_amdgcn_update_dpp(0, __builtin_bit_cast(int, v), 0x4E, 0xf, 0xf, true));
    v += __builtin_bit_cast(float, __builtin_amdgcn_update_dpp(0, __builtin_bit_cast(int, v), 0x141, 0xf, 0xf, true));
    v += __builtin_bit_cast(float, __builtin_amdgcn_update_dpp(0, __builtin_bit_cast(int, v), 0x140, 0xf, 0xf, true));
    return v;
}
__device__ __forceinline__ float wave_scan_incl(float v, int lane) {
    v += __builtin_bit_cast(float, __builtin_amdgcn_update_dpp(0, __builtin_bit_cast(int, v), 0x111, 0xf, 0xf, false));
    v += __builtin_bit_cast(float, __builtin_amdgcn_update_dpp(0, __builtin_bit_cast(int, v), 0x112, 0xf, 0xf, false));
    v += __builtin_bit_cast(float, __builtin_amdgcn_update_dpp(0, __builtin_bit_cast(int, v), 0x114, 0xf, 0xf, false));
    v += __builtin_bit_cast(float, __builtin_amdgcn_update_dpp(0, __builtin_bit_cast(int, v), 0x118, 0xf, 0xf, false));
    const float t0 = __builtin_bit_cast(float, __builtin_amdgcn_readlane(__builtin_bit_cast(int, v), 15));
    const float t1 = __builtin_bit_cast(float, __builtin_amdgcn_readlane(__builtin_bit_cast(int, v), 31));
    const float t2 = __builtin_bit_cast(float, __builtin_amdgcn_readlane(__builtin_bit_cast(int, v), 47));
    float add = 0.f; if (lane >= 16) add = t0; if (lane >= 32) add = t0 + t1; if (lane >= 48) add = (t0 + t1) + t2;
    return v + add;
}
__device__ __forceinline__ int opaque_tid() { int t = threadIdx.x; asm volatile("" : "+v"(t)); return t; }
__device__ __forceinline__ int wave_sum_dpp(int v) {
    v += __builtin_amdgcn_update_dpp(0, v, 0xB1, 0xf, 0xf, true);
    v += __builtin_amdgcn_update_dpp(0, v, 0x4E, 0xf, 0xf, true);
    v += __builtin_amdgcn_update_dpp(0, v, 0x141, 0xf, 0xf, true);
    v += __builtin_amdgcn_update_dpp(0, v, 0x140, 0xf, 0xf, true);
    return __builtin_amdgcn_readlane(v, 0) + __builtin_amdgcn_readlane(v, 16) + __builtin_amdgcn_readlane(v, 32) + __builtin_amdgcn_readlane(v, 48);
}
__device__ __forceinline__ int latrow_of(int row) { if (row < NP) return row; const int r = row - NP; return NP + (r >> 6) * LS + PAST + (r & 63); }
__device__ __forceinline__ int pos_of(int row) { return row < NP ? (row & (TP - 1)) : PAST + ((row - NP) & 63); }
namespace pg8 {
#define PG8_LAS __attribute__((address_space(3)))
constexpr int BM = 256, BK = 64, HALF = 128, HTB = HALF * BK * 2  , STAGE_BYTES = 8 * HTB, NXCD = 8, WGM = 8;

__host__ __device__ __forceinline__ int lds_byte(int r, int c) { const int st = (r >> 4) * 2 + (c >> 5), rr = r & 15, cc = c & 31, ob = rr * 64 + cc * 2; return st * 1024 + (ob ^ (((ob >> 9) & 1) << 5)); }
__host__ __device__ __forceinline__ void stage_rc(int b, int& R, int& C) { const int st = b / 1024, sb = b % 1024, swz = sb ^ (((sb >> 9) & 1) << 5); R = (st >> 1) * 16 + swz / 64; C = (st & 1) * 32 + (swz % 64) / 2; }
__host__ __device__ __forceinline__ int perm32(int rho) { const int n = rho >> 4, i = rho & 15; return 8 * (i >> 2) + 4 * n + (i & 3); }

struct Unit { int pm, pn; };
struct Gemm { const bf16_t* A; const bf16_t* Bt; int M, N, K, lda; };

struct StaticOrder {
    int nM, nN, nwg, G, c;
    __host__ __device__ void init(int M, int N, int G_, int c_) { nM = M / BM; nN = N / BM; nwg = nM * nN; G = G_; c = c_; }
    __host__ __device__ bool next(int i, Unit& u) const {
        const long L = (long)i * G + c; if (L >= nwg) return false;
        int wgid = (int)L; { const int q = nwg / NXCD, r = nwg % NXCD, xcd = wgid % NXCD, off = wgid / NXCD; wgid = (xcd < r ? xcd * (q + 1) : r * (q + 1) + (xcd - r) * q) + off; }
        const int nig = WGM * nN, gid = wgid / nig, fm = gid * WGM, gsz = (nM - fm) < WGM ? (nM - fm) : WGM;
        u.pm = fm + ((wgid % nig) % gsz); u.pn = (wgid % nig) / gsz; return true;
    }
    __device__ __forceinline__ void a_ready(const Unit&) const {}
    __device__ __forceinline__ void done(const Unit&) const {}
};

template <class Epi, class Sched>
__device__ __forceinline__ void gemm_phase(PG8_LAS unsigned char* lds, const Gemm g, const Sched& S, const Epi& E) {
    constexpr bool STAMP = false; unsigned long long* stamps = nullptr;
    int tid_ = threadIdx.x; asm volatile("" : "+v"(tid_));
    const int tid = tid_, wid = __builtin_amdgcn_readfirstlane(tid >> 6), lane = tid & 63, wr = wid >> 2, wc = wid & 3, fr = lane & 15, fq = lane >> 4;
    const int K = g.K, nt = K / BK;
    int ts_lo = 0, ts_hi = 0, nts = 0; const unsigned long long rt_entry = STAMP ? (unsigned long long)wall_clock64() : 0ull;
#define PG8_STAMP() do { if (STAMP && wid == 0 && nts < 64) { const unsigned long long _c = (unsigned long long)clock64(); \
        ts_lo = (lane == nts) ? (int)(unsigned)_c : ts_lo; ts_hi = (lane == nts) ? (int)(unsigned)(_c >> 32) : ts_hi; ++nts; } } while (0)
    PG8_STAMP();
    unsigned voffA[2], voffB[2];
#pragma unroll
    for (int i = 0; i < 2; ++i) { int R, C; stage_rc(tid * 16 + i * 8192, R, C); const int Rb = Epi::PERM ? ((R & ~31) + perm32(R & 31)) : R;
        voffA[i] = (unsigned)(R * g.lda + C) * 2u; voffB[i] = (unsigned)(Rb * K + C) * 2u; }
    const size_t kstep = (size_t)(BK * 2);
    const size_t hstep = (size_t)HALF * K * 2; const size_t hstepA = (size_t)HALF * g.lda * 2;
    const size_t tstep = 2 * hstep; const size_t tstepA = 2 * hstepA;
    const unsigned ldsw = (unsigned)wid * 1024u;
    const int aoff = lds_byte(wr * 64 + fr, fq * 8), boff = lds_byte(wc * 32 + fr, fq * 8);
#define PG8_SA(b, h) (((b) * 2 + (h)) * HTB)
#define PG8_SB(b, h) ((4 + (b) * 2 + (h)) * HTB)
#define PG8_STAGE(bufoff, gbase, voff) do { _Pragma("unroll") for (int _i = 0; _i < 2; ++_i) \
        __builtin_amdgcn_global_load_lds((const unsigned*)((const char*)(gbase) + (voff)[_i]), (PG8_LAS unsigned*)(lds + (bufoff) + ldsw + _i * 8192), 16, 0, 0); } while (0)
#define PG8_LDA(dst, b, h) do { _Pragma("unroll") for (int m = 0; m < 4; ++m) _Pragma("unroll") for (int k = 0; k < 2; ++k) dst[m][k] = *(const PG8_LAS bf16x8*)(lds + PG8_SA(b, h) + aoff + m * 2048 + k * 1024); } while (0)
#define PG8_LDB(dst, b, h) do { _Pragma("unroll") for (int n = 0; n < 2; ++n) _Pragma("unroll") for (int k = 0; k < 2; ++k) dst[n][k] = *(const PG8_LAS bf16x8*)(lds + PG8_SB(b, h) + boff + n * 2048 + k * 1024); } while (0)
#define PG8_MMA(ai, bj, At, Bt) do { __builtin_amdgcn_s_setprio(1); _Pragma("unroll") for (int m = 0; m < 4; ++m) _Pragma("unroll") for (int n = 0; n < 2; ++n) _Pragma("unroll") for (int k = 0; k < 2; ++k) \
        acc[ai][bj][m][n] = __builtin_amdgcn_mfma_f32_16x16x32_bf16(Bt[n][k], At[m][k], acc[ai][bj][m][n], 0, 0, 0); __builtin_amdgcn_s_setprio(0); } while (0)
#define PG8_WAIT_V(n) asm volatile("s_waitcnt vmcnt(" #n ")" ::: "memory")
#define PG8_WAIT_L(n) asm volatile("s_waitcnt lgkmcnt(" #n ")" ::: "memory")
#define PG8_BAR __builtin_amdgcn_s_barrier()
#define PG8_SCHED __builtin_amdgcn_sched_barrier(0)
    Unit cur, nxt; int ui = 0;
    if (!S.next(0, cur)) return;
    f32x4 acc[2][2][4][2];
#pragma unroll
    for (int a = 0; a < 2; ++a)
#pragma unroll
        for (int b = 0; b < 2; ++b)
#pragma unroll
            for (int m = 0; m < 4; ++m)
#pragma unroll
                for (int n = 0; n < 2; ++n) acc[a][b][m][n] = (f32x4){0.f, 0.f, 0.f, 0.f};
    bf16x8 At[4][2], B0[2][2], B1[2][2];
    const char* cA = (const char*)g.A + (size_t)cur.pm * tstepA; const char* cB = (const char*)g.Bt + (size_t)cur.pn * tstep;
    S.a_ready(cur);
    PG8_STAGE(PG8_SB(0, 0), cB, voffB); PG8_STAGE(PG8_SA(0, 0), cA, voffA); PG8_STAGE(PG8_SB(0, 1), cB + hstep, voffB); PG8_STAGE(PG8_SA(0, 1), cA + hstepA, voffA);
    if (wr == 1) PG8_BAR;
    PG8_WAIT_V(4); PG8_BAR;
    PG8_STAGE(PG8_SB(1, 0), cB + kstep, voffB); PG8_STAGE(PG8_SA(1, 0), cA + kstep, voffA); PG8_STAGE(PG8_SB(1, 1), cB + hstep + kstep, voffB);
    PG8_WAIT_V(6); PG8_BAR;
    PG8_STAMP();
    for (;;) {
        const bool has_next = S.next(ui + 1, nxt);
        const char* nA = has_next ? (const char*)g.A + (size_t)nxt.pm * tstepA : cA; const char* nB = has_next ? (const char*)g.Bt + (size_t)nxt.pn * tstep : cB;
        for (int t = 0; t < nt; t += 2) {
            const bool last = (t == nt - 2);
            const char* a1 = cA + (size_t)(t + 1) * kstep;
            const char* a2 = last ? nA : cA + (size_t)(t + 2) * kstep; const char* b2 = last ? nB : cB + (size_t)(t + 2) * kstep;
            const char* a3 = a2 + kstep; const char* b3 = b2 + kstep;
            if (last && has_next) S.a_ready(nxt);
            PG8_LDB(B0, 0, 0); PG8_SCHED; PG8_LDA(At, 0, 0); PG8_STAGE(PG8_SA(1, 1), a1 + hstepA, voffA);
            PG8_WAIT_L(8); PG8_BAR; PG8_WAIT_L(0); PG8_MMA(0, 0, At, B0); PG8_BAR; PG8_SCHED;
            PG8_LDB(B1, 0, 1); PG8_STAGE(PG8_SB(0, 0), b2, voffB);
            PG8_BAR; PG8_WAIT_L(0); PG8_MMA(0, 1, At, B1); PG8_BAR;
            PG8_LDA(At, 0, 1); PG8_STAGE(PG8_SA(0, 0), a2, voffA);
            PG8_BAR; PG8_WAIT_L(0); PG8_MMA(1, 0, At, B0); PG8_BAR; PG8_SCHED;
            PG8_STAGE(PG8_SB(0, 1), b2 + hstep, voffB);
            PG8_WAIT_V(6); PG8_BAR; PG8_MMA(1, 1, At, B1); PG8_BAR;
            PG8_LDB(B0, 1, 0); PG8_SCHED; PG8_LDA(At, 1, 0); PG8_STAGE(PG8_SA(0, 1), a2 + hstepA, voffA);
            PG8_WAIT_L(8); PG8_BAR; PG8_WAIT_L(0); PG8_MMA(0, 0, At, B0); PG8_BAR; PG8_SCHED;
            PG8_LDB(B1, 1, 1); PG8_STAGE(PG8_SB(1, 0), b3, voffB);
            PG8_BAR; PG8_WAIT_L(0); PG8_MMA(0, 1, At, B1); PG8_BAR;
            PG8_LDA(At, 1, 1); PG8_STAGE(PG8_SA(1, 0), a3, voffA);
            PG8_BAR; PG8_WAIT_L(0); PG8_MMA(1, 0, At, B0); PG8_BAR; PG8_SCHED;
            PG8_STAGE(PG8_SB(1, 1), b3 + hstep, voffB);
            PG8_WAIT_V(6); PG8_BAR; PG8_MMA(1, 1, At, B1); PG8_BAR;
        }
        PG8_STAMP();
        if constexpr (!Epi::AFTER_DRAIN) { E(acc, cur, wr, wc, fr, fq); S.done(cur); }
        PG8_STAMP();
        if (!has_next) break;
#pragma unroll
        for (int a = 0; a < 2; ++a)
#pragma unroll
            for (int b = 0; b < 2; ++b)
#pragma unroll
                for (int m = 0; m < 4; ++m)
#pragma unroll
                    for (int n = 0; n < 2; ++n) acc[a][b][m][n] = (f32x4){0.f, 0.f, 0.f, 0.f};
        cur = nxt; cA = nA; cB = nB; ++ui;
    }
    PG8_WAIT_V(0);
    if (wr == 0) PG8_BAR;
    PG8_BAR;
    if constexpr (Epi::AFTER_DRAIN) { E.fused(acc, cur, wr, wc, fr, fq, lds, wid, lane); S.done(cur); }
    PG8_STAMP();
    if (STAMP && wid == 0) { stamps[lane] = lane < nts ? (((unsigned long long)(unsigned)ts_hi << 32) | (unsigned)ts_lo) : 0ull;
        if (lane == 62) stamps[62] = rt_entry; if (lane == 63) stamps[63] = (unsigned long long)wall_clock64(); }
#undef PG8_STAMP
#undef PG8_SA
#undef PG8_SB
#undef PG8_STAGE
#undef PG8_LDA
#undef PG8_LDB
#undef PG8_MMA
#undef PG8_WAIT_V
#undef PG8_WAIT_L
#undef PG8_BAR
#undef PG8_SCHED
}
}


template <class F> struct EpiGen {
    static constexpr bool PERM = false, AFTER_DRAIN = false;
    F f;
    __device__ __forceinline__ void operator()(const f32x4 (&acc)[2][2][4][2], const pg8::Unit& u, int wr, int wc, int fr, int fq) const {
        int row0 = u.pm * 256 + wr * 64 + fr, col0 = u.pn * 256 + wc * 32 + 4 * fq;
        asm volatile("" : "+v"(row0), "+v"(col0));
#pragma unroll
        for (int ai = 0; ai < 2; ++ai)
#pragma unroll
            for (int m = 0; m < 4; ++m) {
                const int row = row0 + ai * 128 + m * 16;
#pragma unroll
                for (int bj = 0; bj < 2; ++bj)
#pragma unroll
                    for (int n = 0; n < 2; ++n) f(row, col0 + bj * 128 + n * 16, acc[ai][bj][m][n], u.pn);
            }
    }
};

#define EPI_ITER(...) do { int row0_ = row0, col0_ = col0; asm volatile("" : "+v"(row0_), "+v"(col0_)); _Pragma("unroll") for (int ai = 0; ai < 2; ++ai) _Pragma("unroll") for (int m = 0; m < 4; ++m) { const int row = row0_ + ai * 128 + m * 16; \
    _Pragma("unroll") for (int bj = 0; bj < 2; ++bj) _Pragma("unroll") for (int n = 0; n < 2; ++n) { const int col = col0_ + bj * 128 + n * 16; const f32x4 v = acc[ai][bj][m][n]; __VA_ARGS__ } } } while (0)
struct EpiInProj0 {
    static constexpr bool PERM = false, AFTER_DRAIN = false;
    char* ws; float* out; const float* dtb;
    __device__ __forceinline__ void operator()(const f32x4 (&acc)[2][2][4][2], const pg8::Unit& u, int wr, int wc, int fr, int fq) const {
        int row0 = u.pm * 256 + wr * 64 + fr, col0 = u.pn * 256 + wc * 32 + 4 * fq; const int pn = u.pn;
        asm volatile("" : "+v"(row0), "+v"(col0));
        if (pn < 4) {
            EPI_ITER({ *(u32x2*)((bf16_t*)(ws + W_MIX) + (size_t)row * 3072 + col) = pack4(v); });
        } else if (pn < 12) {
            const bool isv = pn >= 8; const int cs = isv ? 2048 : 1024;
            bf16_t* kp = (bf16_t*)(ws + (isv ? W_VP : W_KP)); bf16_t* ks = (bf16_t*)(ws + (isv ? W_VS : W_KS)); float* op = out + (isv ? O_AVP : O_AKP); float* os = out + (isv ? O_AVS : O_AKS);
            EPI_ITER({ const int c = col - cs; bf16_t* kb; float* o;
                if (row < NP) { kb = kp + (size_t)row * 1024 + c; o = op + (size_t)row * 1024 + c; }
                else { const int r = row - NP; kb = ks + ((size_t)(r >> 6) * LS + PAST + (r & 63)) * 1024 + c; o = os + (size_t)r * 1024 + c; }
                *(u32x2*)kb = pack4(v); *(f32x4*)o = v; });
        } else if (pn < 16) {
            EPI_ITER({ f32x4 s = {silu_f(v[0]), silu_f(v[1]), silu_f(v[2]), silu_f(v[3])}; *(u32x2*)((bf16_t*)(ws + W_SG) + (size_t)row * 1024 + (col - 3072)) = pack4(s); });
        } else if (pn < 20) {
            EPI_ITER({ *(u32x2*)((bf16_t*)(ws + W_IQ) + (size_t)row * 1024 + (col - 4096)) = pack4(v); });
        } else if (pn < 28) {
            EPI_ITER({ f32x4 s = {silu_f(v[0]), silu_f(v[1]), silu_f(v[2]), silu_f(v[3])}; *(u32x2*)((bf16_t*)(ws + W_MIX) + (size_t)row * 3072 + 1024 + (col - 5120)) = pack4(s); });
        } else if (pn < 40) {
            EPI_ITER({ const int c = col - 7168;
                *(u32x2*)((bf16_t*)(ws + W_XBC) + (size_t)row * 3072 + c) = pack4(v);
                if (row < NP) { const int t = row & (TP - 1); if (t >= TP - 3) *(f32x4*)(out + O_BCP + ((size_t)(row >> 12) * 3 + (t - (TP - 3))) * 3072 + c) = v; }
                else { const int r = row - NP, t = r & 63; if (t >= TS - 3) *(f32x4*)(out + O_BCS + ((size_t)(r >> 6) * 3 + (t - (TS - 3))) * 3072 + c) = v; } });
        } else {
            int r0 = row0, c0 = col0; asm volatile("" : "+v"(r0), "+v"(c0));
#pragma unroll
            for (int n = 0; n < 2; ++n) {
                const int c = c0 - 10240 + n * 16;
                if (c < 64) {
#pragma unroll
                    for (int ai = 0; ai < 2; ++ai)
#pragma unroll
                        for (int m = 0; m < 4; ++m) { const int row = r0 + ai * 128 + m * 16; const f32x4 v = acc[ai][0][m][n]; bf16_t* kb; float* o;
                            if (row < NP) { kb = (bf16_t*)(ws + W_KIDXP) + (size_t)row * 64 + c; o = out + O_KIP + (size_t)row * 64 + c; }
                            else { const int r = row - NP; kb = (bf16_t*)(ws + W_KIDXS) + ((size_t)(r >> 6) * LS + PAST + (r & 63)) * 64 + c; o = out + O_KIS + (size_t)r * 64 + c; }
                            *(u32x2*)kb = pack4(v); *(f32x4*)o = v; }
                } else if (c < 80) {
#pragma unroll
                    for (int ai = 0; ai < 2; ++ai)
#pragma unroll
                        for (int m = 0; m < 4; ++m) { const int row = r0 + ai * 128 + m * 16; *(f32x4*)((float*)(ws + W_IW) + (size_t)row * 16 + (c - 64)) = acc[ai][0][m][n] * 0.03125f; }
                } else if (c < 112) {
                    const f32x4 db = *(const f32x4*)(dtb + (c - 80));
#pragma unroll
                    for (int ai = 0; ai < 2; ++ai)
#pragma unroll
                        for (int m = 0; m < 4; ++m) { const int row = r0 + ai * 128 + m * 16; const f32x4 v = acc[ai][0][m][n] + db; f32x4 d;
#pragma unroll
                            for (int j = 0; j < 4; ++j) d[j] = v[j] > 20.f ? v[j] : log1pf(__expf(v[j]));
                            *(f32x4*)((float*)(ws + W_DT) + (size_t)row * 32 + (c - 80)) = d; }
                }
            }
        }
    }
};

struct FResid {
    const float* r0; const float* r1; float* y;
    __device__ __forceinline__ void operator()(int row, int col, f32x4 v, int) const {
        const float* rp = row < NP ? r0 + (size_t)row * DM + col : r1 + (size_t)(row - NP) * DM + col;
        const f32x4 x = *(const f32x4*)rp;
        *(f32x4*)(y + (size_t)row * DM + col) = v + x * ALPHA_RES;
    }
};

struct FInProj1 {
    char* ws;
    __device__ __forceinline__ void operator()(int row, int col, f32x4 v, int pn) const {
        if (pn < 4) *(f32x4*)((float*)(ws + W_CQKV) + (size_t)row * 1088 + col) = v;
        else if (pn < 12) { f32x4 s = {silu_f(v[0]), silu_f(v[1]), silu_f(v[2]), silu_f(v[3])}; *(u32x2*)((bf16_t*)(ws + W_SGATE) + (size_t)row * 2048 + (col - 1024)) = pack4(s); }
        else { const int c = col - 3072; if (c < 64) *(f32x4*)((float*)(ws + W_CQKV) + (size_t)row * 1088 + 1024 + c) = v; }
    }
};

struct FQUp {
    char* ws;
    __device__ __forceinline__ void operator()(int row, int col, f32x4 v, int pn) const {
        if (pn >= 8) {
            const int jj = (col - 2048) & 63, i0 = (jj >> 2) * 2, pos = pos_of(row);
            const float2* tab = (const float2*)(ws + W_ROPE) + (size_t)pos * 32 + i0;
            const float2 c0 = tab[0], c1 = tab[1];
            f32x4 o; o[0] = v[0] * c0.x - v[2] * c0.y; o[2] = v[0] * c0.y + v[2] * c0.x; o[1] = v[1] * c1.x - v[3] * c1.y; o[3] = v[1] * c1.y + v[3] * c1.x; v = o;
        }
        *(u32x2*)((bf16_t*)(ws + W_Q2) + (size_t)row * 3072 + col) = pack4(v);
    }
};
struct FKvUp { char* ws; __device__ __forceinline__ void operator()(int row, int col, f32x4 v, int) const { *(u32x2*)((bf16_t*)(ws + W_KVALL) + (size_t)row * 4096 + col) = pack4(v); } };

template <class F> __device__ __forceinline__ void run_gemm(char* lds, const bf16_t* A, int lda, const bf16_t* Bt, int M, int N, int K, const F& f, const bool rev = false) {
    pg8::Gemm g; g.A = A; g.Bt = Bt; g.M = M; g.N = N; g.K = K; g.lda = lda;
    pg8::StaticOrder S; S.init(M, N, (int)gridDim.x, rev ? (int)(gridDim.x - 1 - blockIdx.x) : (int)blockIdx.x);
    EpiGen<F> E{f};
    pg8::gemm_phase<EpiGen<F>, pg8::StaticOrder>((PG8_LAS unsigned char*)lds, g, S, E);
}

__device__ __forceinline__ int orig_col(int w, int n) {
    switch (w) {
    case 0: if (n < 5120) return n; if (n < 7168) return 5200 + (n - 5120); if (n < 10240) return 7248 + (n - 7168); if (n < 10304) return 5120 + (n - 10240);
            if (n < 10320) return 5184 + (n - 10304); if (n < 10352) return n; return -1;
    case 2: if (n < 1024) return n; if (n < 3072) return 1088 + (n - 1024); if (n < 3136) return 1024 + (n - 3072); return -1;
    case 3: if (n < 2048) return (n >> 7) * 192 + (n & 127);
            { const int j = n - 2048, h = j >> 6, jj = j & 63, g4 = jj >> 2, e = jj & 3; return h * 192 + 128 + (e >> 1) * 32 + 2 * g4 + (e & 1); }
    case 4: if (n < 2048) return (n >> 7) * 256 + (n & 127); { const int j = n - 2048; return (j >> 7) * 256 + 128 + (j & 127); }
    default: return n;
    }
}
__device__ __forceinline__ void phase_prep(CPARAMS& p, char* lds) {
    const int tid = opaque_tid();
    {
        bf16_t* tile = (bf16_t*)lds;
        int base = 0;
#pragma unroll 1
        for (int w = 0; w < 6; ++w) {
            int K, N, NPd; const float* W; bf16_t* Bt;
            switch (w) {
            case 0: K = 2048; N = NIN0; NPd = NIN0P; W = p.in[I_WIN0]; Bt = (bf16_t*)(p.ws + W_BT0); break;
            case 1: K = 3072; N = 2048; NPd = 2048; W = p.in[I_WOUT0]; Bt = (bf16_t*)(p.ws + W_BTOUT0); break;
            case 2: K = 2048; N = NIN1; NPd = NIN1P; W = p.in[I_WIN1]; Bt = (bf16_t*)(p.ws + W_BT1); break;
            case 3: K = 512; N = 3072; NPd = 3072; W = p.in[I_WUQ]; Bt = (bf16_t*)(p.ws + W_BTUQ); break;
            case 4: K = 512; N = 4096; NPd = 4096; W = p.in[I_WUKV]; Bt = (bf16_t*)(p.ws + W_BTUKV); break;
            default: K = 2048; N = 2048; NPd = 2048; W = p.in[I_WOUT1]; Bt = (bf16_t*)(p.ws + W_BTOUT1); break;
            }
            const int nkt = K / 64, nnt = NPd / 64, ntiles = nkt * nnt;
            int first = (int)blockIdx.x - (base % (int)gridDim.x); if (first < 0) first += gridDim.x;
#pragma unroll 1
            for (int tix = first; tix < ntiles; tix += gridDim.x) {
                const int kt = tix % nkt, nt = tix / nkt;
                const int nl = tid & 63, n = nt * 64 + nl, oc = orig_col(w, n);
#pragma unroll
                for (int i = 0; i < 8; ++i) {
                    const int kl = i * 8 + (tid >> 6), k = kt * 64 + kl;
                    const float v = oc >= 0 ? W[(size_t)k * N + oc] : 0.f;
                    tile[nl * 66 + kl] = f2bf(v);
                }
                __syncthreads();
                { const int nr = tid >> 3, ks = (tid & 7) * 8; const unsigned* src = (const unsigned*)(tile + nr * 66 + ks);
                  u32x4 o = {src[0], src[1], src[2], src[3]};
                  *(u32x4*)(Bt + (size_t)(nt * 64 + nr) * K + kt * 64 + ks) = o; }
                __syncthreads();
            }
            base += ntiles;
        }
    }
    const size_t gtid = (size_t)blockIdx.x * 512 + tid, gstride = (size_t)gridDim.x * 512;
    { bf16_t* xb = (bf16_t*)(p.ws + W_XB); const size_t n8p = (size_t)NP * DM / 8, n8 = (size_t)MALL * DM / 8;
      for (size_t i0 = gtid; i0 < n8; i0 += 4 * gstride) {
        f32x4 a[4], b[4];
#pragma unroll
        for (int u = 0; u < 4; ++u) { const size_t i = i0 + u * gstride; if (i < n8) { const float* s = i < n8p ? p.in[I_XP] + i * 8 : p.in[I_XS] + (i - n8p) * 8; a[u] = *(const f32x4*)s; b[u] = *(const f32x4*)(s + 4); } }
#pragma unroll
        for (int u = 0; u < 4; ++u) { const size_t i = i0 + u * gstride; if (i < n8) { const float t[8] = {a[u][0], a[u][1], a[u][2], a[u][3], b[u][0], b[u][1], b[u][2], b[u][3]}; *(bf16x8*)(xb + i * 8) = pack8(t); } }
      } }
    { const size_t n8 = (size_t)8 * PAST * 1024 / 8;
      for (size_t i = gtid; i < 2 * n8; i += gstride) { const bool isv = i >= n8; const size_t j = isv ? i - n8 : i; const float* s = p.in[isv ? I_CAV : I_CAK] + j * 8;
        const size_t e = j * 8, b = e / ((size_t)PAST * 1024), rem = e % ((size_t)PAST * 1024);
        const f32x4 a = *(const f32x4*)s, c = *(const f32x4*)(s + 4); const float t[8] = {a[0], a[1], a[2], a[3], c[0], c[1], c[2], c[3]};
        *(bf16x8*)((bf16_t*)(p.ws + (isv ? W_VS : W_KS)) + b * (size_t)LS * 1024 + rem) = pack8(t); }
      const size_t m8 = (size_t)8 * PAST * 64 / 8;
      for (size_t i = gtid; i < m8; i += gstride) { const float* s = p.in[I_CAKI] + i * 8; const size_t e = i * 8, b = e / ((size_t)PAST * 64), rem = e % ((size_t)PAST * 64);
        const f32x4 a = *(const f32x4*)s, c = *(const f32x4*)(s + 4); const float t[8] = {a[0], a[1], a[2], a[3], c[0], c[1], c[2], c[3]};
        *(bf16x8*)((bf16_t*)(p.ws + W_KIDXS) + b * (size_t)LS * 64 + rem) = pack8(t); } }
    { float2* tab = (float2*)(p.ws + W_ROPE);
      for (size_t i = gtid; i < (size_t)4096 * 32; i += gstride) { const int pos = (int)(i >> 5), f = (int)(i & 31);
        const float inv = powf(10000.f, -(float)f / 32.f), ang = (float)pos * inv; float s, c; sincosf(ang, &s, &c); tab[i] = make_float2(c, s); } }
}

__device__ __forceinline__ void phase_index(CPARAMS& p, char* lds) {
    const int tid = opaque_tid(), wid = tid >> 6, lane = tid & 63, r32 = lane & 31, hi = lane >> 5;
    unsigned* sk = (unsigned*)lds;
    const int NU = 4096 + 64;
#pragma unroll 1
    for (int idx = blockIdx.x; idx < NU; idx += gridDim.x) {
        int b, t0, n, nblk_tot, rowg; const bf16_t* ki; u64* mrow; int ldm; bool sample;
        if (idx < 4096) { const int k = idx >> 8, w = idx & 255; b = k >> 1; const int j = (k & 1) ? 511 - w : w; t0 = j * 8; n = ((t0 >> 6) + 1) * 64; nblk_tot = ((t0 >> 8) + 1) * 4;
            rowg = b * TP + t0; ki = (const bf16_t*)(p.ws + W_KIDXP) + (size_t)b * TP * 64; mrow = (u64*)(p.ws + W_MASKP) + (size_t)rowg * 64; ldm = 64; sample = false; }
        else { const int s = idx - 4096; b = s >> 3; t0 = (s & 7) * 8; n = LS; nblk_tot = 17; rowg = NP + b * 64 + t0;
            ki = (const bf16_t*)(p.ws + W_KIDXS) + (size_t)b * LS * 64; mrow = (u64*)(p.ws + W_MASKS) + (size_t)(b * 64 + t0) * 32; ldm = 32; sample = true; }
        (void)sample;
        if (n <= 256) {
            if (lane < nblk_tot) mrow[(size_t)wid * ldm + lane] = (lane * 64 < n) ? ~0ull : 0ull;
            continue;
        }
        {
            const int pr = wid >> 1, par = wid & 1;
            const int qsel = (r32 >> 2) & 1, head = (r32 & 3) + 4 * (r32 >> 3);
            const bf16_t* qp = (const bf16_t*)(p.ws + W_IQ) + (size_t)(rowg + 2 * pr + qsel) * 1024 + head * 64 + hi * 8;
            bf16x8 qa[4];
#pragma unroll
            for (int s = 0; s < 4; ++s) qa[s] = *(const bf16x8*)(qp + s * 16);
            const float* wp = (const float*)(p.ws + W_IW) + (size_t)(rowg + 2 * pr + hi) * 16;
            float wv[16];
#pragma unroll
            for (int s = 0; s < 4; ++s) { const f32x4 t = *(const f32x4*)(wp + s * 4); wv[s * 4] = t[0]; wv[s * 4 + 1] = t[1]; wv[s * 4 + 2] = t[2]; wv[s * 4 + 3] = t[3]; }
            unsigned* dst = sk + (2 * pr + hi) * 4096 + par * 32 + r32;
            char* kst = lds + 131072;
            const int skey = tid >> 3, scolB = (tid & 7) * 16, ntile = n >> 6, ngrp = (ntile + 3) >> 2;
            const bf16_t* ksrc = ki + (size_t)skey * 64 + (scolB >> 1);
            bf16x8 pre[3][4];
#pragma unroll
            for (int sl = 0; sl < 3; ++sl)
#pragma unroll
                for (int u = 0; u < 4; ++u) { const int t = sl * 4 + u; pre[sl][u] = *(const bf16x8*)(ksrc + (size_t)(t < ntile ? t : 0) * 64 * 64); }
#define IDX_GROUP(SL, G) do { const int g_ = (G); \
                __syncthreads(); \
                _Pragma("unroll") for (int u = 0; u < 4; ++u) *(bf16x8*)(kst + u * 8192 + KRSWZ(skey, scolB)) = pre[SL][u]; \
                _Pragma("unroll") for (int u = 0; u < 4; ++u) { const int t = (g_ + 3) * 4 + u; pre[SL][u] = *(const bf16x8*)(ksrc + (size_t)(t < ntile ? t : 0) * 64 * 64); } \
                __syncthreads(); \
                _Pragma("unroll") for (int u = 0; u < 4; ++u) { const int t = g_ * 4 + u; \
                    if (t < ntile) { f32x16 acc = {}; \
                        _Pragma("unroll") for (int s = 0; s < 4; ++s) { const bf16x8 kf = *(const bf16x8*)(kst + u * 8192 + KRSWZ(par * 32 + r32, (s * 16 + hi * 8) * 2)); acc = __builtin_amdgcn_mfma_f32_32x32x16_bf16(qa[s], kf, acc, 0, 0, 0); } \
                        float sc = 0.f; \
                        _Pragma("unroll") for (int r = 0; r < 16; ++r) sc = fmaf(wv[r], fmaxf(acc[r], 0.f), sc); \
                        sc += 0.f; \
                        const unsigned uu = __float_as_uint(sc); \
                        dst[t * 64] = (uu & 0x80000000u) ? ~uu : (uu | 0x80000000u); } } } while (0)
#pragma unroll 1
            for (int g0 = 0; g0 < ngrp; g0 += 3) {
                IDX_GROUP(0, g0);
                if (g0 + 1 < ngrp) IDX_GROUP(1, g0 + 1);
                if (g0 + 2 < ngrp) IDX_GROUP(2, g0 + 2);
            }
#undef IDX_GROUP
        }
        __syncthreads();
        {
            const unsigned* k = sk + wid * 4096;
            u32x4 kv[16];
#pragma unroll
            for (int j = 0; j < 16; ++j) kv[j] = (j * 256 < n && j * 256 + lane * 4 < n) ? *(const u32x4*)(k + j * 256 + lane * 4) : (u32x4){0u, 0u, 0u, 0u};
            unsigned prefix = 0;
#pragma unroll 1
            for (int bit = 31; bit >= 0; --bit) {
                const unsigned cand = prefix | (1u << bit);
                int cnt = 0;
#pragma unroll
                for (int j = 0; j < 16; ++j) if (j * 256 < n) cnt += (kv[j][0] >= cand) + (kv[j][1] >= cand) + (kv[j][2] >= cand) + (kv[j][3] >= cand);
                cnt = wave_sum_dpp(cnt);
                if (cnt >= 256) { prefix = cand; if (cnt == 256) break; }
            }
            int cgt = 0;
#pragma unroll
            for (int j = 0; j < 16; ++j) if (j * 256 < n) cgt += (kv[j][0] > prefix) + (kv[j][1] > prefix) + (kv[j][2] > prefix) + (kv[j][3] > prefix);
            cgt = wave_sum_dpp(cgt);
            const int need = 256 - cgt; int running = 0;
            u64* mr = mrow + (size_t)wid * ldm;
            const u64 lt = (1ull << lane) - 1ull;
#pragma unroll 1
            for (int blk = 0; blk < nblk_tot; ++blk) {
                u64 word = 0ull;
                if (blk * 64 < n) {
                    const unsigned v = k[blk * 64 + lane];
                    const u64 eqm = __ballot(v == prefix);
                    const int rank = running + __popcll(eqm & lt);
                    const bool sel = (v > prefix) || (v == prefix && rank < need);
                    word = __ballot(sel); running += __popcll(eqm);
                }
                if (lane == 0) mr[blk] = word;
            }
        }
        __syncthreads();
    }
}

#define KSWZ(row, colB) ((row) * 256 + ((colB) ^ (((row) & 7) << 4)))
__device__ __forceinline__ int crow(int r, int hi) { return (r & 3) + 8 * (r >> 2) + 4 * hi; }
__device__ __forceinline__ int v_st(int k, int c) { const int kk = (k & ~0xC) | ((k & 4) << 1) | ((k & 8) >> 1); return ((kk >> 3) * 4 + (c >> 5)) * 512 + ((kk & 7) * 32 + (c & 31)) * 2; }
__device__ __forceinline__ int v_rd_base(int lane) { return ((lane & 3) << 3) | (((lane >> 2) & 3) << 6) | (((lane >> 4) & 1) << 5) | (((lane >> 5) & 1) << 8); }
constexpr int v_rd_off(int d0, int ks, int half) { return d0 * 512 + ks * 4096 + half * 2048; }
template <int OFF> __device__ __forceinline__ s16x4 tr_read(int vb) { s16x4 r; asm volatile("ds_read_b64_tr_b16 %0, %1 offset:%2" : "=&v"(r) : "v"(vb), "i"(OFF) : "memory"); return r; }
template <int D0> __device__ __forceinline__ void pv_one(f32x16& od, int vb, bf16x8 pa0, bf16x8 pa1, bf16x8 pa2, bf16x8 pa3) {
    const s16x4 l0 = tr_read<v_rd_off(D0, 0, 0)>(vb), h0 = tr_read<v_rd_off(D0, 0, 1)>(vb), l1 = tr_read<v_rd_off(D0, 1, 0)>(vb), h1 = tr_read<v_rd_off(D0, 1, 1)>(vb);
    const s16x4 l2 = tr_read<v_rd_off(D0, 2, 0)>(vb), h2 = tr_read<v_rd_off(D0, 2, 1)>(vb), l3 = tr_read<v_rd_off(D0, 3, 0)>(vb), h3 = tr_read<v_rd_off(D0, 3, 1)>(vb);
    asm volatile("s_waitcnt lgkmcnt(0)" ::: "memory"); __builtin_amdgcn_sched_barrier(0);
#define PKV(L, H) (bf16x8){L[0], L[1], L[2], L[3], H[0], H[1], H[2], H[3]}
    od = __builtin_amdgcn_mfma_f32_32x32x16_bf16(pa0, PKV(l0, h0), od, 0, 0, 0);
    od = __builtin_amdgcn_mfma_f32_32x32x16_bf16(pa1, PKV(l1, h1), od, 0, 0, 0);
    od = __builtin_amdgcn_mfma_f32_32x32x16_bf16(pa2, PKV(l2, h2), od, 0, 0, 0);
    od = __builtin_amdgcn_mfma_f32_32x32x16_bf16(pa3, PKV(l3, h3), od, 0, 0, 0);
#undef PKV
}

struct AttnUnit {
    const bf16_t* Q; const bf16_t* Qr; const bf16_t* K; const bf16_t* V; const bf16_t* Kr; bf16_t* O; const bf16_t* G; const u64* M;
    int ldq, ldqr, ldk, ldo, ldg, ldm, nvalid, qpos0, NT, head;
};
constexpr int AT_V = 0, AT_K = 32768, AT_KR = 65536, AT_WS = 81920, AT_TB = 81920 + 2048;

template <int MODE>
__device__ __forceinline__ void attn_unit(const AttnUnit& u, char* lds, const float* t5, const float Cs  , const bool dry = false) {
    const int tid = opaque_tid(), wid = __builtin_amdgcn_readfirstlane(tid >> 6), lane = tid & 63, r32 = lane & 31, hi = lane >> 5;
    float* wsf = (float*)(lds + AT_WS) + wid * 64; float* al_l = wsf; float* li_l = wsf + 32;
    float* tb = (float*)(lds + AT_TB);
    const int rowb = wid * 32 + r32, rowc = rowb < u.nvalid ? rowb : u.nvalid - 1;
    const int wrow0 = (wid * 32 < u.nvalid) ? wid * 32 : u.nvalid - 1;
    const int qc_w = (u.qpos0 + wrow0) >> 6;
    const int qpos = u.qpos0 + rowc;
    constexpr int NQ = MODE == 1 ? 12 : 8;
    bf16x8 qr[NQ];
    { const bf16_t* Qw = u.Q + (size_t)rowc * u.ldq + hi * 8;
#pragma unroll
      for (int d0 = 0; d0 < 8; ++d0) qr[d0] = *(const bf16x8*)(Qw + d0 * 16);
      if constexpr (MODE == 1) { const bf16_t* Qw2 = u.Qr + (size_t)rowc * u.ldqr + hi * 8;
#pragma unroll
        for (int d0 = 0; d0 < 4; ++d0) qr[8 + d0] = *(const bf16x8*)(Qw2 + d0 * 16); } }
    if constexpr (MODE == 0) {
        if (tid < 155) { const int rel = tid - 63, nn = rel < 0 ? -rel : rel;
            const int bk = (rel < 0 ? 16 : 0) + (nn < 8 ? nn : 8 + (nn >= 12) + (nn >= 16) + (nn >= 23) + (nn >= 32) + (nn >= 46) + (nn >= 64) + (nn >= 91));
            tb[tid] = t5[bk * 8 + u.head] * LOG2E; }
    }
    float m_reg = -1e29f, l_reg = 0.f; f32x16 o[4];
#pragma unroll
    for (int d = 0; d < 4; ++d) o[d] = (f32x16){};
    const int vb0 = (int)(uintptr_t)(lds + AT_V) + v_rd_base(lane);
    int koff[2], voff[2], kroff = 0;
#pragma unroll
    for (int i = 0; i < 2; ++i) { const int X = (i * 8 + wid) * 1024 + lane * 16;
        { const int row = X >> 8, colB = (X & 255) ^ ((row & 7) << 4); koff[i] = row * u.ldk + (colB >> 1); }
        { const int sub = X >> 9, y = X & 511, kk = (sub >> 2) * 8 + (y >> 6), k = (kk & ~0xC) | ((kk & 4) << 1) | ((kk & 8) >> 1), c = (sub & 3) * 32 + ((y & 63) >> 1); voff[i] = k * u.ldk + c; } }
    if constexpr (MODE == 1) { const int X = wid * 1024 + lane * 16, row = X >> 7, colB = (X & 127) ^ (((row >> 1) & 7) << 4); kroff = row * 64 + (colB >> 1); }
    LAS char* ldl = (LAS char*)lds;
#define AT_ISSUE(b, k0) do { const bf16_t* kb_ = u.K + (size_t)(k0) * u.ldk; const bf16_t* vb_ = u.V + (size_t)(k0) * u.ldk; \
        _Pragma("unroll") for (int i_ = 0; i_ < 2; ++i_) { \
            __builtin_amdgcn_global_load_lds((const unsigned*)(kb_ + koff[i_]), (LAS unsigned*)(ldl + AT_K + (b) * 16384 + (i_ * 8 + wid) * 1024), 16, 0, 0); \
            __builtin_amdgcn_global_load_lds((const unsigned*)(vb_ + voff[i_]), (LAS unsigned*)(ldl + AT_V + (b) * 16384 + (i_ * 8 + wid) * 1024), 16, 0, 0); } \
        if constexpr (MODE == 1) __builtin_amdgcn_global_load_lds((const unsigned*)(u.Kr + (size_t)(k0) * 64 + kroff), (LAS unsigned*)(ldl + AT_KR + (b) * 8192 + wid * 1024), 16, 0, 0); } while (0)
    AT_ISSUE(0, 0);
    asm volatile("s_waitcnt vmcnt(0)" ::: "memory");
    __syncthreads();
#pragma unroll 1
    for (int j = 0; j < u.NT; ++j) {
        const int cur = j & 1;
        if (j + 1 < u.NT) AT_ISSUE(cur ^ 1, (j + 1) * 64);
        if (j <= qc_w && wid * 32 < u.nvalid) {
            u64 mw = 0;
            if constexpr (MODE == 0) mw = u.M[(size_t)rowc * u.ldm + j];
            f32x16 p0 = {}, p1 = {};
            const char* Ks = lds + AT_K + cur * 16384;
            __builtin_amdgcn_s_setprio(1);
#pragma unroll
            for (int d0 = 0; d0 < 8; ++d0) { const int cb = (d0 * 16 + hi * 8) * 2;
                const bf16x8 b0 = *(const bf16x8*)(Ks + KSWZ(r32, cb)), b1 = *(const bf16x8*)(Ks + KSWZ(32 + r32, cb));
                p0 = __builtin_amdgcn_mfma_f32_32x32x16_bf16(b0, qr[d0], p0, 0, 0, 0); p1 = __builtin_amdgcn_mfma_f32_32x32x16_bf16(b1, qr[d0], p1, 0, 0, 0);
                if ((d0 & 3) == 3) __builtin_amdgcn_sched_barrier(0); }
            if constexpr (MODE == 1) { const char* Krs = lds + AT_KR + cur * 8192;
#pragma unroll
                for (int d0 = 0; d0 < 4; ++d0) { const int cb = (d0 * 16 + hi * 8) * 2;
                    const bf16x8 b0 = *(const bf16x8*)(Krs + KRSWZ(r32, cb)), b1 = *(const bf16x8*)(Krs + KRSWZ(32 + r32, cb));
                    p0 = __builtin_amdgcn_mfma_f32_32x32x16_bf16(b0, qr[8 + d0], p0, 0, 0, 0); p1 = __builtin_amdgcn_mfma_f32_32x32x16_bf16(b1, qr[8 + d0], p1, 0, 0, 0); } }
            __builtin_amdgcn_s_setprio(0);
            float esc = Cs, ebias = 0.f;
            unsigned mlo = 0u, mhi = 0u;
            if constexpr (MODE == 0) {
                mlo = (unsigned)mw >> (4 * hi); mhi = (unsigned)(mw >> 32) >> (4 * hi);
                const int kb = j * 64;
                const bool far = (u.qpos0 + wrow0) - (kb + 63) >= 91;
                if (far) ebias = tb[154];
                else { const int rel0 = qpos - kb - 4 * hi; esc = 1.f;
#pragma unroll
                    for (int r = 0; r < 16; ++r) { const int c0 = crow(r, 0);
                        int i0 = rel0 - c0; i0 = i0 < -63 ? -63 : (i0 > 91 ? 91 : i0); int i1 = rel0 - c0 - 32; i1 = i1 < -63 ? -63 : (i1 > 91 ? 91 : i1);
                        p0[r] = fmaf(p0[r], Cs, tb[i0 + 63]); p1[r] = fmaf(p1[r], Cs, tb[i1 + 63]); }
                }
            }
            float pmax = p0[0];
#pragma unroll
            for (int r = 1; r < 16; ++r) pmax = fmaxf(pmax, p0[r]);
#pragma unroll
            for (int r = 0; r < 16; ++r) pmax = fmaxf(pmax, p1[r]);
            { auto rr = __builtin_amdgcn_permlane32_swap(__float_as_uint(pmax), __float_as_uint(pmax), false, false); pmax = fmaxf(__uint_as_float(rr[0]), __uint_as_float(rr[1])); }
            const float pmax_t = fmaf(pmax, esc, ebias);
            float mn = m_reg, alpha = 1.f;
            const bool grow = !__all(pmax_t - m_reg <= 11.5f);
            if (grow) { mn = fmaxf(m_reg, pmax_t); alpha = __builtin_amdgcn_exp2f(m_reg - mn); m_reg = mn; }
            const float mns = ebias - mn;
            float ps = 0.f;
#pragma unroll
            for (int r = 0; r < 16; ++r) { p0[r] = __builtin_amdgcn_exp2f(fmaf(p0[r], esc, mns)); p1[r] = __builtin_amdgcn_exp2f(fmaf(p1[r], esc, mns)); }
            if constexpr (MODE == 0) {
#pragma unroll
                for (int r = 0; r < 16; ++r) { const int c0 = crow(r, 0);
                    p0[r] = __uint_as_float(__float_as_uint(p0[r]) & (unsigned)((int)(mlo << (31 - c0)) >> 31));
                    p1[r] = __uint_as_float(__float_as_uint(p1[r]) & (unsigned)((int)(mhi << (31 - c0)) >> 31)); }
            }
#pragma unroll
            for (int r = 0; r < 16; ++r) ps += p0[r] + p1[r];
            { auto rr = __builtin_amdgcn_permlane32_swap(__float_as_uint(ps), __float_as_uint(ps), false, false); ps = __uint_as_float(rr[0]) + __uint_as_float(rr[1]); }
            l_reg = l_reg * alpha + ps;
            if (grow) {
                if (hi == 0) al_l[r32] = alpha;
                asm volatile("s_waitcnt lgkmcnt(0)" ::: "memory");
#pragma unroll
                for (int r = 0; r < 16; ++r) { const float a = al_l[crow(r, hi)];
#pragma unroll
                    for (int d = 0; d < 4; ++d) o[d][r] *= a; }
            }
            bf16x8 pa0, pa1, pa2, pa3;
#define PK4(P, BASE, OUT) do { unsigned a0 = cvtpk(P[BASE + 0], P[BASE + 1]), a1 = cvtpk(P[BASE + 2], P[BASE + 3]);   \
    unsigned b0 = cvtpk(P[BASE + 4], P[BASE + 5]), b1 = cvtpk(P[BASE + 6], P[BASE + 7]);                              \
    auto r0 = __builtin_amdgcn_permlane32_swap(a0, b0, false, false); auto r1 = __builtin_amdgcn_permlane32_swap(a1, b1, false, false); \
    u32x4 w = {r0[0], r1[0], r0[1], r1[1]}; OUT = *reinterpret_cast<bf16x8*>(&w); } while (0)
            PK4(p0, 0, pa0); PK4(p0, 8, pa1); PK4(p1, 0, pa2); PK4(p1, 8, pa3);
#undef PK4
            const int vb = vb0 + cur * 16384;
            __builtin_amdgcn_s_setprio(1);
            pv_one<0>(o[0], vb, pa0, pa1, pa2, pa3); pv_one<1>(o[1], vb, pa0, pa1, pa2, pa3); pv_one<2>(o[2], vb, pa0, pa1, pa2, pa3); pv_one<3>(o[3], vb, pa0, pa1, pa2, pa3);
            __builtin_amdgcn_s_setprio(0);
        }
        asm volatile("s_waitcnt vmcnt(0)" ::: "memory");
        __syncthreads();
    }
#undef AT_ISSUE
    if (hi == 0) li_l[r32] = l_reg;
    asm volatile("s_waitcnt lgkmcnt(0)" ::: "memory");
#pragma unroll
    for (int r = 0; r < 16; ++r) {
        const int orow = wid * 32 + crow(r, hi);
        const float rl = __builtin_amdgcn_rcpf(li_l[crow(r, hi)]);
        if (orow < u.nvalid && !dry) {
#pragma unroll
            for (int d0 = 0; d0 < 4; ++d0) { const int c = d0 * 32 + r32;
                const float g = bf2f(u.G[(size_t)orow * u.ldg + c]);
                u.O[(size_t)orow * u.ldo + c] = f2bf(o[d0][r] * rl * g); }
        }
    }
    __syncthreads();
}

__device__ __forceinline__ void phase_attn_dsa(CPARAMS& p, char* lds, const bool dry = false) {
    const float Cs = 0.08838834764831845f * LOG2E;
    const int NU = 1024 + 64;
#pragma unroll 1
    for (int idx = blockIdx.x; idx < NU; idx += gridDim.x) {
        AttnUnit u;
        bf16_t* mix = (bf16_t*)(p.ws + W_MIX);
        if (idx < 1024) { const int k = idx >> 8, w = idx & 255, h = w & 7, qb0 = (w >> 3) & 15, b = (w >> 7) + 2 * k, qb = (k & 1) ? 15 - qb0 : qb0;
            const size_t row0 = (size_t)b * TP + qb * 256;
            u.Q = mix + row0 * 3072 + h * 128; u.O = mix + row0 * 3072 + h * 128; u.G = (const bf16_t*)(p.ws + W_SG) + row0 * 1024 + h * 128;
            u.K = (const bf16_t*)(p.ws + W_KP) + (size_t)b * TP * 1024 + h * 128; u.V = (const bf16_t*)(p.ws + W_VP) + (size_t)b * TP * 1024 + h * 128;
            u.M = (const u64*)(p.ws + W_MASKP) + row0 * 64; u.ldm = 64; u.nvalid = 256; u.qpos0 = qb * 256; u.NT = 4 * (qb + 1); u.head = h;
        } else { const int s = idx - 1024, b = s >> 3, h = s & 7; const size_t row0 = (size_t)NP + b * 64;
            u.Q = mix + row0 * 3072 + h * 128; u.O = mix + row0 * 3072 + h * 128; u.G = (const bf16_t*)(p.ws + W_SG) + row0 * 1024 + h * 128;
            u.K = (const bf16_t*)(p.ws + W_KS) + (size_t)b * LS * 1024 + h * 128; u.V = (const bf16_t*)(p.ws + W_VS) + (size_t)b * LS * 1024 + h * 128;
            u.M = (const u64*)(p.ws + W_MASKS) + (size_t)b * 64 * 32; u.ldm = 32; u.nvalid = 64; u.qpos0 = PAST; u.NT = 17; u.head = h; }
        u.Qr = nullptr; u.Kr = nullptr; u.ldq = 3072; u.ldqr = 0; u.ldk = 1024; u.ldo = 3072; u.ldg = 1024;
        attn_unit<0>(u, lds, p.in[I_T5], Cs, dry);
    }
}
__device__ __forceinline__ void phase_attn_mla(CPARAMS& p, char* lds, const bool dry = false) {
    const float Cs = 0.07216878364870323f * LOG2E;
    const int NU = 2048 + 128;
#pragma unroll 1
    for (int idx = blockIdx.x; idx < NU; idx += gridDim.x) {
        AttnUnit u;
        bf16_t* q2 = (bf16_t*)(p.ws + W_Q2); const bf16_t* kv = (const bf16_t*)(p.ws + W_KVALL); const bf16_t* kr = (const bf16_t*)(p.ws + W_KR);
        size_t row0, lrow0; int h;
        if (idx < 2048) { const int k = idx >> 8, w = idx & 255, qb0 = (w >> 4) & 15, b = k, qb = (k & 1) ? 15 - qb0 : qb0; h = w & 15;
            row0 = (size_t)b * TP + qb * 256; lrow0 = (size_t)b * TP; u.nvalid = 256; u.qpos0 = qb * 256; u.NT = 4 * (qb + 1);
        } else { const int s = idx - 2048, b = s >> 4; h = s & 15; row0 = (size_t)NP + b * 64; lrow0 = (size_t)NP + (size_t)b * LS; u.nvalid = 64; u.qpos0 = PAST; u.NT = 17; }
        u.Q = q2 + row0 * 3072 + h * 128; u.Qr = q2 + row0 * 3072 + 2048 + h * 64; u.O = q2 + row0 * 3072 + h * 128; u.G = (const bf16_t*)(p.ws + W_SGATE) + row0 * 2048 + h * 128;
        u.K = kv + lrow0 * 4096 + h * 128; u.V = kv + lrow0 * 4096 + 2048 + h * 128; u.Kr = kr + lrow0 * 64; u.M = nullptr;
        u.ldq = 3072; u.ldqr = 3072; u.ldk = 4096; u.ldo = 3072; u.ldg = 2048; u.ldm = 0; u.head = h;
        attn_unit<1>(u, lds, nullptr, Cs, dry);
    }
}

__device__ __forceinline__ void phase_conv(CPARAMS& p) {
    const int tid = opaque_tid();
    if (tid < 384) {
        const int ch = tid * 8;
        float cw[4][8], cb[8];
        { const float* cwp = p.in[I_CONVW] + ch; const float* cbp = p.in[I_CONVB] + ch;
#pragma unroll
          for (int j = 0; j < 4; ++j) { const f32x4 a = *(const f32x4*)(cwp + j * 3072), bq = *(const f32x4*)(cwp + j * 3072 + 4);
              cw[j][0] = a[0]; cw[j][1] = a[1]; cw[j][2] = a[2]; cw[j][3] = a[3]; cw[j][4] = bq[0]; cw[j][5] = bq[1]; cw[j][6] = bq[2]; cw[j][7] = bq[3]; }
          const f32x4 a = *(const f32x4*)cbp, bq = *(const f32x4*)(cbp + 4); cb[0] = a[0]; cb[1] = a[1]; cb[2] = a[2]; cb[3] = a[3]; cb[4] = bq[0]; cb[5] = bq[1]; cb[6] = bq[2]; cb[7] = bq[3]; }
        const bf16_t* xbc = (const bf16_t*)(p.ws + W_XBC);
        bf16_t* dst = ch < 2048 ? (bf16_t*)(p.ws + W_XACT) + ch : (bf16_t*)(p.ws + W_BCACT) + (ch - 2048);
        const int dstride = ch < 2048 ? 2048 : 1024;
#pragma unroll 1
        for (int unit = blockIdx.x; unit < MALL / 64; unit += gridDim.x) {
            const size_t row0 = (size_t)unit * 64;
            float w[3][8];
            const bool seqstart = row0 >= NP || (row0 & (TP - 1)) == 0;
            if (seqstart) {
                if (row0 >= NP) { const float* sp = p.in[I_SCONV] + ((row0 - NP) >> 6) * 3 * 3072 + ch;
#pragma unroll
                    for (int j = 0; j < 3; ++j) { const f32x4 a = *(const f32x4*)(sp + j * 3072), bq = *(const f32x4*)(sp + j * 3072 + 4);
                        w[j][0] = a[0]; w[j][1] = a[1]; w[j][2] = a[2]; w[j][3] = a[3]; w[j][4] = bq[0]; w[j][5] = bq[1]; w[j][6] = bq[2]; w[j][7] = bq[3]; } }
                else {
#pragma unroll
                    for (int j = 0; j < 3; ++j)
#pragma unroll
                        for (int e = 0; e < 8; ++e) w[j][e] = 0.f; }
            } else {
#pragma unroll
                for (int j = 0; j < 3; ++j) { const bf16x8 r = *(const bf16x8*)(xbc + (row0 - 3 + j) * 3072 + ch);
#pragma unroll
                    for (int e = 0; e < 8; ++e) w[j][e] = bf2f((bf16_t)r[e]); }
            }
#pragma unroll 1
            for (int r0 = 0; r0 < 64; r0 += 8) {
                bf16x8 raw[8];
#pragma unroll
                for (int r = 0; r < 8; ++r) raw[r] = *(const bf16x8*)(xbc + (row0 + r0 + r) * 3072 + ch);
#pragma unroll
                for (int r = 0; r < 8; ++r) { float o[8];
#pragma unroll
                    for (int e = 0; e < 8; ++e) { const float cur = bf2f((bf16_t)raw[r][e]);
                        o[e] = silu_f(cb[e] + cw[0][e] * w[0][e] + cw[1][e] * w[1][e] + cw[2][e] * w[2][e] + cw[3][e] * cur);
                        w[0][e] = w[1][e]; w[1][e] = w[2][e]; w[2][e] = cur; }
                    *(bf16x8*)(dst + (row0 + r0 + r) * dstride) = pack8(o); }
            }
        }
    }
}

constexpr int SD_XT = 0, SD_BS = 9216, SD_BTT = 26624, SD_CS = 45056, SD_CS2 = 62464, SD_WS = 79872, SD_H0 = 89088, SD_F = 106496;
__device__ __forceinline__ void phase_ssd(CPARAMS& p, char* lds, const bool dry = false) {
    const int tid = opaque_tid(), wid = tid >> 6, lane = tid & 63, l16 = lane & 15, lq = lane >> 4;
    bf16_t* XT = (bf16_t*)(lds + SD_XT); bf16_t* Bs = (bf16_t*)(lds + SD_BS); bf16_t* BTt = (bf16_t*)(lds + SD_BTT); bf16_t* Cs = (bf16_t*)(lds + SD_CS);
    bf16_t* Cs2 = (bf16_t*)(lds + SD_CS2); bf16_t* Ws = (bf16_t*)(lds + SD_WS); bf16_t* H0 = (bf16_t*)(lds + SD_H0);
    float* s_acum = (float*)(lds + SD_F); float* s_dt = s_acum + 64; float* s_ea = s_acum + 128; float* s_tail = s_acum + 192; float* s_ssq = s_acum + 256;
    const bf16_t* xbc = (const bf16_t*)(p.ws + W_XBC); bf16_t* mix = (bf16_t*)(p.ws + W_MIX);
    const float* dtbuf = (const float*)(p.ws + W_DT); float* ssqg = (float*)(p.ws + W_SSQ);
#pragma unroll 1
    for (int idx = blockIdx.x; idx < 512; idx += gridDim.x) {
        const bool sample = idx >= 256; const int bh = idx & 255, b = bh >> 5, h = bh & 31, g = h >> 3;
        const size_t row0 = sample ? (size_t)NP + b * 64 : (size_t)b * TP; const int nch = sample ? 1 : 64;
        const float a_h = -__expf(p.in[I_ALOG][h]), d_h = p.in[I_DSKIP][h];
        f32x4 hacc[4];
        const int pt = wid >> 1;
#pragma unroll
        for (int j = 0; j < 4; ++j) { const int nt = (wid & 1) * 4 + j;
#pragma unroll
            for (int i = 0; i < 4; ++i) { const int pp = pt * 16 + 4 * lq + i, nn = nt * 16 + l16;
                hacc[j][i] = sample ? p.in[I_SSSM][(((size_t)b * 32 + h) * 64 + pp) * 128 + nn] : 0.f;
                H0[pp * 136 + nn] = f2bf(hacc[j][i]); } }
        const int cg8 = tid % 40, rb = tid / 40; const bool ldr = tid < 320;
        const bf16_t* asrc = cg8 < 8 ? (const bf16_t*)(p.ws + W_XACT) + h * 64 + cg8 * 8 : (const bf16_t*)(p.ws + W_BCACT) + (cg8 < 24 ? g * 128 + (cg8 - 8) * 8 : 512 + g * 128 + (cg8 - 24) * 8);
        const size_t astride = cg8 < 8 ? 2048 : 1024;
        bf16x8 av[8];
#pragma unroll
        for (int r = 0; r < 8; ++r) av[r] = ldr ? *(const bf16x8*)(asrc + (row0 + rb * 8 + r) * astride) : (bf16x8){0, 0, 0, 0, 0, 0, 0, 0};
        float dt_next = (wid == 0) ? dtbuf[(row0 + lane) * 32 + h] : 0.f;
        bf16_t szv[2][4];
#pragma unroll
        for (int q = 0; q < 2; ++q) { const int id = wid * 2 + q, mt = id >> 2, nt = id & 3;
#pragma unroll
            for (int i = 0; i < 4; ++i) szv[q][i] = mix[(row0 + mt * 16 + 4 * lq + i) * 3072 + 1024 + h * 64 + nt * 16 + l16]; }
#pragma unroll 1
        for (int c = 0; c < nch; ++c) {
            const size_t crow0 = row0 + (size_t)c * 64;
            if (wid == 0) {
                if (c > 0 && !dry) ssqg[(size_t)h * MALL + (crow0 - 64 + lane)] = (s_ssq[lane] + s_ssq[64 + lane]) + (s_ssq[128 + lane] + s_ssq[192 + lane]);
                const float dtv = dt_next; float ac = dtv * a_h;
                if (c + 1 < nch) dt_next = dtbuf[(crow0 + 64 + lane) * 32 + h];
                ac = wave_scan_incl(ac, lane);
                const float a63 = __builtin_bit_cast(float, __builtin_amdgcn_readlane(__builtin_bit_cast(int, ac), 63));
                s_acum[lane] = ac; s_dt[lane] = dtv; s_ea[lane] = __expf(ac); s_tail[lane] = __expf(a63 - ac) * dtv;
            }
            __syncthreads();
            if (ldr) {
                const int t0l = rb * 8;
#pragma unroll
                for (int hf = 0; hf < 2; ++hf) {
                    float vout[8][4];
#pragma unroll
                    for (int r = 0; r < 8; ++r)
#pragma unroll
                        for (int e = 0; e < 4; ++e) vout[r][e] = bf2f((bf16_t)av[r][hf * 4 + e]);
                    if (cg8 < 8) {
#pragma unroll
                        for (int e = 0; e < 4; ++e) { float t[8];
#pragma unroll
                            for (int r = 0; r < 8; ++r) t[r] = vout[r][e];
                            *(bf16x8*)(XT + (cg8 * 8 + hf * 4 + e) * 72 + t0l) = pack8(t); }
                    } else if (cg8 < 24) {
                        const int n0 = (cg8 - 8) * 8 + hf * 4;
#pragma unroll
                        for (int r = 0; r < 8; ++r) { const f32x4 q = {vout[r][0], vout[r][1], vout[r][2], vout[r][3]}; *(u32x2*)(Bs + (t0l + r) * 136 + n0) = pack4(q); }
                        float tl8[8];
#pragma unroll
                        for (int r = 0; r < 8; ++r) tl8[r] = s_tail[t0l + r];
#pragma unroll
                        for (int e = 0; e < 4; ++e) { float t[8];
#pragma unroll
                            for (int r = 0; r < 8; ++r) t[r] = vout[r][e] * tl8[r];
                            *(bf16x8*)(BTt + (n0 + e) * 72 + t0l) = pack8(t); }
                    } else {
                        const int n0 = (cg8 - 24) * 8 + hf * 4;
#pragma unroll
                        for (int r = 0; r < 8; ++r) { const f32x4 q = {vout[r][0], vout[r][1], vout[r][2], vout[r][3]}; *(u32x2*)(Cs + (t0l + r) * 136 + n0) = pack4(q);
                            const float ea = s_ea[t0l + r]; *(u32x2*)(Cs2 + (t0l + r) * 136 + n0) = pack4(q * ea); }
                    }
                }
                if (c + 1 < nch) {
#pragma unroll
                    for (int r = 0; r < 8; ++r) av[r] = *(const bf16x8*)(asrc + (crow0 + 64 + rb * 8 + r) * astride);
                }
            }
            __syncthreads();
#pragma unroll
            for (int q = 0; q < 2; ++q) { const int id = wid * 2 + q, mt = id >> 2, nt = id & 3;
                f32x4 acc = {0.f, 0.f, 0.f, 0.f};
                if (nt <= mt) {
#pragma unroll
                    for (int ks = 0; ks < 4; ++ks) { const bf16x8 af = *(const bf16x8*)(Cs + (mt * 16 + l16) * 136 + ks * 32 + lq * 8), bf = *(const bf16x8*)(Bs + (nt * 16 + l16) * 136 + ks * 32 + lq * 8);
                        acc = __builtin_amdgcn_mfma_f32_16x16x32_bf16(af, bf, acc, 0, 0, 0); }
                }
                const int s = nt * 16 + l16; const float as = s_acum[s], dts = s_dt[s];
#pragma unroll
                for (int i = 0; i < 4; ++i) { const int t = mt * 16 + 4 * lq + i; const float w = (s <= t) ? acc[i] * __expf(s_acum[t] - as) * dts : 0.f; Ws[t * 72 + s] = f2bf(w); }
            }
            __syncthreads();
#pragma unroll
            for (int q = 0; q < 2; ++q) { const int id = wid * 2 + q, mt = id >> 2, nt = id & 3;
                f32x4 acc = {0.f, 0.f, 0.f, 0.f};
#pragma unroll
                for (int ks = 0; ks < 2; ++ks) { const bf16x8 af = *(const bf16x8*)(Ws + (mt * 16 + l16) * 72 + ks * 32 + lq * 8), bf = *(const bf16x8*)(XT + (nt * 16 + l16) * 72 + ks * 32 + lq * 8);
                    acc = __builtin_amdgcn_mfma_f32_16x16x32_bf16(af, bf, acc, 0, 0, 0); }
#pragma unroll
                for (int ks = 0; ks < 4; ++ks) { const bf16x8 af = *(const bf16x8*)(Cs2 + (mt * 16 + l16) * 136 + ks * 32 + lq * 8), bf = *(const bf16x8*)(H0 + (nt * 16 + l16) * 136 + ks * 32 + lq * 8);
                    acc = __builtin_amdgcn_mfma_f32_16x16x32_bf16(af, bf, acc, 0, 0, 0); }
                const int pp = nt * 16 + l16;
#pragma unroll
                for (int i = 0; i < 4; ++i) { const int t = mt * 16 + 4 * lq + i;
                    const float xv = bf2f(XT[pp * 72 + t]);
                    const float yg = (acc[i] + d_h * xv) * bf2f(szv[q][i]);
                    if (!dry) mix[(crow0 + t) * 3072 + 1024 + h * 64 + pp] = f2bf(yg);
                    float sq = yg * yg;
                    sq = row16_sum(sq);
                    if (l16 == 0) s_ssq[nt * 64 + t] = sq; }
            }
            if (c + 1 < nch) {
#pragma unroll
                for (int q = 0; q < 2; ++q) { const int id = wid * 2 + q, mt = id >> 2, nt = id & 3;
#pragma unroll
                    for (int i = 0; i < 4; ++i) szv[q][i] = mix[(crow0 + 64 + mt * 16 + 4 * lq + i) * 3072 + 1024 + h * 64 + nt * 16 + l16]; } }
            const float e63 = s_ea[63];
            __syncthreads();
#pragma unroll
            for (int j = 0; j < 4; ++j) { const int nt = (wid & 1) * 4 + j;
                f32x4 acc = hacc[j] * e63;
#pragma unroll
                for (int ks = 0; ks < 2; ++ks) { const bf16x8 af = *(const bf16x8*)(XT + (pt * 16 + l16) * 72 + ks * 32 + lq * 8), bf = *(const bf16x8*)(BTt + (nt * 16 + l16) * 72 + ks * 32 + lq * 8);
                    acc = __builtin_amdgcn_mfma_f32_16x16x32_bf16(af, bf, acc, 0, 0, 0); }
                hacc[j] = acc;
#pragma unroll
                for (int i = 0; i < 4; ++i) H0[(pt * 16 + 4 * lq + i) * 136 + nt * 16 + l16] = f2bf(acc[i]);
            }
        }
        __syncthreads();
        if (wid == 0 && !dry) ssqg[(size_t)h * MALL + (row0 + (size_t)(nch - 1) * 64 + lane)] = (s_ssq[lane] + s_ssq[64 + lane]) + (s_ssq[128 + lane] + s_ssq[192 + lane]);
        if (!dry) { float* ho = p.out + (sample ? O_BSS : O_BSP) + ((size_t)b * 32 + h) * 64 * 128;
#pragma unroll
          for (int j = 0; j < 4; ++j) { const int nt = (wid & 1) * 4 + j;
#pragma unroll
              for (int i = 0; i < 4; ++i) ho[(size_t)(pt * 16 + 4 * lq + i) * 128 + nt * 16 + l16] = hacc[j][i]; } }
        __syncthreads();
    }
}

__device__ __forceinline__ void phase_bnorm(CPARAMS& p) {
    bf16_t* mix = (bf16_t*)(p.ws + W_MIX); const float* ssq = (const float*)(p.ws + W_SSQ); const float* nw = p.in[I_SNORM];
    const size_t n = (size_t)MALL * 256, stride = (size_t)gridDim.x * 512;
    const int tidb = opaque_tid();
    for (size_t i0 = (size_t)blockIdx.x * 512 + tidb; i0 < n; i0 += 4 * stride) {
        bf16x8 v[4]; float tot[4];
#pragma unroll
        for (int u = 0; u < 4; ++u) { const size_t i = i0 + u * stride; tot[u] = 0.f; v[u] = (bf16x8){0, 0, 0, 0, 0, 0, 0, 0};
            if (i < n) { const size_t row = i >> 8; const int c0 = (int)(i & 255) * 8, g = c0 >> 9;
                v[u] = *(const bf16x8*)(mix + row * 3072 + 1024 + c0);
#pragma unroll
                for (int hh = 0; hh < 8; ++hh) tot[u] += ssq[(size_t)(g * 8 + hh) * MALL + row]; } }
#pragma unroll
        for (int u = 0; u < 4; ++u) { const size_t i = i0 + u * stride;
            if (i < n) { const size_t row = i >> 8; const int c0 = (int)(i & 255) * 8;
                const float r = rsqrtf(tot[u] * (1.f / 512.f) + EPSV);
                const f32x4 w0 = *(const f32x4*)(nw + c0), w1 = *(const f32x4*)(nw + c0 + 4);
                float t[8];
#pragma unroll
                for (int e2 = 0; e2 < 8; ++e2) t[e2] = bf2f((bf16_t)v[u][e2]) * r * (e2 < 4 ? w0[e2] : w1[e2 - 4]);
                *(bf16x8*)(mix + row * 3072 + 1024 + c0) = pack8(t); } }
    }
}
__device__ __forceinline__ void phase_ln(CPARAMS& p, const float* gw, const float* bw, bf16_t* yb, const bool dry = false) {
    int tid_ = threadIdx.x; asm volatile("" : "+v"(tid_));
    const int wid = tid_ >> 6, lane = tid_ & 63;
    float* y = p.out + O_Y;
    for (int row = blockIdx.x * 8 + wid; row < MALL; row += gridDim.x * 8) {
        float* rp = y + (size_t)row * DM;
        f32x4 v[8]; float s = 0.f;
#pragma unroll
        for (int j = 0; j < 8; ++j) { v[j] = *(const f32x4*)(rp + j * 256 + lane * 4); s += v[j][0] + v[j][1] + v[j][2] + v[j][3]; }
        const float mu = wave_sum(s) * (1.f / DM);
        float q = 0.f;
#pragma unroll
        for (int j = 0; j < 8; ++j) { v[j] = v[j] - mu; q += v[j][0] * v[j][0] + v[j][1] * v[j][1] + v[j][2] * v[j][2] + v[j][3] * v[j][3]; }
        const float rs = rsqrtf(wave_sum(q) * (1.f / DM) + EPSV);
#pragma unroll
        for (int j = 0; j < 8; ++j) { const int c = j * 256 + lane * 4; const f32x4 gg = *(const f32x4*)(gw + c), bb = *(const f32x4*)(bw + c);
            const f32x4 o = v[j] * rs * gg + bb; if (!dry) { *(f32x4*)(rp + c) = o; if (yb) *(u32x2*)(yb + (size_t)row * DM + c) = pack4(o); } else if (o[0] == 1.2345e30f) rp[c] = 0.f; }
    }
}
__device__ __forceinline__ void phase_post1(CPARAMS& p) {
    const int tidp = opaque_tid(); const int wid = tidp >> 6, lane = tidp & 63;
    const float* cqkv = (const float*)(p.ws + W_CQKV); bf16_t* cqn = (bf16_t*)(p.ws + W_CQN); bf16_t* lat = (bf16_t*)(p.ws + W_LAT); bf16_t* krb = (bf16_t*)(p.ws + W_KR);
    const float2* tab = (const float2*)(p.ws + W_ROPE);
    for (int row = blockIdx.x * 8 + wid; row < MALL; row += gridDim.x * 8) {
        const float* rp = cqkv + (size_t)row * 1088;
        const f32x4 a0 = *(const f32x4*)(rp + lane * 8), a1 = *(const f32x4*)(rp + lane * 8 + 4), c0 = *(const f32x4*)(rp + 512 + lane * 8), c1 = *(const f32x4*)(rp + 512 + lane * 8 + 4);
        const float kv = rp[1024 + lane];
        float sa = 0.f, sc = 0.f;
#pragma unroll
        for (int e = 0; e < 4; ++e) { sa += a0[e] * a0[e] + a1[e] * a1[e]; sc += c0[e] * c0[e] + c1[e] * c1[e]; }
        const float ra = rsqrtf(wave_sum(sa) * (1.f / 512.f) + EPSV), rc = rsqrtf(wave_sum(sc) * (1.f / 512.f) + EPSV);
        const f32x4 qw0 = *(const f32x4*)(p.in[I_QNW] + lane * 8), qw1 = *(const f32x4*)(p.in[I_QNW] + lane * 8 + 4), kw0 = *(const f32x4*)(p.in[I_KVNW] + lane * 8), kw1 = *(const f32x4*)(p.in[I_KVNW] + lane * 8 + 4);
        const f32x4 qa = a0 * ra * qw0, qb = a1 * ra * qw1, la = c0 * rc * kw0, lb = c1 * rc * kw1;
        { const float t[8] = {qa[0], qa[1], qa[2], qa[3], qb[0], qb[1], qb[2], qb[3]}; *(bf16x8*)(cqn + (size_t)row * 512 + lane * 8) = pack8(t); }
        const int lr = latrow_of(row);
        { const float t[8] = {la[0], la[1], la[2], la[3], lb[0], lb[1], lb[2], lb[3]}; *(bf16x8*)(lat + (size_t)lr * 512 + lane * 8) = pack8(t); }
        float* clo = row < NP ? p.out + O_CLP + (size_t)row * 512 : p.out + O_CLS + (size_t)(row - NP) * 512;
        *(f32x4*)(clo + lane * 8) = la; *(f32x4*)(clo + lane * 8 + 4) = lb;
        const float other = __shfl_xor(kv, 32);
        const int i = lane & 31, pos = pos_of(row); const float2 cs = tab[(size_t)pos * 32 + i];
        const float o = lane < 32 ? kv * cs.x - other * cs.y : other * cs.y + kv * cs.x;
        float* cko = row < NP ? p.out + O_CKP + (size_t)row * 64 : p.out + O_CKS + (size_t)(row - NP) * 64;
        cko[lane] = o;
        krb[(size_t)lr * 64 + 4 * (i >> 1) + (i & 1) + (lane >= 32 ? 2 : 0)] = f2bf(o);
    }
    const size_t gtid = (size_t)blockIdx.x * 512 + tidp, gstride = (size_t)gridDim.x * 512;
    { const size_t n8 = (size_t)8 * PAST * 512 / 8;
      for (size_t i = gtid; i < n8; i += gstride) { const size_t e = i * 8, b = e / ((size_t)PAST * 512), rem = e % ((size_t)PAST * 512); const float* s = p.in[I_CLAT] + e;
        const f32x4 a = *(const f32x4*)s, c = *(const f32x4*)(s + 4); const float t[8] = {a[0], a[1], a[2], a[3], c[0], c[1], c[2], c[3]};
        *(bf16x8*)(lat + ((size_t)NP + b * LS) * 512 + rem) = pack8(t); } }
    { const size_t n = (size_t)8 * PAST * 64;
      for (size_t e = gtid; e < n; e += gstride) { const size_t b = e / ((size_t)PAST * 64), rem = e % ((size_t)PAST * 64), t = rem >> 6; const int j = (int)(rem & 63), i = j & 31;
        krb[((size_t)NP + b * LS + t) * 64 + 4 * (i >> 1) + (i & 1) + (j >= 32 ? 2 : 0)] = f2bf(p.in[I_CKR][e]); } }
}

__device__ __forceinline__ CPARAMS& get_params() {
    const unsigned long long v = (unsigned long long)__builtin_amdgcn_kernarg_segment_ptr(); unsigned lo = (unsigned)v, hi = (unsigned)(v >> 32);
    asm volatile("" : "+s"(lo), "+s"(hi));
    lo = __builtin_amdgcn_readfirstlane(lo); hi = __builtin_amdgcn_readfirstlane(hi);
    return *(CPARAMS*)(((unsigned long long)hi << 32) | lo);
}
#ifndef PROBE_STOP
#define PROBE_STOP 0
#endif
__device__ __forceinline__ void phase_dump(CPARAMS& p) {
    const unsigned short* w = (const unsigned short*)p.ws; float* y = p.out + O_Y; const size_t n = (size_t)MALL * DM;
#ifdef PROBE_THRASH
    { const f32x4* xs = (const f32x4*)p.in[I_XP] + (size_t)((blockIdx.x >> 3) & 31) * (NP * (size_t)DM / 4 / 32); f32x4 a = {0.f, 0.f, 0.f, 0.f};
      for (size_t i = threadIdx.x; i < NP * (size_t)DM / 4 / 32; i += 512) a += xs[i];
      if (a[0] + a[1] + a[2] + a[3] == 1.2345e30f) y[0] = 1.f;
      __syncthreads(); __threadfence(); }
    cg::this_grid().sync(); __threadfence();
#endif
    for (size_t i = (size_t)blockIdx.x * 512 + threadIdx.x; i < n; i += (size_t)gridDim.x * 512) {
        unsigned h = 0x12345u;
#pragma unroll
        for (int r = 0; r < 8; ++r) { const size_t o = (size_t)r * n + i; const unsigned v = (o * 2 < W_END) ? w[o] : 0u; h = (h ^ v) * 0x9E3779B1u; }
        h ^= h >> 15; y[i] = (float)((h >> 8) & 127u);
    }
}
#define PROBE_AT(k) do { if (PROBE_STOP == (k)) { CPARAMS& pq = get_params(); phase_dump(pq); return; } } while (0)
__global__ void __launch_bounds__(512) fwd_megakernel(Params p_unused) {
    extern __shared__ __attribute__((aligned(16))) char lds[];
    cg::grid_group grid = cg::this_grid();
#ifndef TIME_X2
#define TIME_X2 0
#endif
    const bool dryflag = get_params().ws != nullptr;
    unsigned nbar = 0;
#define GSYNC_CG() do { __builtin_amdgcn_fence(__ATOMIC_RELEASE, "agent"); asm volatile("s_waitcnt vmcnt(0)" ::: "memory"); grid.sync(); __builtin_amdgcn_fence(__ATOMIC_ACQUIRE, "agent"); } while (0)
#define GSYNC() do { ++nbar; asm volatile("s_waitcnt vmcnt(0)" ::: "memory"); __syncthreads(); \
        if (threadIdx.x == 0) { unsigned* ctr_ = (unsigned*)(get_params().ws + W_BAR); const unsigned tgt_ = nbar * gridDim.x; \
            __builtin_amdgcn_fence(__ATOMIC_RELEASE, "agent"); asm volatile("s_waitcnt vmcnt(0)" ::: "memory"); \
            __hip_atomic_fetch_add(ctr_, 1u, __ATOMIC_RELAXED, __HIP_MEMORY_SCOPE_AGENT); \
            while (__hip_atomic_load(ctr_, __ATOMIC_RELAXED, __HIP_MEMORY_SCOPE_AGENT) < tgt_) __builtin_amdgcn_s_sleep(1); \
            __builtin_amdgcn_fence(__ATOMIC_ACQUIRE, "agent"); asm volatile("s_waitcnt vmcnt(0)" ::: "memory"); } \
        __syncthreads(); } while (0)
    if (TIME_X2 == 1) { CPARAMS& p = get_params(); phase_prep(p, lds); __syncthreads(); }
    { CPARAMS& p = get_params(); phase_prep(p, lds); }
    if (__builtin_expect(get_params().ws == nullptr, 0)) GSYNC_CG();
    GSYNC();
    PROBE_AT(1);
    if (TIME_X2 == 2)
    { CPARAMS& p = get_params(); pg8::Gemm g; g.A = (const bf16_t*)(p.ws + W_XB); g.Bt = (const bf16_t*)(p.ws + W_BT0); g.M = MALL; g.N = NIN0P; g.K = DM; g.lda = DM;
      pg8::StaticOrder S; S.init(MALL, NIN0P, (int)gridDim.x, (int)blockIdx.x); EpiInProj0 E{p.ws, p.out, p.in[I_DTB]};
      pg8::gemm_phase<EpiInProj0, pg8::StaticOrder>((PG8_LAS unsigned char*)lds, g, S, E); }
    { CPARAMS& p = get_params(); pg8::Gemm g; g.A = (const bf16_t*)(p.ws + W_XB); g.Bt = (const bf16_t*)(p.ws + W_BT0); g.M = MALL; g.N = NIN0P; g.K = DM; g.lda = DM;
      pg8::StaticOrder S; S.init(MALL, NIN0P, (int)gridDim.x, (int)blockIdx.x); EpiInProj0 E{p.ws, p.out, p.in[I_DTB]};
      pg8::gemm_phase<EpiInProj0, pg8::StaticOrder>((PG8_LAS unsigned char*)lds, g, S, E); }
    GSYNC();
    PROBE_AT(2);
    if (TIME_X2 == 3) { CPARAMS& p = get_params(); phase_index(p, lds); }
    if (TIME_X2 == 12) { CPARAMS& p = get_params(); phase_conv(p); }
    { CPARAMS& p = get_params(); phase_conv(p); }
    { CPARAMS& p = get_params(); phase_index(p, lds); }
    GSYNC();
    PROBE_AT(3);
    if (TIME_X2 == 4) { CPARAMS& p = get_params(); phase_attn_dsa(p, lds, dryflag); }
    if (TIME_X2 == 5) { CPARAMS& p = get_params(); phase_ssd(p, lds, dryflag); }
#ifndef PROBE_SKIP_DSA
    { CPARAMS& p = get_params(); phase_attn_dsa(p, lds); }
#endif
#ifndef PROBE_SKIP_SSD
    { CPARAMS& p = get_params(); phase_ssd(p, lds); }
#endif
    GSYNC();
    PROBE_AT(4);
    { CPARAMS& p = get_params(); phase_bnorm(p); }
    GSYNC();
    PROBE_AT(5);
    if (TIME_X2 == 6)
    { CPARAMS& p = get_params(); FResid f{p.in[I_XP], p.in[I_XS], p.out + O_Y}; run_gemm(lds, (const bf16_t*)(p.ws + W_MIX), 3072, (const bf16_t*)(p.ws + W_BTOUT0), MALL, DM, 3072, f); }
    { CPARAMS& p = get_params(); FResid f{p.in[I_XP], p.in[I_XS], p.out + O_Y}; run_gemm(lds, (const bf16_t*)(p.ws + W_MIX), 3072, (const bf16_t*)(p.ws + W_BTOUT0), MALL, DM, 3072, f); }
    GSYNC();
    PROBE_AT(6);
    if (TIME_X2 == 7) { CPARAMS& p = get_params(); phase_ln(p, p.in[I_LN0G], p.in[I_LN0B], (bf16_t*)(p.ws + W_XB), dryflag); }
    { CPARAMS& p = get_params(); phase_ln(p, p.in[I_LN0G], p.in[I_LN0B], (bf16_t*)(p.ws + W_XB)); }
    GSYNC();
    PROBE_AT(7);
    if (TIME_X2 == 8)
    { CPARAMS& p = get_params(); FInProj1 f{p.ws}; run_gemm(lds, (const bf16_t*)(p.ws + W_XB), DM, (const bf16_t*)(p.ws + W_BT1), MALL, NIN1P, DM, f); }
    { CPARAMS& p = get_params(); FInProj1 f{p.ws}; run_gemm(lds, (const bf16_t*)(p.ws + W_XB), DM, (const bf16_t*)(p.ws + W_BT1), MALL, NIN1P, DM, f); }
    GSYNC();
    PROBE_AT(8);
    if (TIME_X2 == 9) { CPARAMS& p = get_params(); phase_post1(p); }
    { CPARAMS& p = get_params(); phase_post1(p); }
    GSYNC();
    PROBE_AT(9);
    if (TIME_X2 == 10)
    { CPARAMS& p = get_params(); FQUp f{p.ws}; run_gemm(lds, (const bf16_t*)(p.ws + W_CQN), 512, (const bf16_t*)(p.ws + W_BTUQ), MALL, 3072, 512, f); }
    { CPARAMS& p = get_params(); FQUp f{p.ws}; run_gemm(lds, (const bf16_t*)(p.ws + W_CQN), 512, (const bf16_t*)(p.ws + W_BTUQ), MALL, 3072, 512, f); }
    { CPARAMS& p = get_params(); FKvUp f{p.ws}; run_gemm(lds, (const bf16_t*)(p.ws + W_LAT), 512, (const bf16_t*)(p.ws + W_BTUKV), LATROWS, 4096, 512, f, true); }
    GSYNC();
    PROBE_AT(10);
    if (TIME_X2 == 11) { CPARAMS& p = get_params(); phase_attn_mla(p, lds, dryflag); }
    { CPARAMS& p = get_params(); phase_attn_mla(p, lds); }
    GSYNC();
    PROBE_AT(11);
    { CPARAMS& p = get_params(); FResid f{p.out + O_Y, p.out + O_Y + (size_t)NP * DM, p.out + O_Y}; run_gemm(lds, (const bf16_t*)(p.ws + W_Q2), 3072, (const bf16_t*)(p.ws + W_BTOUT1), MALL, DM, DM, f); }
    GSYNC();
    PROBE_AT(12);
    { CPARAMS& p = get_params(); phase_ln(p, p.in[I_LN1G], p.in[I_LN1B], nullptr); }
}

extern "C" void kernel_launch(void* const* d_in, const int* in_sizes, int n_in, void* d_out, int out_size, void* d_ws, size_t ws_size, hipStream_t stream) {
    static int grid_blocks = 0;
    if (!grid_blocks) {
        if (n_in != N_IN || (size_t)out_size != O_END || ws_size < W_END) { fprintf(stderr, "kernel_launch: unexpected shapes n_in %d out %d ws %zu\n", n_in, out_size, ws_size); return; }
        if (hipFuncSetAttribute((const void*)fwd_megakernel, hipFuncAttributeMaxDynamicSharedMemorySize, LDS_BYTES) != hipSuccess) { fprintf(stderr, "kernel_launch: LDS attribute failed\n"); return; }
        int dev = 0, cus = 0, per_cu = 0;
        hipGetDevice(&dev); hipDeviceGetAttribute(&cus, hipDeviceAttributeMultiprocessorCount, dev);
        hipOccupancyMaxActiveBlocksPerMultiprocessor(&per_cu, fwd_megakernel, 512, LDS_BYTES);
        if (per_cu < 1) { fprintf(stderr, "kernel_launch: occupancy 0\n"); return; }
        grid_blocks = cus;
    }
    if (hipMemsetAsync((char*)d_ws + W_BAR, 0, 256, stream) != hipSuccess) { fprintf(stderr, "kernel_launch: memset failed\n"); return; }
    Params p{};
    for (int i = 0; i < N_IN; ++i) p.in[i] = (const float*)d_in[i];
    p.out = (float*)d_out; p.ws = (char*)d_ws;
    void* args[] = {&p};
    hipError_t e = hipLaunchCooperativeKernel((const void*)fwd_megakernel, dim3(grid_blocks), dim3(512), args, LDS_BYTES, stream);
    if (e != hipSuccess) fprintf(stderr, "cooperative launch failed: %s (grid %d)\n", hipGetErrorString(e), grid_blocks);
}
```

```cpp
#include <hip/hip_runtime.h>
#include <hip/hip_cooperative_groups.h>
#include <cstdio>
#include <cstdint>
namespace cg = cooperative_groups;

#define LAS __attribute__((address_space(3)))
typedef unsigned short bf16_t;
typedef short bf16x8 __attribute__((ext_vector_type(8)));
typedef short s16x4 __attribute__((ext_vector_type(4)));
typedef float f32x4 __attribute__((ext_vector_type(4)));
typedef float f32x8 __attribute__((ext_vector_type(8)));
typedef float f32x16 __attribute__((ext_vector_type(16)));
typedef unsigned u32x4 __attribute__((ext_vector_type(4)));
typedef unsigned u32x2 __attribute__((ext_vector_type(2)));
typedef unsigned long long u64;

constexpr int DM = 2048, NP = 32768, NS = 512, MALL = NP + NS  , TP = 4096, TS = 64, PAST = 1024, LS = PAST + TS  ;
constexpr int NIN0 = 10352, NIN0P = 10496, NIN1 = 3136, NIN1P = 3328;
constexpr int LATROWS = NP + 8 * LS;
constexpr float ALPHA_RES = 1.4142135623730951f;
constexpr float LOG2E = 1.4426950408889634f;
constexpr float EPSV = 1e-5f;

enum { I_XP = 0, I_XS, I_CAK, I_CAV, I_CAKI, I_SCONV, I_SSSM, I_CLAT, I_CKR, I_T5, I_WIN0, I_WOUT0, I_CONVW, I_CONVB, I_DTB, I_ALOG, I_DSKIP,
       I_SNORM, I_LN0G, I_LN0B, I_WIN1, I_QNW, I_KVNW, I_WUQ, I_WUKV, I_WOUT1, I_LN1G, I_LN1B, N_IN };

constexpr size_t O_Y = 0;
constexpr size_t O_AKP = (size_t)MALL * DM;
constexpr size_t O_AKS = O_AKP + (size_t)NP * 1024;
constexpr size_t O_AVP = O_AKS + (size_t)NS * 1024;
constexpr size_t O_AVS = O_AVP + (size_t)NP * 1024;
constexpr size_t O_KIP = O_AVS + (size_t)NS * 1024;
constexpr size_t O_KIS = O_KIP + (size_t)NP * 64;
constexpr size_t O_BCP = O_KIS + (size_t)NS * 64;
constexpr size_t O_BCS = O_BCP + (size_t)8 * 3 * 3072;
constexpr size_t O_BSP = O_BCS + (size_t)8 * 3 * 3072;
constexpr size_t O_BSS = O_BSP + (size_t)8 * 32 * 64 * 128;
constexpr size_t O_CLP = O_BSS + (size_t)8 * 32 * 64 * 128;
constexpr size_t O_CLS = O_CLP + (size_t)NP * 512;
constexpr size_t O_CKP = O_CLS + (size_t)NS * 512;
constexpr size_t O_CKS = O_CKP + (size_t)NP * 64;
constexpr size_t O_END = O_CKS + (size_t)NS * 64;

constexpr size_t MiB = 1ull << 20;
constexpr size_t W_BT0 = 0;
constexpr size_t W_BTOUT0 = 41 * MiB;
constexpr size_t W_BT1 = 53 * MiB;
constexpr size_t W_BTUQ = 66 * MiB;
constexpr size_t W_BTUKV = 69 * MiB;
constexpr size_t W_BTOUT1 = 73 * MiB;
constexpr size_t W_ROPE = 81 * MiB;
constexpr size_t W_KIDXP = 82 * MiB;
constexpr size_t W_KIDXS = 86 * MiB;
constexpr size_t W_IW = 88 * MiB;
constexpr size_t W_DT = 91 * MiB;
constexpr size_t W_MASKP = 96 * MiB;
constexpr size_t W_MASKS = 112 * MiB;
constexpr size_t W_SSQ = 113 * MiB;
constexpr size_t W_BAR = 118 * MiB;
constexpr size_t W_XB = 120 * MiB;
constexpr size_t W_MIX = 250 * MiB;
constexpr size_t W_KP = 445 * MiB;
constexpr size_t W_KS = 509 * MiB;
constexpr size_t W_VP = 526 * MiB;
constexpr size_t W_VS = 590 * MiB;
constexpr size_t W_SG = 607 * MiB;
constexpr size_t W_IQ = 672 * MiB;
constexpr size_t W_XBC = 737 * MiB;
constexpr size_t W_KVALL = 120 * MiB;
constexpr size_t W_CQKV = 445 * MiB;
constexpr size_t W_CQN = 584 * MiB;
constexpr size_t W_LAT = 617 * MiB;
constexpr size_t W_KR = 658 * MiB;
constexpr size_t W_Q2 = 664 * MiB;
constexpr size_t W_SGATE = 860 * MiB;
constexpr size_t W_XACT = W_XB;
constexpr size_t W_BCACT = 932 * MiB;
constexpr size_t W_END = 997 * MiB;

struct Params { const float* in[N_IN]; float* out; char* ws; };
#define CPARAMS const __attribute__((address_space(4))) Params

constexpr int LDS_BYTES = 131072 + 32768;
#define KRSWZ(row, colB) ((row) * 128 + ((colB) ^ ((((row) >> 1) & 7) << 4)))

typedef __bf16 bf16x2_t __attribute__((ext_vector_type(2)));
typedef float f32x2_t __attribute__((ext_vector_type(2)));
__device__ __forceinline__ unsigned cvtpk(float lo, float hi) { const f32x2_t v = {lo, hi}; const bf16x2_t r = __builtin_convertvector(v, bf16x2_t); return __builtin_bit_cast(unsigned, r); }
__device__ __forceinline__ bf16_t f2bf(float f) { return (bf16_t)(cvtpk(f, f) & 0xffffu); }
__device__ __forceinline__ float bf2f(bf16_t b) { return __uint_as_float(((unsigned)b) << 16); }
__device__ __forceinline__ float silu_f(float v) { return v / (1.f + __expf(-v)); }
__device__ __forceinline__ bf16x8 pack8(const float* x) { u32x4 w = {cvtpk(x[0], x[1]), cvtpk(x[2], x[3]), cvtpk(x[4], x[5]), cvtpk(x[6], x[7])}; return *reinterpret_cast<bf16x8*>(&w); }
__device__ __forceinline__ u32x2 pack4(f32x4 v) { u32x2 w = {cvtpk(v[0], v[1]), cvtpk(v[2], v[3])}; return w; }
__device__ __forceinline__ float wave_sum(float v) {
#pragma unroll
  for (int o = 32; o > 0; o >>= 1) v += __shfl_xor(v, o);
  return v;
}
__device__ __forceinline__ int wave_sum_i(int v) {
#pragma unroll
  for (int o = 32; o > 0; o >>= 1) v += __shfl_xor(v, o);
  return v;
}
__device__ __forceinline__ float row16_sum(float v) {
    v += __builtin_bit_cast(float, __builtin_amdgcn_update_dpp(0, __builtin_bit_cast(int, v), 0xB1, 0xf, 0xf, true));
    v += __builtin_bit_cast(float, __builtin_amdgcn_update_dpp(0, __builtin_bit_cast(int, v), 0x4E, 0xf, 0xf, true));
    v += __builtin_bit_cast(float, __builtin_amdgcn_update_dpp(0, __builtin_bit_cast(int, v), 0x141, 0xf, 0xf, true));
    v += __builtin_bit_cast(float, __builtin_amdgcn_update_dpp(0, __builtin_bit_cast(int, v), 0x140, 0xf, 0xf, true));
    return v;
}
__device__ __forceinline__ float wave_scan_incl(float v, int lane) {
    v += __builtin_bit_cast(float, __builtin_amdgcn_update_dpp(0, __builtin_bit_cast(int, v), 0x111, 0xf, 0xf, false));
    v += __builtin_bit_cast(float, __builtin_amdgcn_update_dpp(0, __builtin_bit_cast(int, v), 0x112, 0xf, 0xf, false));
    v += __builtin_bit_cast(float, __builtin_amdgcn_update_dpp(0, __builtin_bit_cast(int, v), 0x114, 0xf, 0xf, false));
    v += __builtin_bit_cast(float, __builtin_amdgcn_update_dpp(0, __builtin_bit_cast(int, v), 0x118, 0xf, 0xf, false));
    const float t0 = __builtin_bit_cast(float, __builtin_amdgcn_readlane(__builtin_bit_cast(int, v), 15));
    const float t1 = __builtin_bit_cast(float, __builtin_amdgcn_readlane(__builtin_bit_cast(int, v), 31));
    const float t2 = __builtin_bit_cast(float, __builtin_amdgcn_readlane(__builtin_bit_cast(int, v), 47));
    float add = 0.f; if (lane >= 16) add = t0; if (lane >= 32) add = t0 + t1; if (lane >= 48) add = (t0 + t1) + t2;
    return v + add;
}
__device__ __forceinline__ int opaque_tid() { int t = threadIdx.x; asm volatile("" : "+v"(t)); return t; }
__device__ __forceinline__ int wave_sum_dpp(int v) {
    v += __builtin_amdgcn_update_dpp(0, v, 0xB1, 0xf, 0xf, true);
    v += __builtin_amdgcn_update_dpp(0, v, 0x4E, 0xf, 0xf, true);
    v += __builtin_amdgcn_update_dpp(0, v, 0x141, 0xf, 0xf, true);
    v += __builtin_amdgcn_update_dpp(0, v, 0x140, 0xf, 0xf, true);
    return __builtin_amdgcn_readlane(v, 0) + __builtin_amdgcn_readlane(v, 16) + __builtin_amdgcn_readlane(v, 32) + __builtin_amdgcn_readlane(v, 48);
}
__device__ __forceinline__ int latrow_of(int row) { if (row < NP) return row; const int r = row - NP; return NP + (r >> 6) * LS + PAST + (r & 63); }
__device__ __forceinline__ int pos_of(int row) { return row < NP ? (row & (TP - 1)) : PAST + ((row - NP) & 63); }
namespace pg8 {
#define PG8_LAS __attribute__((address_space(3)))
constexpr int BM = 256, BK = 64, HALF = 128, HTB = HALF * BK * 2  , STAGE_BYTES = 8 * HTB, NXCD = 8, WGM = 8;

__host__ __device__ __forceinline__ int lds_byte(int r, int c) { const int st = (r >> 4) * 2 + (c >> 5), rr = r & 15, cc = c & 31, ob = rr * 64 + cc * 2; return st * 1024 + (ob ^ (((ob >> 9) & 1) << 5)); }
__host__ __device__ __forceinline__ void stage_rc(int b, int& R, int& C) { const int st = b / 1024, sb = b % 1024, swz = sb ^ (((sb >> 9) & 1) << 5); R = (st >> 1) * 16 + swz / 64; C = (st & 1) * 32 + (swz % 64) / 2; }
__host__ __device__ __forceinline__ int perm32(int rho) { const int n = rho >> 4, i = rho & 15; return 8 * (i >> 2) + 4 * n + (i & 3); }

struct Unit { int pm, pn; };
struct Gemm { const bf16_t* A; const bf16_t* Bt; int M, N, K, lda; };

struct StaticOrder {
    int nM, nN, nwg, G, c;
    __host__ __device__ void init(int M, int N, int G_, int c_) { nM = M / BM; nN = N / BM; nwg = nM * nN; G = G_; c = c_; }
    __host__ __device__ bool next(int i, Unit& u) const {
        const long L = (long)i * G + c; if (L >= nwg) return false;
        int wgid = (int)L; { const int q = nwg / NXCD, r = nwg % NXCD, xcd = wgid % NXCD, off = wgid / NXCD; wgid = (xcd < r ? xcd * (q + 1) : r * (q + 1) + (xcd - r) * q) + off; }
        const int nig = WGM * nN, gid = wgid / nig, fm = gid * WGM, gsz = (nM - fm) < WGM ? (nM - fm) : WGM;
        u.pm = fm + ((wgid % nig) % gsz); u.pn = (wgid % nig) / gsz; return true;
    }
    __device__ __forceinline__ void a_ready(const Unit&) const {}
    __device__ __forceinline__ void done(const Unit&) const {}
};

template <class Epi, class Sched>
__device__ __forceinline__ void gemm_phase(PG8_LAS unsigned char* lds, const Gemm g, const Sched& S, const Epi& E) {
    constexpr bool STAMP = false; unsigned long long* stamps = nullptr;
    int tid_ = threadIdx.x; asm volatile("" : "+v"(tid_));
    const int tid = tid_, wid = __builtin_amdgcn_readfirstlane(tid >> 6), lane = tid & 63, wr = wid >> 2, wc = wid & 3, fr = lane & 15, fq = lane >> 4;
    const int K = g.K, nt = K / BK;
    int ts_lo = 0, ts_hi = 0, nts = 0; const unsigned long long rt_entry = STAMP ? (unsigned long long)wall_clock64() : 0ull;
#define PG8_STAMP() do { if (STAMP && wid == 0 && nts < 64) { const unsigned long long _c = (unsigned long long)clock64(); \
        ts_lo = (lane == nts) ? (int)(unsigned)_c : ts_lo; ts_hi = (lane == nts) ? (int)(unsigned)(_c >> 32) : ts_hi; ++nts; } } while (0)
    PG8_STAMP();
    unsigned voffA[2], voffB[2];
#pragma unroll
    for (int i = 0; i < 2; ++i) { int R, C; stage_rc(tid * 16 + i * 8192, R, C); const int Rb = Epi::PERM ? ((R & ~31) + perm32(R & 31)) : R;
        voffA[i] = (unsigned)(R * g.lda + C) * 2u; voffB[i] = (unsigned)(Rb * K + C) * 2u; }
    const size_t kstep = (size_t)(BK * 2);
    const size_t hstep = (size_t)HALF * K * 2; const size_t hstepA = (size_t)HALF * g.lda * 2;
    const size_t tstep = 2 * hstep; const size_t tstepA = 2 * hstepA;
    const unsigned ldsw = (unsigned)wid * 1024u;
    const int aoff = lds_byte(wr * 64 + fr, fq * 8), boff = lds_byte(wc * 32 + fr, fq * 8);
#define PG8_SA(b, h) (((b) * 2 + (h)) * HTB)
#define PG8_SB(b, h) ((4 + (b) * 2 + (h)) * HTB)
#define PG8_STAGE(bufoff, gbase, voff) do { _Pragma("unroll") for (int _i = 0; _i < 2; ++_i) \
        __builtin_amdgcn_global_load_lds((const unsigned*)((const char*)(gbase) + (voff)[_i]), (PG8_LAS unsigned*)(lds + (bufoff) + ldsw + _i * 8192), 16, 0, 0); } while (0)
#define PG8_LDA(dst, b, h) do { _Pragma("unroll") for (int m = 0; m < 4; ++m) _Pragma("unroll") for (int k = 0; k < 2; ++k) dst[m][k] = *(const PG8_LAS bf16x8*)(lds + PG8_SA(b, h) + aoff + m * 2048 + k * 1024); } while (0)
#define PG8_LDB(dst, b, h) do { _Pragma("unroll") for (int n = 0; n < 2; ++n) _Pragma("unroll") for (int k = 0; k < 2; ++k) dst[n][k] = *(const PG8_LAS bf16x8*)(lds + PG8_SB(b, h) + boff + n * 2048 + k * 1024); } while (0)
#define PG8_MMA(ai, bj, At, Bt) do { __builtin_amdgcn_s_setprio(1); _Pragma("unroll") for (int m = 0; m < 4; ++m) _Pragma("unroll") for (int n = 0; n < 2; ++n) _Pragma("unroll") for (int k = 0; k < 2; ++k) \
        acc[ai][bj][m][n] = __builtin_amdgcn_mfma_f32_16x16x32_bf16(Bt[n][k], At[m][k], acc[ai][bj][m][n], 0, 0, 0); __builtin_amdgcn_s_setprio(0); } while (0)
#define PG8_WAIT_V(n) asm volatile("s_waitcnt vmcnt(" #n ")" ::: "memory")
#define PG8_WAIT_L(n) asm volatile("s_waitcnt lgkmcnt(" #n ")" ::: "memory")
#define PG8_BAR __builtin_amdgcn_s_barrier()
#define PG8_SCHED __builtin_amdgcn_sched_barrier(0)
    Unit cur, nxt; int ui = 0;
    if (!S.next(0, cur)) return;
    f32x4 acc[2][2][4][2];
#pragma unroll
    for (int a = 0; a < 2; ++a)
#pragma unroll
        for (int b = 0; b < 2; ++b)
#pragma unroll
            for (int m = 0; m < 4; ++m)
#pragma unroll
                for (int n = 0; n < 2; ++n) acc[a][b][m][n] = (f32x4){0.f, 0.f, 0.f, 0.f};
    bf16x8 At[4][2], B0[2][2], B1[2][2];
    const char* cA = (const char*)g.A + (size_t)cur.pm * tstepA; const char* cB = (const char*)g.Bt + (size_t)cur.pn * tstep;
    S.a_ready(cur);
    PG8_STAGE(PG8_SB(0, 0), cB, voffB); PG8_STAGE(PG8_SA(0, 0), cA, voffA); PG8_STAGE(PG8_SB(0, 1), cB + hstep, voffB); PG8_STAGE(PG8_SA(0, 1), cA + hstepA, voffA);
    if (wr == 1) PG8_BAR;
    PG8_WAIT_V(4); PG8_BAR;
    PG8_STAGE(PG8_SB(1, 0), cB + kstep, voffB); PG8_STAGE(PG8_SA(1, 0), cA + kstep, voffA); PG8_STAGE(PG8_SB(1, 1), cB + hstep + kstep, voffB);
    PG8_WAIT_V(6); PG8_BAR;
    PG8_STAMP();
    for (;;) {
        const bool has_next = S.next(ui + 1, nxt);
        const char* nA = has_next ? (const char*)g.A + (size_t)nxt.pm * tstepA : cA; const char* nB = has_next ? (const char*)g.Bt + (size_t)nxt.pn * tstep : cB;
        for (int t = 0; t < nt; t += 2) {
            const bool last = (t == nt - 2);
            const char* a1 = cA + (size_t)(t + 1) * kstep;
            const char* a2 = last ? nA : cA + (size_t)(t + 2) * kstep; const char* b2 = last ? nB : cB + (size_t)(t + 2) * kstep;
            const char* a3 = a2 + kstep; const char* b3 = b2 + kstep;
            if (last && has_next) S.a_ready(nxt);
            PG8_LDB(B0, 0, 0); PG8_SCHED; PG8_LDA(At, 0, 0); PG8_STAGE(PG8_SA(1, 1), a1 + hstepA, voffA);
            PG8_WAIT_L(8); PG8_BAR; PG8_WAIT_L(0); PG8_MMA(0, 0, At, B0); PG8_BAR; PG8_SCHED;
            PG8_LDB(B1, 0, 1); PG8_STAGE(PG8_SB(0, 0), b2, voffB);
            PG8_BAR; PG8_WAIT_L(0); PG8_MMA(0, 1, At, B1); PG8_BAR;
            PG8_LDA(At, 0, 1); PG8_STAGE(PG8_SA(0, 0), a2, voffA);
            PG8_BAR; PG8_WAIT_L(0); PG8_MMA(1, 0, At, B0); PG8_BAR; PG8_SCHED;
            PG8_STAGE(PG8_SB(0, 1), b2 + hstep, voffB);
            PG8_WAIT_V(6); PG8_BAR; PG8_MMA(1, 1, At, B1); PG8_BAR;
            PG8_LDB(B0, 1, 0); PG8_SCHED; PG8_LDA(At, 1, 0); PG8_STAGE(PG8_SA(0, 1), a2 + hstepA, voffA);
            PG8_WAIT_L(8); PG8_BAR; PG8_WAIT_L(0); PG8_MMA(0, 0, At, B0); PG8_BAR; PG8_SCHED;
            PG8_LDB(B1, 1, 1); PG8_STAGE(PG8_SB(1, 0), b3, voffB);
            PG8_BAR; PG8_WAIT_L(0); PG8_MMA(0, 1, At, B1); PG8_BAR;
            PG8_LDA(At, 1, 1); PG8_STAGE(PG8_SA(1, 0), a3, voffA);
            PG8_BAR; PG8_WAIT_L(0); PG8_MMA(1, 0, At, B0); PG8_BAR; PG8_SCHED;
            PG8_STAGE(PG8_SB(1, 1), b3 + hstep, voffB);
            PG8_WAIT_V(6); PG8_BAR; PG8_MMA(1, 1, At, B1); PG8_BAR;
        }
        PG8_STAMP();
        if constexpr (!Epi::AFTER_DRAIN) { E(acc, cur, wr, wc, fr, fq); S.done(cur); }
        PG8_STAMP();
        if (!has_next) break;
#pragma unroll
        for (int a = 0; a < 2; ++a)
#pragma unroll
            for (int b = 0; b < 2; ++b)
#pragma unroll
                for (int m = 0; m < 4; ++m)
#pragma unroll
                    for (int n = 0; n < 2; ++n) acc[a][b][m][n] = (f32x4){0.f, 0.f, 0.f, 0.f};
        cur = nxt; cA = nA; cB = nB; ++ui;
    }
    PG8_WAIT_V(0);
    if (wr == 0) PG8_BAR;
    PG8_BAR;
    if constexpr (Epi::AFTER_DRAIN) { E.fused(acc, cur, wr, wc, fr, fq, lds, wid, lane); S.done(cur); }
    PG8_STAMP();
    if (STAMP && wid == 0) { stamps[lane] = lane < nts ? (((unsigned long long)(unsigned)ts_hi << 32) | (unsigned)ts_lo) : 0ull;
        if (lane == 62) stamps[62] = rt_entry; if (lane == 63) stamps[63] = (unsigned long long)wall_clock64(); }
#undef PG8_STAMP
#undef PG8_SA
#undef PG8_SB
#undef PG8_STAGE
#undef PG8_LDA
#undef PG8_LDB
#undef PG8_MMA
#undef PG8_WAIT_V
#undef PG8_WAIT_L
#undef PG8_BAR
#undef PG8_SCHED
}
}


template <class F> struct EpiGen {
    static constexpr bool PERM = false, AFTER_DRAIN = false;
    F f;
    __device__ __forceinline__ void operator()(const f32x4 (&acc)[2][2][4][2], const pg8::Unit& u, int wr, int wc, int fr, int fq) const {
        int row0 = u.pm * 256 + wr * 64 + fr, col0 = u.pn * 256 + wc * 32 + 4 * fq;
        asm volatile("" : "+v"(row0), "+v"(col0));
#pragma unroll
        for (int ai = 0; ai < 2; ++ai)
#pragma unroll
            for (int m = 0; m < 4; ++m) {
                const int row = row0 + ai * 128 + m * 16;
#pragma unroll
                for (int bj = 0; bj < 2; ++bj)
#pragma unroll
                    for (int n = 0; n < 2; ++n) f(row, col0 + bj * 128 + n * 16, acc[ai][bj][m][n], u.pn);
            }
    }
};

#define EPI_ITER(...) do { int row0_ = row0, col0_ = col0; asm volatile("" : "+v"(row0_), "+v"(col0_)); _Pragma("unroll") for (int ai = 0; ai < 2; ++ai) _Pragma("unroll") for (int m = 0; m < 4; ++m) { const int row = row0_ + ai * 128 + m * 16; \
    _Pragma("unroll") for (int bj = 0; bj < 2; ++bj) _Pragma("unroll") for (int n = 0; n < 2; ++n) { const int col = col0_ + bj * 128 + n * 16; const f32x4 v = acc[ai][bj][m][n]; __VA_ARGS__ } } } while (0)
struct EpiInProj0 {
    static constexpr bool PERM = false, AFTER_DRAIN = false;
    char* ws; float* out; const float* dtb;
    __device__ __forceinline__ void operator()(const f32x4 (&acc)[2][2][4][2], const pg8::Unit& u, int wr, int wc, int fr, int fq) const {
        int row0 = u.pm * 256 + wr * 64 + fr, col0 = u.pn * 256 + wc * 32 + 4 * fq; const int pn = u.pn;
        asm volatile("" : "+v"(row0), "+v"(col0));
        if (pn < 4) {
            EPI_ITER({ *(u32x2*)((bf16_t*)(ws + W_MIX) + (size_t)row * 3072 + col) = pack4(v); });
        } else if (pn < 12) {
            const bool isv = pn >= 8; const int cs = isv ? 2048 : 1024;
            bf16_t* kp = (bf16_t*)(ws + (isv ? W_VP : W_KP)); bf16_t* ks = (bf16_t*)(ws + (isv ? W_VS : W_KS)); float* op = out + (isv ? O_AVP : O_AKP); float* os = out + (isv ? O_AVS : O_AKS);
            EPI_ITER({ const int c = col - cs; bf16_t* kb; float* o;
                if (row < NP) { kb = kp + (size_t)row * 1024 + c; o = op + (size_t)row * 1024 + c; }
                else { const int r = row - NP; kb = ks + ((size_t)(r >> 6) * LS + PAST + (r & 63)) * 1024 + c; o = os + (size_t)r * 1024 + c; }
                *(u32x2*)kb = pack4(v); *(f32x4*)o = v; });
        } else if (pn < 16) {
            EPI_ITER({ f32x4 s = {silu_f(v[0]), silu_f(v[1]), silu_f(v[2]), silu_f(v[3])}; *(u32x2*)((bf16_t*)(ws + W_SG) + (size_t)row * 1024 + (col - 3072)) = pack4(s); });
        } else if (pn < 20) {
            EPI_ITER({ *(u32x2*)((bf16_t*)(ws + W_IQ) + (size_t)row * 1024 + (col - 4096)) = pack4(v); });
        } else if (pn < 28) {
            EPI_ITER({ f32x4 s = {silu_f(v[0]), silu_f(v[1]), silu_f(v[2]), silu_f(v[3])}; *(u32x2*)((bf16_t*)(ws + W_MIX) + (size_t)row * 3072 + 1024 + (col - 5120)) = pack4(s); });
        } else if (pn < 40) {
            EPI_ITER({ const int c = col - 7168;
                *(u32x2*)((bf16_t*)(ws + W_XBC) + (size_t)row * 3072 + c) = pack4(v);
                if (row < NP) { const int t = row & (TP - 1); if (t >= TP - 3) *(f32x4*)(out + O_BCP + ((size_t)(row >> 12) * 3 + (t - (TP - 3))) * 3072 + c) = v; }
                else { const int r = row - NP, t = r & 63; if (t >= TS - 3) *(f32x4*)(out + O_BCS + ((size_t)(r >> 6) * 3 + (t - (TS - 3))) * 3072 + c) = v; } });
        } else {
            int r0 = row0, c0 = col0; asm volatile("" : "+v"(r0), "+v"(c0));
#pragma unroll
            for (int n = 0; n < 2; ++n) {
                const int c = c0 - 10240 + n * 16;
                if (c < 64) {
#pragma unroll
                    for (int ai = 0; ai < 2; ++ai)
#pragma unroll
                        for (int m = 0; m < 4; ++m) { const int row = r0 + ai * 128 + m * 16; const f32x4 v = acc[ai][0][m][n]; bf16_t* kb; float* o;
                            if (row < NP) { kb = (bf16_t*)(ws + W_KIDXP) + (size_t)row * 64 + c; o = out + O_KIP + (size_t)row * 64 + c; }
                            else { const int r = row - NP; kb = (bf16_t*)(ws + W_KIDXS) + ((size_t)(r >> 6) * LS + PAST + (r & 63)) * 64 + c; o = out + O_KIS + (size_t)r * 64 + c; }
                            *(u32x2*)kb = pack4(v); *(f32x4*)o = v; }
                } else if (c < 80) {
#pragma unroll
                    for (int ai = 0; ai < 2; ++ai)
#pragma unroll
                        for (int m = 0; m < 4; ++m) { const int row = r0 + ai * 128 + m * 16; *(f32x4*)((float*)(ws + W_IW) + (size_t)row * 16 + (c - 64)) = acc[ai][0][m][n] * 0.03125f; }
                } else if (c < 112) {
                    const f32x4 db = *(const f32x4*)(dtb + (c - 80));
#pragma unroll
                    for (int ai = 0; ai < 2; ++ai)
#pragma unroll
                        for (int m = 0; m < 4; ++m) { const int row = r0 + ai * 128 + m * 16; const f32x4 v = acc[ai][0][m][n] + db; f32x4 d;
#pragma unroll
                            for (int j = 0; j < 4; ++j) d[j] = v[j] > 20.f ? v[j] : log1pf(__expf(v[j]));
                            *(f32x4*)((float*)(ws + W_DT) + (size_t)row * 32 + (c - 80)) = d; }
                }
            }
        }
    }
};

struct FResid {
    const float* r0; const float* r1; float* y;
    __device__ __forceinline__ void operator()(int row, int col, f32x4 v, int) const {
        const float* rp = row < NP ? r0 + (size_t)row * DM + col : r1 + (size_t)(row - NP) * DM + col;
        const f32x4 x = *(const f32x4*)rp;
        *(f32x4*)(y + (size_t)row * DM + col) = v + x * ALPHA_RES;
    }
};

struct FInProj1 {
    char* ws;
    __device__ __forceinline__ void operator()(int row, int col, f32x4 v, int pn) const {
        if (pn < 4) *(f32x4*)((float*)(ws + W_CQKV) + (size_t)row * 1088 + col) = v;
        else if (pn < 12) { f32x4 s = {silu_f(v[0]), silu_f(v[1]), silu_f(v[2]), silu_f(v[3])}; *(u32x2*)((bf16_t*)(ws + W_SGATE) + (size_t)row * 2048 + (col - 1024)) = pack4(s); }
        else { const int c = col - 3072; if (c < 64) *(f32x4*)((float*)(ws + W_CQKV) + (size_t)row * 1088 + 1024 + c) = v; }
    }
};

struct FQUp {
    char* ws;
    __device__ __forceinline__ void operator()(int row, int col, f32x4 v, int pn) const {
        if (pn >= 8) {
            const int jj = (col - 2048) & 63, i0 = (jj >> 2) * 2, pos = pos_of(row);
            const float2* tab = (const float2*)(ws + W_ROPE) + (size_t)pos * 32 + i0;
            const float2 c0 = tab[0], c1 = tab[1];
            f32x4 o; o[0] = v[0] * c0.x - v[2] * c0.y; o[2] = v[0] * c0.y + v[2] * c0.x; o[1] = v[1] * c1.x - v[3] * c1.y; o[3] = v[1] * c1.y + v[3] * c1.x; v = o;
        }
        *(u32x2*)((bf16_t*)(ws + W_Q2) + (size_t)row * 3072 + col) = pack4(v);
    }
};
struct FKvUp { char* ws; __device__ __forceinline__ void operator()(int row, int col, f32x4 v, int) const { *(u32x2*)((bf16_t*)(ws + W_KVALL) + (size_t)row * 4096 + col) = pack4(v); } };

template <class F> __device__ __forceinline__ void run_gemm(char* lds, const bf16_t* A, int lda, const bf16_t* Bt, int M, int N, int K, const F& f, const bool rev = false) {
    pg8::Gemm g; g.A = A; g.Bt = Bt; g.M = M; g.N = N; g.K = K; g.lda = lda;
    pg8::StaticOrder S; S.init(M, N, (int)gridDim.x, rev ? (int)(gridDim.x - 1 - blockIdx.x) : (int)blockIdx.x);
    EpiGen<F> E{f};
    pg8::gemm_phase<EpiGen<F>, pg8::StaticOrder>((PG8_LAS unsigned char*)lds, g, S, E);
}

__device__ __forceinline__ int orig_col(int w, int n) {
    switch (w) {
    case 0: if (n < 5120) return n; if (n < 7168) return 5200 + (n - 5120); if (n < 10240) return 7248 + (n - 7168); if (n < 10304) return 5120 + (n - 10240);
            if (n < 10320) return 5184 + (n - 10304); if (n < 10352) return n; return -1;
    case 2: if (n < 1024) return n; if (n < 3072) return 1088 + (n - 1024); if (n < 3136) return 1024 + (n - 3072); return -1;
    case 3: if (n < 2048) return (n >> 7) * 192 + (n & 127);
            { const int j = n - 2048, h = j >> 6, jj = j & 63, g4 = jj >> 2, e = jj & 3; return h * 192 + 128 + (e >> 1) * 32 + 2 * g4 + (e & 1); }
    case 4: if (n < 2048) return (n >> 7) * 256 + (n & 127); { const int j = n - 2048; return (j >> 7) * 256 + 128 + (j & 127); }
    default: return n;
    }
}
__device__ __forceinline__ void phase_prep(CPARAMS& p, char* lds) {
    const int tid = opaque_tid();
    {
        bf16_t* tile = (bf16_t*)lds;
        int base = 0;
#pragma unroll 1
        for (int w = 0; w < 6; ++w) {
            int K, N, NPd; const float* W; bf16_t* Bt;
            switch (w) {
            case 0: K = 2048; N = NIN0; NPd = NIN0P; W = p.in[I_WIN0]; Bt = (bf16_t*)(p.ws + W_BT0); break;
            case 1: K = 3072; N = 2048; NPd = 2048; W = p.in[I_WOUT0]; Bt = (bf16_t*)(p.ws + W_BTOUT0); break;
            case 2: K = 2048; N = NIN1; NPd = NIN1P; W = p.in[I_WIN1]; Bt = (bf16_t*)(p.ws + W_BT1); break;
            case 3: K = 512; N = 3072; NPd = 3072; W = p.in[I_WUQ]; Bt = (bf16_t*)(p.ws + W_BTUQ); break;
            case 4: K = 512; N = 4096; NPd = 4096; W = p.in[I_WUKV]; Bt = (bf16_t*)(p.ws + W_BTUKV); break;
            default: K = 2048; N = 2048; NPd = 2048; W = p.in[I_WOUT1]; Bt = (bf16_t*)(p.ws + W_BTOUT1); break;
            }
            const int nkt = K / 64, nnt = NPd / 64, ntiles = nkt * nnt;
            int first = (int)blockIdx.x - (base % (int)gridDim.x); if (first < 0) first += gridDim.x;
            const int nl = tid & 63;
            float cur[8];
            if (first < ntiles) { const int kt = first % nkt, nt = first / nkt, oc = orig_col(w, nt * 64 + nl);
#pragma unroll
                for (int i = 0; i < 8; ++i) { const int k = kt * 64 + i * 8 + (tid >> 6); cur[i] = oc >= 0 ? W[(size_t)k * N + oc] : 0.f; } }
#pragma unroll 1
            for (int tix = first; tix < ntiles; tix += gridDim.x) {
                const int kt = tix % nkt, nt = tix / nkt;
                float nxt[8];
                const int tix2 = tix + (int)gridDim.x;
                if (tix2 < ntiles) { const int kt2 = tix2 % nkt, nt2 = tix2 / nkt, oc2 = orig_col(w, nt2 * 64 + nl);
#pragma unroll
                    for (int i = 0; i < 8; ++i) { const int k = kt2 * 64 + i * 8 + (tid >> 6); nxt[i] = oc2 >= 0 ? W[(size_t)k * N + oc2] : 0.f; } }
                else {
#pragma unroll
                    for (int i = 0; i < 8; ++i) nxt[i] = 0.f; }
#pragma unroll
                for (int i = 0; i < 8; ++i) tile[nl * 66 + i * 8 + (tid >> 6)] = f2bf(cur[i]);
                __syncthreads();
                { const int nr = tid >> 3, ks = (tid & 7) * 8; const unsigned* src = (const unsigned*)(tile + nr * 66 + ks);
                  u32x4 o = {src[0], src[1], src[2], src[3]};
                  *(u32x4*)(Bt + (size_t)(nt * 64 + nr) * K + kt * 64 + ks) = o; }
                __syncthreads();
#pragma unroll
                for (int i = 0; i < 8; ++i) cur[i] = nxt[i];
            }
            base += ntiles;
        }
    }
    const size_t gtid = (size_t)blockIdx.x * 512 + tid, gstride = (size_t)gridDim.x * 512;
    { bf16_t* xb = (bf16_t*)(p.ws + W_XB); const size_t n8p = (size_t)NP * DM / 8, n8 = (size_t)MALL * DM / 8;
      for (size_t i0 = gtid; i0 < n8; i0 += 4 * gstride) {
        f32x4 a[4], b[4];
#pragma unroll
        for (int u = 0; u < 4; ++u) { const size_t i = i0 + u * gstride; if (i < n8) { const float* s = i < n8p ? p.in[I_XP] + i * 8 : p.in[I_XS] + (i - n8p) * 8; a[u] = *(const f32x4*)s; b[u] = *(const f32x4*)(s + 4); } }
#pragma unroll
        for (int u = 0; u < 4; ++u) { const size_t i = i0 + u * gstride; if (i < n8) { const float t[8] = {a[u][0], a[u][1], a[u][2], a[u][3], b[u][0], b[u][1], b[u][2], b[u][3]}; *(bf16x8*)(xb + i * 8) = pack8(t); } }
      } }
    { const size_t n8 = (size_t)8 * PAST * 1024 / 8;
      for (size_t i = gtid; i < 2 * n8; i += gstride) { const bool isv = i >= n8; const size_t j = isv ? i - n8 : i; const float* s = p.in[isv ? I_CAV : I_CAK] + j * 8;
        const size_t e = j * 8, b = e / ((size_t)PAST * 1024), rem = e % ((size_t)PAST * 1024);
        const f32x4 a = *(const f32x4*)s, c = *(const f32x4*)(s + 4); const float t[8] = {a[0], a[1], a[2], a[3], c[0], c[1], c[2], c[3]};
        *(bf16x8*)((bf16_t*)(p.ws + (isv ? W_VS : W_KS)) + b * (size_t)LS * 1024 + rem) = pack8(t); }
      const size_t m8 = (size_t)8 * PAST * 64 / 8;
      for (size_t i = gtid; i < m8; i += gstride) { const float* s = p.in[I_CAKI] + i * 8; const size_t e = i * 8, b = e / ((size_t)PAST * 64), rem = e % ((size_t)PAST * 64);
        const f32x4 a = *(const f32x4*)s, c = *(const f32x4*)(s + 4); const float t[8] = {a[0], a[1], a[2], a[3], c[0], c[1], c[2], c[3]};
        *(bf16x8*)((bf16_t*)(p.ws + W_KIDXS) + b * (size_t)LS * 64 + rem) = pack8(t); } }
    { float2* tab = (float2*)(p.ws + W_ROPE);
      for (size_t i = gtid; i < (size_t)4096 * 32; i += gstride) { const int pos = (int)(i >> 5), f = (int)(i & 31);
        const float inv = powf(10000.f, -(float)f / 32.f), ang = (float)pos * inv; float s, c; sincosf(ang, &s, &c); tab[i] = make_float2(c, s); } }
}

__device__ __forceinline__ void phase_index(CPARAMS& p, char* lds) {
    const int tid = opaque_tid(), wid = tid >> 6, lane = tid & 63, r32 = lane & 31, hi = lane >> 5;
    unsigned* sk = (unsigned*)lds;
    const int NU = 4096 + 64;
#pragma unroll 1
    for (int idx = blockIdx.x; idx < NU; idx += gridDim.x) {
        int b, t0, n, nblk_tot, rowg; const bf16_t* ki; u64* mrow; int ldm; bool sample;
        if (idx < 4096) { const int k = idx >> 8, w = idx & 255; b = k >> 1; const int j = (k & 1) ? 511 - w : w; t0 = j * 8; n = ((t0 >> 6) + 1) * 64; nblk_tot = ((t0 >> 8) + 1) * 4;
            rowg = b * TP + t0; ki = (const bf16_t*)(p.ws + W_KIDXP) + (size_t)b * TP * 64; mrow = (u64*)(p.ws + W_MASKP) + (size_t)rowg * 64; ldm = 64; sample = false; }
        else { const int s = idx - 4096; b = s >> 3; t0 = (s & 7) * 8; n = LS; nblk_tot = 17; rowg = NP + b * 64 + t0;
            ki = (const bf16_t*)(p.ws + W_KIDXS) + (size_t)b * LS * 64; mrow = (u64*)(p.ws + W_MASKS) + (size_t)(b * 64 + t0) * 32; ldm = 32; sample = true; }
        (void)sample;
        if (n <= 256) {
            if (lane < nblk_tot) mrow[(size_t)wid * ldm + lane] = (lane * 64 < n) ? ~0ull : 0ull;
            continue;
        }
        {
            const int pr = wid >> 1, par = wid & 1;
            const int qsel = (r32 >> 2) & 1, head = (r32 & 3) + 4 * (r32 >> 3);
            const bf16_t* qp = (const bf16_t*)(p.ws + W_IQ) + (size_t)(rowg + 2 * pr + qsel) * 1024 + head * 64 + hi * 8;
            bf16x8 qa[4];
#pragma unroll
            for (int s = 0; s < 4; ++s) qa[s] = *(const bf16x8*)(qp + s * 16);
            const float* wp = (const float*)(p.ws + W_IW) + (size_t)(rowg + 2 * pr + hi) * 16;
            float wv[16];
#pragma unroll
            for (int s = 0; s < 4; ++s) { const f32x4 t = *(const f32x4*)(wp + s * 4); wv[s * 4] = t[0]; wv[s * 4 + 1] = t[1]; wv[s * 4 + 2] = t[2]; wv[s * 4 + 3] = t[3]; }
            unsigned* dst = sk + (2 * pr + hi) * 4096 + par * 32 + r32;
            char* kst = lds + 131072;
            const int skey = tid >> 3, scolB = (tid & 7) * 16, ntile = n >> 6, ngrp = (ntile + 3) >> 2;
            const bf16_t* ksrc = ki + (size_t)skey * 64 + (scolB >> 1);
            bf16x8 pre[3][4];
#pragma unroll
            for (int sl = 0; sl < 3; ++sl)
#pragma unroll
                for (int u = 0; u < 4; ++u) { const int t = sl * 4 + u; pre[sl][u] = *(const bf16x8*)(ksrc + (size_t)(t < ntile ? t : 0) * 64 * 64); }
#define IDX_GROUP(SL, G) do { const int g_ = (G); \
                __syncthreads(); \
                _Pragma("unroll") for (int u = 0; u < 4; ++u) *(bf16x8*)(kst + u * 8192 + KRSWZ(skey, scolB)) = pre[SL][u]; \
                _Pragma("unroll") for (int u = 0; u < 4; ++u) { const int t = (g_ + 3) * 4 + u; pre[SL][u] = *(const bf16x8*)(ksrc + (size_t)(t < ntile ? t : 0) * 64 * 64); } \
                __syncthreads(); \
                _Pragma("unroll") for (int u = 0; u < 4; ++u) { const int t = g_ * 4 + u; \
                    if (t < ntile) { f32x16 acc = {}; \
                        _Pragma("unroll") for (int s = 0; s < 4; ++s) { const bf16x8 kf = *(const bf16x8*)(kst + u * 8192 + KRSWZ(par * 32 + r32, (s * 16 + hi * 8) * 2)); acc = __builtin_amdgcn_mfma_f32_32x32x16_bf16(qa[s], kf, acc, 0, 0, 0); } \
                        float sc = 0.f; \
                        _Pragma("unroll") for (int r = 0; r < 16; ++r) sc = fmaf(wv[r], fmaxf(acc[r], 0.f), sc); \
                        sc += 0.f; \
                        const unsigned uu = __float_as_uint(sc); \
                        dst[t * 64] = (uu & 0x80000000u) ? ~uu : (uu | 0x80000000u); } } } while (0)
#pragma unroll 1
            for (int g0 = 0; g0 < ngrp; g0 += 3) {
                IDX_GROUP(0, g0);
                if (g0 + 1 < ngrp) IDX_GROUP(1, g0 + 1);
                if (g0 + 2 < ngrp) IDX_GROUP(2, g0 + 2);
            }
#undef IDX_GROUP
        }
        __syncthreads();
        {
            const unsigned* k = sk + wid * 4096;
            u32x4 kv[16];
#pragma unroll
            for (int j = 0; j < 16; ++j) kv[j] = (j * 256 < n && j * 256 + lane * 4 < n) ? *(const u32x4*)(k + j * 256 + lane * 4) : (u32x4){0u, 0u, 0u, 0u};
            unsigned prefix = 0;
#pragma unroll 1
            for (int bit = 31; bit >= 0; --bit) {
                const unsigned cand = prefix | (1u << bit);
                int cnt = 0;
#pragma unroll
                for (int j = 0; j < 16; ++j) if (j * 256 < n) cnt += (kv[j][0] >= cand) + (kv[j][1] >= cand) + (kv[j][2] >= cand) + (kv[j][3] >= cand);
                cnt = wave_sum_dpp(cnt);
                if (cnt >= 256) { prefix = cand; if (cnt == 256) break; }
            }
            int cgt = 0;
#pragma unroll
            for (int j = 0; j < 16; ++j) if (j * 256 < n) cgt += (kv[j][0] > prefix) + (kv[j][1] > prefix) + (kv[j][2] > prefix) + (kv[j][3] > prefix);
            cgt = wave_sum_dpp(cgt);
            const int need = 256 - cgt; int running = 0;
            u64* mr = mrow + (size_t)wid * ldm;
            const u64 lt = (1ull << lane) - 1ull;
#pragma unroll 1
            for (int blk = 0; blk < nblk_tot; ++blk) {
                u64 word = 0ull;
                if (blk * 64 < n) {
                    const unsigned v = k[blk * 64 + lane];
                    const u64 eqm = __ballot(v == prefix);
                    const int rank = running + __popcll(eqm & lt);
                    const bool sel = (v > prefix) || (v == prefix && rank < need);
                    word = __ballot(sel); running += __popcll(eqm);
                }
                if (lane == 0) mr[blk] = word;
            }
        }
        __syncthreads();
    }
}

#define KSWZ(row, colB) ((row) * 256 + ((colB) ^ (((row) & 7) << 4)))
__device__ __forceinline__ int crow(int r, int hi) { return (r & 3) + 8 * (r >> 2) + 4 * hi; }
__device__ __forceinline__ int v_st(int k, int c) { const int kk = (k & ~0xC) | ((k & 4) << 1) | ((k & 8) >> 1); return ((kk >> 3) * 4 + (c >> 5)) * 512 + ((kk & 7) * 32 + (c & 31)) * 2; }
__device__ __forceinline__ int v_rd_base(int lane) { return ((lane & 3) << 3) | (((lane >> 2) & 3) << 6) | (((lane >> 4) & 1) << 5) | (((lane >> 5) & 1) << 8); }
constexpr int v_rd_off(int d0, int ks, int half) { return d0 * 512 + ks * 4096 + half * 2048; }
template <int OFF> __device__ __forceinline__ s16x4 tr_read(int vb) { s16x4 r; asm volatile("ds_read_b64_tr_b16 %0, %1 offset:%2" : "=&v"(r) : "v"(vb), "i"(OFF) : "memory"); return r; }
template <int D0> __device__ __forceinline__ void pv_one(f32x16& od, int vb, bf16x8 pa0, bf16x8 pa1, bf16x8 pa2, bf16x8 pa3) {
    const s16x4 l0 = tr_read<v_rd_off(D0, 0, 0)>(vb), h0 = tr_read<v_rd_off(D0, 0, 1)>(vb), l1 = tr_read<v_rd_off(D0, 1, 0)>(vb), h1 = tr_read<v_rd_off(D0, 1, 1)>(vb);
    const s16x4 l2 = tr_read<v_rd_off(D0, 2, 0)>(vb), h2 = tr_read<v_rd_off(D0, 2, 1)>(vb), l3 = tr_read<v_rd_off(D0, 3, 0)>(vb), h3 = tr_read<v_rd_off(D0, 3, 1)>(vb);
    asm volatile("s_waitcnt lgkmcnt(0)" ::: "memory"); __builtin_amdgcn_sched_barrier(0);
#define PKV(L, H) (bf16x8){L[0], L[1], L[2], L[3], H[0], H[1], H[2], H[3]}
    od = __builtin_amdgcn_mfma_f32_32x32x16_bf16(pa0, PKV(l0, h0), od, 0, 0, 0);
    od = __builtin_amdgcn_mfma_f32_32x32x16_bf16(pa1, PKV(l1, h1), od, 0, 0, 0);
    od = __builtin_amdgcn_mfma_f32_32x32x16_bf16(pa2, PKV(l2, h2), od, 0, 0, 0);
    od = __builtin_amdgcn_mfma_f32_32x32x16_bf16(pa3, PKV(l3, h3), od, 0, 0, 0);
#undef PKV
}

struct AttnUnit {
    const bf16_t* Q; const bf16_t* Qr; const bf16_t* K; const bf16_t* V; const bf16_t* Kr; bf16_t* O; const bf16_t* G; const u64* M;
    int ldq, ldqr, ldk, ldo, ldg, ldm, nvalid, qpos0, NT, head;
};
constexpr int AT_V = 0, AT_K = 32768, AT_KR = 65536, AT_WS = 81920, AT_TB = 81920 + 2048;

template <int MODE>
__device__ __forceinline__ void attn_unit(const AttnUnit& u, char* lds, const float* t5, const float Cs  , const bool dry = false) {
    const int tid = opaque_tid(), wid = __builtin_amdgcn_readfirstlane(tid >> 6), lane = tid & 63, r32 = lane & 31, hi = lane >> 5;
    float* wsf = (float*)(lds + AT_WS) + wid * 64; float* al_l = wsf; float* li_l = wsf + 32;
    float* tb = (float*)(lds + AT_TB);
    const int rowb = wid * 32 + r32, rowc = rowb < u.nvalid ? rowb : u.nvalid - 1;
    const int wrow0 = (wid * 32 < u.nvalid) ? wid * 32 : u.nvalid - 1;
    const int qc_w = (u.qpos0 + wrow0) >> 6;
    const int qpos = u.qpos0 + rowc;
    constexpr int NQ = MODE == 1 ? 12 : 8;
    bf16x8 qr[NQ];
    { const bf16_t* Qw = u.Q + (size_t)rowc * u.ldq + hi * 8;
#pragma unroll
      for (int d0 = 0; d0 < 8; ++d0) qr[d0] = *(const bf16x8*)(Qw + d0 * 16);
      if constexpr (MODE == 1) { const bf16_t* Qw2 = u.Qr + (size_t)rowc * u.ldqr + hi * 8;
#pragma unroll
        for (int d0 = 0; d0 < 4; ++d0) qr[8 + d0] = *(const bf16x8*)(Qw2 + d0 * 16); } }
    if constexpr (MODE == 0) {
        if (tid < 155) { const int rel = tid - 63, nn = rel < 0 ? -rel : rel;
            const int bk = (rel < 0 ? 16 : 0) + (nn < 8 ? nn : 8 + (nn >= 12) + (nn >= 16) + (nn >= 23) + (nn >= 32) + (nn >= 46) + (nn >= 64) + (nn >= 91));
            tb[tid] = t5[bk * 8 + u.head] * LOG2E; }
    }
    float m_reg = -1e29f, l_reg = 0.f; f32x16 o[4];
#pragma unroll
    for (int d = 0; d < 4; ++d) o[d] = (f32x16){};
    const int vb0 = (int)(uintptr_t)(lds + AT_V) + v_rd_base(lane);
    int koff[2], voff[2], kroff = 0;
#pragma unroll
    for (int i = 0; i < 2; ++i) { const int X = (i * 8 + wid) * 1024 + lane * 16;
        { const int row = X >> 8, colB = (X & 255) ^ ((row & 7) << 4); koff[i] = row * u.ldk + (colB >> 1); }
        { const int sub = X >> 9, y = X & 511, kk = (sub >> 2) * 8 + (y >> 6), k = (kk & ~0xC) | ((kk & 4) << 1) | ((kk & 8) >> 1), c = (sub & 3) * 32 + ((y & 63) >> 1); voff[i] = k * u.ldk + c; } }
    if constexpr (MODE == 1) { const int X = wid * 1024 + lane * 16, row = X >> 7, colB = (X & 127) ^ (((row >> 1) & 7) << 4); kroff = row * 64 + (colB >> 1); }
    LAS char* ldl = (LAS char*)lds;
#define AT_ISSUE(b, k0) do { const bf16_t* kb_ = u.K + (size_t)(k0) * u.ldk; const bf16_t* vb_ = u.V + (size_t)(k0) * u.ldk; \
        _Pragma("unroll") for (int i_ = 0; i_ < 2; ++i_) { \
            __builtin_amdgcn_global_load_lds((const unsigned*)(kb_ + koff[i_]), (LAS unsigned*)(ldl + AT_K + (b) * 16384 + (i_ * 8 + wid) * 1024), 16, 0, 0); \
            __builtin_amdgcn_global_load_lds((const unsigned*)(vb_ + voff[i_]), (LAS unsigned*)(ldl + AT_V + (b) * 16384 + (i_ * 8 + wid) * 1024), 16, 0, 0); } \
        if constexpr (MODE == 1) __builtin_amdgcn_global_load_lds((const unsigned*)(u.Kr + (size_t)(k0) * 64 + kroff), (LAS unsigned*)(ldl + AT_KR + (b) * 8192 + wid * 1024), 16, 0, 0); } while (0)
    AT_ISSUE(0, 0);
    asm volatile("s_waitcnt vmcnt(0)" ::: "memory");
    __syncthreads();
#pragma unroll 1
    for (int j = 0; j < u.NT; ++j) {
        const int cur = j & 1;
        if (j + 1 < u.NT) AT_ISSUE(cur ^ 1, (j + 1) * 64);
        if (j <= qc_w && wid * 32 < u.nvalid) {
            u64 mw = 0;
            if constexpr (MODE == 0) mw = u.M[(size_t)rowc * u.ldm + j];
            f32x16 p0 = {}, p1 = {};
            const char* Ks = lds + AT_K + cur * 16384;
            __builtin_amdgcn_s_setprio(1);
#pragma unroll
            for (int d0 = 0; d0 < 8; ++d0) { const int cb = (d0 * 16 + hi * 8) * 2;
                const bf16x8 b0 = *(const bf16x8*)(Ks + KSWZ(r32, cb)), b1 = *(const bf16x8*)(Ks + KSWZ(32 + r32, cb));
                p0 = __builtin_amdgcn_mfma_f32_32x32x16_bf16(b0, qr[d0], p0, 0, 0, 0); p1 = __builtin_amdgcn_mfma_f32_32x32x16_bf16(b1, qr[d0], p1, 0, 0, 0);
                if ((d0 & 3) == 3) __builtin_amdgcn_sched_barrier(0); }
            if constexpr (MODE == 1) { const char* Krs = lds + AT_KR + cur * 8192;
#pragma unroll
                for (int d0 = 0; d0 < 4; ++d0) { const int cb = (d0 * 16 + hi * 8) * 2;
                    const bf16x8 b0 = *(const bf16x8*)(Krs + KRSWZ(r32, cb)), b1 = *(const bf16x8*)(Krs + KRSWZ(32 + r32, cb));
                    p0 = __builtin_amdgcn_mfma_f32_32x32x16_bf16(b0, qr[8 + d0], p0, 0, 0, 0); p1 = __builtin_amdgcn_mfma_f32_32x32x16_bf16(b1, qr[8 + d0], p1, 0, 0, 0); } }
            __builtin_amdgcn_s_setprio(0);
            float esc = Cs, ebias = 0.f;
            unsigned mlo = 0u, mhi = 0u;
            if constexpr (MODE == 0) {
                mlo = (unsigned)mw >> (4 * hi); mhi = (unsigned)(mw >> 32) >> (4 * hi);
                const int kb = j * 64;
                const bool far = (u.qpos0 + wrow0) - (kb + 63) >= 91;
                if (far) ebias = tb[154];
                else { const int rel0 = qpos - kb - 4 * hi; esc = 1.f;
#pragma unroll
                    for (int r = 0; r < 16; ++r) { const int c0 = crow(r, 0);
                        int i0 = rel0 - c0; i0 = i0 < -63 ? -63 : (i0 > 91 ? 91 : i0); int i1 = rel0 - c0 - 32; i1 = i1 < -63 ? -63 : (i1 > 91 ? 91 : i1);
                        p0[r] = fmaf(p0[r], Cs, tb[i0 + 63]); p1[r] = fmaf(p1[r], Cs, tb[i1 + 63]); }
                }
            }
            float pmax = p0[0];
#pragma unroll
            for (int r = 1; r < 16; ++r) pmax = fmaxf(pmax, p0[r]);
#pragma unroll
            for (int r = 0; r < 16; ++r) pmax = fmaxf(pmax, p1[r]);
            { auto rr = __builtin_amdgcn_permlane32_swap(__float_as_uint(pmax), __float_as_uint(pmax), false, false); pmax = fmaxf(__uint_as_float(rr[0]), __uint_as_float(rr[1])); }
            const float pmax_t = fmaf(pmax, esc, ebias);
            float mn = m_reg, alpha = 1.f;
            const bool grow = !__all(pmax_t - m_reg <= 11.5f);
            if (grow) { mn = fmaxf(m_reg, pmax_t); alpha = __builtin_amdgcn_exp2f(m_reg - mn); m_reg = mn; }
            const float mns = ebias - mn;
            float ps = 0.f;
#pragma unroll
            for (int r = 0; r < 16; ++r) { p0[r] = __builtin_amdgcn_exp2f(fmaf(p0[r], esc, mns)); p1[r] = __builtin_amdgcn_exp2f(fmaf(p1[r], esc, mns)); }
            if constexpr (MODE == 0) {
#pragma unroll
                for (int r = 0; r < 16; ++r) { const int c0 = crow(r, 0);
                    p0[r] = __uint_as_float(__float_as_uint(p0[r]) & (unsigned)((int)(mlo << (31 - c0)) >> 31));
                    p1[r] = __uint_as_float(__float_as_uint(p1[r]) & (unsigned)((int)(mhi << (31 - c0)) >> 31)); }
            }
#pragma unroll
            for (int r = 0; r < 16; ++r) ps += p0[r] + p1[r];
            { auto rr = __builtin_amdgcn_permlane32_swap(__float_as_uint(ps), __float_as_uint(ps), false, false); ps = __uint_as_float(rr[0]) + __uint_as_float(rr[1]); }
            l_reg = l_reg * alpha + ps;
            if (grow) {
                if (hi == 0) al_l[r32] = alpha;
                asm volatile("s_waitcnt lgkmcnt(0)" ::: "memory");
#pragma unroll
                for (int r = 0; r < 16; ++r) { const float a = al_l[crow(r, hi)];
#pragma unroll
                    for (int d = 0; d < 4; ++d) o[d][r] *= a; }
            }
            bf16x8 pa0, pa1, pa2, pa3;
#define PK4(P, BASE, OUT) do { unsigned a0 = cvtpk(P[BASE + 0], P[BASE + 1]), a1 = cvtpk(P[BASE + 2], P[BASE + 3]);   \
    unsigned b0 = cvtpk(P[BASE + 4], P[BASE + 5]), b1 = cvtpk(P[BASE + 6], P[BASE + 7]);                              \
    auto r0 = __builtin_amdgcn_permlane32_swap(a0, b0, false, false); auto r1 = __builtin_amdgcn_permlane32_swap(a1, b1, false, false); \
    u32x4 w = {r0[0], r1[0], r0[1], r1[1]}; OUT = *reinterpret_cast<bf16x8*>(&w); } while (0)
            PK4(p0, 0, pa0); PK4(p0, 8, pa1); PK4(p1, 0, pa2); PK4(p1, 8, pa3);
#undef PK4
            const int vb = vb0 + cur * 16384;
            __builtin_amdgcn_s_setprio(1);
            pv_one<0>(o[0], vb, pa0, pa1, pa2, pa3); pv_one<1>(o[1], vb, pa0, pa1, pa2, pa3); pv_one<2>(o[2], vb, pa0, pa1, pa2, pa3); pv_one<3>(o[3], vb, pa0, pa1, pa2, pa3);
            __builtin_amdgcn_s_setprio(0);
        }
        asm volatile("s_waitcnt vmcnt(0)" ::: "memory");
        __syncthreads();
    }
#undef AT_ISSUE
    if (hi == 0) li_l[r32] = l_reg;
    asm volatile("s_waitcnt lgkmcnt(0)" ::: "memory");
#pragma unroll
    for (int r = 0; r < 16; ++r) {
        const int orow = wid * 32 + crow(r, hi);
        const float rl = __builtin_amdgcn_rcpf(li_l[crow(r, hi)]);
        if (orow < u.nvalid && !dry) {
#pragma unroll
            for (int d0 = 0; d0 < 4; ++d0) { const int c = d0 * 32 + r32;
                const float g = bf2f(u.G[(size_t)orow * u.ldg + c]);
                u.O[(size_t)orow * u.ldo + c] = f2bf(o[d0][r] * rl * g); }
        }
    }
    __syncthreads();
}

__device__ __forceinline__ void phase_attn_dsa(CPARAMS& p, char* lds, const bool dry = false) {
    const float Cs = 0.08838834764831845f * LOG2E;
    const int NU = 1024 + 64;
#pragma unroll 1
    for (int idx = blockIdx.x; idx < NU; idx += gridDim.x) {
        AttnUnit u;
        bf16_t* mix = (bf16_t*)(p.ws + W_MIX);
        if (idx < 1024) { const int k = idx >> 8, w = idx & 255, h = w & 7, qb0 = (w >> 3) & 15, b = (w >> 7) + 2 * k, qb = (k & 1) ? 15 - qb0 : qb0;
            const size_t row0 = (size_t)b * TP + qb * 256;
            u.Q = mix + row0 * 3072 + h * 128; u.O = mix + row0 * 3072 + h * 128; u.G = (const bf16_t*)(p.ws + W_SG) + row0 * 1024 + h * 128;
            u.K = (const bf16_t*)(p.ws + W_KP) + (size_t)b * TP * 1024 + h * 128; u.V = (const bf16_t*)(p.ws + W_VP) + (size_t)b * TP * 1024 + h * 128;
            u.M = (const u64*)(p.ws + W_MASKP) + row0 * 64; u.ldm = 64; u.nvalid = 256; u.qpos0 = qb * 256; u.NT = 4 * (qb + 1); u.head = h;
        } else { const int s = idx - 1024, b = s >> 3, h = s & 7; const size_t row0 = (size_t)NP + b * 64;
            u.Q = mix + row0 * 3072 + h * 128; u.O = mix + row0 * 3072 + h * 128; u.G = (const bf16_t*)(p.ws + W_SG) + row0 * 1024 + h * 128;
            u.K = (const bf16_t*)(p.ws + W_KS) + (size_t)b * LS * 1024 + h * 128; u.V = (const bf16_t*)(p.ws + W_VS) + (size_t)b * LS * 1024 + h * 128;
            u.M = (const u64*)(p.ws + W_MASKS) + (size_t)b * 64 * 32; u.ldm = 32; u.nvalid = 64; u.qpos0 = PAST; u.NT = 17; u.head = h; }
        u.Qr = nullptr; u.Kr = nullptr; u.ldq = 3072; u.ldqr = 0; u.ldk = 1024; u.ldo = 3072; u.ldg = 1024;
        attn_unit<0>(u, lds, p.in[I_T5], Cs, dry);
    }
}
__device__ __forceinline__ void phase_attn_mla(CPARAMS& p, char* lds, const bool dry = false) {
    const float Cs = 0.07216878364870323f * LOG2E;
    const int NU = 2048 + 128;
#pragma unroll 1
    for (int idx = blockIdx.x; idx < NU; idx += gridDim.x) {
        AttnUnit u;
        bf16_t* q2 = (bf16_t*)(p.ws + W_Q2); const bf16_t* kv = (const bf16_t*)(p.ws + W_KVALL); const bf16_t* kr = (const bf16_t*)(p.ws + W_KR);
        size_t row0, lrow0; int h;
        if (idx < 2048) { const int k = idx >> 8, w = idx & 255, qb0 = (w >> 4) & 15, b = k, qb = (k & 1) ? 15 - qb0 : qb0; h = w & 15;
            row0 = (size_t)b * TP + qb * 256; lrow0 = (size_t)b * TP; u.nvalid = 256; u.qpos0 = qb * 256; u.NT = 4 * (qb + 1);
        } else { const int s = idx - 2048, b = s >> 4; h = s & 15; row0 = (size_t)NP + b * 64; lrow0 = (size_t)NP + (size_t)b * LS; u.nvalid = 64; u.qpos0 = PAST; u.NT = 17; }
        u.Q = q2 + row0 * 3072 + h * 128; u.Qr = q2 + row0 * 3072 + 2048 + h * 64; u.O = q2 + row0 * 3072 + h * 128; u.G = (const bf16_t*)(p.ws + W_SGATE) + row0 * 2048 + h * 128;
        u.K = kv + lrow0 * 4096 + h * 128; u.V = kv + lrow0 * 4096 + 2048 + h * 128; u.Kr = kr + lrow0 * 64; u.M = nullptr;
        u.ldq = 3072; u.ldqr = 3072; u.ldk = 4096; u.ldo = 3072; u.ldg = 2048; u.ldm = 0; u.head = h;
        attn_unit<1>(u, lds, nullptr, Cs, dry);
    }
}

__device__ __forceinline__ void phase_conv(CPARAMS& p) {
    const int tid = opaque_tid();
    if (tid < 384) {
        const int ch = tid * 8;
        float cw[4][8], cb[8];
        { const float* cwp = p.in[I_CONVW] + ch; const float* cbp = p.in[I_CONVB] + ch;
#pragma unroll
          for (int j = 0; j < 4; ++j) { const f32x4 a = *(const f32x4*)(cwp + j * 3072), bq = *(const f32x4*)(cwp + j * 3072 + 4);
              cw[j][0] = a[0]; cw[j][1] = a[1]; cw[j][2] = a[2]; cw[j][3] = a[3]; cw[j][4] = bq[0]; cw[j][5] = bq[1]; cw[j][6] = bq[2]; cw[j][7] = bq[3]; }
          const f32x4 a = *(const f32x4*)cbp, bq = *(const f32x4*)(cbp + 4); cb[0] = a[0]; cb[1] = a[1]; cb[2] = a[2]; cb[3] = a[3]; cb[4] = bq[0]; cb[5] = bq[1]; cb[6] = bq[2]; cb[7] = bq[3]; }
        const bf16_t* xbc = (const bf16_t*)(p.ws + W_XBC);
        bf16_t* dst = ch < 2048 ? (bf16_t*)(p.ws + W_XACT) + ch : (bf16_t*)(p.ws + W_BCACT) + (ch - 2048);
        const int dstride = ch < 2048 ? 2048 : 1024;
#pragma unroll 1
        for (int unit = blockIdx.x; unit < MALL / 64; unit += gridDim.x) {
            const size_t row0 = (size_t)unit * 64;
            float w[3][8];
            const bool seqstart = row0 >= NP || (row0 & (TP - 1)) == 0;
            if (seqstart) {
                if (row0 >= NP) { const float* sp = p.in[I_SCONV] + ((row0 - NP) >> 6) * 3 * 3072 + ch;
#pragma unroll
                    for (int j = 0; j < 3; ++j) { const f32x4 a = *(const f32x4*)(sp + j * 3072), bq = *(const f32x4*)(sp + j * 3072 + 4);
                        w[j][0] = a[0]; w[j][1] = a[1]; w[j][2] = a[2]; w[j][3] = a[3]; w[j][4] = bq[0]; w[j][5] = bq[1]; w[j][6] = bq[2]; w[j][7] = bq[3]; } }
                else {
#pragma unroll
                    for (int j = 0; j < 3; ++j)
#pragma unroll
                        for (int e = 0; e < 8; ++e) w[j][e] = 0.f; }
            } else {
#pragma unroll
                for (int j = 0; j < 3; ++j) { const bf16x8 r = *(const bf16x8*)(xbc + (row0 - 3 + j) * 3072 + ch);
#pragma unroll
                    for (int e = 0; e < 8; ++e) w[j][e] = bf2f((bf16_t)r[e]); }
            }
#pragma unroll 1
            for (int r0 = 0; r0 < 64; r0 += 8) {
                bf16x8 raw[8];
#pragma unroll
                for (int r = 0; r < 8; ++r) raw[r] = *(const bf16x8*)(xbc + (row0 + r0 + r) * 3072 + ch);
#pragma unroll
                for (int r = 0; r < 8; ++r) { float o[8];
#pragma unroll
                    for (int e = 0; e < 8; ++e) { const float cur = bf2f((bf16_t)raw[r][e]);
                        o[e] = silu_f(cb[e] + cw[0][e] * w[0][e] + cw[1][e] * w[1][e] + cw[2][e] * w[2][e] + cw[3][e] * cur);
                        w[0][e] = w[1][e]; w[1][e] = w[2][e]; w[2][e] = cur; }
                    *(bf16x8*)(dst + (row0 + r0 + r) * dstride) = pack8(o); }
            }
        }
    }
}

constexpr int SD_XT = 0, SD_BS = 9216, SD_BTT = 26624, SD_CS = 45056, SD_CS2 = 62464, SD_WS = 79872, SD_H0 = 89088, SD_F = 106496;
__device__ __forceinline__ void phase_ssd(CPARAMS& p, char* lds, const bool dry = false) {
    const int tid = opaque_tid(), wid = tid >> 6, lane = tid & 63, l16 = lane & 15, lq = lane >> 4;
    bf16_t* XT = (bf16_t*)(lds + SD_XT); bf16_t* Bs = (bf16_t*)(lds + SD_BS); bf16_t* BTt = (bf16_t*)(lds + SD_BTT); bf16_t* Cs = (bf16_t*)(lds + SD_CS);
    bf16_t* Cs2 = (bf16_t*)(lds + SD_CS2); bf16_t* Ws = (bf16_t*)(lds + SD_WS); bf16_t* H0 = (bf16_t*)(lds + SD_H0);
    float* s_acum = (float*)(lds + SD_F); float* s_dt = s_acum + 64; float* s_ea = s_acum + 128; float* s_tail = s_acum + 192; float* s_ssq = s_acum + 256;
    const bf16_t* xbc = (const bf16_t*)(p.ws + W_XBC); bf16_t* mix = (bf16_t*)(p.ws + W_MIX);
    const float* dtbuf = (const float*)(p.ws + W_DT); float* ssqg = (float*)(p.ws + W_SSQ);
#pragma unroll 1
    for (int idx = blockIdx.x; idx < 512; idx += gridDim.x) {
        const bool sample = idx >= 256; const int bh = idx & 255, b = bh >> 5, h = bh & 31, g = h >> 3;
        const size_t row0 = sample ? (size_t)NP + b * 64 : (size_t)b * TP; const int nch = sample ? 1 : 64;
        const float a_h = -__expf(p.in[I_ALOG][h]), d_h = p.in[I_DSKIP][h];
        f32x4 hacc[4];
        const int pt = wid >> 1;
#pragma unroll
        for (int j = 0; j < 4; ++j) { const int nt = (wid & 1) * 4 + j;
#pragma unroll
            for (int i = 0; i < 4; ++i) { const int pp = pt * 16 + 4 * lq + i, nn = nt * 16 + l16;
                hacc[j][i] = sample ? p.in[I_SSSM][(((size_t)b * 32 + h) * 64 + pp) * 128 + nn] : 0.f;
                H0[pp * 136 + nn] = f2bf(hacc[j][i]); } }
        const int cg8 = tid % 40, rb = tid / 40; const bool ldr = tid < 320;
        const bf16_t* asrc = cg8 < 8 ? (const bf16_t*)(p.ws + W_XACT) + h * 64 + cg8 * 8 : (const bf16_t*)(p.ws + W_BCACT) + (cg8 < 24 ? g * 128 + (cg8 - 8) * 8 : 512 + g * 128 + (cg8 - 24) * 8);
        const size_t astride = cg8 < 8 ? 2048 : 1024;
        bf16x8 av[8];
#pragma unroll
        for (int r = 0; r < 8; ++r) av[r] = ldr ? *(const bf16x8*)(asrc + (row0 + rb * 8 + r) * astride) : (bf16x8){0, 0, 0, 0, 0, 0, 0, 0};
        float dt_next = (wid == 0) ? dtbuf[(row0 + lane) * 32 + h] : 0.f;
        bf16_t szv[2][4];
#pragma unroll
        for (int q = 0; q < 2; ++q) { const int id = wid * 2 + q, mt = id >> 2, nt = id & 3;
#pragma unroll
            for (int i = 0; i < 4; ++i) szv[q][i] = mix[(row0 + mt * 16 + 4 * lq + i) * 3072 + 1024 + h * 64 + nt * 16 + l16]; }
#pragma unroll 1
        for (int c = 0; c < nch; ++c) {
            const size_t crow0 = row0 + (size_t)c * 64;
            if (wid == 0) {
                if (c > 0 && !dry) ssqg[(size_t)h * MALL + (crow0 - 64 + lane)] = (s_ssq[lane] + s_ssq[64 + lane]) + (s_ssq[128 + lane] + s_ssq[192 + lane]);
                const float dtv = dt_next; float ac = dtv * a_h;
                if (c + 1 < nch) dt_next = dtbuf[(crow0 + 64 + lane) * 32 + h];
                ac = wave_scan_incl(ac, lane);
                const float a63 = __builtin_bit_cast(float, __builtin_amdgcn_readlane(__builtin_bit_cast(int, ac), 63));
                s_acum[lane] = ac; s_dt[lane] = dtv; s_ea[lane] = __expf(ac); s_tail[lane] = __expf(a63 - ac) * dtv;
            }
            __syncthreads();
            if (ldr) {
                const int t0l = rb * 8;
#pragma unroll
                for (int hf = 0; hf < 2; ++hf) {
                    float vout[8][4];
#pragma unroll
                    for (int r = 0; r < 8; ++r)
#pragma unroll
                        for (int e = 0; e < 4; ++e) vout[r][e] = bf2f((bf16_t)av[r][hf * 4 + e]);
                    if (cg8 < 8) {
#pragma unroll
                        for (int e = 0; e < 4; ++e) { float t[8];
#pragma unroll
                            for (int r = 0; r < 8; ++r) t[r] = vout[r][e];
                            *(bf16x8*)(XT + (cg8 * 8 + hf * 4 + e) * 72 + t0l) = pack8(t); }
                    } else if (cg8 < 24) {
                        const int n0 = (cg8 - 8) * 8 + hf * 4;
#pragma unroll
                        for (int r = 0; r < 8; ++r) { const f32x4 q = {vout[r][0], vout[r][1], vout[r][2], vout[r][3]}; *(u32x2*)(Bs + (t0l + r) * 136 + n0) = pack4(q); }
                        float tl8[8];
#pragma unroll
                        for (int r = 0; r < 8; ++r) tl8[r] = s_tail[t0l + r];
#pragma unroll
                        for (int e = 0; e < 4; ++e) { float t[8];
#pragma unroll
                            for (int r = 0; r < 8; ++r) t[r] = vout[r][e] * tl8[r];
                            *(bf16x8*)(BTt + (n0 + e) * 72 + t0l) = pack8(t); }
                    } else {
                        const int n0 = (cg8 - 24) * 8 + hf * 4;
#pragma unroll
                        for (int r = 0; r < 8; ++r) { const f32x4 q = {vout[r][0], vout[r][1], vout[r][2], vout[r][3]}; *(u32x2*)(Cs + (t0l + r) * 136 + n0) = pack4(q);
                            const float ea = s_ea[t0l + r]; *(u32x2*)(Cs2 + (t0l + r) * 136 + n0) = pack4(q * ea); }
                    }
                }
                if (c + 1 < nch) {
#pragma unroll
                    for (int r = 0; r < 8; ++r) av[r] = *(const bf16x8*)(asrc + (crow0 + 64 + rb * 8 + r) * astride);
                }
            }
            __syncthreads();
#pragma unroll
            for (int q = 0; q < 2; ++q) { const int id = wid * 2 + q, mt = id >> 2, nt = id & 3;
                f32x4 acc = {0.f, 0.f, 0.f, 0.f};
                if (nt <= mt) {
#pragma unroll
                    for (int ks = 0; ks < 4; ++ks) { const bf16x8 af = *(const bf16x8*)(Cs + (mt * 16 + l16) * 136 + ks * 32 + lq * 8), bf = *(const bf16x8*)(Bs + (nt * 16 + l16) * 136 + ks * 32 + lq * 8);
                        acc = __builtin_amdgcn_mfma_f32_16x16x32_bf16(af, bf, acc, 0, 0, 0); }
                }
                const int s = nt * 16 + l16; const float as = s_acum[s], dts = s_dt[s];
#pragma unroll
                for (int i = 0; i < 4; ++i) { const int t = mt * 16 + 4 * lq + i; const float w = (s <= t) ? acc[i] * __expf(s_acum[t] - as) * dts : 0.f; Ws[t * 72 + s] = f2bf(w); }
            }
            __syncthreads();
#pragma unroll
            for (int q = 0; q < 2; ++q) { const int id = wid * 2 + q, mt = id >> 2, nt = id & 3;
                f32x4 acc = {0.f, 0.f, 0.f, 0.f};
#pragma unroll
                for (int ks = 0; ks < 2; ++ks) { const bf16x8 af = *(const bf16x8*)(Ws + (mt * 16 + l16) * 72 + ks * 32 + lq * 8), bf = *(const bf16x8*)(XT + (nt * 16 + l16) * 72 + ks * 32 + lq * 8);
                    acc = __builtin_amdgcn_mfma_f32_16x16x32_bf16(af, bf, acc, 0, 0, 0); }
#pragma unroll
                for (int ks = 0; ks < 4; ++ks) { const bf16x8 af = *(const bf16x8*)(Cs2 + (mt * 16 + l16) * 136 + ks * 32 + lq * 8), bf = *(const bf16x8*)(H0 + (nt * 16 + l16) * 136 + ks * 32 + lq * 8);
                    acc = __builtin_amdgcn_mfma_f32_16x16x32_bf16(af, bf, acc, 0, 0, 0); }
                const int pp = nt * 16 + l16;
#pragma unroll
                for (int i = 0; i < 4; ++i) { const int t = mt * 16 + 4 * lq + i;
                    const float xv = bf2f(XT[pp * 72 + t]);
                    const float yg = (acc[i] + d_h * xv) * bf2f(szv[q][i]);
                    if (!dry) mix[(crow0 + t) * 3072 + 1024 + h * 64 + pp] = f2bf(yg);
                    float sq = yg * yg;
                    sq = row16_sum(sq);
                    if (l16 == 0) s_ssq[nt * 64 + t] = sq; }
            }
            if (c + 1 < nch) {
#pragma unroll
                for (int q = 0; q < 2; ++q) { const int id = wid * 2 + q, mt = id >> 2, nt = id & 3;
#pragma unroll
                    for (int i = 0; i < 4; ++i) szv[q][i] = mix[(crow0 + 64 + mt * 16 + 4 * lq + i) * 3072 + 1024 + h * 64 + nt * 16 + l16]; } }
            const float e63 = s_ea[63];
            __syncthreads();
#pragma unroll
            for (int j = 0; j < 4; ++j) { const int nt = (wid & 1) * 4 + j;
                f32x4 acc = hacc[j] * e63;
#pragma unroll
                for (int ks = 0; ks < 2; ++ks) { const bf16x8 af = *(const bf16x8*)(XT + (pt * 16 + l16) * 72 + ks * 32 + lq * 8), bf = *(const bf16x8*)(BTt + (nt * 16 + l16) * 72 + ks * 32 + lq * 8);
                    acc = __builtin_amdgcn_mfma_f32_16x16x32_bf16(af, bf, acc, 0, 0, 0); }
                hacc[j] = acc;
#pragma unroll
                for (int i = 0; i < 4; ++i) H0[(pt * 16 + 4 * lq + i) * 136 + nt * 16 + l16] = f2bf(acc[i]);
            }
        }
        __syncthreads();
        if (wid == 0 && !dry) ssqg[(size_t)h * MALL + (row0 + (size_t)(nch - 1) * 64 + lane)] = (s_ssq[lane] + s_ssq[64 + lane]) + (s_ssq[128 + lane] + s_ssq[192 + lane]);
        if (!dry) { float* ho = p.out + (sample ? O_BSS : O_BSP) + ((size_t)b * 32 + h) * 64 * 128;
#pragma unroll
          for (int j = 0; j < 4; ++j) { const int nt = (wid & 1) * 4 + j;
#pragma unroll
              for (int i = 0; i < 4; ++i) ho[(size_t)(pt * 16 + 4 * lq + i) * 128 + nt * 16 + l16] = hacc[j][i]; } }
        __syncthreads();
    }
}

__device__ __forceinline__ void phase_bnorm(CPARAMS& p) {
    bf16_t* mix = (bf16_t*)(p.ws + W_MIX); const float* ssq = (const float*)(p.ws + W_SSQ); const float* nw = p.in[I_SNORM];
    const size_t n = (size_t)MALL * 256, stride = (size_t)gridDim.x * 512;
    const int tidb = opaque_tid();
    for (size_t i0 = (size_t)blockIdx.x * 512 + tidb; i0 < n; i0 += 4 * stride) {
        bf16x8 v[4]; float tot[4];
#pragma unroll
        for (int u = 0; u < 4; ++u) { const size_t i = i0 + u * stride; tot[u] = 0.f; v[u] = (bf16x8){0, 0, 0, 0, 0, 0, 0, 0};
            if (i < n) { const size_t row = i >> 8; const int c0 = (int)(i & 255) * 8, g = c0 >> 9;
                v[u] = *(const bf16x8*)(mix + row * 3072 + 1024 + c0);
#pragma unroll
                for (int hh = 0; hh < 8; ++hh) tot[u] += ssq[(size_t)(g * 8 + hh) * MALL + row]; } }
#pragma unroll
        for (int u = 0; u < 4; ++u) { const size_t i = i0 + u * stride;
            if (i < n) { const size_t row = i >> 8; const int c0 = (int)(i & 255) * 8;
                const float r = rsqrtf(tot[u] * (1.f / 512.f) + EPSV);
                const f32x4 w0 = *(const f32x4*)(nw + c0), w1 = *(const f32x4*)(nw + c0 + 4);
                float t[8];
#pragma unroll
                for (int e2 = 0; e2 < 8; ++e2) t[e2] = bf2f((bf16_t)v[u][e2]) * r * (e2 < 4 ? w0[e2] : w1[e2 - 4]);
                *(bf16x8*)(mix + row * 3072 + 1024 + c0) = pack8(t); } }
    }
}
__device__ __forceinline__ void phase_ln(CPARAMS& p, const float* gw, const float* bw, bf16_t* yb, const bool dry = false) {
    int tid_ = threadIdx.x; asm volatile("" : "+v"(tid_));
    const int wid = tid_ >> 6, lane = tid_ & 63;
    float* y = p.out + O_Y;
    for (int row = blockIdx.x * 8 + wid; row < MALL; row += gridDim.x * 8) {
        float* rp = y + (size_t)row * DM;
        f32x4 v[8]; float s = 0.f;
#pragma unroll
        for (int j = 0; j < 8; ++j) { v[j] = *(const f32x4*)(rp + j * 256 + lane * 4); s += v[j][0] + v[j][1] + v[j][2] + v[j][3]; }
        const float mu = wave_sum(s) * (1.f / DM);
        float q = 0.f;
#pragma unroll
        for (int j = 0; j < 8; ++j) { v[j] = v[j] - mu; q += v[j][0] * v[j][0] + v[j][1] * v[j][1] + v[j][2] * v[j][2] + v[j][3] * v[j][3]; }
        const float rs = rsqrtf(wave_sum(q) * (1.f / DM) + EPSV);
#pragma unroll
        for (int j = 0; j < 8; ++j) { const int c = j * 256 + lane * 4; const f32x4 gg = *(const f32x4*)(gw + c), bb = *(const f32x4*)(bw + c);
            const f32x4 o = v[j] * rs * gg + bb; if (!dry) { *(f32x4*)(rp + c) = o; if (yb) *(u32x2*)(yb + (size_t)row * DM + c) = pack4(o); } else if (o[0] == 1.2345e30f) rp[c] = 0.f; }
    }
}
__device__ __forceinline__ void phase_post1(CPARAMS& p) {
    const int tidp = opaque_tid(); const int wid = tidp >> 6, lane = tidp & 63;
    const float* cqkv = (const float*)(p.ws + W_CQKV); bf16_t* cqn = (bf16_t*)(p.ws + W_CQN); bf16_t* lat = (bf16_t*)(p.ws + W_LAT); bf16_t* krb = (bf16_t*)(p.ws + W_KR);
    const float2* tab = (const float2*)(p.ws + W_ROPE);
    for (int row = blockIdx.x * 8 + wid; row < MALL; row += gridDim.x * 8) {
        const float* rp = cqkv + (size_t)row * 1088;
        const f32x4 a0 = *(const f32x4*)(rp + lane * 8), a1 = *(const f32x4*)(rp + lane * 8 + 4), c0 = *(const f32x4*)(rp + 512 + lane * 8), c1 = *(const f32x4*)(rp + 512 + lane * 8 + 4);
        const float kv = rp[1024 + lane];
        float sa = 0.f, sc = 0.f;
#pragma unroll
        for (int e = 0; e < 4; ++e) { sa += a0[e] * a0[e] + a1[e] * a1[e]; sc += c0[e] * c0[e] + c1[e] * c1[e]; }
        const float ra = rsqrtf(wave_sum(sa) * (1.f / 512.f) + EPSV), rc = rsqrtf(wave_sum(sc) * (1.f / 512.f) + EPSV);
        const f32x4 qw0 = *(const f32x4*)(p.in[I_QNW] + lane * 8), qw1 = *(const f32x4*)(p.in[I_QNW] + lane * 8 + 4), kw0 = *(const f32x4*)(p.in[I_KVNW] + lane * 8), kw1 = *(const f32x4*)(p.in[I_KVNW] + lane * 8 + 4);
        const f32x4 qa = a0 * ra * qw0, qb = a1 * ra * qw1, la = c0 * rc * kw0, lb = c1 * rc * kw1;
        { const float t[8] = {qa[0], qa[1], qa[2], qa[3], qb[0], qb[1], qb[2], qb[3]}; *(bf16x8*)(cqn + (size_t)row * 512 + lane * 8) = pack8(t); }
        const int lr = latrow_of(row);
        { const float t[8] = {la[0], la[1], la[2], la[3], lb[0], lb[1], lb[2], lb[3]}; *(bf16x8*)(lat + (size_t)lr * 512 + lane * 8) = pack8(t); }
        float* clo = row < NP ? p.out + O_CLP + (size_t)row * 512 : p.out + O_CLS + (size_t)(row - NP) * 512;
        *(f32x4*)(clo + lane * 8) = la; *(f32x4*)(clo + lane * 8 + 4) = lb;
        const float other = __shfl_xor(kv, 32);
        const int i = lane & 31, pos = pos_of(row); const float2 cs = tab[(size_t)pos * 32 + i];
        const float o = lane < 32 ? kv * cs.x - other * cs.y : other * cs.y + kv * cs.x;
        float* cko = row < NP ? p.out + O_CKP + (size_t)row * 64 : p.out + O_CKS + (size_t)(row - NP) * 64;
        cko[lane] = o;
        krb[(size_t)lr * 64 + 4 * (i >> 1) + (i & 1) + (lane >= 32 ? 2 : 0)] = f2bf(o);
    }
    const size_t gtid = (size_t)blockIdx.x * 512 + tidp, gstride = (size_t)gridDim.x * 512;
    { const size_t n8 = (size_t)8 * PAST * 512 / 8;
      for (size_t i = gtid; i < n8; i += gstride) { const size_t e = i * 8, b = e / ((size_t)PAST * 512), rem = e % ((size_t)PAST * 512); const float* s = p.in[I_CLAT] + e;
        const f32x4 a = *(const f32x4*)s, c = *(const f32x4*)(s + 4); const float t[8] = {a[0], a[1], a[2], a[3], c[0], c[1], c[2], c[3]};
        *(bf16x8*)(lat + ((size_t)NP + b * LS) * 512 + rem) = pack8(t); } }
    { const size_t n = (size_t)8 * PAST * 64;
      for (size_t e = gtid; e < n; e += gstride) { const size_t b = e / ((size_t)PAST * 64), rem = e % ((size_t)PAST * 64), t = rem >> 6; const int j = (int)(rem & 63), i = j & 31;
        krb[((size_t)NP + b * LS + t) * 64 + 4 * (i >> 1) + (i & 1) + (j >= 32 ? 2 : 0)] = f2bf(p.in[I_CKR][e]); } }
}

__device__ __forceinline__ CPARAMS& get_params() {
    const unsigned long long v = (unsigned long long)__builtin_amdgcn_kernarg_segment_ptr(); unsigned lo = (unsigned)v, hi = (unsigned)(v >> 32);
    asm volatile("" : "+s"(lo), "+s"(hi));
    lo = __builtin_amdgcn_readfirstlane(lo); hi = __builtin_amdgcn_readfirstlane(hi);
    return *(CPARAMS*)(((unsigned long long)hi << 32) | lo);
}
#ifndef PROBE_STOP
#define PROBE_STOP 0
#endif
__device__ __forceinline__ void phase_dump(CPARAMS& p) {
    const unsigned short* w = (const unsigned short*)p.ws; float* y = p.out + O_Y; const size_t n = (size_t)MALL * DM;
#ifdef PROBE_THRASH
    { const f32x4* xs = (const f32x4*)p.in[I_XP] + (size_t)((blockIdx.x >> 3) & 31) * (NP * (size_t)DM / 4 / 32); f32x4 a = {0.f, 0.f, 0.f, 0.f};
      for (size_t i = threadIdx.x; i < NP * (size_t)DM / 4 / 32; i += 512) a += xs[i];
      if (a[0] + a[1] + a[2] + a[3] == 1.2345e30f) y[0] = 1.f;
      __syncthreads(); __threadfence(); }
    cg::this_grid().sync(); __threadfence();
#endif
    for (size_t i = (size_t)blockIdx.x * 512 + threadIdx.x; i < n; i += (size_t)gridDim.x * 512) {
        unsigned h = 0x12345u;
#pragma unroll
        for (int r = 0; r < 8; ++r) { const size_t o = (size_t)r * n + i; const unsigned v = (o * 2 < W_END) ? w[o] : 0u; h = (h ^ v) * 0x9E3779B1u; }
        h ^= h >> 15; y[i] = (float)((h >> 8) & 127u);
    }
}
#define PROBE_AT(k) do { if (PROBE_STOP == (k)) { CPARAMS& pq = get_params(); phase_dump(pq); return; } } while (0)
__global__ void __launch_bounds__(512) fwd_megakernel(Params p_unused) {
    extern __shared__ __attribute__((aligned(16))) char lds[];
    cg::grid_group grid = cg::this_grid();
#ifndef TIME_X2
#define TIME_X2 0
#endif
    const bool dryflag = get_params().ws != nullptr;
    unsigned nbar = 0;
#define GSYNC_CG() do { __builtin_amdgcn_fence(__ATOMIC_RELEASE, "agent"); asm volatile("s_waitcnt vmcnt(0)" ::: "memory"); grid.sync(); __builtin_amdgcn_fence(__ATOMIC_ACQUIRE, "agent"); } while (0)
#define GSYNC() do { ++nbar; asm volatile("s_waitcnt vmcnt(0)" ::: "memory"); __syncthreads(); \
        if (threadIdx.x == 0) { unsigned* ctr_ = (unsigned*)(get_params().ws + W_BAR); const unsigned tgt_ = nbar * gridDim.x; \
            __builtin_amdgcn_fence(__ATOMIC_RELEASE, "agent"); asm volatile("s_waitcnt vmcnt(0)" ::: "memory"); \
            __hip_atomic_fetch_add(ctr_, 1u, __ATOMIC_RELAXED, __HIP_MEMORY_SCOPE_AGENT); \
            while (__hip_atomic_load(ctr_, __ATOMIC_RELAXED, __HIP_MEMORY_SCOPE_AGENT) < tgt_) __builtin_amdgcn_s_sleep(1); \
            __builtin_amdgcn_fence(__ATOMIC_ACQUIRE, "agent"); asm volatile("s_waitcnt vmcnt(0)" ::: "memory"); } \
        __syncthreads(); } while (0)
    if (TIME_X2 == 1) { CPARAMS& p = get_params(); phase_prep(p, lds); __syncthreads(); }
    { CPARAMS& p = get_params(); phase_prep(p, lds); }
    if (__builtin_expect(get_params().ws == nullptr, 0)) GSYNC_CG();
    GSYNC();
    PROBE_AT(1);
    if (TIME_X2 == 2)
    { CPARAMS& p = get_params(); pg8::Gemm g; g.A = (const bf16_t*)(p.ws + W_XB); g.Bt = (const bf16_t*)(p.ws + W_BT0); g.M = MALL; g.N = NIN0P; g.K = DM; g.lda = DM;
      pg8::StaticOrder S; S.init(MALL, NIN0P, (int)gridDim.x, (int)blockIdx.x); EpiInProj0 E{p.ws, p.out, p.in[I_DTB]};
      pg8::gemm_phase<EpiInProj0, pg8::StaticOrder>((PG8_LAS unsigned char*)lds, g, S, E); }
    { CPARAMS& p = get_params(); pg8::Gemm g; g.A = (const bf16_t*)(p.ws + W_XB); g.Bt = (const bf16_t*)(p.ws + W_BT0); g.M = MALL; g.N = NIN0P; g.K = DM; g.lda = DM;
      pg8::StaticOrder S; S.init(MALL, NIN0P, (int)gridDim.x, (int)blockIdx.x); EpiInProj0 E{p.ws, p.out, p.in[I_DTB]};
      pg8::gemm_phase<EpiInProj0, pg8::StaticOrder>((PG8_LAS unsigned char*)lds, g, S, E); }
    GSYNC();
    PROBE_AT(2);
    if (TIME_X2 == 3) { CPARAMS& p = get_params(); phase_index(p, lds); }
    if (TIME_X2 == 12) { CPARAMS& p = get_params(); phase_conv(p); }
    { CPARAMS& p = get_params(); phase_conv(p); }
    { CPARAMS& p = get_params(); phase_index(p, lds); }
    GSYNC();
    PROBE_AT(3);
    if (TIME_X2 == 4) { CPARAMS& p = get_params(); phase_attn_dsa(p, lds, dryflag); }
    if (TIME_X2 == 5) { CPARAMS& p = get_params(); phase_ssd(p, lds, dryflag); }
#ifndef PROBE_SKIP_DSA
    { CPARAMS& p = get_params(); phase_attn_dsa(p, lds); }
#endif
#ifndef PROBE_SKIP_SSD
    { CPARAMS& p = get_params(); phase_ssd(p, lds); }
#endif
    GSYNC();
    PROBE_AT(4);
    { CPARAMS& p = get_params(); phase_bnorm(p); }
    GSYNC();
    PROBE_AT(5);
    if (TIME_X2 == 6)
    { CPARAMS& p = get_params(); FResid f{p.in[I_XP], p.in[I_XS], p.out + O_Y}; run_gemm(lds, (const bf16_t*)(p.ws + W_MIX), 3072, (const bf16_t*)(p.ws + W_BTOUT0), MALL, DM, 3072, f); }
    { CPARAMS& p = get_params(); FResid f{p.in[I_XP], p.in[I_XS], p.out + O_Y}; run_gemm(lds, (const bf16_t*)(p.ws + W_MIX), 3072, (const bf16_t*)(p.ws + W_BTOUT0), MALL, DM, 3072, f); }
    GSYNC();
    PROBE_AT(6);
    if (TIME_X2 == 7) { CPARAMS& p = get_params(); phase_ln(p, p.in[I_LN0G], p.in[I_LN0B], (bf16_t*)(p.ws + W_XB), dryflag); }
    { CPARAMS& p = get_params(); phase_ln(p, p.in[I_LN0G], p.in[I_LN0B], (bf16_t*)(p.ws + W_XB)); }
    GSYNC();
    PROBE_AT(7);
    if (TIME_X2 == 8)
    { CPARAMS& p = get_params(); FInProj1 f{p.ws}; run_gemm(lds, (const bf16_t*)(p.ws + W_XB), DM, (const bf16_t*)(p.ws + W_BT1), MALL, NIN1P, DM, f); }
    { CPARAMS& p = get_params(); FInProj1 f{p.ws}; run_gemm(lds, (const bf16_t*)(p.ws + W_XB), DM, (const bf16_t*)(p.ws + W_BT1), MALL, NIN1P, DM, f); }
    GSYNC();
    PROBE_AT(8);
    if (TIME_X2 == 9) { CPARAMS& p = get_params(); phase_post1(p); }
    { CPARAMS& p = get_params(); phase_post1(p); }
    GSYNC();
    PROBE_AT(9);
    if (TIME_X2 == 10)
    { CPARAMS& p = get_params(); FQUp f{p.ws}; run_gemm(lds, (const bf16_t*)(p.ws + W_CQN), 512, (const bf16_t*)(p.ws + W_BTUQ), MALL, 3072, 512, f); }
    { CPARAMS& p = get_params(); FQUp f{p.ws}; run_gemm(lds, (const bf16_t*)(p.ws + W_CQN), 512, (const bf16_t*)(p.ws + W_BTUQ), MALL, 3072, 512, f); }
    { CPARAMS& p = get_params(); FKvUp f{p.ws}; run_gemm(lds, (const bf16_t*)(p.ws + W_LAT), 512, (const bf16_t*)(p.ws + W_BTUKV), LATROWS, 4096, 512, f, true); }
    GSYNC();
    PROBE_AT(10);
    if (TIME_X2 == 11) { CPARAMS& p = get_params(); phase_attn_mla(p, lds, dryflag); }
    { CPARAMS& p = get_params(); phase_attn_mla(p, lds); }
    GSYNC();
    PROBE_AT(11);
    { CPARAMS& p = get_params(); FResid f{p.out + O_Y, p.out + O_Y + (size_t)NP * DM, p.out + O_Y}; run_gemm(lds, (const bf16_t*)(p.ws + W_Q2), 3072, (const bf16_t*)(p.ws + W_BTOUT1), MALL, DM, DM, f); }
    GSYNC();
    PROBE_AT(12);
    { CPARAMS& p = get_params(); phase_ln(p, p.in[I_LN1G], p.in[I_LN1B], nullptr); }
}

extern "C" void kernel_launch(void* const* d_in, const int* in_sizes, int n_in, void* d_out, int out_size, void* d_ws, size_t ws_size, hipStream_t stream) {
    static int grid_blocks = 0;
    if (!grid_blocks) {
        if (n_in != N_IN || (size_t)out_size != O_END || ws_size < W_END) { fprintf(stderr, "kernel_launch: unexpected shapes n_in %d out %d ws %zu\n", n_in, out_size, ws_size); return; }
        if (hipFuncSetAttribute((const void*)fwd_megakernel, hipFuncAttributeMaxDynamicSharedMemorySize, LDS_BYTES) != hipSuccess) { fprintf(stderr, "kernel_launch: LDS attribute failed\n"); return; }
        int dev = 0, cus = 0, per_cu = 0;
        hipGetDevice(&dev); hipDeviceGetAttribute(&cus, hipDeviceAttributeMultiprocessorCount, dev);
        hipOccupancyMaxActiveBlocksPerMultiprocessor(&per_cu, fwd_megakernel, 512, LDS_BYTES);
        if (per_cu < 1) { fprintf(stderr, "kernel_launch: occupancy 0\n"); return; }
        grid_blocks = cus;
    }
    if (hipMemsetAsync((char*)d_ws + W_BAR, 0, 256, stream) != hipSuccess) { fprintf(stderr, "kernel_launch: memset failed\n"); return; }
    Params p{};
    for (int i = 0; i < N_IN; ++i) p.in[i] = (const float*)d_in[i];
    p.out = (float*)d_out; p.ws = (char*)d_ws;
    void* args[] = {&p};
    hipError_t e = hipLaunchCooperativeKernel((const void*)fwd_megakernel, dim3(grid_blocks), dim3(512), args, LDS_BYTES, stream);
    if (e != hipSuccess) fprintf(stderr, "cooperative launch failed: %s (grid %d)\n", hipGetErrorString(e), grid_blocks);
}
```

```cpp
#include <hip/hip_runtime.h>
#include <hip/hip_cooperative_groups.h>
#include <cstdio>
#include <cstdint>
namespace cg = cooperative_groups;

#define LAS __attribute__((address_space(3)))
typedef unsigned short bf16_t;
typedef short bf16x8 __attribute__((ext_vector_type(8)));
typedef short s16x4 __attribute__((ext_vector_type(4)));
typedef float f32x4 __attribute__((ext_vector_type(4)));
typedef float f32x8 __attribute__((ext_vector_type(8)));
typedef float f32x16 __attribute__((ext_vector_type(16)));
typedef unsigned u32x4 __attribute__((ext_vector_type(4)));
typedef unsigned u32x2 __attribute__((ext_vector_type(2)));
typedef unsigned long long u64;

constexpr int DM = 2048, NP = 32768, NS = 512, MALL = NP + NS  , TP = 4096, TS = 64, PAST = 1024, LS = PAST + TS  ;
constexpr int NIN0 = 10352, NIN0P = 10496, NIN1 = 3136, NIN1P = 3328;
constexpr int LATROWS = NP + 8 * LS;
constexpr float ALPHA_RES = 1.4142135623730951f;
constexpr float LOG2E = 1.4426950408889634f;
constexpr float EPSV = 1e-5f;

enum { I_XP = 0, I_XS, I_CAK, I_CAV, I_CAKI, I_SCONV, I_SSSM, I_CLAT, I_CKR, I_T5, I_WIN0, I_WOUT0, I_CONVW, I_CONVB, I_DTB, I_ALOG, I_DSKIP,
       I_SNORM, I_LN0G, I_LN0B, I_WIN1, I_QNW, I_KVNW, I_WUQ, I_WUKV, I_WOUT1, I_LN1G, I_LN1B, N_IN };

constexpr size_t O_Y = 0;
constexpr size_t O_AKP = (size_t)MALL * DM;
constexpr size_t O_AKS = O_AKP + (size_t)NP * 1024;
constexpr size_t O_AVP = O_AKS + (size_t)NS * 1024;
constexpr size_t O_AVS = O_AVP + (size_t)NP * 1024;
constexpr size_t O_KIP = O_AVS + (size_t)NS * 1024;
constexpr size_t O_KIS = O_KIP + (size_t)NP * 64;
constexpr size_t O_BCP = O_KIS + (size_t)NS * 64;
constexpr size_t O_BCS = O_BCP + (size_t)8 * 3 * 3072;
constexpr size_t O_BSP = O_BCS + (size_t)8 * 3 * 3072;
constexpr size_t O_BSS = O_BSP + (size_t)8 * 32 * 64 * 128;
constexpr size_t O_CLP = O_BSS + (size_t)8 * 32 * 64 * 128;
constexpr size_t O_CLS = O_CLP + (size_t)NP * 512;
constexpr size_t O_CKP = O_CLS + (size_t)NS * 512;
constexpr size_t O_CKS = O_CKP + (size_t)NP * 64;
constexpr size_t O_END = O_CKS + (size_t)NS * 64;

constexpr size_t MiB = 1ull << 20;
constexpr size_t W_BT0 = 0;
constexpr size_t W_BTOUT0 = 41 * MiB;
constexpr size_t W_BT1 = 53 * MiB;
constexpr size_t W_BTUQ = 66 * MiB;
constexpr size_t W_BTUKV = 69 * MiB;
constexpr size_t W_BTOUT1 = 73 * MiB;
constexpr size_t W_ROPE = 81 * MiB;
constexpr size_t W_KIDXP = 82 * MiB;
constexpr size_t W_KIDXS = 86 * MiB;
constexpr size_t W_IW = 88 * MiB;
constexpr size_t W_DT = 91 * MiB;
constexpr size_t W_MASKP = 96 * MiB;
constexpr size_t W_MASKS = 112 * MiB;
constexpr size_t W_SSQ = 113 * MiB;
constexpr size_t W_BAR = 118 * MiB;
constexpr size_t W_XB = 120 * MiB;
constexpr size_t W_MIX = 250 * MiB;
constexpr size_t W_KP = 445 * MiB;
constexpr size_t W_KS = 509 * MiB;
constexpr size_t W_VP = 526 * MiB;
constexpr size_t W_VS = 590 * MiB;
constexpr size_t W_SG = 607 * MiB;
constexpr size_t W_IQ = 672 * MiB;
constexpr size_t W_XBC = 737 * MiB;
constexpr size_t W_KVALL = 120 * MiB;
constexpr size_t W_CQKV = 445 * MiB;
constexpr size_t W_CQN = 584 * MiB;
constexpr size_t W_LAT = 617 * MiB;
constexpr size_t W_KR = 658 * MiB;
constexpr size_t W_Q2 = 664 * MiB;
constexpr size_t W_SGATE = 860 * MiB;
constexpr size_t W_XACT = W_XB;
constexpr size_t W_BCACT = 932 * MiB;
constexpr size_t W_END = 997 * MiB;

struct Params { const float* in[N_IN]; float* out; char* ws; };
#define CPARAMS const __attribute__((address_space(4))) Params

constexpr int LDS_BYTES = 131072 + 32768;
#define KRSWZ(row, colB) ((row) * 128 + ((colB) ^ ((((row) >> 1) & 7) << 4)))

typedef __bf16 bf16x2_t __attribute__((ext_vector_type(2)));
typedef float f32x2_t __attribute__((ext_vector_type(2)));
__device__ __forceinline__ unsigned cvtpk(float lo, float hi) { const f32x2_t v = {lo, hi}; const bf16x2_t r = __builtin_convertvector(v, bf16x2_t); return __builtin_bit_cast(unsigned, r); }
__device__ __forceinline__ bf16_t f2bf(float f) { return (bf16_t)(cvtpk(f, f) & 0xffffu); }
__device__ __forceinline__ float bf2f(bf16_t b) { return __uint_as_float(((unsigned)b) << 16); }
__device__ __forceinline__ float silu_f(float v) { return v / (1.f + __expf(-v)); }
__device__ __forceinline__ bf16x8 pack8(const float* x) { u32x4 w = {cvtpk(x[0], x[1]), cvtpk(x[2], x[3]), cvtpk(x[4], x[5]), cvtpk(x[6], x[7])}; return *reinterpret_cast<bf16x8*>(&w); }
__device__ __forceinline__ u32x2 pack4(f32x4 v) { u32x2 w = {cvtpk(v[0], v[1]), cvtpk(v[2], v[3])}; return w; }
__device__ __forceinline__ float wave_sum(float v) {
#pragma unroll
  for (int o = 32; o > 0; o >>= 1) v += __shfl_xor(v, o);
  return v;
}
__device__ __forceinline__ int wave_sum_i(int v) {
#pragma unroll
  for (int o = 32; o > 0; o >>= 1) v += __shfl_xor(v, o);
  return v;
}
__device__ __forceinline__ float row16_sum(float v) {
    v += __builtin_bit_cast(float, __builtin_amdgcn_update_dpp(0, __builtin_bit_cast(int, v), 0xB1, 0xf, 0xf, true));
    v += __builtin_bit_cast(float, __builtin_amdgcn_update_dpp(0, __builtin_bit_cast(int, v), 0x4E, 0xf, 0xf, true));
    v += __builtin_bit_cast(float, __builtin_amdgcn_update_dpp(0, __builtin_bit_cast(int, v), 0x141, 0xf, 0xf, true));
    v += __builtin_bit_cast(float, __builtin_amdgcn_update_dpp(0, __builtin_bit_cast(int, v), 0x140, 0xf, 0xf, true));
    return v;
}
__device__ __forceinline__ float wave_scan_incl(float v, int lane) {
    v += __builtin_bit_cast(float, __builtin_amdgcn_update_dpp(0, __builtin_bit_cast(int, v), 0x111, 0xf, 0xf, false));
    v += __builtin_bit_cast(float, __builtin_amdgcn_update_dpp(0, __builtin_bit_cast(int, v), 0x112, 0xf, 0xf, false));
    v += __builtin_bit_cast(float, __builtin_amdgcn_update_dpp(0, __builtin_bit_cast(int, v), 0x114, 0xf, 0xf, false));
    v += __builtin_bit_cast(float, __builtin_amdgcn_update_dpp(0, __builtin_bit_cast(int, v), 0x118, 0xf, 0xf, false));
    const float t0 = __builtin_bit_cast(float, __builtin_amdgcn_readlane(__builtin_bit_cast(int, v), 15));
    const float t1 = __builtin_bit_cast(float, __builtin_amdgcn_readlane(__builtin_bit_cast(int, v), 31));
    const float t2 = __builtin_bit_cast(float, __builtin_amdgcn_readlane(__builtin_bit_cast(int, v), 47));
    float add = 0.f; if (lane >= 16) add = t0; if (lane >= 32) add = t0 + t1; if (lane >= 48) add = (t0 + t1) + t2;
    return v + add;
}
__device__ __forceinline__ int opaque_tid() { int t = threadIdx.x; asm volatile("" : "+v"(t)); return t; }
__device__ __forceinline__ int wave_sum_dpp(int v) {
    v += __builtin_amdgcn_update_dpp(0, v, 0xB1, 0xf, 0xf, true);
    v += __builtin_amdgcn_update_dpp(0, v, 0x4E, 0xf, 0xf, true);
    v += __builtin_amdgcn_update_dpp(0, v, 0x141, 0xf, 0xf, true);
    v += __builtin_amdgcn_update_dpp(0, v, 0x140, 0xf, 0xf, true);
    return __builtin_amdgcn_readlane(v, 0) + __builtin_amdgcn_readlane(v, 16) + __builtin_amdgcn_readlane(v, 32) + __builtin_amdgcn_readlane(v, 48);
}
__device__ __forceinline__ int latrow_of(int row) { if (row < NP) return row; const int r = row - NP; return NP + (r >> 6) * LS + PAST + (r & 63); }
__device__ __forceinline__ int pos_of(int row) { return row < NP ? (row & (TP - 1)) : PAST + ((row - NP) & 63); }
namespace pg8 {
#define PG8_LAS __attribute__((address_space(3)))
constexpr int BM = 256, BK = 64, HALF = 128, HTB = HALF * BK * 2  , STAGE_BYTES = 8 * HTB, NXCD = 8, WGM = 8;

__host__ __device__ __forceinline__ int lds_byte(int r, int c) { const int st = (r >> 4) * 2 + (c >> 5), rr = r & 15, cc = c & 31, ob = rr * 64 + cc * 2; return st * 1024 + (ob ^ (((ob >> 9) & 1) << 5)); }
__host__ __device__ __forceinline__ void stage_rc(int b, int& R, int& C) { const int st = b / 1024, sb = b % 1024, swz = sb ^ (((sb >> 9) & 1) << 5); R = (st >> 1) * 16 + swz / 64; C = (st & 1) * 32 + (swz % 64) / 2; }
__host__ __device__ __forceinline__ int perm32(int rho) { const int n = rho >> 4, i = rho & 15; return 8 * (i >> 2) + 4 * n + (i & 3); }

struct Unit { int pm, pn; };
struct Gemm { const bf16_t* A; const bf16_t* Bt; int M, N, K, lda; };

struct StaticOrder {
    int nM, nN, nwg, G, c;
    __host__ __device__ void init(int M, int N, int G_, int c_) { nM = M / BM; nN = N / BM; nwg = nM * nN; G = G_; c = c_; }
    __host__ __device__ bool next(int i, Unit& u) const {
        const long L = (long)i * G + c; if (L >= nwg) return false;
        int wgid = (int)L; { const int q = nwg / NXCD, r = nwg % NXCD, xcd = wgid % NXCD, off = wgid / NXCD; wgid = (xcd < r ? xcd * (q + 1) : r * (q + 1) + (xcd - r) * q) + off; }
        const int nig = WGM * nN, gid = wgid / nig, fm = gid * WGM, gsz = (nM - fm) < WGM ? (nM - fm) : WGM;
        u.pm = fm + ((wgid % nig) % gsz); u.pn = (wgid % nig) / gsz; return true;
    }
    __device__ __forceinline__ void a_ready(const Unit&) const {}
    __device__ __forceinline__ void done(const Unit&) const {}
};

template <class Epi, class Sched>
__device__ __forceinline__ void gemm_phase(PG8_LAS unsigned char* lds, const Gemm g, const Sched& S, const Epi& E) {
    constexpr bool STAMP = false; unsigned long long* stamps = nullptr;
    int tid_ = threadIdx.x; asm volatile("" : "+v"(tid_));
    const int tid = tid_, wid = __builtin_amdgcn_readfirstlane(tid >> 6), lane = tid & 63, wr = wid >> 2, wc = wid & 3, fr = lane & 15, fq = lane >> 4;
    const int K = g.K, nt = K / BK;
    int ts_lo = 0, ts_hi = 0, nts = 0; const unsigned long long rt_entry = STAMP ? (unsigned long long)wall_clock64() : 0ull;
#define PG8_STAMP() do { if (STAMP && wid == 0 && nts < 64) { const unsigned long long _c = (unsigned long long)clock64(); \
        ts_lo = (lane == nts) ? (int)(unsigned)_c : ts_lo; ts_hi = (lane == nts) ? (int)(unsigned)(_c >> 32) : ts_hi; ++nts; } } while (0)
    PG8_STAMP();
    unsigned voffA[2], voffB[2];
#pragma unroll
    for (int i = 0; i < 2; ++i) { int R, C; stage_rc(tid * 16 + i * 8192, R, C); const int Rb = Epi::PERM ? ((R & ~31) + perm32(R & 31)) : R;
        voffA[i] = (unsigned)(R * g.lda + C) * 2u; voffB[i] = (unsigned)(Rb * K + C) * 2u; }
    const size_t kstep = (size_t)(BK * 2);
    const size_t hstep = (size_t)HALF * K * 2; const size_t hstepA = (size_t)HALF * g.lda * 2;
    const size_t tstep = 2 * hstep; const size_t tstepA = 2 * hstepA;
    const unsigned ldsw = (unsigned)wid * 1024u;
    const int aoff = lds_byte(wr * 64 + fr, fq * 8), boff = lds_byte(wc * 32 + fr, fq * 8);
#define PG8_SA(b, h) (((b) * 2 + (h)) * HTB)
#define PG8_SB(b, h) ((4 + (b) * 2 + (h)) * HTB)
#define PG8_STAGE(bufoff, gbase, voff) do { _Pragma("unroll") for (int _i = 0; _i < 2; ++_i) \
        __builtin_amdgcn_global_load_lds((const unsigned*)((const char*)(gbase) + (voff)[_i]), (PG8_LAS unsigned*)(lds + (bufoff) + ldsw + _i * 8192), 16, 0, 0); } while (0)
#define PG8_LDA(dst, b, h) do { _Pragma("unroll") for (int m = 0; m < 4; ++m) _Pragma("unroll") for (int k = 0; k < 2; ++k) dst[m][k] = *(const PG8_LAS bf16x8*)(lds + PG8_SA(b, h) + aoff + m * 2048 + k * 1024); } while (0)
#define PG8_LDB(dst, b, h) do { _Pragma("unroll") for (int n = 0; n < 2; ++n) _Pragma("unroll") for (int k = 0; k < 2; ++k) dst[n][k] = *(const PG8_LAS bf16x8*)(lds + PG8_SB(b, h) + boff + n * 2048 + k * 1024); } while (0)
#define PG8_MMA(ai, bj, At, Bt) do { __builtin_amdgcn_s_setprio(1); _Pragma("unroll") for (int m = 0; m < 4; ++m) _Pragma("unroll") for (int n = 0; n < 2; ++n) _Pragma("unroll") for (int k = 0; k < 2; ++k) \
        acc[ai][bj][m][n] = __builtin_amdgcn_mfma_f32_16x16x32_bf16(Bt[n][k], At[m][k], acc[ai][bj][m][n], 0, 0, 0); __builtin_amdgcn_s_setprio(0); } while (0)
#define PG8_WAIT_V(n) asm volatile("s_waitcnt vmcnt(" #n ")" ::: "memory")
#define PG8_WAIT_L(n) asm volatile("s_waitcnt lgkmcnt(" #n ")" ::: "memory")
#define PG8_BAR __builtin_amdgcn_s_barrier()
#define PG8_SCHED __builtin_amdgcn_sched_barrier(0)
    Unit cur, nxt; int ui = 0;
    if (!S.next(0, cur)) return;
    f32x4 acc[2][2][4][2];
#pragma unroll
    for (int a = 0; a < 2; ++a)
#pragma unroll
        for (int b = 0; b < 2; ++b)
#pragma unroll
            for (int m = 0; m < 4; ++m)
#pragma unroll
                for (int n = 0; n < 2; ++n) acc[a][b][m][n] = (f32x4){0.f, 0.f, 0.f, 0.f};
    bf16x8 At[4][2], B0[2][2], B1[2][2];
    const char* cA = (const char*)g.A + (size_t)cur.pm * tstepA; const char* cB = (const char*)g.Bt + (size_t)cur.pn * tstep;
    S.a_ready(cur);
    PG8_STAGE(PG8_SB(0, 0), cB, voffB); PG8_STAGE(PG8_SA(0, 0), cA, voffA); PG8_STAGE(PG8_SB(0, 1), cB + hstep, voffB); PG8_STAGE(PG8_SA(0, 1), cA + hstepA, voffA);
    if (wr == 1) PG8_BAR;
    PG8_WAIT_V(4); PG8_BAR;
    PG8_STAGE(PG8_SB(1, 0), cB + kstep, voffB); PG8_STAGE(PG8_SA(1, 0), cA + kstep, voffA); PG8_STAGE(PG8_SB(1, 1), cB + hstep + kstep, voffB);
    PG8_WAIT_V(6); PG8_BAR;
    PG8_STAMP();
    for (;;) {
        const bool has_next = S.next(ui + 1, nxt);
        const char* nA = has_next ? (const char*)g.A + (size_t)nxt.pm * tstepA : cA; const char* nB = has_next ? (const char*)g.Bt + (size_t)nxt.pn * tstep : cB;
        for (int t = 0; t < nt; t += 2) {
            const bool last = (t == nt - 2);
            const char* a1 = cA + (size_t)(t + 1) * kstep;
            const char* a2 = last ? nA : cA + (size_t)(t + 2) * kstep; const char* b2 = last ? nB : cB + (size_t)(t + 2) * kstep;
            const char* a3 = a2 + kstep; const char* b3 = b2 + kstep;
            if (last && has_next) S.a_ready(nxt);
            PG8_LDB(B0, 0, 0); PG8_SCHED; PG8_LDA(At, 0, 0); PG8_STAGE(PG8_SA(1, 1), a1 + hstepA, voffA);
            PG8_WAIT_L(8); PG8_BAR; PG8_WAIT_L(0); PG8_MMA(0, 0, At, B0); PG8_BAR; PG8_SCHED;
            PG8_LDB(B1, 0, 1); PG8_STAGE(PG8_SB(0, 0), b2, voffB);
            PG8_BAR; PG8_WAIT_L(0); PG8_MMA(0, 1, At, B1); PG8_BAR;
            PG8_LDA(At, 0, 1); PG8_STAGE(PG8_SA(0, 0), a2, voffA);
            PG8_BAR; PG8_WAIT_L(0); PG8_MMA(1, 0, At, B0); PG8_BAR; PG8_SCHED;
            PG8_STAGE(PG8_SB(0, 1), b2 + hstep, voffB);
            PG8_WAIT_V(6); PG8_BAR; PG8_MMA(1, 1, At, B1); PG8_BAR;
            PG8_LDB(B0, 1, 0); PG8_SCHED; PG8_LDA(At, 1, 0); PG8_STAGE(PG8_SA(0, 1), a2 + hstepA, voffA);
            PG8_WAIT_L(8); PG8_BAR; PG8_WAIT_L(0); PG8_MMA(0, 0, At, B0); PG8_BAR; PG8_SCHED;
            PG8_LDB(B1, 1, 1); PG8_STAGE(PG8_SB(1, 0), b3, voffB);
            PG8_BAR; PG8_WAIT_L(0); PG8_MMA(0, 1, At, B1); PG8_BAR;
            PG8_LDA(At, 1, 1); PG8_STAGE(PG8_SA(1, 0), a3, voffA);
            PG8_BAR; PG8_WAIT_L(0); PG8_MMA(1, 0, At, B0); PG8_BAR; PG8_SCHED;
            PG8_STAGE(PG8_SB(1, 1), b3 + hstep, voffB);
            PG8_WAIT_V(6); PG8_BAR; PG8_MMA(1, 1, At, B1); PG8_BAR;
        }
        PG8_STAMP();
        if constexpr (!Epi::AFTER_DRAIN) { E(acc, cur, wr, wc, fr, fq); S.done(cur); }
        PG8_STAMP();
        if (!has_next) break;
#pragma unroll
        for (int a = 0; a < 2; ++a)
#pragma unroll
            for (int b = 0; b < 2; ++b)
#pragma unroll
                for (int m = 0; m < 4; ++m)
#pragma unroll
                    for (int n = 0; n < 2; ++n) acc[a][b][m][n] = (f32x4){0.f, 0.f, 0.f, 0.f};
        cur = nxt; cA = nA; cB = nB; ++ui;
    }
    PG8_WAIT_V(0);
    if (wr == 0) PG8_BAR;
    PG8_BAR;
    if constexpr (Epi::AFTER_DRAIN) { E.fused(acc, cur, wr, wc, fr, fq, lds, wid, lane); S.done(cur); }
    PG8_STAMP();
    if (STAMP && wid == 0) { stamps[lane] = lane < nts ? (((unsigned long long)(unsigned)ts_hi << 32) | (unsigned)ts_lo) : 0ull;
        if (lane == 62) stamps[62] = rt_entry; if (lane == 63) stamps[63] = (unsigned long long)wall_clock64(); }
#undef PG8_STAMP
#undef PG8_SA
#undef PG8_SB
#undef PG8_STAGE
#undef PG8_LDA
#undef PG8_LDB
#undef PG8_MMA
#undef PG8_WAIT_V
#undef PG8_WAIT_L
#undef PG8_BAR
#undef PG8_SCHED
}
}


template <class F> struct EpiGen {
    static constexpr bool PERM = false, AFTER_DRAIN = false;
    F f;
    __device__ __forceinline__ void operator()(const f32x4 (&acc)[2][2][4][2], const pg8::Unit& u, int wr, int wc, int fr, int fq) const {
        int row0 = u.pm * 256 + wr * 64 + fr, col0 = u.pn * 256 + wc * 32 + 4 * fq;
        asm volatile("" : "+v"(row0), "+v"(col0));
#pragma unroll
        for (int ai = 0; ai < 2; ++ai)
#pragma unroll
            for (int m = 0; m < 4; ++m) {
                const int row = row0 + ai * 128 + m * 16;
#pragma unroll
                for (int bj = 0; bj < 2; ++bj)
#pragma unroll
                    for (int n = 0; n < 2; ++n) f(row, col0 + bj * 128 + n * 16, acc[ai][bj][m][n], u.pn);
            }
    }
};

#define EPI_ITER(...) do { int row0_ = row0, col0_ = col0; asm volatile("" : "+v"(row0_), "+v"(col0_)); _Pragma("unroll") for (int ai = 0; ai < 2; ++ai) _Pragma("unroll") for (int m = 0; m < 4; ++m) { const int row = row0_ + ai * 128 + m * 16; \
    _Pragma("unroll") for (int bj = 0; bj < 2; ++bj) _Pragma("unroll") for (int n = 0; n < 2; ++n) { const int col = col0_ + bj * 128 + n * 16; const f32x4 v = acc[ai][bj][m][n]; __VA_ARGS__ } } } while (0)
struct EpiInProj0 {
    static constexpr bool PERM = false, AFTER_DRAIN = false;
    char* ws; float* out; const float* dtb;
    __device__ __forceinline__ void operator()(const f32x4 (&acc)[2][2][4][2], const pg8::Unit& u, int wr, int wc, int fr, int fq) const {
        int row0 = u.pm * 256 + wr * 64 + fr, col0 = u.pn * 256 + wc * 32 + 4 * fq; const int pn = u.pn;
        asm volatile("" : "+v"(row0), "+v"(col0));
        if (pn < 4) {
            EPI_ITER({ *(u32x2*)((bf16_t*)(ws + W_MIX) + (size_t)row * 3072 + col) = pack4(v); });
        } else if (pn < 12) {
            const bool isv = pn >= 8; const int cs = isv ? 2048 : 1024;
            bf16_t* kp = (bf16_t*)(ws + (isv ? W_VP : W_KP)); bf16_t* ks = (bf16_t*)(ws + (isv ? W_VS : W_KS)); float* op = out + (isv ? O_AVP : O_AKP); float* os = out + (isv ? O_AVS : O_AKS);
            EPI_ITER({ const int c = col - cs; bf16_t* kb; float* o;
                if (row < NP) { kb = kp + (size_t)row * 1024 + c; o = op + (size_t)row * 1024 + c; }
                else { const int r = row - NP; kb = ks + ((size_t)(r >> 6) * LS + PAST + (r & 63)) * 1024 + c; o = os + (size_t)r * 1024 + c; }
                *(u32x2*)kb = pack4(v); *(f32x4*)o = v; });
        } else if (pn < 16) {
            EPI_ITER({ f32x4 s = {silu_f(v[0]), silu_f(v[1]), silu_f(v[2]), silu_f(v[3])}; *(u32x2*)((bf16_t*)(ws + W_SG) + (size_t)row * 1024 + (col - 3072)) = pack4(s); });
        } else if (pn < 20) {
            EPI_ITER({ *(u32x2*)((bf16_t*)(ws + W_IQ) + (size_t)row * 1024 + (col - 4096)) = pack4(v); });
        } else if (pn < 28) {
            EPI_ITER({ f32x4 s = {silu_f(v[0]), silu_f(v[1]), silu_f(v[2]), silu_f(v[3])}; *(u32x2*)((bf16_t*)(ws + W_MIX) + (size_t)row * 3072 + 1024 + (col - 5120)) = pack4(s); });
        } else if (pn < 40) {
            EPI_ITER({ const int c = col - 7168;
                *(u32x2*)((bf16_t*)(ws + W_XBC) + (size_t)row * 3072 + c) = pack4(v);
                if (row < NP) { const int t = row & (TP - 1); if (t >= TP - 3) *(f32x4*)(out + O_BCP + ((size_t)(row >> 12) * 3 + (t - (TP - 3))) * 3072 + c) = v; }
                else { const int r = row - NP, t = r & 63; if (t >= TS - 3) *(f32x4*)(out + O_BCS + ((size_t)(r >> 6) * 3 + (t - (TS - 3))) * 3072 + c) = v; } });
        } else {
            int r0 = row0, c0 = col0; asm volatile("" : "+v"(r0), "+v"(c0));
#pragma unroll
            for (int n = 0; n < 2; ++n) {
                const int c = c0 - 10240 + n * 16;
                if (c < 64) {
#pragma unroll
                    for (int ai = 0; ai < 2; ++ai)
#pragma unroll
                        for (int m = 0; m < 4; ++m) { const int row = r0 + ai * 128 + m * 16; const f32x4 v = acc[ai][0][m][n]; bf16_t* kb; float* o;
                            if (row < NP) { kb = (bf16_t*)(ws + W_KIDXP) + (size_t)row * 64 + c; o = out + O_KIP + (size_t)row * 64 + c; }
                            else { const int r = row - NP; kb = (bf16_t*)(ws + W_KIDXS) + ((size_t)(r >> 6) * LS + PAST + (r & 63)) * 64 + c; o = out + O_KIS + (size_t)r * 64 + c; }
                            *(u32x2*)kb = pack4(v); *(f32x4*)o = v; }
                } else if (c < 80) {
#pragma unroll
                    for (int ai = 0; ai < 2; ++ai)
#pragma unroll
                        for (int m = 0; m < 4; ++m) { const int row = r0 + ai * 128 + m * 16; *(f32x4*)((float*)(ws + W_IW) + (size_t)row * 16 + (c - 64)) = acc[ai][0][m][n] * 0.03125f; }
                } else if (c < 112) {
                    const f32x4 db = *(const f32x4*)(dtb + (c - 80));
#pragma unroll
                    for (int ai = 0; ai < 2; ++ai)
#pragma unroll
                        for (int m = 0; m < 4; ++m) { const int row = r0 + ai * 128 + m * 16; const f32x4 v = acc[ai][0][m][n] + db; f32x4 d;
#pragma unroll
                            for (int j = 0; j < 4; ++j) d[j] = v[j] > 20.f ? v[j] : log1pf(__expf(v[j]));
                            *(f32x4*)((float*)(ws + W_DT) + (size_t)row * 32 + (c - 80)) = d; }
                }
            }
        }
    }
};

struct FResid {
    const float* r0; const float* r1; float* y;
    __device__ __forceinline__ void operator()(int row, int col, f32x4 v, int) const {
        const float* rp = row < NP ? r0 + (size_t)row * DM + col : r1 + (size_t)(row - NP) * DM + col;
        const f32x4 x = *(const f32x4*)rp;
        *(f32x4*)(y + (size_t)row * DM + col) = v + x * ALPHA_RES;
    }
};

struct FInProj1 {
    char* ws;
    __device__ __forceinline__ void operator()(int row, int col, f32x4 v, int pn) const {
        if (pn < 4) *(f32x4*)((float*)(ws + W_CQKV) + (size_t)row * 1088 + col) = v;
        else if (pn < 12) { f32x4 s = {silu_f(v[0]), silu_f(v[1]), silu_f(v[2]), silu_f(v[3])}; *(u32x2*)((bf16_t*)(ws + W_SGATE) + (size_t)row * 2048 + (col - 1024)) = pack4(s); }
        else { const int c = col - 3072; if (c < 64) *(f32x4*)((float*)(ws + W_CQKV) + (size_t)row * 1088 + 1024 + c) = v; }
    }
};

struct FQUp {
    char* ws;
    __device__ __forceinline__ void operator()(int row, int col, f32x4 v, int pn) const {
        if (pn >= 8) {
            const int jj = (col - 2048) & 63, i0 = (jj >> 2) * 2, pos = pos_of(row);
            const float2* tab = (const float2*)(ws + W_ROPE) + (size_t)pos * 32 + i0;
            const float2 c0 = tab[0], c1 = tab[1];
            f32x4 o; o[0] = v[0] * c0.x - v[2] * c0.y; o[2] = v[0] * c0.y + v[2] * c0.x; o[1] = v[1] * c1.x - v[3] * c1.y; o[3] = v[1] * c1.y + v[3] * c1.x; v = o;
        }
        *(u32x2*)((bf16_t*)(ws + W_Q2) + (size_t)row * 3072 + col) = pack4(v);
    }
};
struct FKvUp { char* ws; __device__ __forceinline__ void operator()(int row, int col, f32x4 v, int) const { *(u32x2*)((bf16_t*)(ws + W_KVALL) + (size_t)row * 4096 + col) = pack4(v); } };

template <class F> __device__ __forceinline__ void run_gemm(char* lds, const bf16_t* A, int lda, const bf16_t* Bt, int M, int N, int K, const F& f, const bool rev = false) {
    pg8::Gemm g; g.A = A; g.Bt = Bt; g.M = M; g.N = N; g.K = K; g.lda = lda;
    pg8::StaticOrder S; S.init(M, N, (int)gridDim.x, rev ? (int)(gridDim.x - 1 - blockIdx.x) : (int)blockIdx.x);
    EpiGen<F> E{f};
    pg8::gemm_phase<EpiGen<F>, pg8::StaticOrder>((PG8_LAS unsigned char*)lds, g, S, E);
}

__device__ __forceinline__ int orig_col(int w, int n) {
    switch (w) {
    case 0: if (n < 5120) return n; if (n < 7168) return 5200 + (n - 5120); if (n < 10240) return 7248 + (n - 7168); if (n < 10304) return 5120 + (n - 10240);
            if (n < 10320) return 5184 + (n - 10304); if (n < 10352) return n; return -1;
    case 2: if (n < 1024) return n; if (n < 3072) return 1088 + (n - 1024); if (n < 3136) return 1024 + (n - 3072); return -1;
    case 3: if (n < 2048) return (n >> 7) * 192 + (n & 127);
            { const int j = n - 2048, h = j >> 6, jj = j & 63, g4 = jj >> 2, e = jj & 3; return h * 192 + 128 + (e >> 1) * 32 + 2 * g4 + (e & 1); }
    case 4: if (n < 2048) return (n >> 7) * 256 + (n & 127); { const int j = n - 2048; return (j >> 7) * 256 + 128 + (j & 127); }
    default: return n;
    }
}
__device__ __forceinline__ void phase_prep(CPARAMS& p, char* lds) {
    const int tid = opaque_tid();
    {
        bf16_t* tile = (bf16_t*)lds;
        int base = 0;
#pragma unroll 1
        for (int w = 0; w < 6; ++w) {
            int K, N, NPd; const float* W; bf16_t* Bt;
            switch (w) {
            case 0: K = 2048; N = NIN0; NPd = NIN0P; W = p.in[I_WIN0]; Bt = (bf16_t*)(p.ws + W_BT0); break;
            case 1: K = 3072; N = 2048; NPd = 2048; W = p.in[I_WOUT0]; Bt = (bf16_t*)(p.ws + W_BTOUT0); break;
            case 2: K = 2048; N = NIN1; NPd = NIN1P; W = p.in[I_WIN1]; Bt = (bf16_t*)(p.ws + W_BT1); break;
            case 3: K = 512; N = 3072; NPd = 3072; W = p.in[I_WUQ]; Bt = (bf16_t*)(p.ws + W_BTUQ); break;
            case 4: K = 512; N = 4096; NPd = 4096; W = p.in[I_WUKV]; Bt = (bf16_t*)(p.ws + W_BTUKV); break;
            default: K = 2048; N = 2048; NPd = 2048; W = p.in[I_WOUT1]; Bt = (bf16_t*)(p.ws + W_BTOUT1); break;
            }
            const int nkt = K / 64, nnt = NPd / 64, ntiles = nkt * nnt;
            int first = (int)blockIdx.x - (base % (int)gridDim.x); if (first < 0) first += gridDim.x;
            const int nl = tid & 63;
            float cur[8];
            if (first < ntiles) { const int kt = first % nkt, nt = first / nkt, oc = orig_col(w, nt * 64 + nl);
#pragma unroll
                for (int i = 0; i < 8; ++i) { const int k = kt * 64 + i * 8 + (tid >> 6); cur[i] = oc >= 0 ? W[(size_t)k * N + oc] : 0.f; } }
#pragma unroll 1
            for (int tix = first; tix < ntiles; tix += gridDim.x) {
                const int kt = tix % nkt, nt = tix / nkt;
                float nxt[8];
                const int tix2 = tix + (int)gridDim.x;
                if (tix2 < ntiles) { const int kt2 = tix2 % nkt, nt2 = tix2 / nkt, oc2 = orig_col(w, nt2 * 64 + nl);
#pragma unroll
                    for (int i = 0; i < 8; ++i) { const int k = kt2 * 64 + i * 8 + (tid >> 6); nxt[i] = oc2 >= 0 ? W[(size_t)k * N + oc2] : 0.f; } }
                else {
#pragma unroll
                    for (int i = 0; i < 8; ++i) nxt[i] = 0.f; }
#pragma unroll
                for (int i = 0; i < 8; ++i) tile[nl * 66 + i * 8 + (tid >> 6)] = f2bf(cur[i]);
                __syncthreads();
                { const int nr = tid >> 3, ks = (tid & 7) * 8; const unsigned* src = (const unsigned*)(tile + nr * 66 + ks);
                  u32x4 o = {src[0], src[1], src[2], src[3]};
                  *(u32x4*)(Bt + (size_t)(nt * 64 + nr) * K + kt * 64 + ks) = o; }
                __syncthreads();
#pragma unroll
                for (int i = 0; i < 8; ++i) cur[i] = nxt[i];
            }
            base += ntiles;
        }
    }
    const size_t gtid = (size_t)blockIdx.x * 512 + tid, gstride = (size_t)gridDim.x * 512;
    { bf16_t* xb = (bf16_t*)(p.ws + W_XB); const size_t n8p = (size_t)NP * DM / 8, n8 = (size_t)MALL * DM / 8;
      for (size_t i0 = gtid; i0 < n8; i0 += 4 * gstride) {
        f32x4 a[4], b[4];
#pragma unroll
        for (int u = 0; u < 4; ++u) { const size_t i = i0 + u * gstride; if (i < n8) { const float* s = i < n8p ? p.in[I_XP] + i * 8 : p.in[I_XS] + (i - n8p) * 8; a[u] = *(const f32x4*)s; b[u] = *(const f32x4*)(s + 4); } }
#pragma unroll
        for (int u = 0; u < 4; ++u) { const size_t i = i0 + u * gstride; if (i < n8) { const float t[8] = {a[u][0], a[u][1], a[u][2], a[u][3], b[u][0], b[u][1], b[u][2], b[u][3]}; *(bf16x8*)(xb + i * 8) = pack8(t); } }
      } }
    { const size_t n8 = (size_t)8 * PAST * 1024 / 8;
      for (size_t i = gtid; i < 2 * n8; i += gstride) { const bool isv = i >= n8; const size_t j = isv ? i - n8 : i; const float* s = p.in[isv ? I_CAV : I_CAK] + j * 8;
        const size_t e = j * 8, b = e / ((size_t)PAST * 1024), rem = e % ((size_t)PAST * 1024);
        const f32x4 a = *(const f32x4*)s, c = *(const f32x4*)(s + 4); const float t[8] = {a[0], a[1], a[2], a[3], c[0], c[1], c[2], c[3]};
        *(bf16x8*)((bf16_t*)(p.ws + (isv ? W_VS : W_KS)) + b * (size_t)LS * 1024 + rem) = pack8(t); }
      const size_t m8 = (size_t)8 * PAST * 64 / 8;
      for (size_t i = gtid; i < m8; i += gstride) { const float* s = p.in[I_CAKI] + i * 8; const size_t e = i * 8, b = e / ((size_t)PAST * 64), rem = e % ((size_t)PAST * 64);
        const f32x4 a = *(const f32x4*)s, c = *(const f32x4*)(s + 4); const float t[8] = {a[0], a[1], a[2], a[3], c[0], c[1], c[2], c[3]};
        *(bf16x8*)((bf16_t*)(p.ws + W_KIDXS) + b * (size_t)LS * 64 + rem) = pack8(t); } }
    { float2* tab = (float2*)(p.ws + W_ROPE);
      for (size_t i = gtid; i < (size_t)4096 * 32; i += gstride) { const int pos = (int)(i >> 5), f = (int)(i & 31);
        const float inv = powf(10000.f, -(float)f / 32.f), ang = (float)pos * inv; float s, c; sincosf(ang, &s, &c); tab[i] = make_float2(c, s); } }
}

__device__ __forceinline__ void phase_index(CPARAMS& p, char* lds) {
    const int tid = opaque_tid(), wid = tid >> 6, lane = tid & 63, r32 = lane & 31, hi = lane >> 5;
    unsigned* sk = (unsigned*)lds;
    const int NU = 4096 + 64;
#pragma unroll 1
    for (int idx = blockIdx.x; idx < NU; idx += gridDim.x) {
        int b, t0, n, nblk_tot, rowg; const bf16_t* ki; u64* mrow; int ldm; bool sample;
        if (idx < 4096) { const int k = idx >> 8, w = idx & 255; b = k >> 1; const int j = (k & 1) ? 511 - w : w; t0 = j * 8; n = ((t0 >> 6) + 1) * 64; nblk_tot = ((t0 >> 8) + 1) * 4;
            rowg = b * TP + t0; ki = (const bf16_t*)(p.ws + W_KIDXP) + (size_t)b * TP * 64; mrow = (u64*)(p.ws + W_MASKP) + (size_t)rowg * 64; ldm = 64; sample = false; }
        else { const int s = idx - 4096; b = s >> 3; t0 = (s & 7) * 8; n = LS; nblk_tot = 17; rowg = NP + b * 64 + t0;
            ki = (const bf16_t*)(p.ws + W_KIDXS) + (size_t)b * LS * 64; mrow = (u64*)(p.ws + W_MASKS) + (size_t)(b * 64 + t0) * 32; ldm = 32; sample = true; }
        (void)sample;
        if (n <= 256) {
            if (lane < nblk_tot) mrow[(size_t)wid * ldm + lane] = (lane * 64 < n) ? ~0ull : 0ull;
            continue;
        }
        {
            const int pr = wid >> 1, par = wid & 1;
            const int qsel = (r32 >> 2) & 1, head = (r32 & 3) + 4 * (r32 >> 3);
            const bf16_t* qp = (const bf16_t*)(p.ws + W_IQ) + (size_t)(rowg + 2 * pr + qsel) * 1024 + head * 64 + hi * 8;
            bf16x8 qa[4];
#pragma unroll
            for (int s = 0; s < 4; ++s) qa[s] = *(const bf16x8*)(qp + s * 16);
            const float* wp = (const float*)(p.ws + W_IW) + (size_t)(rowg + 2 * pr + hi) * 16;
            float wv[16];
#pragma unroll
            for (int s = 0; s < 4; ++s) { const f32x4 t = *(const f32x4*)(wp + s * 4); wv[s * 4] = t[0]; wv[s * 4 + 1] = t[1]; wv[s * 4 + 2] = t[2]; wv[s * 4 + 3] = t[3]; }
            unsigned* dst = sk + (2 * pr + hi) * 4096 + par * 32 + r32;
            char* kst = lds + 131072;
            const int skey = tid >> 3, scolB = (tid & 7) * 16, ntile = n >> 6, ngrp = (ntile + 3) >> 2;
            const bf16_t* ksrc = ki + (size_t)skey * 64 + (scolB >> 1);
            bf16x8 pre[3][4];
#pragma unroll
            for (int sl = 0; sl < 3; ++sl)
#pragma unroll
                for (int u = 0; u < 4; ++u) { const int t = sl * 4 + u; pre[sl][u] = *(const bf16x8*)(ksrc + (size_t)(t < ntile ? t : 0) * 64 * 64); }
#define IDX_GROUP(SL, G) do { const int g_ = (G); \
                __syncthreads(); \
                _Pragma("unroll") for (int u = 0; u < 4; ++u) *(bf16x8*)(kst + u * 8192 + KRSWZ(skey, scolB)) = pre[SL][u]; \
                _Pragma("unroll") for (int u = 0; u < 4; ++u) { const int t = (g_ + 3) * 4 + u; pre[SL][u] = *(const bf16x8*)(ksrc + (size_t)(t < ntile ? t : 0) * 64 * 64); } \
                __syncthreads(); \
                _Pragma("unroll") for (int u = 0; u < 4; ++u) { const int t = g_ * 4 + u; \
                    if (t < ntile) { f32x16 acc = {}; \
                        _Pragma("unroll") for (int s = 0; s < 4; ++s) { const bf16x8 kf = *(const bf16x8*)(kst + u * 8192 + KRSWZ(par * 32 + r32, (s * 16 + hi * 8) * 2)); acc = __builtin_amdgcn_mfma_f32_32x32x16_bf16(qa[s], kf, acc, 0, 0, 0); } \
                        float sc = 0.f; \
                        _Pragma("unroll") for (int r = 0; r < 16; ++r) sc = fmaf(wv[r], fmaxf(acc[r], 0.f), sc); \
                        sc += 0.f; \
                        const unsigned uu = __float_as_uint(sc); \
                        dst[t * 64] = (uu & 0x80000000u) ? ~uu : (uu | 0x80000000u); } } } while (0)
#pragma unroll 1
            for (int g0 = 0; g0 < ngrp; g0 += 3) {
                IDX_GROUP(0, g0);
                if (g0 + 1 < ngrp) IDX_GROUP(1, g0 + 1);
                if (g0 + 2 < ngrp) IDX_GROUP(2, g0 + 2);
            }
#undef IDX_GROUP
        }
        __syncthreads();
        {
            const unsigned* k = sk + wid * 4096;
            u32x4 kv[16];
#pragma unroll
            for (int j = 0; j < 16; ++j) kv[j] = (j * 256 < n && j * 256 + lane * 4 < n) ? *(const u32x4*)(k + j * 256 + lane * 4) : (u32x4){0u, 0u, 0u, 0u};
            unsigned prefix = 0;
#pragma unroll 1
            for (int bit = 31; bit >= 0; --bit) {
                const unsigned cand = prefix | (1u << bit);
                int cnt = 0;
#pragma unroll
                for (int j = 0; j < 16; ++j) if (j * 256 < n) cnt += (kv[j][0] >= cand) + (kv[j][1] >= cand) + (kv[j][2] >= cand) + (kv[j][3] >= cand);
                cnt = wave_sum_dpp(cnt);
                if (cnt >= 256) { prefix = cand; if (cnt == 256) break; }
            }
            int cgt = 0;
#pragma unroll
            for (int j = 0; j < 16; ++j) if (j * 256 < n) cgt += (kv[j][0] > prefix) + (kv[j][1] > prefix) + (kv[j][2] > prefix) + (kv[j][3] > prefix);
            cgt = wave_sum_dpp(cgt);
            const int need = 256 - cgt; int running = 0;
            u64* mr = mrow + (size_t)wid * ldm;
            const u64 lt = (1ull << lane) - 1ull;
#pragma unroll 1
            for (int blk = 0; blk < nblk_tot; ++blk) {
                u64 word = 0ull;
                if (blk * 64 < n) {
                    const unsigned v = k[blk * 64 + lane];
                    const u64 eqm = __ballot(v == prefix);
                    const int rank = running + __popcll(eqm & lt);
                    const bool sel = (v > prefix) || (v == prefix && rank < need);
                    word = __ballot(sel); running += __popcll(eqm);
                }
                if (lane == 0) mr[blk] = word;
            }
        }
        __syncthreads();
    }
}

#define KSWZ(row, colB) ((row) * 256 + ((colB) ^ (((row) & 7) << 4)))
__device__ __forceinline__ int crow(int r, int hi) { return (r & 3) + 8 * (r >> 2) + 4 * hi; }
__device__ __forceinline__ int v_st(int k, int c) { const int kk = (k & ~0xC) | ((k & 4) << 1) | ((k & 8) >> 1); return ((kk >> 3) * 4 + (c >> 5)) * 512 + ((kk & 7) * 32 + (c & 31)) * 2; }
__device__ __forceinline__ int v_rd_base(int lane) { return ((lane & 3) << 3) | (((lane >> 2) & 3) << 6) | (((lane >> 4) & 1) << 5) | (((lane >> 5) & 1) << 8); }
constexpr int v_rd_off(int d0, int ks, int half) { return d0 * 512 + ks * 4096 + half * 2048; }
template <int OFF> __device__ __forceinline__ s16x4 tr_read(int vb) { s16x4 r; asm volatile("ds_read_b64_tr_b16 %0, %1 offset:%2" : "=&v"(r) : "v"(vb), "i"(OFF) : "memory"); return r; }
template <int D0> __device__ __forceinline__ void pv_one(f32x16& od, int vb, bf16x8 pa0, bf16x8 pa1, bf16x8 pa2, bf16x8 pa3) {
    const s16x4 l0 = tr_read<v_rd_off(D0, 0, 0)>(vb), h0 = tr_read<v_rd_off(D0, 0, 1)>(vb), l1 = tr_read<v_rd_off(D0, 1, 0)>(vb), h1 = tr_read<v_rd_off(D0, 1, 1)>(vb);
    const s16x4 l2 = tr_read<v_rd_off(D0, 2, 0)>(vb), h2 = tr_read<v_rd_off(D0, 2, 1)>(vb), l3 = tr_read<v_rd_off(D0, 3, 0)>(vb), h3 = tr_read<v_rd_off(D0, 3, 1)>(vb);
    asm volatile("s_waitcnt lgkmcnt(0)" ::: "memory"); __builtin_amdgcn_sched_barrier(0);
#define PKV(L, H) (bf16x8){L[0], L[1], L[2], L[3], H[0], H[1], H[2], H[3]}
    od = __builtin_amdgcn_mfma_f32_32x32x16_bf16(pa0, PKV(l0, h0), od, 0, 0, 0);
    od = __builtin_amdgcn_mfma_f32_32x32x16_bf16(pa1, PKV(l1, h1), od, 0, 0, 0);
    od = __builtin_amdgcn_mfma_f32_32x32x16_bf16(pa2, PKV(l2, h2), od, 0, 0, 0);
    od = __builtin_amdgcn_mfma_f32_32x32x16_bf16(pa3, PKV(l3, h3), od, 0, 0, 0);
#undef PKV
}

template <int D0> __device__ __forceinline__ void pv_two(f32x16& oa, f32x16& ob, int vb, bf16x8 pa0, bf16x8 pa1, bf16x8 pa2, bf16x8 pa3) {
    const s16x4 l0 = tr_read<v_rd_off(D0, 0, 0)>(vb), h0 = tr_read<v_rd_off(D0, 0, 1)>(vb), l1 = tr_read<v_rd_off(D0, 1, 0)>(vb), h1 = tr_read<v_rd_off(D0, 1, 1)>(vb);
    const s16x4 l2 = tr_read<v_rd_off(D0, 2, 0)>(vb), h2 = tr_read<v_rd_off(D0, 2, 1)>(vb), l3 = tr_read<v_rd_off(D0, 3, 0)>(vb), h3 = tr_read<v_rd_off(D0, 3, 1)>(vb);
    const s16x4 m0 = tr_read<v_rd_off(D0 + 1, 0, 0)>(vb), g0 = tr_read<v_rd_off(D0 + 1, 0, 1)>(vb), m1 = tr_read<v_rd_off(D0 + 1, 1, 0)>(vb), g1 = tr_read<v_rd_off(D0 + 1, 1, 1)>(vb);
    const s16x4 m2 = tr_read<v_rd_off(D0 + 1, 2, 0)>(vb), g2 = tr_read<v_rd_off(D0 + 1, 2, 1)>(vb), m3 = tr_read<v_rd_off(D0 + 1, 3, 0)>(vb), g3 = tr_read<v_rd_off(D0 + 1, 3, 1)>(vb);
    asm volatile("s_waitcnt lgkmcnt(8)" ::: "memory"); __builtin_amdgcn_sched_barrier(0);
#define PKV(L, H) (bf16x8){L[0], L[1], L[2], L[3], H[0], H[1], H[2], H[3]}
    oa = __builtin_amdgcn_mfma_f32_32x32x16_bf16(pa0, PKV(l0, h0), oa, 0, 0, 0);
    oa = __builtin_amdgcn_mfma_f32_32x32x16_bf16(pa1, PKV(l1, h1), oa, 0, 0, 0);
    oa = __builtin_amdgcn_mfma_f32_32x32x16_bf16(pa2, PKV(l2, h2), oa, 0, 0, 0);
    oa = __builtin_amdgcn_mfma_f32_32x32x16_bf16(pa3, PKV(l3, h3), oa, 0, 0, 0);
    asm volatile("s_waitcnt lgkmcnt(0)" ::: "memory"); __builtin_amdgcn_sched_barrier(0);
    ob = __builtin_amdgcn_mfma_f32_32x32x16_bf16(pa0, PKV(m0, g0), ob, 0, 0, 0);
    ob = __builtin_amdgcn_mfma_f32_32x32x16_bf16(pa1, PKV(m1, g1), ob, 0, 0, 0);
    ob = __builtin_amdgcn_mfma_f32_32x32x16_bf16(pa2, PKV(m2, g2), ob, 0, 0, 0);
    ob = __builtin_amdgcn_mfma_f32_32x32x16_bf16(pa3, PKV(m3, g3), ob, 0, 0, 0);
#undef PKV
}

struct AttnUnit {
    const bf16_t* Q; const bf16_t* Qr; const bf16_t* K; const bf16_t* V; const bf16_t* Kr; bf16_t* O; const bf16_t* G; const u64* M;
    int ldq, ldqr, ldk, ldo, ldg, ldm, nvalid, qpos0, NT, head;
};
constexpr int AT_V = 0, AT_K = 32768, AT_KR = 65536, AT_WS = 81920, AT_TB = 81920 + 2048;

template <int MODE>
__device__ __forceinline__ void attn_unit(const AttnUnit& u, char* lds, const float* t5, const float Cs  , const bool dry = false) {
    const int tid = opaque_tid(), wid = __builtin_amdgcn_readfirstlane(tid >> 6), lane = tid & 63, r32 = lane & 31, hi = lane >> 5;
    float* wsf = (float*)(lds + AT_WS) + wid * 64; float* al_l = wsf; float* li_l = wsf + 32;
    float* tb = (float*)(lds + AT_TB);
    const int rowb = wid * 32 + r32, rowc = rowb < u.nvalid ? rowb : u.nvalid - 1;
    const int wrow0 = (wid * 32 < u.nvalid) ? wid * 32 : u.nvalid - 1;
    const int qc_w = (u.qpos0 + wrow0) >> 6;
    const int qpos = u.qpos0 + rowc;
    constexpr int NQ = MODE == 1 ? 12 : 8;
    bf16x8 qr[NQ];
    { const bf16_t* Qw = u.Q + (size_t)rowc * u.ldq + hi * 8;
#pragma unroll
      for (int d0 = 0; d0 < 8; ++d0) qr[d0] = *(const bf16x8*)(Qw + d0 * 16);
      if constexpr (MODE == 1) { const bf16_t* Qw2 = u.Qr + (size_t)rowc * u.ldqr + hi * 8;
#pragma unroll
        for (int d0 = 0; d0 < 4; ++d0) qr[8 + d0] = *(const bf16x8*)(Qw2 + d0 * 16); } }
    if constexpr (MODE == 0) {
        if (tid < 155) { const int rel = tid - 63, nn = rel < 0 ? -rel : rel;
            const int bk = (rel < 0 ? 16 : 0) + (nn < 8 ? nn : 8 + (nn >= 12) + (nn >= 16) + (nn >= 23) + (nn >= 32) + (nn >= 46) + (nn >= 64) + (nn >= 91));
            tb[tid] = t5[bk * 8 + u.head] * LOG2E; }
    }
    float m_reg = -1e29f, l_reg = 0.f; f32x16 o[4];
#pragma unroll
    for (int d = 0; d < 4; ++d) o[d] = (f32x16){};
    const int vb0 = (int)(uintptr_t)(lds + AT_V) + v_rd_base(lane);
    int koff[2], voff[2], kroff = 0;
#pragma unroll
    for (int i = 0; i < 2; ++i) { const int X = (i * 8 + wid) * 1024 + lane * 16;
        { const int row = X >> 8, colB = (X & 255) ^ ((row & 7) << 4); koff[i] = row * u.ldk + (colB >> 1); }
        { const int sub = X >> 9, y = X & 511, kk = (sub >> 2) * 8 + (y >> 6), k = (kk & ~0xC) | ((kk & 4) << 1) | ((kk & 8) >> 1), c = (sub & 3) * 32 + ((y & 63) >> 1); voff[i] = k * u.ldk + c; } }
    if constexpr (MODE == 1) { const int X = wid * 1024 + lane * 16, row = X >> 7, colB = (X & 127) ^ (((row >> 1) & 7) << 4); kroff = row * 64 + (colB >> 1); }
    LAS char* ldl = (LAS char*)lds;
#define AT_ISSUE(b, k0) do { const bf16_t* kb_ = u.K + (size_t)(k0) * u.ldk; const bf16_t* vb_ = u.V + (size_t)(k0) * u.ldk; \
        _Pragma("unroll") for (int i_ = 0; i_ < 2; ++i_) { \
            __builtin_amdgcn_global_load_lds((const unsigned*)(kb_ + koff[i_]), (LAS unsigned*)(ldl + AT_K + (b) * 16384 + (i_ * 8 + wid) * 1024), 16, 0, 0); \
            __builtin_amdgcn_global_load_lds((const unsigned*)(vb_ + voff[i_]), (LAS unsigned*)(ldl + AT_V + (b) * 16384 + (i_ * 8 + wid) * 1024), 16, 0, 0); } \
        if constexpr (MODE == 1) __builtin_amdgcn_global_load_lds((const unsigned*)(u.Kr + (size_t)(k0) * 64 + kroff), (LAS unsigned*)(ldl + AT_KR + (b) * 8192 + wid * 1024), 16, 0, 0); } while (0)
    AT_ISSUE(0, 0);
    asm volatile("s_waitcnt vmcnt(0)" ::: "memory");
    __syncthreads();
#pragma unroll 1
    for (int j = 0; j < u.NT; ++j) {
        const int cur = j & 1;
        if (j + 1 < u.NT) AT_ISSUE(cur ^ 1, (j + 1) * 64);
        if (j <= qc_w && wid * 32 < u.nvalid) {
            u64 mw = 0;
            if constexpr (MODE == 0) mw = u.M[(size_t)rowc * u.ldm + j];
            f32x16 p0 = {}, p1 = {};
            const char* Ks = lds + AT_K + cur * 16384;
            __builtin_amdgcn_s_setprio(1);
#pragma unroll
            for (int d0 = 0; d0 < 8; ++d0) { const int cb = (d0 * 16 + hi * 8) * 2;
                const bf16x8 b0 = *(const bf16x8*)(Ks + KSWZ(r32, cb)), b1 = *(const bf16x8*)(Ks + KSWZ(32 + r32, cb));
                p0 = __builtin_amdgcn_mfma_f32_32x32x16_bf16(b0, qr[d0], p0, 0, 0, 0); p1 = __builtin_amdgcn_mfma_f32_32x32x16_bf16(b1, qr[d0], p1, 0, 0, 0);
                if ((d0 & 3) == 3) __builtin_amdgcn_sched_barrier(0); }
            if constexpr (MODE == 1) { const char* Krs = lds + AT_KR + cur * 8192;
#pragma unroll
                for (int d0 = 0; d0 < 4; ++d0) { const int cb = (d0 * 16 + hi * 8) * 2;
                    const bf16x8 b0 = *(const bf16x8*)(Krs + KRSWZ(r32, cb)), b1 = *(const bf16x8*)(Krs + KRSWZ(32 + r32, cb));
                    p0 = __builtin_amdgcn_mfma_f32_32x32x16_bf16(b0, qr[8 + d0], p0, 0, 0, 0); p1 = __builtin_amdgcn_mfma_f32_32x32x16_bf16(b1, qr[8 + d0], p1, 0, 0, 0); } }
            __builtin_amdgcn_s_setprio(0);
            float esc = Cs, ebias = 0.f;
            unsigned mlo = 0u, mhi = 0u;
            if constexpr (MODE == 0) {
                mlo = (unsigned)mw >> (4 * hi); mhi = (unsigned)(mw >> 32) >> (4 * hi);
                const int kb = j * 64;
                const bool far = (u.qpos0 + wrow0) - (kb + 63) >= 91;
                if (far) ebias = tb[154];
                else { const int rel0 = qpos - kb - 4 * hi; esc = 1.f;
#pragma unroll
                    for (int r = 0; r < 16; ++r) { const int c0 = crow(r, 0);
                        int i0 = rel0 - c0; i0 = i0 < -63 ? -63 : (i0 > 91 ? 91 : i0); int i1 = rel0 - c0 - 32; i1 = i1 < -63 ? -63 : (i1 > 91 ? 91 : i1);
                        p0[r] = fmaf(p0[r], Cs, tb[i0 + 63]); p1[r] = fmaf(p1[r], Cs, tb[i1 + 63]); }
                }
            }
            float pmax = p0[0];
#pragma unroll
            for (int r = 1; r < 16; ++r) pmax = fmaxf(pmax, p0[r]);
#pragma unroll
            for (int r = 0; r < 16; ++r) pmax = fmaxf(pmax, p1[r]);
            { auto rr = __builtin_amdgcn_permlane32_swap(__float_as_uint(pmax), __float_as_uint(pmax), false, false); pmax = fmaxf(__uint_as_float(rr[0]), __uint_as_float(rr[1])); }
            const float pmax_t = fmaf(pmax, esc, ebias);
            float mn = m_reg, alpha = 1.f;
            const bool grow = !__all(pmax_t - m_reg <= 11.5f);
            if (grow) { mn = fmaxf(m_reg, pmax_t); alpha = __builtin_amdgcn_exp2f(m_reg - mn); m_reg = mn; }
            const float mns = ebias - mn;
            float ps = 0.f;
#pragma unroll
            for (int r = 0; r < 16; ++r) { p0[r] = __builtin_amdgcn_exp2f(fmaf(p0[r], esc, mns)); p1[r] = __builtin_amdgcn_exp2f(fmaf(p1[r], esc, mns)); }
            if constexpr (MODE == 0) {
#pragma unroll
                for (int r = 0; r < 16; ++r) { const int c0 = crow(r, 0);
                    p0[r] = __uint_as_float(__float_as_uint(p0[r]) & (unsigned)((int)(mlo << (31 - c0)) >> 31));
                    p1[r] = __uint_as_float(__float_as_uint(p1[r]) & (unsigned)((int)(mhi << (31 - c0)) >> 31)); }
            }
#pragma unroll
            for (int r = 0; r < 16; ++r) ps += p0[r] + p1[r];
            { auto rr = __builtin_amdgcn_permlane32_swap(__float_as_uint(ps), __float_as_uint(ps), false, false); ps = __uint_as_float(rr[0]) + __uint_as_float(rr[1]); }
            l_reg = l_reg * alpha + ps;
            if (grow) {
                if (hi == 0) al_l[r32] = alpha;
                asm volatile("s_waitcnt lgkmcnt(0)" ::: "memory");
#pragma unroll
                for (int r = 0; r < 16; ++r) { const float a = al_l[crow(r, hi)];
#pragma unroll
                    for (int d = 0; d < 4; ++d) o[d][r] *= a; }
            }
            bf16x8 pa0, pa1, pa2, pa3;
#define PK4(P, BASE, OUT) do { unsigned a0 = cvtpk(P[BASE + 0], P[BASE + 1]), a1 = cvtpk(P[BASE + 2], P[BASE + 3]);   \
    unsigned b0 = cvtpk(P[BASE + 4], P[BASE + 5]), b1 = cvtpk(P[BASE + 6], P[BASE + 7]);                              \
    auto r0 = __builtin_amdgcn_permlane32_swap(a0, b0, false, false); auto r1 = __builtin_amdgcn_permlane32_swap(a1, b1, false, false); \
    u32x4 w = {r0[0], r1[0], r0[1], r1[1]}; OUT = *reinterpret_cast<bf16x8*>(&w); } while (0)
            PK4(p0, 0, pa0); PK4(p0, 8, pa1); PK4(p1, 0, pa2); PK4(p1, 8, pa3);
#undef PK4
            const int vb = vb0 + cur * 16384;
            __builtin_amdgcn_s_setprio(1);
            pv_two<0>(o[0], o[1], vb, pa0, pa1, pa2, pa3); pv_two<2>(o[2], o[3], vb, pa0, pa1, pa2, pa3);
            __builtin_amdgcn_s_setprio(0);
        }
        asm volatile("s_waitcnt vmcnt(0)" ::: "memory");
        __syncthreads();
    }
#undef AT_ISSUE
    if (hi == 0) li_l[r32] = l_reg;
    asm volatile("s_waitcnt lgkmcnt(0)" ::: "memory");
#pragma unroll
    for (int r = 0; r < 16; ++r) {
        const int orow = wid * 32 + crow(r, hi);
        const float rl = __builtin_amdgcn_rcpf(li_l[crow(r, hi)]);
        if (orow < u.nvalid && !dry) {
#pragma unroll
            for (int d0 = 0; d0 < 4; ++d0) { const int c = d0 * 32 + r32;
                const float g = bf2f(u.G[(size_t)orow * u.ldg + c]);
                u.O[(size_t)orow * u.ldo + c] = f2bf(o[d0][r] * rl * g); }
        }
    }
    __syncthreads();
}

__device__ __forceinline__ void phase_attn_dsa(CPARAMS& p, char* lds, const bool dry = false) {
    const float Cs = 0.08838834764831845f * LOG2E;
    const int NU = 1024 + 64;
#pragma unroll 1
    for (int idx = blockIdx.x; idx < NU; idx += gridDim.x) {
        AttnUnit u;
        bf16_t* mix = (bf16_t*)(p.ws + W_MIX);
        if (idx < 1024) { const int k = idx >> 8, w = idx & 255, h = w & 7, qb0 = (w >> 3) & 15, b = (w >> 7) + 2 * k, qb = (k & 1) ? 15 - qb0 : qb0;
            const size_t row0 = (size_t)b * TP + qb * 256;
            u.Q = mix + row0 * 3072 + h * 128; u.O = mix + row0 * 3072 + h * 128; u.G = (const bf16_t*)(p.ws + W_SG) + row0 * 1024 + h * 128;
            u.K = (const bf16_t*)(p.ws + W_KP) + (size_t)b * TP * 1024 + h * 128; u.V = (const bf16_t*)(p.ws + W_VP) + (size_t)b * TP * 1024 + h * 128;
            u.M = (const u64*)(p.ws + W_MASKP) + row0 * 64; u.ldm = 64; u.nvalid = 256; u.qpos0 = qb * 256; u.NT = 4 * (qb + 1); u.head = h;
        } else { const int s = idx - 1024, b = s >> 3, h = s & 7; const size_t row0 = (size_t)NP + b * 64;
            u.Q = mix + row0 * 3072 + h * 128; u.O = mix + row0 * 3072 + h * 128; u.G = (const bf16_t*)(p.ws + W_SG) + row0 * 1024 + h * 128;
            u.K = (const bf16_t*)(p.ws + W_KS) + (size_t)b * LS * 1024 + h * 128; u.V = (const bf16_t*)(p.ws + W_VS) + (size_t)b * LS * 1024 + h * 128;
            u.M = (const u64*)(p.ws + W_MASKS) + (size_t)b * 64 * 32; u.ldm = 32; u.nvalid = 64; u.qpos0 = PAST; u.NT = 17; u.head = h; }
        u.Qr = nullptr; u.Kr = nullptr; u.ldq = 3072; u.ldqr = 0; u.ldk = 1024; u.ldo = 3072; u.ldg = 1024;
        attn_unit<0>(u, lds, p.in[I_T5], Cs, dry);
    }
}
__device__ __forceinline__ void phase_attn_mla(CPARAMS& p, char* lds, const bool dry = false) {
    const float Cs = 0.07216878364870323f * LOG2E;
    const int NU = 2048 + 128;
#pragma unroll 1
    for (int idx = blockIdx.x; idx < NU; idx += gridDim.x) {
        AttnUnit u;
        bf16_t* q2 = (bf16_t*)(p.ws + W_Q2); const bf16_t* kv = (const bf16_t*)(p.ws + W_KVALL); const bf16_t* kr = (const bf16_t*)(p.ws + W_KR);
        size_t row0, lrow0; int h;
        if (idx < 2048) { const int k = idx >> 8, w = idx & 255, qb0 = (w >> 4) & 15, b = k, qb = (k & 1) ? 15 - qb0 : qb0; h = w & 15;
            row0 = (size_t)b * TP + qb * 256; lrow0 = (size_t)b * TP; u.nvalid = 256; u.qpos0 = qb * 256; u.NT = 4 * (qb + 1);
        } else { const int s = idx - 2048, b = s >> 4; h = s & 15; row0 = (size_t)NP + b * 64; lrow0 = (size_t)NP + (size_t)b * LS; u.nvalid = 64; u.qpos0 = PAST; u.NT = 17; }
        u.Q = q2 + row0 * 3072 + h * 128; u.Qr = q2 + row0 * 3072 + 2048 + h * 64; u.O = q2 + row0 * 3072 + h * 128; u.G = (const bf16_t*)(p.ws + W_SGATE) + row0 * 2048 + h * 128;
        u.K = kv + lrow0 * 4096 + h * 128; u.V = kv + lrow0 * 4096 + 2048 + h * 128; u.Kr = kr + lrow0 * 64; u.M = nullptr;
        u.ldq = 3072; u.ldqr = 3072; u.ldk = 4096; u.ldo = 3072; u.ldg = 2048; u.ldm = 0; u.head = h;
        attn_unit<1>(u, lds, nullptr, Cs, dry);
    }
}

__device__ __forceinline__ void phase_conv(CPARAMS& p) {
    const int tid = opaque_tid();
    if (tid < 384) {
        const int ch = tid * 8;
        float cw[4][8], cb[8];
        { const float* cwp = p.in[I_CONVW] + ch; const float* cbp = p.in[I_CONVB] + ch;
#pragma unroll
          for (int j = 0; j < 4; ++j) { const f32x4 a = *(const f32x4*)(cwp + j * 3072), bq = *(const f32x4*)(cwp + j * 3072 + 4);
              cw[j][0] = a[0]; cw[j][1] = a[1]; cw[j][2] = a[2]; cw[j][3] = a[3]; cw[j][4] = bq[0]; cw[j][5] = bq[1]; cw[j][6] = bq[2]; cw[j][7] = bq[3]; }
          const f32x4 a = *(const f32x4*)cbp, bq = *(const f32x4*)(cbp + 4); cb[0] = a[0]; cb[1] = a[1]; cb[2] = a[2]; cb[3] = a[3]; cb[4] = bq[0]; cb[5] = bq[1]; cb[6] = bq[2]; cb[7] = bq[3]; }
        const bf16_t* xbc = (const bf16_t*)(p.ws + W_XBC);
        bf16_t* dst = ch < 2048 ? (bf16_t*)(p.ws + W_XACT) + ch : (bf16_t*)(p.ws + W_BCACT) + (ch - 2048);
        const int dstride = ch < 2048 ? 2048 : 1024;
#pragma unroll 1
        for (int unit = blockIdx.x; unit < MALL / 64; unit += gridDim.x) {
            const size_t row0 = (size_t)unit * 64;
            float w[3][8];
            const bool seqstart = row0 >= NP || (row0 & (TP - 1)) == 0;
            if (seqstart) {
                if (row0 >= NP) { const float* sp = p.in[I_SCONV] + ((row0 - NP) >> 6) * 3 * 3072 + ch;
#pragma unroll
                    for (int j = 0; j < 3; ++j) { const f32x4 a = *(const f32x4*)(sp + j * 3072), bq = *(const f32x4*)(sp + j * 3072 + 4);
                        w[j][0] = a[0]; w[j][1] = a[1]; w[j][2] = a[2]; w[j][3] = a[3]; w[j][4] = bq[0]; w[j][5] = bq[1]; w[j][6] = bq[2]; w[j][7] = bq[3]; } }
                else {
#pragma unroll
                    for (int j = 0; j < 3; ++j)
#pragma unroll
                        for (int e = 0; e < 8; ++e) w[j][e] = 0.f; }
            } else {
#pragma unroll
                for (int j = 0; j < 3; ++j) { const bf16x8 r = *(const bf16x8*)(xbc + (row0 - 3 + j) * 3072 + ch);
#pragma unroll
                    for (int e = 0; e < 8; ++e) w[j][e] = bf2f((bf16_t)r[e]); }
            }
#pragma unroll 1
            for (int r0 = 0; r0 < 64; r0 += 8) {
                bf16x8 raw[8];
#pragma unroll
                for (int r = 0; r < 8; ++r) raw[r] = *(const bf16x8*)(xbc + (row0 + r0 + r) * 3072 + ch);
#pragma unroll
                for (int r = 0; r < 8; ++r) { float o[8];
#pragma unroll
                    for (int e = 0; e < 8; ++e) { const float cur = bf2f((bf16_t)raw[r][e]);
                        o[e] = silu_f(cb[e] + cw[0][e] * w[0][e] + cw[1][e] * w[1][e] + cw[2][e] * w[2][e] + cw[3][e] * cur);
                        w[0][e] = w[1][e]; w[1][e] = w[2][e]; w[2][e] = cur; }
                    *(bf16x8*)(dst + (row0 + r0 + r) * dstride) = pack8(o); }
            }
        }
    }
}

constexpr int SD_XT = 0, SD_BS = 9216, SD_BTT = 26624, SD_CS = 45056, SD_CS2 = 62464, SD_WS = 79872, SD_H0 = 89088, SD_F = 106496;
__device__ __forceinline__ void phase_ssd(CPARAMS& p, char* lds, const bool dry = false) {
    const int tid = opaque_tid(), wid = tid >> 6, lane = tid & 63, l16 = lane & 15, lq = lane >> 4;
    bf16_t* XT = (bf16_t*)(lds + SD_XT); bf16_t* Bs = (bf16_t*)(lds + SD_BS); bf16_t* BTt = (bf16_t*)(lds + SD_BTT); bf16_t* Cs = (bf16_t*)(lds + SD_CS);
    bf16_t* Cs2 = (bf16_t*)(lds + SD_CS2); bf16_t* Ws = (bf16_t*)(lds + SD_WS); bf16_t* H0 = (bf16_t*)(lds + SD_H0);
    float* s_acum = (float*)(lds + SD_F); float* s_dt = s_acum + 64; float* s_ea = s_acum + 128; float* s_tail = s_acum + 192; float* s_ssq = s_acum + 256;
    const bf16_t* xbc = (const bf16_t*)(p.ws + W_XBC); bf16_t* mix = (bf16_t*)(p.ws + W_MIX);
    const float* dtbuf = (const float*)(p.ws + W_DT); float* ssqg = (float*)(p.ws + W_SSQ);
#pragma unroll 1
    for (int idx = blockIdx.x; idx < 512; idx += gridDim.x) {
        const bool sample = idx >= 256; const int bh = idx & 255, b = bh >> 5, h = bh & 31, g = h >> 3;
        const size_t row0 = sample ? (size_t)NP + b * 64 : (size_t)b * TP; const int nch = sample ? 1 : 64;
        const float a_h = -__expf(p.in[I_ALOG][h]), d_h = p.in[I_DSKIP][h];
        f32x4 hacc[4];
        const int pt = wid >> 1;
#pragma unroll
        for (int j = 0; j < 4; ++j) { const int nt = (wid & 1) * 4 + j;
#pragma unroll
            for (int i = 0; i < 4; ++i) { const int pp = pt * 16 + 4 * lq + i, nn = nt * 16 + l16;
                hacc[j][i] = sample ? p.in[I_SSSM][(((size_t)b * 32 + h) * 64 + pp) * 128 + nn] : 0.f;
                H0[pp * 136 + nn] = f2bf(hacc[j][i]); } }
        const int cg8 = tid % 40, rb = tid / 40; const bool ldr = tid < 320;
        const bf16_t* asrc = cg8 < 8 ? (const bf16_t*)(p.ws + W_XACT) + h * 64 + cg8 * 8 : (const bf16_t*)(p.ws + W_BCACT) + (cg8 < 24 ? g * 128 + (cg8 - 8) * 8 : 512 + g * 128 + (cg8 - 24) * 8);
        const size_t astride = cg8 < 8 ? 2048 : 1024;
        bf16x8 av[8];
#pragma unroll
        for (int r = 0; r < 8; ++r) av[r] = ldr ? *(const bf16x8*)(asrc + (row0 + rb * 8 + r) * astride) : (bf16x8){0, 0, 0, 0, 0, 0, 0, 0};
        float dt_next = (wid == 0) ? dtbuf[(row0 + lane) * 32 + h] : 0.f;
        bf16_t szv[2][4];
#pragma unroll
        for (int q = 0; q < 2; ++q) { const int id = wid * 2 + q, mt = id >> 2, nt = id & 3;
#pragma unroll
            for (int i = 0; i < 4; ++i) szv[q][i] = mix[(row0 + mt * 16 + 4 * lq + i) * 3072 + 1024 + h * 64 + nt * 16 + l16]; }
#pragma unroll 1
        for (int c = 0; c < nch; ++c) {
            const size_t crow0 = row0 + (size_t)c * 64;
            if (wid == 0) {
                if (c > 0 && !dry) ssqg[(size_t)h * MALL + (crow0 - 64 + lane)] = (s_ssq[lane] + s_ssq[64 + lane]) + (s_ssq[128 + lane] + s_ssq[192 + lane]);
                const float dtv = dt_next; float ac = dtv * a_h;
                if (c + 1 < nch) dt_next = dtbuf[(crow0 + 64 + lane) * 32 + h];
                ac = wave_scan_incl(ac, lane);
                const float a63 = __builtin_bit_cast(float, __builtin_amdgcn_readlane(__builtin_bit_cast(int, ac), 63));
                s_acum[lane] = ac; s_dt[lane] = dtv; s_ea[lane] = __expf(ac); s_tail[lane] = __expf(a63 - ac) * dtv;
            }
            __syncthreads();
            if (ldr) {
                const int t0l = rb * 8;
#pragma unroll
                for (int hf = 0; hf < 2; ++hf) {
                    float vout[8][4];
#pragma unroll
                    for (int r = 0; r < 8; ++r)
#pragma unroll
                        for (int e = 0; e < 4; ++e) vout[r][e] = bf2f((bf16_t)av[r][hf * 4 + e]);
                    if (cg8 < 8) {
#pragma unroll
                        for (int e = 0; e < 4; ++e) { float t[8];
#pragma unroll
                            for (int r = 0; r < 8; ++r) t[r] = vout[r][e];
                            *(bf16x8*)(XT + (cg8 * 8 + hf * 4 + e) * 72 + t0l) = pack8(t); }
                    } else if (cg8 < 24) {
                        const int n0 = (cg8 - 8) * 8 + hf * 4;
#pragma unroll
                        for (int r = 0; r < 8; ++r) { const f32x4 q = {vout[r][0], vout[r][1], vout[r][2], vout[r][3]}; *(u32x2*)(Bs + (t0l + r) * 136 + n0) = pack4(q); }
                        float tl8[8];
#pragma unroll
                        for (int r = 0; r < 8; ++r) tl8[r] = s_tail[t0l + r];
#pragma unroll
                        for (int e = 0; e < 4; ++e) { float t[8];
#pragma unroll
                            for (int r = 0; r < 8; ++r) t[r] = vout[r][e] * tl8[r];
                            *(bf16x8*)(BTt + (n0 + e) * 72 + t0l) = pack8(t); }
                    } else {
                        const int n0 = (cg8 - 24) * 8 + hf * 4;
#pragma unroll
                        for (int r = 0; r < 8; ++r) { const f32x4 q = {vout[r][0], vout[r][1], vout[r][2], vout[r][3]}; *(u32x2*)(Cs + (t0l + r) * 136 + n0) = pack4(q);
                            const float ea = s_ea[t0l + r]; *(u32x2*)(Cs2 + (t0l + r) * 136 + n0) = pack4(q * ea); }
                    }
                }
                if (c + 1 < nch) {
#pragma unroll
                    for (int r = 0; r < 8; ++r) av[r] = *(const bf16x8*)(asrc + (crow0 + 64 + rb * 8 + r) * astride);
                }
            }
            __syncthreads();
#pragma unroll
            for (int q = 0; q < 2; ++q) { const int id = wid * 2 + q, mt = id >> 2, nt = id & 3;
                f32x4 acc = {0.f, 0.f, 0.f, 0.f};
                if (nt <= mt) {
#pragma unroll
                    for (int ks = 0; ks < 4; ++ks) { const bf16x8 af = *(const bf16x8*)(Cs + (mt * 16 + l16) * 136 + ks * 32 + lq * 8), bf = *(const bf16x8*)(Bs + (nt * 16 + l16) * 136 + ks * 32 + lq * 8);
                        acc = __builtin_amdgcn_mfma_f32_16x16x32_bf16(af, bf, acc, 0, 0, 0); }
                }
                const int s = nt * 16 + l16; const float as = s_acum[s], dts = s_dt[s];
#pragma unroll
                for (int i = 0; i < 4; ++i) { const int t = mt * 16 + 4 * lq + i; const float w = (s <= t) ? acc[i] * __expf(s_acum[t] - as) * dts : 0.f; Ws[t * 72 + s] = f2bf(w); }
            }
            __syncthreads();
#pragma unroll
            for (int q = 0; q < 2; ++q) { const int id = wid * 2 + q, mt = id >> 2, nt = id & 3;
                f32x4 acc = {0.f, 0.f, 0.f, 0.f};
#pragma unroll
                for (int ks = 0; ks < 2; ++ks) { const bf16x8 af = *(const bf16x8*)(Ws + (mt * 16 + l16) * 72 + ks * 32 + lq * 8), bf = *(const bf16x8*)(XT + (nt * 16 + l16) * 72 + ks * 32 + lq * 8);
                    acc = __builtin_amdgcn_mfma_f32_16x16x32_bf16(af, bf, acc, 0, 0, 0); }
#pragma unroll
                for (int ks = 0; ks < 4; ++ks) { const bf16x8 af = *(const bf16x8*)(Cs2 + (mt * 16 + l16) * 136 + ks * 32 + lq * 8), bf = *(const bf16x8*)(H0 + (nt * 16 + l16) * 136 + ks * 32 + lq * 8);
                    acc = __builtin_amdgcn_mfma_f32_16x16x32_bf16(af, bf, acc, 0, 0, 0); }
                const int pp = nt * 16 + l16;
#pragma unroll
                for (int i = 0; i < 4; ++i) { const int t = mt * 16 + 4 * lq + i;
                    const float xv = bf2f(XT[pp * 72 + t]);
                    const float yg = (acc[i] + d_h * xv) * bf2f(szv[q][i]);
                    if (!dry) mix[(crow0 + t) * 3072 + 1024 + h * 64 + pp] = f2bf(yg);
                    float sq = yg * yg;
                    sq = row16_sum(sq);
                    if (l16 == 0) s_ssq[nt * 64 + t] = sq; }
            }
            if (c + 1 < nch) {
#pragma unroll
                for (int q = 0; q < 2; ++q) { const int id = wid * 2 + q, mt = id >> 2, nt = id & 3;
#pragma unroll
                    for (int i = 0; i < 4; ++i) szv[q][i] = mix[(crow0 + 64 + mt * 16 + 4 * lq + i) * 3072 + 1024 + h * 64 + nt * 16 + l16]; } }
            const float e63 = s_ea[63];
            __syncthreads();
#pragma unroll
            for (int j = 0; j < 4; ++j) { const int nt = (wid & 1) * 4 + j;
                f32x4 acc = hacc[j] * e63;
#pragma unroll
                for (int ks = 0; ks < 2; ++ks) { const bf16x8 af = *(const bf16x8*)(XT + (pt * 16 + l16) * 72 + ks * 32 + lq * 8), bf = *(const bf16x8*)(BTt + (nt * 16 + l16) * 72 + ks * 32 + lq * 8);
                    acc = __builtin_amdgcn_mfma_f32_16x16x32_bf16(af, bf, acc, 0, 0, 0); }
                hacc[j] = acc;
#pragma unroll
                for (int i = 0; i < 4; ++i) H0[(pt * 16 + 4 * lq + i) * 136 + nt * 16 + l16] = f2bf(acc[i]);
            }
        }
        __syncthreads();
        if (wid == 0 && !dry) ssqg[(size_t)h * MALL + (row0 + (size_t)(nch - 1) * 64 + lane)] = (s_ssq[lane] + s_ssq[64 + lane]) + (s_ssq[128 + lane] + s_ssq[192 + lane]);
        if (!dry) { float* ho = p.out + (sample ? O_BSS : O_BSP) + ((size_t)b * 32 + h) * 64 * 128;
#pragma unroll
          for (int j = 0; j < 4; ++j) { const int nt = (wid & 1) * 4 + j;
#pragma unroll
              for (int i = 0; i < 4; ++i) ho[(size_t)(pt * 16 + 4 * lq + i) * 128 + nt * 16 + l16] = hacc[j][i]; } }
        __syncthreads();
    }
}

__device__ __forceinline__ void phase_bnorm(CPARAMS& p) {
    bf16_t* mix = (bf16_t*)(p.ws + W_MIX); const float* ssq = (const float*)(p.ws + W_SSQ); const float* nw = p.in[I_SNORM];
    const size_t n = (size_t)MALL * 256, stride = (size_t)gridDim.x * 512;
    const int tidb = opaque_tid();
    for (size_t i0 = (size_t)blockIdx.x * 512 + tidb; i0 < n; i0 += 4 * stride) {
        bf16x8 v[4]; float tot[4];
#pragma unroll
        for (int u = 0; u < 4; ++u) { const size_t i = i0 + u * stride; tot[u] = 0.f; v[u] = (bf16x8){0, 0, 0, 0, 0, 0, 0, 0};
            if (i < n) { const size_t row = i >> 8; const int c0 = (int)(i & 255) * 8, g = c0 >> 9;
                v[u] = *(const bf16x8*)(mix + row * 3072 + 1024 + c0);
#pragma unroll
                for (int hh = 0; hh < 8; ++hh) tot[u] += ssq[(size_t)(g * 8 + hh) * MALL + row]; } }
#pragma unroll
        for (int u = 0; u < 4; ++u) { const size_t i = i0 + u * stride;
            if (i < n) { const size_t row = i >> 8; const int c0 = (int)(i & 255) * 8;
                const float r = rsqrtf(tot[u] * (1.f / 512.f) + EPSV);
                const f32x4 w0 = *(const f32x4*)(nw + c0), w1 = *(const f32x4*)(nw + c0 + 4);
                float t[8];
#pragma unroll
                for (int e2 = 0; e2 < 8; ++e2) t[e2] = bf2f((bf16_t)v[u][e2]) * r * (e2 < 4 ? w0[e2] : w1[e2 - 4]);
                *(bf16x8*)(mix + row * 3072 + 1024 + c0) = pack8(t); } }
    }
}
__device__ __forceinline__ void phase_ln(CPARAMS& p, const float* gw, const float* bw, bf16_t* yb, const bool dry = false) {
    int tid_ = threadIdx.x; asm volatile("" : "+v"(tid_));
    const int wid = tid_ >> 6, lane = tid_ & 63;
    float* y = p.out + O_Y;
    for (int row = blockIdx.x * 8 + wid; row < MALL; row += gridDim.x * 8) {
        float* rp = y + (size_t)row * DM;
        f32x4 v[8]; float s = 0.f;
#pragma unroll
        for (int j = 0; j < 8; ++j) { v[j] = *(const f32x4*)(rp + j * 256 + lane * 4); s += v[j][0] + v[j][1] + v[j][2] + v[j][3]; }
        const float mu = wave_sum(s) * (1.f / DM);
        float q = 0.f;
#pragma unroll
        for (int j = 0; j < 8; ++j) { v[j] = v[j] - mu; q += v[j][0] * v[j][0] + v[j][1] * v[j][1] + v[j][2] * v[j][2] + v[j][3] * v[j][3]; }
        const float rs = rsqrtf(wave_sum(q) * (1.f / DM) + EPSV);
#pragma unroll
        for (int j = 0; j < 8; ++j) { const int c = j * 256 + lane * 4; const f32x4 gg = *(const f32x4*)(gw + c), bb = *(const f32x4*)(bw + c);
            const f32x4 o = v[j] * rs * gg + bb; if (!dry) { *(f32x4*)(rp + c) = o; if (yb) *(u32x2*)(yb + (size_t)row * DM + c) = pack4(o); } else if (o[0] == 1.2345e30f) rp[c] = 0.f; }
    }
}
__device__ __forceinline__ void phase_post1(CPARAMS& p) {
    const int tidp = opaque_tid(); const int wid = tidp >> 6, lane = tidp & 63;
    const float* cqkv = (const float*)(p.ws + W_CQKV); bf16_t* cqn = (bf16_t*)(p.ws + W_CQN); bf16_t* lat = (bf16_t*)(p.ws + W_LAT); bf16_t* krb = (bf16_t*)(p.ws + W_KR);
    const float2* tab = (const float2*)(p.ws + W_ROPE);
    for (int row = blockIdx.x * 8 + wid; row < MALL; row += gridDim.x * 8) {
        const float* rp = cqkv + (size_t)row * 1088;
        const f32x4 a0 = *(const f32x4*)(rp + lane * 8), a1 = *(const f32x4*)(rp + lane * 8 + 4), c0 = *(const f32x4*)(rp + 512 + lane * 8), c1 = *(const f32x4*)(rp + 512 + lane * 8 + 4);
        const float kv = rp[1024 + lane];
        float sa = 0.f, sc = 0.f;
#pragma unroll
        for (int e = 0; e < 4; ++e) { sa += a0[e] * a0[e] + a1[e] * a1[e]; sc += c0[e] * c0[e] + c1[e] * c1[e]; }
        const float ra = rsqrtf(wave_sum(sa) * (1.f / 512.f) + EPSV), rc = rsqrtf(wave_sum(sc) * (1.f / 512.f) + EPSV);
        const f32x4 qw0 = *(const f32x4*)(p.in[I_QNW] + lane * 8), qw1 = *(const f32x4*)(p.in[I_QNW] + lane * 8 + 4), kw0 = *(const f32x4*)(p.in[I_KVNW] + lane * 8), kw1 = *(const f32x4*)(p.in[I_KVNW] + lane * 8 + 4);
        const f32x4 qa = a0 * ra * qw0, qb = a1 * ra * qw1, la = c0 * rc * kw0, lb = c1 * rc * kw1;
        { const float t[8] = {qa[0], qa[1], qa[2], qa[3], qb[0], qb[1], qb[2], qb[3]}; *(bf16x8*)(cqn + (size_t)row * 512 + lane * 8) = pack8(t); }
        const int lr = latrow_of(row);
        { const float t[8] = {la[0], la[1], la[2], la[3], lb[0], lb[1], lb[2], lb[3]}; *(bf16x8*)(lat + (size_t)lr * 512 + lane * 8) = pack8(t); }
        float* clo = row < NP ? p.out + O_CLP + (size_t)row * 512 : p.out + O_CLS + (size_t)(row - NP) * 512;
        *(f32x4*)(clo + lane * 8) = la; *(f32x4*)(clo + lane * 8 + 4) = lb;
        const float other = __shfl_xor(kv, 32);
        const int i = lane & 31, pos = pos_of(row); const float2 cs = tab[(size_t)pos * 32 + i];
        const float o = lane < 32 ? kv * cs.x - other * cs.y : other * cs.y + kv * cs.x;
        float* cko = row < NP ? p.out + O_CKP + (size_t)row * 64 : p.out + O_CKS + (size_t)(row - NP) * 64;
        cko[lane] = o;
        krb[(size_t)lr * 64 + 4 * (i >> 1) + (i & 1) + (lane >= 32 ? 2 : 0)] = f2bf(o);
    }
    const size_t gtid = (size_t)blockIdx.x * 512 + tidp, gstride = (size_t)gridDim.x * 512;
    { const size_t n8 = (size_t)8 * PAST * 512 / 8;
      for (size_t i = gtid; i < n8; i += gstride) { const size_t e = i * 8, b = e / ((size_t)PAST * 512), rem = e % ((size_t)PAST * 512); const float* s = p.in[I_CLAT] + e;
        const f32x4 a = *(const f32x4*)s, c = *(const f32x4*)(s + 4); const float t[8] = {a[0], a[1], a[2], a[3], c[0], c[1], c[2], c[3]};
        *(bf16x8*)(lat + ((size_t)NP + b * LS) * 512 + rem) = pack8(t); } }
    { const size_t n = (size_t)8 * PAST * 64;
      for (size_t e = gtid; e < n; e += gstride) { const size_t b = e / ((size_t)PAST * 64), rem = e % ((size_t)PAST * 64), t = rem >> 6; const int j = (int)(rem & 63), i = j & 31;
        krb[((size_t)NP + b * LS + t) * 64 + 4 * (i >> 1) + (i & 1) + (j >= 32 ? 2 : 0)] = f2bf(p.in[I_CKR][e]); } }
}

__device__ __forceinline__ CPARAMS& get_params() {
    const unsigned long long v = (unsigned long long)__builtin_amdgcn_kernarg_segment_ptr(); unsigned lo = (unsigned)v, hi = (unsigned)(v >> 32);
    asm volatile("" : "+s"(lo), "+s"(hi));
    lo = __builtin_amdgcn_readfirstlane(lo); hi = __builtin_amdgcn_readfirstlane(hi);
    return *(CPARAMS*)(((unsigned long long)hi << 32) | lo);
}
#ifndef PROBE_STOP
#define PROBE_STOP 0
#endif
__device__ __forceinline__ void phase_dump(CPARAMS& p) {
    const unsigned short* w = (const unsigned short*)p.ws; float* y = p.out + O_Y; const size_t n = (size_t)MALL * DM;
#ifdef PROBE_THRASH
    { const f32x4* xs = (const f32x4*)p.in[I_XP] + (size_t)((blockIdx.x >> 3) & 31) * (NP * (size_t)DM / 4 / 32); f32x4 a = {0.f, 0.f, 0.f, 0.f};
      for (size_t i = threadIdx.x; i < NP * (size_t)DM / 4 / 32; i += 512) a += xs[i];
      if (a[0] + a[1] + a[2] + a[3] == 1.2345e30f) y[0] = 1.f;
      __syncthreads(); __threadfence(); }
    cg::this_grid().sync(); __threadfence();
#endif
    for (size_t i = (size_t)blockIdx.x * 512 + threadIdx.x; i < n; i += (size_t)gridDim.x * 512) {
        unsigned h = 0x12345u;
#pragma unroll
        for (int r = 0; r < 8; ++r) { const size_t o = (size_t)r * n + i; const unsigned v = (o * 2 < W_END) ? w[o] : 0u; h = (h ^ v) * 0x9E3779B1u; }
        h ^= h >> 15; y[i] = (float)((h >> 8) & 127u);
    }
}
#define PROBE_AT(k) do { if (PROBE_STOP == (k)) { CPARAMS& pq = get_params(); phase_dump(pq); return; } } while (0)
__global__ void __launch_bounds__(512) fwd_megakernel(Params p_unused) {
    extern __shared__ __attribute__((aligned(16))) char lds[];
    cg::grid_group grid = cg::this_grid();
#ifndef TIME_X2
#define TIME_X2 0
#endif
    const bool dryflag = get_params().ws != nullptr;
    unsigned nbar = 0;
#define GSYNC_CG() do { __builtin_amdgcn_fence(__ATOMIC_RELEASE, "agent"); asm volatile("s_waitcnt vmcnt(0)" ::: "memory"); grid.sync(); __builtin_amdgcn_fence(__ATOMIC_ACQUIRE, "agent"); } while (0)
#define GSYNC() do { ++nbar; asm volatile("s_waitcnt vmcnt(0)" ::: "memory"); __syncthreads(); \
        if (threadIdx.x == 0) { unsigned* ctr_ = (unsigned*)(get_params().ws + W_BAR); const unsigned tgt_ = nbar * gridDim.x; \
            __builtin_amdgcn_fence(__ATOMIC_RELEASE, "agent"); asm volatile("s_waitcnt vmcnt(0)" ::: "memory"); \
            __hip_atomic_fetch_add(ctr_, 1u, __ATOMIC_RELAXED, __HIP_MEMORY_SCOPE_AGENT); \
            while (__hip_atomic_load(ctr_, __ATOMIC_RELAXED, __HIP_MEMORY_SCOPE_AGENT) < tgt_) __builtin_amdgcn_s_sleep(1); \
            __builtin_amdgcn_fence(__ATOMIC_ACQUIRE, "agent"); asm volatile("s_waitcnt vmcnt(0)" ::: "memory"); } \
        __syncthreads(); } while (0)
    if (TIME_X2 == 1) { CPARAMS& p = get_params(); phase_prep(p, lds); __syncthreads(); }
    { CPARAMS& p = get_params(); phase_prep(p, lds); }
    if (__builtin_expect(get_params().ws == nullptr, 0)) GSYNC_CG();
    GSYNC();
    PROBE_AT(1);
    if (TIME_X2 == 2)
    { CPARAMS& p = get_params(); pg8::Gemm g; g.A = (const bf16_t*)(p.ws + W_XB); g.Bt = (const bf16_t*)(p.ws + W_BT0); g.M = MALL; g.N = NIN0P; g.K = DM; g.lda = DM;
      pg8::StaticOrder S; S.init(MALL, NIN0P, (int)gridDim.x, (int)blockIdx.x); EpiInProj0 E{p.ws, p.out, p.in[I_DTB]};
      pg8::gemm_phase<EpiInProj0, pg8::StaticOrder>((PG8_LAS unsigned char*)lds, g, S, E); }
    { CPARAMS& p = get_params(); pg8::Gemm g; g.A = (const bf16_t*)(p.ws + W_XB); g.Bt = (const bf16_t*)(p.ws + W_BT0); g.M = MALL; g.N = NIN0P; g.K = DM; g.lda = DM;
      pg8::StaticOrder S; S.init(MALL, NIN0P, (int)gridDim.x, (int)blockIdx.x); EpiInProj0 E{p.ws, p.out, p.in[I_DTB]};
      pg8::gemm_phase<EpiInProj0, pg8::StaticOrder>((PG8_LAS unsigned char*)lds, g, S, E); }
    GSYNC();
    PROBE_AT(2);
    if (TIME_X2 == 3) { CPARAMS& p = get_params(); phase_index(p, lds); }
    if (TIME_X2 == 12) { CPARAMS& p = get_params(); phase_conv(p); }
    { CPARAMS& p = get_params(); phase_conv(p); }
    { CPARAMS& p = get_params(); phase_index(p, lds); }
    GSYNC();
    PROBE_AT(3);
    if (TIME_X2 == 4) { CPARAMS& p = get_params(); phase_attn_dsa(p, lds, dryflag); }
    if (TIME_X2 == 5) { CPARAMS& p = get_params(); phase_ssd(p, lds, dryflag); }
#ifndef PROBE_SKIP_DSA
    { CPARAMS& p = get_params(); phase_attn_dsa(p, lds); }
#endif
#ifndef PROBE_SKIP_SSD
    { CPARAMS& p = get_params(); phase_ssd(p, lds); }
#endif
    GSYNC();
    PROBE_AT(4);
    { CPARAMS& p = get_params(); phase_bnorm(p); }
    GSYNC();
    PROBE_AT(5);
    if (TIME_X2 == 6)
    { CPARAMS& p = get_params(); FResid f{p.in[I_XP], p.in[I_XS], p.out + O_Y}; run_gemm(lds, (const bf16_t*)(p.ws + W_MIX), 3072, (const bf16_t*)(p.ws + W_BTOUT0), MALL, DM, 3072, f); }
    { CPARAMS& p = get_params(); FResid f{p.in[I_XP], p.in[I_XS], p.out + O_Y}; run_gemm(lds, (const bf16_t*)(p.ws + W_MIX), 3072, (const bf16_t*)(p.ws + W_BTOUT0), MALL, DM, 3072, f); }
    GSYNC();
    PROBE_AT(6);
    if (TIME_X2 == 7) { CPARAMS& p = get_params(); phase_ln(p, p.in[I_LN0G], p.in[I_LN0B], (bf16_t*)(p.ws + W_XB), dryflag); }
    { CPARAMS& p = get_params(); phase_ln(p, p.in[I_LN0G], p.in[I_LN0B], (bf16_t*)(p.ws + W_XB)); }
    GSYNC();
    PROBE_AT(7);
    if (TIME_X2 == 8)
    { CPARAMS& p = get_params(); FInProj1 f{p.ws}; run_gemm(lds, (const bf16_t*)(p.ws + W_XB), DM, (const bf16_t*)(p.ws + W_BT1), MALL, NIN1P, DM, f); }
    { CPARAMS& p = get_params(); FInProj1 f{p.ws}; run_gemm(lds, (const bf16_t*)(p.ws + W_XB), DM, (const bf16_t*)(p.ws + W_BT1), MALL, NIN1P, DM, f); }
    GSYNC();
    PROBE_AT(8);
    if (TIME_X2 == 9) { CPARAMS& p = get_params(); phase_post1(p); }
    { CPARAMS& p = get_params(); phase_post1(p); }
    GSYNC();
    PROBE_AT(9);
    if (TIME_X2 == 10)
    { CPARAMS& p = get_params(); FQUp f{p.ws}; run_gemm(lds, (const bf16_t*)(p.ws + W_CQN), 512, (const bf16_t*)(p.ws + W_BTUQ), MALL, 3072, 512, f); }
    { CPARAMS& p = get_params(); FQUp f{p.ws}; run_gemm(lds, (const bf16_t*)(p.ws + W_CQN), 512, (const bf16_t*)(p.ws + W_BTUQ), MALL, 3072, 512, f); }
    { CPARAMS& p = get_params(); FKvUp f{p.ws}; run_gemm(lds, (const bf16_t*)(p.ws + W_LAT), 512, (const bf16_t*)(p.ws + W_BTUKV), LATROWS, 4096, 512, f, true); }
    GSYNC();
    PROBE_AT(10);
    if (TIME_X2 == 11) { CPARAMS& p = get_params(); phase_attn_mla(p, lds, dryflag); }
    { CPARAMS& p = get_params(); phase_attn_mla(p, lds); }
    GSYNC();
    PROBE_AT(11);
    { CPARAMS& p = get_params(); FResid f{p.out + O_Y, p.out + O_Y + (size_t)NP * DM, p.out + O_Y}; run_gemm(lds, (const bf16_t*)(p.ws + W_Q2), 3072, (const bf16_t*)(p.ws + W_BTOUT1), MALL, DM, DM, f); }
    GSYNC();
    PROBE_AT(12);
    { CPARAMS& p = get_params(); phase_ln(p, p.in[I_LN1G], p.in[I_LN1B], nullptr); }
}

extern "C" void kernel_launch(void* const* d_in, const int* in_sizes, int n_in, void* d_out, int out_size, void* d_ws, size_t ws_size, hipStream_t stream) {
    static int grid_blocks = 0;
    if (!grid_blocks) {
        if (n_in != N_IN || (size_t)out_size != O_END || ws_size < W_END) { fprintf(stderr, "kernel_launch: unexpected shapes n_in %d out %d ws %zu\n", n_in, out_size, ws_size); return; }
        if (hipFuncSetAttribute((const void*)fwd_megakernel, hipFuncAttributeMaxDynamicSharedMemorySize, LDS_BYTES) != hipSuccess) { fprintf(stderr, "kernel_launch: LDS attribute failed\n"); return; }
        int dev = 0, cus = 0, per_cu = 0;
        hipGetDevice(&dev); hipDeviceGetAttribute(&cus, hipDeviceAttributeMultiprocessorCount, dev);
        hipOccupancyMaxActiveBlocksPerMultiprocessor(&per_cu, fwd_megakernel, 512, LDS_BYTES);
        if (per_cu < 1) { fprintf(stderr, "kernel_launch: occupancy 0\n"); return; }
        grid_blocks = cus;
    }
    if (hipMemsetAsync((char*)d_ws + W_BAR, 0, 256, stream) != hipSuccess) { fprintf(stderr, "kernel_launch: memset failed\n"); return; }
    Params p{};
    for (int i = 0; i < N_IN; ++i) p.in[i] = (const float*)d_in[i];
    p.out = (float*)d_out; p.ws = (char*)d_ws;
    void* args[] = {&p};
    hipError_t e = hipLaunchCooperativeKernel((const void*)fwd_megakernel, dim3(grid_blocks), dim3(512), args, LDS_BYTES, stream);
    if (e != hipSuccess) fprintf(stderr, "cooperative launch failed: %s (grid %d)\n", hipGetErrorString(e), grid_blocks);
}
```

```cpp
#include <hip/hip_runtime.h>
#include <hip/hip_cooperative_groups.h>
#include <cstdio>
#include <cstdint>
namespace cg = cooperative_groups;

#define LAS __attribute__((address_space(3)))
typedef unsigned short bf16_t;
typedef short bf16x8 __attribute__((ext_vector_type(8)));
typedef short s16x4 __attribute__((ext_vector_type(4)));
typedef float f32x4 __attribute__((ext_vector_type(4)));
typedef float f32x8 __attribute__((ext_vector_type(8)));
typedef float f32x16 __attribute__((ext_vector_type(16)));
typedef unsigned u32x4 __attribute__((ext_vector_type(4)));
typedef unsigned u32x2 __attribute__((ext_vector_type(2)));
typedef unsigned long long u64;

constexpr int DM = 2048, NP = 32768, NS = 512, MALL = NP + NS  , TP = 4096, TS = 64, PAST = 1024, LS = PAST + TS  ;
constexpr int NIN0 = 10352, NIN0P = 10496, NIN1 = 3136, NIN1P = 3328;
constexpr int LATROWS = NP + 8 * LS;
constexpr float ALPHA_RES = 1.4142135623730951f;
constexpr float LOG2E = 1.4426950408889634f;
constexpr float EPSV = 1e-5f;

enum { I_XP = 0, I_XS, I_CAK, I_CAV, I_CAKI, I_SCONV, I_SSSM, I_CLAT, I_CKR, I_T5, I_WIN0, I_WOUT0, I_CONVW, I_CONVB, I_DTB, I_ALOG, I_DSKIP,
       I_SNORM, I_LN0G, I_LN0B, I_WIN1, I_QNW, I_KVNW, I_WUQ, I_WUKV, I_WOUT1, I_LN1G, I_LN1B, N_IN };

constexpr size_t O_Y = 0;
constexpr size_t O_AKP = (size_t)MALL * DM;
constexpr size_t O_AKS = O_AKP + (size_t)NP * 1024;
constexpr size_t O_AVP = O_AKS + (size_t)NS * 1024;
constexpr size_t O_AVS = O_AVP + (size_t)NP * 1024;
constexpr size_t O_KIP = O_AVS + (size_t)NS * 1024;
constexpr size_t O_KIS = O_KIP + (size_t)NP * 64;
constexpr size_t O_BCP = O_KIS + (size_t)NS * 64;
constexpr size_t O_BCS = O_BCP + (size_t)8 * 3 * 3072;
constexpr size_t O_BSP = O_BCS + (size_t)8 * 3 * 3072;
constexpr size_t O_BSS = O_BSP + (size_t)8 * 32 * 64 * 128;
constexpr size_t O_CLP = O_BSS + (size_t)8 * 32 * 64 * 128;
constexpr size_t O_CLS = O_CLP + (size_t)NP * 512;
constexpr size_t O_CKP = O_CLS + (size_t)NS * 512;
constexpr size_t O_CKS = O_CKP + (size_t)NP * 64;
constexpr size_t O_END = O_CKS + (size_t)NS * 64;

constexpr size_t MiB = 1ull << 20;
constexpr size_t W_BT0 = 0;
constexpr size_t W_BTOUT0 = 41 * MiB;
constexpr size_t W_BT1 = 53 * MiB;
constexpr size_t W_BTUQ = 66 * MiB;
constexpr size_t W_BTUKV = 69 * MiB;
constexpr size_t W_BTOUT1 = 73 * MiB;
constexpr size_t W_ROPE = 81 * MiB;
constexpr size_t W_KIDXP = 82 * MiB;
constexpr size_t W_KIDXS = 86 * MiB;
constexpr size_t W_IW = 88 * MiB;
constexpr size_t W_DT = 91 * MiB;
constexpr size_t W_MASKP = 96 * MiB;
constexpr size_t W_MASKS = 112 * MiB;
constexpr size_t W_SSQ = 113 * MiB;
constexpr size_t W_BAR = 118 * MiB;
constexpr size_t W_XB = 120 * MiB;
constexpr size_t W_MIX = 250 * MiB;
constexpr size_t W_KP = 445 * MiB;
constexpr size_t W_KS = 509 * MiB;
constexpr size_t W_VP = 526 * MiB;
constexpr size_t W_VS = 590 * MiB;
constexpr size_t W_SG = 607 * MiB;
constexpr size_t W_IQ = 672 * MiB;
constexpr size_t W_XBC = 737 * MiB;
constexpr size_t W_KVALL = 120 * MiB;
constexpr size_t W_CQKV = 445 * MiB;
constexpr size_t W_CQN = 584 * MiB;
constexpr size_t W_LAT = 617 * MiB;
constexpr size_t W_KR = 658 * MiB;
constexpr size_t W_Q2 = 664 * MiB;
constexpr size_t W_SGATE = 860 * MiB;
constexpr size_t W_XACT = W_XB;
constexpr size_t W_BCACT = 932 * MiB;
constexpr size_t W_END = 997 * MiB;

struct Params { const float* in[N_IN]; float* out; char* ws; };
#define CPARAMS const __attribute__((address_space(4))) Params

constexpr int LDS_BYTES = 131072 + 32768;
#define KRSWZ(row, colB) ((row) * 128 + ((colB) ^ ((((row) >> 1) & 7) << 4)))

typedef __bf16 bf16x2_t __attribute__((ext_vector_type(2)));
typedef float f32x2_t __attribute__((ext_vector_type(2)));
__device__ __forceinline__ unsigned cvtpk(float lo, float hi) { const f32x2_t v = {lo, hi}; const bf16x2_t r = __builtin_convertvector(v, bf16x2_t); return __builtin_bit_cast(unsigned, r); }
__device__ __forceinline__ bf16_t f2bf(float f) { return (bf16_t)(cvtpk(f, f) & 0xffffu); }
__device__ __forceinline__ float bf2f(bf16_t b) { return __uint_as_float(((unsigned)b) << 16); }
__device__ __forceinline__ float silu_f(float v) { return v * __builtin_amdgcn_rcpf(1.f + __expf(-v)); }
__device__ __forceinline__ bf16x8 pack8(const float* x) { u32x4 w = {cvtpk(x[0], x[1]), cvtpk(x[2], x[3]), cvtpk(x[4], x[5]), cvtpk(x[6], x[7])}; return *reinterpret_cast<bf16x8*>(&w); }
__device__ __forceinline__ u32x2 pack4(f32x4 v) { u32x2 w = {cvtpk(v[0], v[1]), cvtpk(v[2], v[3])}; return w; }
__device__ __forceinline__ float wave_sum(float v) {
#pragma unroll
  for (int o = 32; o > 0; o >>= 1) v += __shfl_xor(v, o);
  return v;
}
__device__ __forceinline__ int wave_sum_i(int v) {
#pragma unroll
  for (int o = 32; o > 0; o >>= 1) v += __shfl_xor(v, o);
  return v;
}
__device__ __forceinline__ float row16_sum(float v) {
    v += __builtin_bit_cast(float, __builtin_amdgcn_update_dpp(0, __builtin_bit_cast(int, v), 0xB1, 0xf, 0xf, true));
    v += __builtin_bit_cast(float, __builtin_amdgcn_update_dpp(0, __builtin_bit_cast(int, v), 0x4E, 0xf, 0xf, true));
    v += __builtin_bit_cast(float, __builtin_amdgcn_update_dpp(0, __builtin_bit_cast(int, v), 0x141, 0xf, 0xf, true));
    v += __builtin_bit_cast(float, __builtin_amdgcn_update_dpp(0, __builtin_bit_cast(int, v), 0x140, 0xf, 0xf, true));
    return v;
}
__device__ __forceinline__ float wave_scan_incl(float v, int lane) {
    v += __builtin_bit_cast(float, __builtin_amdgcn_update_dpp(0, __builtin_bit_cast(int, v), 0x111, 0xf, 0xf, false));
    v += __builtin_bit_cast(float, __builtin_amdgcn_update_dpp(0, __builtin_bit_cast(int, v), 0x112, 0xf, 0xf, false));
    v += __builtin_bit_cast(float, __builtin_amdgcn_update_dpp(0, __builtin_bit_cast(int, v), 0x114, 0xf, 0xf, false));
    v += __builtin_bit_cast(float, __builtin_amdgcn_update_dpp(0, __builtin_bit_cast(int, v), 0x118, 0xf, 0xf, false));
    const float t0 = __builtin_bit_cast(float, __builtin_amdgcn_readlane(__builtin_bit_cast(int, v), 15));
    const float t1 = __builtin_bit_cast(float, __builtin_amdgcn_readlane(__builtin_bit_cast(int, v), 31));
    const float t2 = __builtin_bit_cast(float, __builtin_amdgcn_readlane(__builtin_bit_cast(int, v), 47));
    float add = 0.f; if (lane >= 16) add = t0; if (lane >= 32) add = t0 + t1; if (lane >= 48) add = (t0 + t1) + t2;
    return v + add;
}
__device__ __forceinline__ int opaque_tid() { int t = threadIdx.x; asm volatile("" : "+v"(t)); return t; }
__device__ __forceinline__ int wave_sum_dpp(int v) {
    v += __builtin_amdgcn_update_dpp(0, v, 0xB1, 0xf, 0xf, true);
    v += __builtin_amdgcn_update_dpp(0, v, 0x4E, 0xf, 0xf, true);
    v += __builtin_amdgcn_update_dpp(0, v, 0x141, 0xf, 0xf, true);
    v += __builtin_amdgcn_update_dpp(0, v, 0x140, 0xf, 0xf, true);
    return __builtin_amdgcn_readlane(v, 0) + __builtin_amdgcn_readlane(v, 16) + __builtin_amdgcn_readlane(v, 32) + __builtin_amdgcn_readlane(v, 48);
}
__device__ __forceinline__ int latrow_of(int row) { if (row < NP) return row; const int r = row - NP; return NP + (r >> 6) * LS + PAST + (r & 63); }
__device__ __forceinline__ int pos_of(int row) { return row < NP ? (row & (TP - 1)) : PAST + ((row - NP) & 63); }
namespace pg8 {
#define PG8_LAS __attribute__((address_space(3)))
constexpr int BM = 256, BK = 64, HALF = 128, HTB = HALF * BK * 2  , STAGE_BYTES = 8 * HTB, NXCD = 8, WGM = 8;

__host__ __device__ __forceinline__ int lds_byte(int r, int c) { const int st = (r >> 4) * 2 + (c >> 5), rr = r & 15, cc = c & 31, ob = rr * 64 + cc * 2; return st * 1024 + (ob ^ (((ob >> 9) & 1) << 5)); }
__host__ __device__ __forceinline__ void stage_rc(int b, int& R, int& C) { const int st = b / 1024, sb = b % 1024, swz = sb ^ (((sb >> 9) & 1) << 5); R = (st >> 1) * 16 + swz / 64; C = (st & 1) * 32 + (swz % 64) / 2; }
__host__ __device__ __forceinline__ int perm32(int rho) { const int n = rho >> 4, i = rho & 15; return 8 * (i >> 2) + 4 * n + (i & 3); }

struct Unit { int pm, pn; };
struct Gemm { const bf16_t* A; const bf16_t* Bt; int M, N, K, lda; };

struct StaticOrder {
    int nM, nN, nwg, G, c;
    __host__ __device__ void init(int M, int N, int G_, int c_) { nM = M / BM; nN = N / BM; nwg = nM * nN; G = G_; c = c_; }
    __host__ __device__ bool next(int i, Unit& u) const {
        const long L = (long)i * G + c; if (L >= nwg) return false;
        int wgid = (int)L; { const int q = nwg / NXCD, r = nwg % NXCD, xcd = wgid % NXCD, off = wgid / NXCD; wgid = (xcd < r ? xcd * (q + 1) : r * (q + 1) + (xcd - r) * q) + off; }
        const int nig = WGM * nN, gid = wgid / nig, fm = gid * WGM, gsz = (nM - fm) < WGM ? (nM - fm) : WGM;
        u.pm = fm + ((wgid % nig) % gsz); u.pn = (wgid % nig) / gsz; return true;
    }
    __device__ __forceinline__ void a_ready(const Unit&) const {}
    __device__ __forceinline__ void done(const Unit&) const {}
};

template <class Epi, class Sched>
__device__ __forceinline__ void gemm_phase(PG8_LAS unsigned char* lds, const Gemm g, const Sched& S, const Epi& E) {
    constexpr bool STAMP = false; unsigned long long* stamps = nullptr;
    int tid_ = threadIdx.x; asm volatile("" : "+v"(tid_));
    const int tid = tid_, wid = __builtin_amdgcn_readfirstlane(tid >> 6), lane = tid & 63, wr = wid >> 2, wc = wid & 3, fr = lane & 15, fq = lane >> 4;
    const int K = g.K, nt = K / BK;
    int ts_lo = 0, ts_hi = 0, nts = 0; const unsigned long long rt_entry = STAMP ? (unsigned long long)wall_clock64() : 0ull;
#define PG8_STAMP() do { if (STAMP && wid == 0 && nts < 64) { const unsigned long long _c = (unsigned long long)clock64(); \
        ts_lo = (lane == nts) ? (int)(unsigned)_c : ts_lo; ts_hi = (lane == nts) ? (int)(unsigned)(_c >> 32) : ts_hi; ++nts; } } while (0)
    PG8_STAMP();
    unsigned voffA[2], voffB[2];
#pragma unroll
    for (int i = 0; i < 2; ++i) { int R, C; stage_rc(tid * 16 + i * 8192, R, C); const int Rb = Epi::PERM ? ((R & ~31) + perm32(R & 31)) : R;
        voffA[i] = (unsigned)(R * g.lda + C) * 2u; voffB[i] = (unsigned)(Rb * K + C) * 2u; }
    const size_t kstep = (size_t)(BK * 2);
    const size_t hstep = (size_t)HALF * K * 2; const size_t hstepA = (size_t)HALF * g.lda * 2;
    const size_t tstep = 2 * hstep; const size_t tstepA = 2 * hstepA;
    const unsigned ldsw = (unsigned)wid * 1024u;
    const int aoff = lds_byte(wr * 64 + fr, fq * 8), boff = lds_byte(wc * 32 + fr, fq * 8);
#define PG8_SA(b, h) (((b) * 2 + (h)) * HTB)
#define PG8_SB(b, h) ((4 + (b) * 2 + (h)) * HTB)
#define PG8_STAGE(bufoff, gbase, voff) do { _Pragma("unroll") for (int _i = 0; _i < 2; ++_i) \
        __builtin_amdgcn_global_load_lds((const unsigned*)((const char*)(gbase) + (voff)[_i]), (PG8_LAS unsigned*)(lds + (bufoff) + ldsw + _i * 8192), 16, 0, 0); } while (0)
#define PG8_LDA(dst, b, h) do { _Pragma("unroll") for (int m = 0; m < 4; ++m) _Pragma("unroll") for (int k = 0; k < 2; ++k) dst[m][k] = *(const PG8_LAS bf16x8*)(lds + PG8_SA(b, h) + aoff + m * 2048 + k * 1024); } while (0)
#define PG8_LDB(dst, b, h) do { _Pragma("unroll") for (int n = 0; n < 2; ++n) _Pragma("unroll") for (int k = 0; k < 2; ++k) dst[n][k] = *(const PG8_LAS bf16x8*)(lds + PG8_SB(b, h) + boff + n * 2048 + k * 1024); } while (0)
#define PG8_MMA(ai, bj, At, Bt) do { __builtin_amdgcn_s_setprio(1); _Pragma("unroll") for (int m = 0; m < 4; ++m) _Pragma("unroll") for (int n = 0; n < 2; ++n) _Pragma("unroll") for (int k = 0; k < 2; ++k) \
        acc[ai][bj][m][n] = __builtin_amdgcn_mfma_f32_16x16x32_bf16(Bt[n][k], At[m][k], acc[ai][bj][m][n], 0, 0, 0); __builtin_amdgcn_s_setprio(0); } while (0)
#define PG8_WAIT_V(n) asm volatile("s_waitcnt vmcnt(" #n ")" ::: "memory")
#define PG8_WAIT_L(n) asm volatile("s_waitcnt lgkmcnt(" #n ")" ::: "memory")
#define PG8_BAR __builtin_amdgcn_s_barrier()
#define PG8_SCHED __builtin_amdgcn_sched_barrier(0)
    Unit cur, nxt; int ui = 0;
    if (!S.next(0, cur)) return;
    f32x4 acc[2][2][4][2];
#pragma unroll
    for (int a = 0; a < 2; ++a)
#pragma unroll
        for (int b = 0; b < 2; ++b)
#pragma unroll
            for (int m = 0; m < 4; ++m)
#pragma unroll
                for (int n = 0; n < 2; ++n) acc[a][b][m][n] = (f32x4){0.f, 0.f, 0.f, 0.f};
    bf16x8 At[4][2], B0[2][2], B1[2][2];
    const char* cA = (const char*)g.A + (size_t)cur.pm * tstepA; const char* cB = (const char*)g.Bt + (size_t)cur.pn * tstep;
    S.a_ready(cur);
    PG8_STAGE(PG8_SB(0, 0), cB, voffB); PG8_STAGE(PG8_SA(0, 0), cA, voffA); PG8_STAGE(PG8_SB(0, 1), cB + hstep, voffB); PG8_STAGE(PG8_SA(0, 1), cA + hstepA, voffA);
    if (wr == 1) PG8_BAR;
    PG8_WAIT_V(4); PG8_BAR;
    PG8_STAGE(PG8_SB(1, 0), cB + kstep, voffB); PG8_STAGE(PG8_SA(1, 0), cA + kstep, voffA); PG8_STAGE(PG8_SB(1, 1), cB + hstep + kstep, voffB);
    PG8_WAIT_V(6); PG8_BAR;
    PG8_STAMP();
    for (;;) {
        const bool has_next = S.next(ui + 1, nxt);
        const char* nA = has_next ? (const char*)g.A + (size_t)nxt.pm * tstepA : cA; const char* nB = has_next ? (const char*)g.Bt + (size_t)nxt.pn * tstep : cB;
        for (int t = 0; t < nt; t += 2) {
            const bool last = (t == nt - 2);
            const char* a1 = cA + (size_t)(t + 1) * kstep;
            const char* a2 = last ? nA : cA + (size_t)(t + 2) * kstep; const char* b2 = last ? nB : cB + (size_t)(t + 2) * kstep;
            const char* a3 = a2 + kstep; const char* b3 = b2 + kstep;
            if (last && has_next) S.a_ready(nxt);
            PG8_LDB(B0, 0, 0); PG8_SCHED; PG8_LDA(At, 0, 0); PG8_STAGE(PG8_SA(1, 1), a1 + hstepA, voffA);
            PG8_WAIT_L(8); PG8_BAR; PG8_WAIT_L(0); PG8_MMA(0, 0, At, B0); PG8_BAR; PG8_SCHED;
            PG8_LDB(B1, 0, 1); PG8_STAGE(PG8_SB(0, 0), b2, voffB);
            PG8_BAR; PG8_WAIT_L(0); PG8_MMA(0, 1, At, B1); PG8_BAR;
            PG8_LDA(At, 0, 1); PG8_STAGE(PG8_SA(0, 0), a2, voffA);
            PG8_BAR; PG8_WAIT_L(0); PG8_MMA(1, 0, At, B0); PG8_BAR; PG8_SCHED;
            PG8_STAGE(PG8_SB(0, 1), b2 + hstep, voffB);
            PG8_WAIT_V(6); PG8_BAR; PG8_MMA(1, 1, At, B1); PG8_BAR;
            PG8_LDB(B0, 1, 0); PG8_SCHED; PG8_LDA(At, 1, 0); PG8_STAGE(PG8_SA(0, 1), a2 + hstepA, voffA);
            PG8_WAIT_L(8); PG8_BAR; PG8_WAIT_L(0); PG8_MMA(0, 0, At, B0); PG8_BAR; PG8_SCHED;
            PG8_LDB(B1, 1, 1); PG8_STAGE(PG8_SB(1, 0), b3, voffB);
            PG8_BAR; PG8_WAIT_L(0); PG8_MMA(0, 1, At, B1); PG8_BAR;
            PG8_LDA(At, 1, 1); PG8_STAGE(PG8_SA(1, 0), a3, voffA);
            PG8_BAR; PG8_WAIT_L(0); PG8_MMA(1, 0, At, B0); PG8_BAR; PG8_SCHED;
            PG8_STAGE(PG8_SB(1, 1), b3 + hstep, voffB);
            PG8_WAIT_V(6); PG8_BAR; PG8_MMA(1, 1, At, B1); PG8_BAR;
        }
        PG8_STAMP();
        if constexpr (!Epi::AFTER_DRAIN) { E(acc, cur, wr, wc, fr, fq); S.done(cur); }
        PG8_STAMP();
        if (!has_next) break;
#pragma unroll
        for (int a = 0; a < 2; ++a)
#pragma unroll
            for (int b = 0; b < 2; ++b)
#pragma unroll
                for (int m = 0; m < 4; ++m)
#pragma unroll
                    for (int n = 0; n < 2; ++n) acc[a][b][m][n] = (f32x4){0.f, 0.f, 0.f, 0.f};
        cur = nxt; cA = nA; cB = nB; ++ui;
    }
    PG8_WAIT_V(0);
    if (wr == 0) PG8_BAR;
    PG8_BAR;
    if constexpr (Epi::AFTER_DRAIN) { E.fused(acc, cur, wr, wc, fr, fq, lds, wid, lane); S.done(cur); }
    PG8_STAMP();
    if (STAMP && wid == 0) { stamps[lane] = lane < nts ? (((unsigned long long)(unsigned)ts_hi << 32) | (unsigned)ts_lo) : 0ull;
        if (lane == 62) stamps[62] = rt_entry; if (lane == 63) stamps[63] = (unsigned long long)wall_clock64(); }
#undef PG8_STAMP
#undef PG8_SA
#undef PG8_SB
#undef PG8_STAGE
#undef PG8_LDA
#undef PG8_LDB
#undef PG8_MMA
#undef PG8_WAIT_V
#undef PG8_WAIT_L
#undef PG8_BAR
#undef PG8_SCHED
}
}


template <class F> struct EpiGen {
    static constexpr bool PERM = false, AFTER_DRAIN = false;
    F f;
    __device__ __forceinline__ void operator()(const f32x4 (&acc)[2][2][4][2], const pg8::Unit& u, int wr, int wc, int fr, int fq) const {
        int row0 = u.pm * 256 + wr * 64 + fr, col0 = u.pn * 256 + wc * 32 + 4 * fq;
        asm volatile("" : "+v"(row0), "+v"(col0));
#pragma unroll
        for (int ai = 0; ai < 2; ++ai)
#pragma unroll
            for (int m = 0; m < 4; ++m) {
                const int row = row0 + ai * 128 + m * 16;
#pragma unroll
                for (int bj = 0; bj < 2; ++bj)
#pragma unroll
                    for (int n = 0; n < 2; ++n) f(row, col0 + bj * 128 + n * 16, acc[ai][bj][m][n], u.pn);
            }
    }
};

#define EPI_ITER(...) do { int row0_ = row0, col0_ = col0; asm volatile("" : "+v"(row0_), "+v"(col0_)); _Pragma("unroll") for (int ai = 0; ai < 2; ++ai) _Pragma("unroll") for (int m = 0; m < 4; ++m) { const int row = row0_ + ai * 128 + m * 16; \
    _Pragma("unroll") for (int bj = 0; bj < 2; ++bj) _Pragma("unroll") for (int n = 0; n < 2; ++n) { const int col = col0_ + bj * 128 + n * 16; const f32x4 v = acc[ai][bj][m][n]; __VA_ARGS__ } } } while (0)
struct EpiInProj0 {
    static constexpr bool PERM = false, AFTER_DRAIN = false;
    char* ws; float* out; const float* dtb;
    __device__ __forceinline__ void operator()(const f32x4 (&acc)[2][2][4][2], const pg8::Unit& u, int wr, int wc, int fr, int fq) const {
        int row0 = u.pm * 256 + wr * 64 + fr, col0 = u.pn * 256 + wc * 32 + 4 * fq; const int pn = u.pn;
        asm volatile("" : "+v"(row0), "+v"(col0));
        if (pn < 4) {
            EPI_ITER({ *(u32x2*)((bf16_t*)(ws + W_MIX) + (size_t)row * 3072 + col) = pack4(v); });
        } else if (pn < 12) {
            const bool isv = pn >= 8; const int cs = isv ? 2048 : 1024;
            bf16_t* kp = (bf16_t*)(ws + (isv ? W_VP : W_KP)); bf16_t* ks = (bf16_t*)(ws + (isv ? W_VS : W_KS)); float* op = out + (isv ? O_AVP : O_AKP); float* os = out + (isv ? O_AVS : O_AKS);
            EPI_ITER({ const int c = col - cs; bf16_t* kb; float* o;
                if (row < NP) { kb = kp + (size_t)row * 1024 + c; o = op + (size_t)row * 1024 + c; }
                else { const int r = row - NP; kb = ks + ((size_t)(r >> 6) * LS + PAST + (r & 63)) * 1024 + c; o = os + (size_t)r * 1024 + c; }
                *(u32x2*)kb = pack4(v); *(f32x4*)o = v; });
        } else if (pn < 16) {
            EPI_ITER({ f32x4 s = {silu_f(v[0]), silu_f(v[1]), silu_f(v[2]), silu_f(v[3])}; *(u32x2*)((bf16_t*)(ws + W_SG) + (size_t)row * 1024 + (col - 3072)) = pack4(s); });
        } else if (pn < 20) {
            EPI_ITER({ *(u32x2*)((bf16_t*)(ws + W_IQ) + (size_t)row * 1024 + (col - 4096)) = pack4(v); });
        } else if (pn < 28) {
            EPI_ITER({ f32x4 s = {silu_f(v[0]), silu_f(v[1]), silu_f(v[2]), silu_f(v[3])}; *(u32x2*)((bf16_t*)(ws + W_MIX) + (size_t)row * 3072 + 1024 + (col - 5120)) = pack4(s); });
        } else if (pn < 40) {
            EPI_ITER({ const int c = col - 7168;
                *(u32x2*)((bf16_t*)(ws + W_XBC) + (size_t)row * 3072 + c) = pack4(v);
                if (row < NP) { const int t = row & (TP - 1); if (t >= TP - 3) *(f32x4*)(out + O_BCP + ((size_t)(row >> 12) * 3 + (t - (TP - 3))) * 3072 + c) = v; }
                else { const int r = row - NP, t = r & 63; if (t >= TS - 3) *(f32x4*)(out + O_BCS + ((size_t)(r >> 6) * 3 + (t - (TS - 3))) * 3072 + c) = v; } });
        } else {
            int r0 = row0, c0 = col0; asm volatile("" : "+v"(r0), "+v"(c0));
#pragma unroll
            for (int n = 0; n < 2; ++n) {
                const int c = c0 - 10240 + n * 16;
                if (c < 64) {
#pragma unroll
                    for (int ai = 0; ai < 2; ++ai)
#pragma unroll
                        for (int m = 0; m < 4; ++m) { const int row = r0 + ai * 128 + m * 16; const f32x4 v = acc[ai][0][m][n]; bf16_t* kb; float* o;
                            if (row < NP) { kb = (bf16_t*)(ws + W_KIDXP) + (size_t)row * 64 + c; o = out + O_KIP + (size_t)row * 64 + c; }
                            else { const int r = row - NP; kb = (bf16_t*)(ws + W_KIDXS) + ((size_t)(r >> 6) * LS + PAST + (r & 63)) * 64 + c; o = out + O_KIS + (size_t)r * 64 + c; }
                            *(u32x2*)kb = pack4(v); *(f32x4*)o = v; }
                } else if (c < 80) {
#pragma unroll
                    for (int ai = 0; ai < 2; ++ai)
#pragma unroll
                        for (int m = 0; m < 4; ++m) { const int row = r0 + ai * 128 + m * 16; *(f32x4*)((float*)(ws + W_IW) + (size_t)row * 16 + (c - 64)) = acc[ai][0][m][n] * 0.03125f; }
                } else if (c < 112) {
                    const f32x4 db = *(const f32x4*)(dtb + (c - 80));
#pragma unroll
                    for (int ai = 0; ai < 2; ++ai)
#pragma unroll
                        for (int m = 0; m < 4; ++m) { const int row = r0 + ai * 128 + m * 16; const f32x4 v = acc[ai][0][m][n] + db; f32x4 d;
#pragma unroll
                            for (int j = 0; j < 4; ++j) d[j] = v[j] > 20.f ? v[j] : log1pf(__expf(v[j]));
                            *(f32x4*)((float*)(ws + W_DT) + (size_t)row * 32 + (c - 80)) = d; }
                }
            }
        }
    }
};

struct FResid {
    const float* r0; const float* r1; float* y;
    __device__ __forceinline__ void operator()(int row, int col, f32x4 v, int) const {
        const float* rp = row < NP ? r0 + (size_t)row * DM + col : r1 + (size_t)(row - NP) * DM + col;
        const f32x4 x = *(const f32x4*)rp;
        *(f32x4*)(y + (size_t)row * DM + col) = v + x * ALPHA_RES;
    }
};

struct FInProj1 {
    char* ws;
    __device__ __forceinline__ void operator()(int row, int col, f32x4 v, int pn) const {
        if (pn < 4) *(f32x4*)((float*)(ws + W_CQKV) + (size_t)row * 1088 + col) = v;
        else if (pn < 12) { f32x4 s = {silu_f(v[0]), silu_f(v[1]), silu_f(v[2]), silu_f(v[3])}; *(u32x2*)((bf16_t*)(ws + W_SGATE) + (size_t)row * 2048 + (col - 1024)) = pack4(s); }
        else { const int c = col - 3072; if (c < 64) *(f32x4*)((float*)(ws + W_CQKV) + (size_t)row * 1088 + 1024 + c) = v; }
    }
};

struct FQUp {
    char* ws;
    __device__ __forceinline__ void operator()(int row, int col, f32x4 v, int pn) const {
        if (pn >= 8) {
            const int jj = (col - 2048) & 63, i0 = (jj >> 2) * 2, pos = pos_of(row);
            const float2* tab = (const float2*)(ws + W_ROPE) + (size_t)pos * 32 + i0;
            const float2 c0 = tab[0], c1 = tab[1];
            f32x4 o; o[0] = v[0] * c0.x - v[2] * c0.y; o[2] = v[0] * c0.y + v[2] * c0.x; o[1] = v[1] * c1.x - v[3] * c1.y; o[3] = v[1] * c1.y + v[3] * c1.x; v = o;
        }
        *(u32x2*)((bf16_t*)(ws + W_Q2) + (size_t)row * 3072 + col) = pack4(v);
    }
};
struct FKvUp { char* ws; __device__ __forceinline__ void operator()(int row, int col, f32x4 v, int) const { *(u32x2*)((bf16_t*)(ws + W_KVALL) + (size_t)row * 4096 + col) = pack4(v); } };

template <class F> __device__ __forceinline__ void run_gemm(char* lds, const bf16_t* A, int lda, const bf16_t* Bt, int M, int N, int K, const F& f, const bool rev = false) {
    pg8::Gemm g; g.A = A; g.Bt = Bt; g.M = M; g.N = N; g.K = K; g.lda = lda;
    pg8::StaticOrder S; S.init(M, N, (int)gridDim.x, rev ? (int)(gridDim.x - 1 - blockIdx.x) : (int)blockIdx.x);
    EpiGen<F> E{f};
    pg8::gemm_phase<EpiGen<F>, pg8::StaticOrder>((PG8_LAS unsigned char*)lds, g, S, E);
}

__device__ __forceinline__ int orig_col(int w, int n) {
    switch (w) {
    case 0: if (n < 5120) return n; if (n < 7168) return 5200 + (n - 5120); if (n < 10240) return 7248 + (n - 7168); if (n < 10304) return 5120 + (n - 10240);
            if (n < 10320) return 5184 + (n - 10304); if (n < 10352) return n; return -1;
    case 2: if (n < 1024) return n; if (n < 3072) return 1088 + (n - 1024); if (n < 3136) return 1024 + (n - 3072); return -1;
    case 3: if (n < 2048) return (n >> 7) * 192 + (n & 127);
            { const int j = n - 2048, h = j >> 6, jj = j & 63, g4 = jj >> 2, e = jj & 3; return h * 192 + 128 + (e >> 1) * 32 + 2 * g4 + (e & 1); }
    case 4: if (n < 2048) return (n >> 7) * 256 + (n & 127); { const int j = n - 2048; return (j >> 7) * 256 + 128 + (j & 127); }
    default: return n;
    }
}
__device__ __forceinline__ void phase_prep(CPARAMS& p, char* lds) {
    const int tid = opaque_tid();
    {
        bf16_t* tile = (bf16_t*)lds;
        int base = 0;
#pragma unroll 1
        for (int w = 0; w < 6; ++w) {
            int K, N, NPd; const float* W; bf16_t* Bt;
            switch (w) {
            case 0: K = 2048; N = NIN0; NPd = NIN0P; W = p.in[I_WIN0]; Bt = (bf16_t*)(p.ws + W_BT0); break;
            case 1: K = 3072; N = 2048; NPd = 2048; W = p.in[I_WOUT0]; Bt = (bf16_t*)(p.ws + W_BTOUT0); break;
            case 2: K = 2048; N = NIN1; NPd = NIN1P; W = p.in[I_WIN1]; Bt = (bf16_t*)(p.ws + W_BT1); break;
            case 3: K = 512; N = 3072; NPd = 3072; W = p.in[I_WUQ]; Bt = (bf16_t*)(p.ws + W_BTUQ); break;
            case 4: K = 512; N = 4096; NPd = 4096; W = p.in[I_WUKV]; Bt = (bf16_t*)(p.ws + W_BTUKV); break;
            default: K = 2048; N = 2048; NPd = 2048; W = p.in[I_WOUT1]; Bt = (bf16_t*)(p.ws + W_BTOUT1); break;
            }
            const int nkt = K / 64, nnt = NPd / 64, ntiles = nkt * nnt;
            int first = (int)blockIdx.x - (base % (int)gridDim.x); if (first < 0) first += gridDim.x;
            const int nl = tid & 63;
            float cur[8];
            if (first < ntiles) { const int kt = first % nkt, nt = first / nkt, oc = orig_col(w, nt * 64 + nl);
#pragma unroll
                for (int i = 0; i < 8; ++i) { const int k = kt * 64 + i * 8 + (tid >> 6); cur[i] = oc >= 0 ? W[(size_t)k * N + oc] : 0.f; } }
#pragma unroll 1
            for (int tix = first; tix < ntiles; tix += gridDim.x) {
                const int kt = tix % nkt, nt = tix / nkt;
                float nxt[8];
                const int tix2 = tix + (int)gridDim.x;
                if (tix2 < ntiles) { const int kt2 = tix2 % nkt, nt2 = tix2 / nkt, oc2 = orig_col(w, nt2 * 64 + nl);
#pragma unroll
                    for (int i = 0; i < 8; ++i) { const int k = kt2 * 64 + i * 8 + (tid >> 6); nxt[i] = oc2 >= 0 ? W[(size_t)k * N + oc2] : 0.f; } }
                else {
#pragma unroll
                    for (int i = 0; i < 8; ++i) nxt[i] = 0.f; }
#pragma unroll
                for (int i = 0; i < 8; ++i) tile[nl * 66 + i * 8 + (tid >> 6)] = f2bf(cur[i]);
                __syncthreads();
                { const int nr = tid >> 3, ks = (tid & 7) * 8; const unsigned* src = (const unsigned*)(tile + nr * 66 + ks);
                  u32x4 o = {src[0], src[1], src[2], src[3]};
                  *(u32x4*)(Bt + (size_t)(nt * 64 + nr) * K + kt * 64 + ks) = o; }
                __syncthreads();
#pragma unroll
                for (int i = 0; i < 8; ++i) cur[i] = nxt[i];
            }
            base += ntiles;
        }
    }
    const size_t gtid = (size_t)blockIdx.x * 512 + tid, gstride = (size_t)gridDim.x * 512;
    { bf16_t* xb = (bf16_t*)(p.ws + W_XB); const size_t n8p = (size_t)NP * DM / 8, n8 = (size_t)MALL * DM / 8;
      for (size_t i0 = gtid; i0 < n8; i0 += 4 * gstride) {
        f32x4 a[4], b[4];
#pragma unroll
        for (int u = 0; u < 4; ++u) { const size_t i = i0 + u * gstride; if (i < n8) { const float* s = i < n8p ? p.in[I_XP] + i * 8 : p.in[I_XS] + (i - n8p) * 8; a[u] = *(const f32x4*)s; b[u] = *(const f32x4*)(s + 4); } }
#pragma unroll
        for (int u = 0; u < 4; ++u) { const size_t i = i0 + u * gstride; if (i < n8) { const float t[8] = {a[u][0], a[u][1], a[u][2], a[u][3], b[u][0], b[u][1], b[u][2], b[u][3]}; *(bf16x8*)(xb + i * 8) = pack8(t); } }
      } }
    { const size_t n8 = (size_t)8 * PAST * 1024 / 8;
      for (size_t i = gtid; i < 2 * n8; i += gstride) { const bool isv = i >= n8; const size_t j = isv ? i - n8 : i; const float* s = p.in[isv ? I_CAV : I_CAK] + j * 8;
        const size_t e = j * 8, b = e / ((size_t)PAST * 1024), rem = e % ((size_t)PAST * 1024);
        const f32x4 a = *(const f32x4*)s, c = *(const f32x4*)(s + 4); const float t[8] = {a[0], a[1], a[2], a[3], c[0], c[1], c[2], c[3]};
        *(bf16x8*)((bf16_t*)(p.ws + (isv ? W_VS : W_KS)) + b * (size_t)LS * 1024 + rem) = pack8(t); }
      const size_t m8 = (size_t)8 * PAST * 64 / 8;
      for (size_t i = gtid; i < m8; i += gstride) { const float* s = p.in[I_CAKI] + i * 8; const size_t e = i * 8, b = e / ((size_t)PAST * 64), rem = e % ((size_t)PAST * 64);
        const f32x4 a = *(const f32x4*)s, c = *(const f32x4*)(s + 4); const float t[8] = {a[0], a[1], a[2], a[3], c[0], c[1], c[2], c[3]};
        *(bf16x8*)((bf16_t*)(p.ws + W_KIDXS) + b * (size_t)LS * 64 + rem) = pack8(t); } }
    { float2* tab = (float2*)(p.ws + W_ROPE);
      for (size_t i = gtid; i < (size_t)4096 * 32; i += gstride) { const int pos = (int)(i >> 5), f = (int)(i & 31);
        const float inv = powf(10000.f, -(float)f / 32.f), ang = (float)pos * inv; float s, c; sincosf(ang, &s, &c); tab[i] = make_float2(c, s); } }
}

__device__ __forceinline__ void phase_index(CPARAMS& p, char* lds) {
    const int tid = opaque_tid(), wid = tid >> 6, lane = tid & 63, r32 = lane & 31, hi = lane >> 5;
    unsigned* sk = (unsigned*)lds;
    const int NU = 4096 + 64;
#pragma unroll 1
    for (int idx = blockIdx.x; idx < NU; idx += gridDim.x) {
        int b, t0, n, nblk_tot, rowg; const bf16_t* ki; u64* mrow; int ldm; bool sample;
        if (idx < 4096) { const int k = idx >> 8, w = idx & 255; b = k >> 1; const int j = (k & 1) ? 511 - w : w; t0 = j * 8; n = ((t0 >> 6) + 1) * 64; nblk_tot = ((t0 >> 8) + 1) * 4;
            rowg = b * TP + t0; ki = (const bf16_t*)(p.ws + W_KIDXP) + (size_t)b * TP * 64; mrow = (u64*)(p.ws + W_MASKP) + (size_t)rowg * 64; ldm = 64; sample = false; }
        else { const int s = idx - 4096; b = s >> 3; t0 = (s & 7) * 8; n = LS; nblk_tot = 17; rowg = NP + b * 64 + t0;
            ki = (const bf16_t*)(p.ws + W_KIDXS) + (size_t)b * LS * 64; mrow = (u64*)(p.ws + W_MASKS) + (size_t)(b * 64 + t0) * 32; ldm = 32; sample = true; }
        (void)sample;
        if (n <= 256) {
            if (lane < nblk_tot) mrow[(size_t)wid * ldm + lane] = (lane * 64 < n) ? ~0ull : 0ull;
            continue;
        }
        {
            const int pr = wid >> 1, par = wid & 1;
            const int qsel = (r32 >> 2) & 1, head = (r32 & 3) + 4 * (r32 >> 3);
            const bf16_t* qp = (const bf16_t*)(p.ws + W_IQ) + (size_t)(rowg + 2 * pr + qsel) * 1024 + head * 64 + hi * 8;
            bf16x8 qa[4];
#pragma unroll
            for (int s = 0; s < 4; ++s) qa[s] = *(const bf16x8*)(qp + s * 16);
            const float* wp = (const float*)(p.ws + W_IW) + (size_t)(rowg + 2 * pr + hi) * 16;
            float wv[16];
#pragma unroll
            for (int s = 0; s < 4; ++s) { const f32x4 t = *(const f32x4*)(wp + s * 4); wv[s * 4] = t[0]; wv[s * 4 + 1] = t[1]; wv[s * 4 + 2] = t[2]; wv[s * 4 + 3] = t[3]; }
            unsigned* dst = sk + (2 * pr + hi) * 4096 + par * 32 + r32;
            char* kst = lds + 131072;
            const int skey = tid >> 3, scolB = (tid & 7) * 16, ntile = n >> 6, ngrp = (ntile + 3) >> 2;
            const bf16_t* ksrc = ki + (size_t)skey * 64 + (scolB >> 1);
            bf16x8 pre[3][4];
#pragma unroll
            for (int sl = 0; sl < 3; ++sl)
#pragma unroll
                for (int u = 0; u < 4; ++u) { const int t = sl * 4 + u; pre[sl][u] = *(const bf16x8*)(ksrc + (size_t)(t < ntile ? t : 0) * 64 * 64); }
#define IDX_GROUP(SL, G) do { const int g_ = (G); \
                __syncthreads(); \
                _Pragma("unroll") for (int u = 0; u < 4; ++u) *(bf16x8*)(kst + u * 8192 + KRSWZ(skey, scolB)) = pre[SL][u]; \
                _Pragma("unroll") for (int u = 0; u < 4; ++u) { const int t = (g_ + 3) * 4 + u; pre[SL][u] = *(const bf16x8*)(ksrc + (size_t)(t < ntile ? t : 0) * 64 * 64); } \
                __syncthreads(); \
                _Pragma("unroll") for (int u = 0; u < 4; ++u) { const int t = g_ * 4 + u; \
                    if (t < ntile) { f32x16 acc = {}; \
                        _Pragma("unroll") for (int s = 0; s < 4; ++s) { const bf16x8 kf = *(const bf16x8*)(kst + u * 8192 + KRSWZ(par * 32 + r32, (s * 16 + hi * 8) * 2)); acc = __builtin_amdgcn_mfma_f32_32x32x16_bf16(qa[s], kf, acc, 0, 0, 0); } \
                        float sc = 0.f; \
                        _Pragma("unroll") for (int r = 0; r < 16; ++r) sc = fmaf(wv[r], fmaxf(acc[r], 0.f), sc); \
                        sc += 0.f; \
                        const unsigned uu = __float_as_uint(sc); \
                        dst[t * 64] = (uu & 0x80000000u) ? ~uu : (uu | 0x80000000u); } } } while (0)
#pragma unroll 1
            for (int g0 = 0; g0 < ngrp; g0 += 3) {
                IDX_GROUP(0, g0);
                if (g0 + 1 < ngrp) IDX_GROUP(1, g0 + 1);
                if (g0 + 2 < ngrp) IDX_GROUP(2, g0 + 2);
            }
#undef IDX_GROUP
        }
        __syncthreads();
        {
            const unsigned* k = sk + wid * 4096;
            u32x4 kv[16];
#pragma unroll
            for (int j = 0; j < 16; ++j) kv[j] = (j * 256 < n && j * 256 + lane * 4 < n) ? *(const u32x4*)(k + j * 256 + lane * 4) : (u32x4){0u, 0u, 0u, 0u};
            unsigned prefix = 0;
#pragma unroll 1
            for (int bit = 31; bit >= 0; --bit) {
                const unsigned cand = prefix | (1u << bit);
                int cnt = 0;
#pragma unroll
                for (int j = 0; j < 16; ++j) if (j * 256 < n) cnt += (kv[j][0] >= cand) + (kv[j][1] >= cand) + (kv[j][2] >= cand) + (kv[j][3] >= cand);
                cnt = wave_sum_dpp(cnt);
                if (cnt >= 256) { prefix = cand; if (cnt == 256) break; }
            }
            int cgt = 0;
#pragma unroll
            for (int j = 0; j < 16; ++j) if (j * 256 < n) cgt += (kv[j][0] > prefix) + (kv[j][1] > prefix) + (kv[j][2] > prefix) + (kv[j][3] > prefix);
            cgt = wave_sum_dpp(cgt);
            const int need = 256 - cgt; int running = 0;
            u64* mr = mrow + (size_t)wid * ldm;
            const u64 lt = (1ull << lane) - 1ull;
#pragma unroll 1
            for (int blk = 0; blk < nblk_tot; ++blk) {
                u64 word = 0ull;
                if (blk * 64 < n) {
                    const unsigned v = k[blk * 64 + lane];
                    const u64 eqm = __ballot(v == prefix);
                    const int rank = running + __popcll(eqm & lt);
                    const bool sel = (v > prefix) || (v == prefix && rank < need);
                    word = __ballot(sel); running += __popcll(eqm);
                }
                if (lane == 0) mr[blk] = word;
            }
        }
        __syncthreads();
    }
}

#define KSWZ(row, colB) ((row) * 256 + ((colB) ^ (((row) & 7) << 4)))
__device__ __forceinline__ int crow(int r, int hi) { return (r & 3) + 8 * (r >> 2) + 4 * hi; }
__device__ __forceinline__ int v_st(int k, int c) { const int kk = (k & ~0xC) | ((k & 4) << 1) | ((k & 8) >> 1); return ((kk >> 3) * 4 + (c >> 5)) * 512 + ((kk & 7) * 32 + (c & 31)) * 2; }
__device__ __forceinline__ int v_rd_base(int lane) { return ((lane & 3) << 3) | (((lane >> 2) & 3) << 6) | (((lane >> 4) & 1) << 5) | (((lane >> 5) & 1) << 8); }
constexpr int v_rd_off(int d0, int ks, int half) { return d0 * 512 + ks * 4096 + half * 2048; }
template <int OFF> __device__ __forceinline__ s16x4 tr_read(int vb) { s16x4 r; asm volatile("ds_read_b64_tr_b16 %0, %1 offset:%2" : "=&v"(r) : "v"(vb), "i"(OFF) : "memory"); return r; }
template <int D0> __device__ __forceinline__ void pv_one(f32x16& od, int vb, bf16x8 pa0, bf16x8 pa1, bf16x8 pa2, bf16x8 pa3) {
    const s16x4 l0 = tr_read<v_rd_off(D0, 0, 0)>(vb), h0 = tr_read<v_rd_off(D0, 0, 1)>(vb), l1 = tr_read<v_rd_off(D0, 1, 0)>(vb), h1 = tr_read<v_rd_off(D0, 1, 1)>(vb);
    const s16x4 l2 = tr_read<v_rd_off(D0, 2, 0)>(vb), h2 = tr_read<v_rd_off(D0, 2, 1)>(vb), l3 = tr_read<v_rd_off(D0, 3, 0)>(vb), h3 = tr_read<v_rd_off(D0, 3, 1)>(vb);
    asm volatile("s_waitcnt lgkmcnt(0)" ::: "memory"); __builtin_amdgcn_sched_barrier(0);
#define PKV(L, H) (bf16x8){L[0], L[1], L[2], L[3], H[0], H[1], H[2], H[3]}
    od = __builtin_amdgcn_mfma_f32_32x32x16_bf16(pa0, PKV(l0, h0), od, 0, 0, 0);
    od = __builtin_amdgcn_mfma_f32_32x32x16_bf16(pa1, PKV(l1, h1), od, 0, 0, 0);
    od = __builtin_amdgcn_mfma_f32_32x32x16_bf16(pa2, PKV(l2, h2), od, 0, 0, 0);
    od = __builtin_amdgcn_mfma_f32_32x32x16_bf16(pa3, PKV(l3, h3), od, 0, 0, 0);
#undef PKV
}

template <int D0> __device__ __forceinline__ void pv_two(f32x16& oa, f32x16& ob, int vb, bf16x8 pa0, bf16x8 pa1, bf16x8 pa2, bf16x8 pa3) {
    const s16x4 l0 = tr_read<v_rd_off(D0, 0, 0)>(vb), h0 = tr_read<v_rd_off(D0, 0, 1)>(vb), l1 = tr_read<v_rd_off(D0, 1, 0)>(vb), h1 = tr_read<v_rd_off(D0, 1, 1)>(vb);
    const s16x4 l2 = tr_read<v_rd_off(D0, 2, 0)>(vb), h2 = tr_read<v_rd_off(D0, 2, 1)>(vb), l3 = tr_read<v_rd_off(D0, 3, 0)>(vb), h3 = tr_read<v_rd_off(D0, 3, 1)>(vb);
    const s16x4 m0 = tr_read<v_rd_off(D0 + 1, 0, 0)>(vb), g0 = tr_read<v_rd_off(D0 + 1, 0, 1)>(vb), m1 = tr_read<v_rd_off(D0 + 1, 1, 0)>(vb), g1 = tr_read<v_rd_off(D0 + 1, 1, 1)>(vb);
    const s16x4 m2 = tr_read<v_rd_off(D0 + 1, 2, 0)>(vb), g2 = tr_read<v_rd_off(D0 + 1, 2, 1)>(vb), m3 = tr_read<v_rd_off(D0 + 1, 3, 0)>(vb), g3 = tr_read<v_rd_off(D0 + 1, 3, 1)>(vb);
    asm volatile("s_waitcnt lgkmcnt(8)" ::: "memory"); __builtin_amdgcn_sched_barrier(0);
#define PKV(L, H) (bf16x8){L[0], L[1], L[2], L[3], H[0], H[1], H[2], H[3]}
    oa = __builtin_amdgcn_mfma_f32_32x32x16_bf16(pa0, PKV(l0, h0), oa, 0, 0, 0);
    oa = __builtin_amdgcn_mfma_f32_32x32x16_bf16(pa1, PKV(l1, h1), oa, 0, 0, 0);
    oa = __builtin_amdgcn_mfma_f32_32x32x16_bf16(pa2, PKV(l2, h2), oa, 0, 0, 0);
    oa = __builtin_amdgcn_mfma_f32_32x32x16_bf16(pa3, PKV(l3, h3), oa, 0, 0, 0);
    asm volatile("s_waitcnt lgkmcnt(0)" ::: "memory"); __builtin_amdgcn_sched_barrier(0);
    ob = __builtin_amdgcn_mfma_f32_32x32x16_bf16(pa0, PKV(m0, g0), ob, 0, 0, 0);
    ob = __builtin_amdgcn_mfma_f32_32x32x16_bf16(pa1, PKV(m1, g1), ob, 0, 0, 0);
    ob = __builtin_amdgcn_mfma_f32_32x32x16_bf16(pa2, PKV(m2, g2), ob, 0, 0, 0);
    ob = __builtin_amdgcn_mfma_f32_32x32x16_bf16(pa3, PKV(m3, g3), ob, 0, 0, 0);
#undef PKV
}

struct AttnUnit {
    const bf16_t* Q; const bf16_t* Qr; const bf16_t* K; const bf16_t* V; const bf16_t* Kr; bf16_t* O; const bf16_t* G; const u64* M;
    int ldq, ldqr, ldk, ldo, ldg, ldm, nvalid, qpos0, NT, head;
};
constexpr int AT_V = 0, AT_K = 32768, AT_KR = 65536, AT_WS = 81920, AT_TB = 81920 + 2048;

template <int MODE>
__device__ __forceinline__ void attn_unit(const AttnUnit& u, char* lds, const float* t5, const float Cs  , const bool dry = false) {
    const int tid = opaque_tid(), wid = __builtin_amdgcn_readfirstlane(tid >> 6), lane = tid & 63, r32 = lane & 31, hi = lane >> 5;
    float* wsf = (float*)(lds + AT_WS) + wid * 64; float* al_l = wsf; float* li_l = wsf + 32;
    float* tb = (float*)(lds + AT_TB);
    const int rowb = wid * 32 + r32, rowc = rowb < u.nvalid ? rowb : u.nvalid - 1;
    const int wrow0 = (wid * 32 < u.nvalid) ? wid * 32 : u.nvalid - 1;
    const int qc_w = (u.qpos0 + wrow0) >> 6;
    const int qpos = u.qpos0 + rowc;
    constexpr int NQ = MODE == 1 ? 12 : 8;
    bf16x8 qr[NQ];
    { const bf16_t* Qw = u.Q + (size_t)rowc * u.ldq + hi * 8;
#pragma unroll
      for (int d0 = 0; d0 < 8; ++d0) qr[d0] = *(const bf16x8*)(Qw + d0 * 16);
      if constexpr (MODE == 1) { const bf16_t* Qw2 = u.Qr + (size_t)rowc * u.ldqr + hi * 8;
#pragma unroll
        for (int d0 = 0; d0 < 4; ++d0) qr[8 + d0] = *(const bf16x8*)(Qw2 + d0 * 16); } }
    if constexpr (MODE == 0) {
        if (tid < 155) { const int rel = tid - 63, nn = rel < 0 ? -rel : rel;
            const int bk = (rel < 0 ? 16 : 0) + (nn < 8 ? nn : 8 + (nn >= 12) + (nn >= 16) + (nn >= 23) + (nn >= 32) + (nn >= 46) + (nn >= 64) + (nn >= 91));
            tb[tid] = t5[bk * 8 + u.head] * LOG2E; }
    }
    float m_reg = -1e29f, l_reg = 0.f; f32x16 o[4];
#pragma unroll
    for (int d = 0; d < 4; ++d) o[d] = (f32x16){};
    const int vb0 = (int)(uintptr_t)(lds + AT_V) + v_rd_base(lane);
    int koff[2], voff[2], kroff = 0;
#pragma unroll
    for (int i = 0; i < 2; ++i) { const int X = (i * 8 + wid) * 1024 + lane * 16;
        { const int row = X >> 8, colB = (X & 255) ^ ((row & 7) << 4); koff[i] = row * u.ldk + (colB >> 1); }
        { const int sub = X >> 9, y = X & 511, kk = (sub >> 2) * 8 + (y >> 6), k = (kk & ~0xC) | ((kk & 4) << 1) | ((kk & 8) >> 1), c = (sub & 3) * 32 + ((y & 63) >> 1); voff[i] = k * u.ldk + c; } }
    if constexpr (MODE == 1) { const int X = wid * 1024 + lane * 16, row = X >> 7, colB = (X & 127) ^ (((row >> 1) & 7) << 4); kroff = row * 64 + (colB >> 1); }
    LAS char* ldl = (LAS char*)lds;
#define AT_ISSUE(b, k0) do { const bf16_t* kb_ = u.K + (size_t)(k0) * u.ldk; const bf16_t* vb_ = u.V + (size_t)(k0) * u.ldk; \
        _Pragma("unroll") for (int i_ = 0; i_ < 2; ++i_) { \
            __builtin_amdgcn_global_load_lds((const unsigned*)(kb_ + koff[i_]), (LAS unsigned*)(ldl + AT_K + (b) * 16384 + (i_ * 8 + wid) * 1024), 16, 0, 0); \
            __builtin_amdgcn_global_load_lds((const unsigned*)(vb_ + voff[i_]), (LAS unsigned*)(ldl + AT_V + (b) * 16384 + (i_ * 8 + wid) * 1024), 16, 0, 0); } \
        if constexpr (MODE == 1) __builtin_amdgcn_global_load_lds((const unsigned*)(u.Kr + (size_t)(k0) * 64 + kroff), (LAS unsigned*)(ldl + AT_KR + (b) * 8192 + wid * 1024), 16, 0, 0); } while (0)
    AT_ISSUE(0, 0);
    asm volatile("s_waitcnt vmcnt(0)" ::: "memory");
    __syncthreads();
#pragma unroll 1
    for (int j = 0; j < u.NT; ++j) {
        const int cur = j & 1;
        if (j + 1 < u.NT) AT_ISSUE(cur ^ 1, (j + 1) * 64);
        if (j <= qc_w && wid * 32 < u.nvalid) {
            u64 mw = 0;
            if constexpr (MODE == 0) mw = u.M[(size_t)rowc * u.ldm + j];
            f32x16 p0 = {}, p1 = {};
            const char* Ks = lds + AT_K + cur * 16384;
            __builtin_amdgcn_s_setprio(1);
#pragma unroll
            for (int d0 = 0; d0 < 8; ++d0) { const int cb = (d0 * 16 + hi * 8) * 2;
                const bf16x8 b0 = *(const bf16x8*)(Ks + KSWZ(r32, cb)), b1 = *(const bf16x8*)(Ks + KSWZ(32 + r32, cb));
                p0 = __builtin_amdgcn_mfma_f32_32x32x16_bf16(b0, qr[d0], p0, 0, 0, 0); p1 = __builtin_amdgcn_mfma_f32_32x32x16_bf16(b1, qr[d0], p1, 0, 0, 0);
                if ((d0 & 3) == 3) __builtin_amdgcn_sched_barrier(0); }
            if constexpr (MODE == 1) { const char* Krs = lds + AT_KR + cur * 8192;
#pragma unroll
                for (int d0 = 0; d0 < 4; ++d0) { const int cb = (d0 * 16 + hi * 8) * 2;
                    const bf16x8 b0 = *(const bf16x8*)(Krs + KRSWZ(r32, cb)), b1 = *(const bf16x8*)(Krs + KRSWZ(32 + r32, cb));
                    p0 = __builtin_amdgcn_mfma_f32_32x32x16_bf16(b0, qr[8 + d0], p0, 0, 0, 0); p1 = __builtin_amdgcn_mfma_f32_32x32x16_bf16(b1, qr[8 + d0], p1, 0, 0, 0); } }
            __builtin_amdgcn_s_setprio(0);
            float esc = Cs, ebias = 0.f;
            unsigned mlo = 0u, mhi = 0u;
            if constexpr (MODE == 0) {
                mlo = (unsigned)mw >> (4 * hi); mhi = (unsigned)(mw >> 32) >> (4 * hi);
                const int kb = j * 64;
                const bool far = (u.qpos0 + wrow0) - (kb + 63) >= 91;
                if (far) ebias = tb[154];
                else { const int rel0 = qpos - kb - 4 * hi; esc = 1.f;
#pragma unroll
                    for (int r = 0; r < 16; ++r) { const int c0 = crow(r, 0);
                        int i0 = rel0 - c0; i0 = i0 < -63 ? -63 : (i0 > 91 ? 91 : i0); int i1 = rel0 - c0 - 32; i1 = i1 < -63 ? -63 : (i1 > 91 ? 91 : i1);
                        p0[r] = fmaf(p0[r], Cs, tb[i0 + 63]); p1[r] = fmaf(p1[r], Cs, tb[i1 + 63]); }
                }
            }
            float pmax = p0[0];
#pragma unroll
            for (int r = 1; r < 16; ++r) pmax = fmaxf(pmax, p0[r]);
#pragma unroll
            for (int r = 0; r < 16; ++r) pmax = fmaxf(pmax, p1[r]);
            { auto rr = __builtin_amdgcn_permlane32_swap(__float_as_uint(pmax), __float_as_uint(pmax), false, false); pmax = fmaxf(__uint_as_float(rr[0]), __uint_as_float(rr[1])); }
            const float pmax_t = fmaf(pmax, esc, ebias);
            float mn = m_reg, alpha = 1.f;
            const bool grow = !__all(pmax_t - m_reg <= 11.5f);
            if (grow) { mn = fmaxf(m_reg, pmax_t); alpha = __builtin_amdgcn_exp2f(m_reg - mn); m_reg = mn; }
            const float mns = ebias - mn;
            float ps = 0.f;
#pragma unroll
            for (int r = 0; r < 16; ++r) { p0[r] = __builtin_amdgcn_exp2f(fmaf(p0[r], esc, mns)); p1[r] = __builtin_amdgcn_exp2f(fmaf(p1[r], esc, mns)); }
            if constexpr (MODE == 0) {
#pragma unroll
                for (int r = 0; r < 16; ++r) { const int c0 = crow(r, 0);
                    p0[r] = __uint_as_float(__float_as_uint(p0[r]) & (unsigned)((int)(mlo << (31 - c0)) >> 31));
                    p1[r] = __uint_as_float(__float_as_uint(p1[r]) & (unsigned)((int)(mhi << (31 - c0)) >> 31)); }
            }
#pragma unroll
            for (int r = 0; r < 16; ++r) ps += p0[r] + p1[r];
            { auto rr = __builtin_amdgcn_permlane32_swap(__float_as_uint(ps), __float_as_uint(ps), false, false); ps = __uint_as_float(rr[0]) + __uint_as_float(rr[1]); }
            l_reg = l_reg * alpha + ps;
            if (grow) {
                if (hi == 0) al_l[r32] = alpha;
                asm volatile("s_waitcnt lgkmcnt(0)" ::: "memory");
#pragma unroll
                for (int r = 0; r < 16; ++r) { const float a = al_l[crow(r, hi)];
#pragma unroll
                    for (int d = 0; d < 4; ++d) o[d][r] *= a; }
            }
            bf16x8 pa0, pa1, pa2, pa3;
#define PK4(P, BASE, OUT) do { unsigned a0 = cvtpk(P[BASE + 0], P[BASE + 1]), a1 = cvtpk(P[BASE + 2], P[BASE + 3]);   \
    unsigned b0 = cvtpk(P[BASE + 4], P[BASE + 5]), b1 = cvtpk(P[BASE + 6], P[BASE + 7]);                              \
    auto r0 = __builtin_amdgcn_permlane32_swap(a0, b0, false, false); auto r1 = __builtin_amdgcn_permlane32_swap(a1, b1, false, false); \
    u32x4 w = {r0[0], r1[0], r0[1], r1[1]}; OUT = *reinterpret_cast<bf16x8*>(&w); } while (0)
            PK4(p0, 0, pa0); PK4(p0, 8, pa1); PK4(p1, 0, pa2); PK4(p1, 8, pa3);
#undef PK4
            const int vb = vb0 + cur * 16384;
            __builtin_amdgcn_s_setprio(1);
            pv_two<0>(o[0], o[1], vb, pa0, pa1, pa2, pa3); pv_two<2>(o[2], o[3], vb, pa0, pa1, pa2, pa3);
            __builtin_amdgcn_s_setprio(0);
        }
        asm volatile("s_waitcnt vmcnt(0)" ::: "memory");
        __syncthreads();
    }
#undef AT_ISSUE
    if (hi == 0) li_l[r32] = l_reg;
    asm volatile("s_waitcnt lgkmcnt(0)" ::: "memory");
#pragma unroll
    for (int r = 0; r < 16; ++r) {
        const int orow = wid * 32 + crow(r, hi);
        const float rl = __builtin_amdgcn_rcpf(li_l[crow(r, hi)]);
        if (orow < u.nvalid && !dry) {
#pragma unroll
            for (int d0 = 0; d0 < 4; ++d0) { const int c = d0 * 32 + r32;
                const float g = bf2f(u.G[(size_t)orow * u.ldg + c]);
                u.O[(size_t)orow * u.ldo + c] = f2bf(o[d0][r] * rl * g); }
        }
    }
    __syncthreads();
}

__device__ __forceinline__ void phase_attn_dsa(CPARAMS& p, char* lds, const bool dry = false) {
    const float Cs = 0.08838834764831845f * LOG2E;
    const int NU = 1024 + 64;
#pragma unroll 1
    for (int idx = blockIdx.x; idx < NU; idx += gridDim.x) {
        AttnUnit u;
        bf16_t* mix = (bf16_t*)(p.ws + W_MIX);
        if (idx < 1024) { const int k = idx >> 8, w = idx & 255, h = w & 7, qb0 = (w >> 3) & 15, b = (w >> 7) + 2 * k, qb = (k & 1) ? 15 - qb0 : qb0;
            const size_t row0 = (size_t)b * TP + qb * 256;
            u.Q = mix + row0 * 3072 + h * 128; u.O = mix + row0 * 3072 + h * 128; u.G = (const bf16_t*)(p.ws + W_SG) + row0 * 1024 + h * 128;
            u.K = (const bf16_t*)(p.ws + W_KP) + (size_t)b * TP * 1024 + h * 128; u.V = (const bf16_t*)(p.ws + W_VP) + (size_t)b * TP * 1024 + h * 128;
            u.M = (const u64*)(p.ws + W_MASKP) + row0 * 64; u.ldm = 64; u.nvalid = 256; u.qpos0 = qb * 256; u.NT = 4 * (qb + 1); u.head = h;
        } else { const int s = idx - 1024, b = s >> 3, h = s & 7; const size_t row0 = (size_t)NP + b * 64;
            u.Q = mix + row0 * 3072 + h * 128; u.O = mix + row0 * 3072 + h * 128; u.G = (const bf16_t*)(p.ws + W_SG) + row0 * 1024 + h * 128;
            u.K = (const bf16_t*)(p.ws + W_KS) + (size_t)b * LS * 1024 + h * 128; u.V = (const bf16_t*)(p.ws + W_VS) + (size_t)b * LS * 1024 + h * 128;
            u.M = (const u64*)(p.ws + W_MASKS) + (size_t)b * 64 * 32; u.ldm = 32; u.nvalid = 64; u.qpos0 = PAST; u.NT = 17; u.head = h; }
        u.Qr = nullptr; u.Kr = nullptr; u.ldq = 3072; u.ldqr = 0; u.ldk = 1024; u.ldo = 3072; u.ldg = 1024;
        attn_unit<0>(u, lds, p.in[I_T5], Cs, dry);
    }
}
__device__ __forceinline__ void phase_attn_mla(CPARAMS& p, char* lds, const bool dry = false) {
    const float Cs = 0.07216878364870323f * LOG2E;
    const int NU = 2048 + 128;
#pragma unroll 1
    for (int idx = blockIdx.x; idx < NU; idx += gridDim.x) {
        AttnUnit u;
        bf16_t* q2 = (bf16_t*)(p.ws + W_Q2); const bf16_t* kv = (const bf16_t*)(p.ws + W_KVALL); const bf16_t* kr = (const bf16_t*)(p.ws + W_KR);
        size_t row0, lrow0; int h;
        if (idx < 2048) { const int k = idx >> 8, w = idx & 255, qb0 = (w >> 4) & 15, b = k, qb = (k & 1) ? 15 - qb0 : qb0; h = w & 15;
            row0 = (size_t)b * TP + qb * 256; lrow0 = (size_t)b * TP; u.nvalid = 256; u.qpos0 = qb * 256; u.NT = 4 * (qb + 1);
        } else { const int s = idx - 2048, b = s >> 4; h = s & 15; row0 = (size_t)NP + b * 64; lrow0 = (size_t)NP + (size_t)b * LS; u.nvalid = 64; u.qpos0 = PAST; u.NT = 17; }
        u.Q = q2 + row0 * 3072 + h * 128; u.Qr = q2 + row0 * 3072 + 2048 + h * 64; u.O = q2 + row0 * 3072 + h * 128; u.G = (const bf16_t*)(p.ws + W_SGATE) + row0 * 2048 + h * 128;
        u.K = kv + lrow0 * 4096 + h * 128; u.V = kv + lrow0 * 4096 + 2048 + h * 128; u.Kr = kr + lrow0 * 64; u.M = nullptr;
        u.ldq = 3072; u.ldqr = 3072; u.ldk = 4096; u.ldo = 3072; u.ldg = 2048; u.ldm = 0; u.head = h;
        attn_unit<1>(u, lds, nullptr, Cs, dry);
    }
}

__device__ __forceinline__ void phase_conv(CPARAMS& p) {
    const int tid = opaque_tid();
    if (tid < 384) {
        const int ch = tid * 8;
        float cw[4][8], cb[8];
        { const float* cwp = p.in[I_CONVW] + ch; const float* cbp = p.in[I_CONVB] + ch;
#pragma unroll
          for (int j = 0; j < 4; ++j) { const f32x4 a = *(const f32x4*)(cwp + j * 3072), bq = *(const f32x4*)(cwp + j * 3072 + 4);
              cw[j][0] = a[0]; cw[j][1] = a[1]; cw[j][2] = a[2]; cw[j][3] = a[3]; cw[j][4] = bq[0]; cw[j][5] = bq[1]; cw[j][6] = bq[2]; cw[j][7] = bq[3]; }
          const f32x4 a = *(const f32x4*)cbp, bq = *(const f32x4*)(cbp + 4); cb[0] = a[0]; cb[1] = a[1]; cb[2] = a[2]; cb[3] = a[3]; cb[4] = bq[0]; cb[5] = bq[1]; cb[6] = bq[2]; cb[7] = bq[3]; }
        const bf16_t* xbc = (const bf16_t*)(p.ws + W_XBC);
        bf16_t* dst = ch < 2048 ? (bf16_t*)(p.ws + W_XACT) + ch : (bf16_t*)(p.ws + W_BCACT) + (ch - 2048);
        const int dstride = ch < 2048 ? 2048 : 1024;
#pragma unroll 1
        for (int unit = blockIdx.x; unit < MALL / 64; unit += gridDim.x) {
            const size_t row0 = (size_t)unit * 64;
            float w[3][8];
            const bool seqstart = row0 >= NP || (row0 & (TP - 1)) == 0;
            if (seqstart) {
                if (row0 >= NP) { const float* sp = p.in[I_SCONV] + ((row0 - NP) >> 6) * 3 * 3072 + ch;
#pragma unroll
                    for (int j = 0; j < 3; ++j) { const f32x4 a = *(const f32x4*)(sp + j * 3072), bq = *(const f32x4*)(sp + j * 3072 + 4);
                        w[j][0] = a[0]; w[j][1] = a[1]; w[j][2] = a[2]; w[j][3] = a[3]; w[j][4] = bq[0]; w[j][5] = bq[1]; w[j][6] = bq[2]; w[j][7] = bq[3]; } }
                else {
#pragma unroll
                    for (int j = 0; j < 3; ++j)
#pragma unroll
                        for (int e = 0; e < 8; ++e) w[j][e] = 0.f; }
            } else {
#pragma unroll
                for (int j = 0; j < 3; ++j) { const bf16x8 r = *(const bf16x8*)(xbc + (row0 - 3 + j) * 3072 + ch);
#pragma unroll
                    for (int e = 0; e < 8; ++e) w[j][e] = bf2f((bf16_t)r[e]); }
            }
#pragma unroll 1
            for (int r0 = 0; r0 < 64; r0 += 8) {
                bf16x8 raw[8];
#pragma unroll
                for (int r = 0; r < 8; ++r) raw[r] = *(const bf16x8*)(xbc + (row0 + r0 + r) * 3072 + ch);
#pragma unroll
                for (int r = 0; r < 8; ++r) { float o[8];
#pragma unroll
                    for (int e = 0; e < 8; ++e) { const float cur = bf2f((bf16_t)raw[r][e]);
                        o[e] = silu_f(cb[e] + cw[0][e] * w[0][e] + cw[1][e] * w[1][e] + cw[2][e] * w[2][e] + cw[3][e] * cur);
                        w[0][e] = w[1][e]; w[1][e] = w[2][e]; w[2][e] = cur; }
                    *(bf16x8*)(dst + (row0 + r0 + r) * dstride) = pack8(o); }
            }
        }
    }
}

constexpr int SD_XT = 0, SD_BS = 9216, SD_BTT = 26624, SD_CS = 45056, SD_CS2 = 62464, SD_WS = 79872, SD_H0 = 89088, SD_F = 106496;
__device__ __forceinline__ void phase_ssd(CPARAMS& p, char* lds, const bool dry = false) {
    const int tid = opaque_tid(), wid = tid >> 6, lane = tid & 63, l16 = lane & 15, lq = lane >> 4;
    bf16_t* XT = (bf16_t*)(lds + SD_XT); bf16_t* Bs = (bf16_t*)(lds + SD_BS); bf16_t* BTt = (bf16_t*)(lds + SD_BTT); bf16_t* Cs = (bf16_t*)(lds + SD_CS);
    bf16_t* Cs2 = (bf16_t*)(lds + SD_CS2); bf16_t* Ws = (bf16_t*)(lds + SD_WS); bf16_t* H0 = (bf16_t*)(lds + SD_H0);
    float* s_acum = (float*)(lds + SD_F); float* s_dt = s_acum + 64; float* s_ea = s_acum + 128; float* s_tail = s_acum + 192; float* s_ssq = s_acum + 256;
    const bf16_t* xbc = (const bf16_t*)(p.ws + W_XBC); bf16_t* mix = (bf16_t*)(p.ws + W_MIX);
    const float* dtbuf = (const float*)(p.ws + W_DT); float* ssqg = (float*)(p.ws + W_SSQ);
#pragma unroll 1
    for (int idx = blockIdx.x; idx < 512; idx += gridDim.x) {
        const bool sample = idx >= 256; const int bh = idx & 255, b = bh >> 5, h = bh & 31, g = h >> 3;
        const size_t row0 = sample ? (size_t)NP + b * 64 : (size_t)b * TP; const int nch = sample ? 1 : 64;
        const float a_h = -__expf(p.in[I_ALOG][h]), d_h = p.in[I_DSKIP][h];
        f32x4 hacc[4];
        const int pt = wid >> 1;
#pragma unroll
        for (int j = 0; j < 4; ++j) { const int nt = (wid & 1) * 4 + j;
#pragma unroll
            for (int i = 0; i < 4; ++i) { const int pp = pt * 16 + 4 * lq + i, nn = nt * 16 + l16;
                hacc[j][i] = sample ? p.in[I_SSSM][(((size_t)b * 32 + h) * 64 + pp) * 128 + nn] : 0.f;
                H0[pp * 136 + nn] = f2bf(hacc[j][i]); } }
        const int cg8 = tid % 40, rb = tid / 40; const bool ldr = tid < 320;
        const bf16_t* asrc = cg8 < 8 ? (const bf16_t*)(p.ws + W_XACT) + h * 64 + cg8 * 8 : (const bf16_t*)(p.ws + W_BCACT) + (cg8 < 24 ? g * 128 + (cg8 - 8) * 8 : 512 + g * 128 + (cg8 - 24) * 8);
        const size_t astride = cg8 < 8 ? 2048 : 1024;
        bf16x8 av[8];
#pragma unroll
        for (int r = 0; r < 8; ++r) av[r] = ldr ? *(const bf16x8*)(asrc + (row0 + rb * 8 + r) * astride) : (bf16x8){0, 0, 0, 0, 0, 0, 0, 0};
        float dt_next = (wid == 0) ? dtbuf[(row0 + lane) * 32 + h] : 0.f;
        bf16_t szv[2][4];
#pragma unroll
        for (int q = 0; q < 2; ++q) { const int id = wid * 2 + q, mt = id >> 2, nt = id & 3;
#pragma unroll
            for (int i = 0; i < 4; ++i) szv[q][i] = mix[(row0 + mt * 16 + 4 * lq + i) * 3072 + 1024 + h * 64 + nt * 16 + l16]; }
#pragma unroll 1
        for (int c = 0; c < nch; ++c) {
            const size_t crow0 = row0 + (size_t)c * 64;
            if (wid == 0) {
                if (c > 0 && !dry) ssqg[(size_t)h * MALL + (crow0 - 64 + lane)] = (s_ssq[lane] + s_ssq[64 + lane]) + (s_ssq[128 + lane] + s_ssq[192 + lane]);
                const float dtv = dt_next; float ac = dtv * a_h;
                if (c + 1 < nch) dt_next = dtbuf[(crow0 + 64 + lane) * 32 + h];
                ac = wave_scan_incl(ac, lane);
                const float a63 = __builtin_bit_cast(float, __builtin_amdgcn_readlane(__builtin_bit_cast(int, ac), 63));
                s_acum[lane] = ac; s_dt[lane] = dtv; s_ea[lane] = __expf(ac); s_tail[lane] = __expf(a63 - ac) * dtv;
            }
            __syncthreads();
            if (ldr) {
                const int t0l = rb * 8;
#pragma unroll
                for (int hf = 0; hf < 2; ++hf) {
                    float vout[8][4];
#pragma unroll
                    for (int r = 0; r < 8; ++r)
#pragma unroll
                        for (int e = 0; e < 4; ++e) vout[r][e] = bf2f((bf16_t)av[r][hf * 4 + e]);
                    if (cg8 < 8) {
#pragma unroll
                        for (int e = 0; e < 4; ++e) { float t[8];
#pragma unroll
                            for (int r = 0; r < 8; ++r) t[r] = vout[r][e];
                            *(bf16x8*)(XT + (cg8 * 8 + hf * 4 + e) * 72 + t0l) = pack8(t); }
                    } else if (cg8 < 24) {
                        const int n0 = (cg8 - 8) * 8 + hf * 4;
#pragma unroll
                        for (int r = 0; r < 8; ++r) { const f32x4 q = {vout[r][0], vout[r][1], vout[r][2], vout[r][3]}; *(u32x2*)(Bs + (t0l + r) * 136 + n0) = pack4(q); }
                        float tl8[8];
#pragma unroll
                        for (int r = 0; r < 8; ++r) tl8[r] = s_tail[t0l + r];
#pragma unroll
                        for (int e = 0; e < 4; ++e) { float t[8];
#pragma unroll
                            for (int r = 0; r < 8; ++r) t[r] = vout[r][e] * tl8[r];
                            *(bf16x8*)(BTt + (n0 + e) * 72 + t0l) = pack8(t); }
                    } else {
                        const int n0 = (cg8 - 24) * 8 + hf * 4;
#pragma unroll
                        for (int r = 0; r < 8; ++r) { const f32x4 q = {vout[r][0], vout[r][1], vout[r][2], vout[r][3]}; *(u32x2*)(Cs + (t0l + r) * 136 + n0) = pack4(q);
                            const float ea = s_ea[t0l + r]; *(u32x2*)(Cs2 + (t0l + r) * 136 + n0) = pack4(q * ea); }
                    }
                }
                if (c + 1 < nch) {
#pragma unroll
                    for (int r = 0; r < 8; ++r) av[r] = *(const bf16x8*)(asrc + (crow0 + 64 + rb * 8 + r) * astride);
                }
            }
            __syncthreads();
#pragma unroll
            for (int q = 0; q < 2; ++q) { const int id = wid * 2 + q, mt = id >> 2, nt = id & 3;
                f32x4 acc = {0.f, 0.f, 0.f, 0.f};
                if (nt <= mt) {
#pragma unroll
                    for (int ks = 0; ks < 4; ++ks) { const bf16x8 af = *(const bf16x8*)(Cs + (mt * 16 + l16) * 136 + ks * 32 + lq * 8), bf = *(const bf16x8*)(Bs + (nt * 16 + l16) * 136 + ks * 32 + lq * 8);
                        acc = __builtin_amdgcn_mfma_f32_16x16x32_bf16(af, bf, acc, 0, 0, 0); }
                }
                const int s = nt * 16 + l16; const float as = s_acum[s], dts = s_dt[s];
#pragma unroll
                for (int i = 0; i < 4; ++i) { const int t = mt * 16 + 4 * lq + i; const float w = (s <= t) ? acc[i] * __expf(s_acum[t] - as) * dts : 0.f; Ws[t * 72 + s] = f2bf(w); }
            }
            __syncthreads();
#pragma unroll
            for (int q = 0; q < 2; ++q) { const int id = wid * 2 + q, mt = id >> 2, nt = id & 3;
                f32x4 acc = {0.f, 0.f, 0.f, 0.f};
#pragma unroll
                for (int ks = 0; ks < 2; ++ks) { const bf16x8 af = *(const bf16x8*)(Ws + (mt * 16 + l16) * 72 + ks * 32 + lq * 8), bf = *(const bf16x8*)(XT + (nt * 16 + l16) * 72 + ks * 32 + lq * 8);
                    acc = __builtin_amdgcn_mfma_f32_16x16x32_bf16(af, bf, acc, 0, 0, 0); }
#pragma unroll
                for (int ks = 0; ks < 4; ++ks) { const bf16x8 af = *(const bf16x8*)(Cs2 + (mt * 16 + l16) * 136 + ks * 32 + lq * 8), bf = *(const bf16x8*)(H0 + (nt * 16 + l16) * 136 + ks * 32 + lq * 8);
                    acc = __builtin_amdgcn_mfma_f32_16x16x32_bf16(af, bf, acc, 0, 0, 0); }
                const int pp = nt * 16 + l16;
#pragma unroll
                for (int i = 0; i < 4; ++i) { const int t = mt * 16 + 4 * lq + i;
                    const float xv = bf2f(XT[pp * 72 + t]);
                    const float yg = (acc[i] + d_h * xv) * bf2f(szv[q][i]);
                    if (!dry) mix[(crow0 + t) * 3072 + 1024 + h * 64 + pp] = f2bf(yg);
                    float sq = yg * yg;
                    sq = row16_sum(sq);
                    if (l16 == 0) s_ssq[nt * 64 + t] = sq; }
            }
            if (c + 1 < nch) {
#pragma unroll
                for (int q = 0; q < 2; ++q) { const int id = wid * 2 + q, mt = id >> 2, nt = id & 3;
#pragma unroll
                    for (int i = 0; i < 4; ++i) szv[q][i] = mix[(crow0 + 64 + mt * 16 + 4 * lq + i) * 3072 + 1024 + h * 64 + nt * 16 + l16]; } }
            const float e63 = s_ea[63];
            __syncthreads();
#pragma unroll
            for (int j = 0; j < 4; ++j) { const int nt = (wid & 1) * 4 + j;
                f32x4 acc = hacc[j] * e63;
#pragma unroll
                for (int ks = 0; ks < 2; ++ks) { const bf16x8 af = *(const bf16x8*)(XT + (pt * 16 + l16) * 72 + ks * 32 + lq * 8), bf = *(const bf16x8*)(BTt + (nt * 16 + l16) * 72 + ks * 32 + lq * 8);
                    acc = __builtin_amdgcn_mfma_f32_16x16x32_bf16(af, bf, acc, 0, 0, 0); }
                hacc[j] = acc;
#pragma unroll
                for (int i = 0; i < 4; ++i) H0[(pt * 16 + 4 * lq + i) * 136 + nt * 16 + l16] = f2bf(acc[i]);
            }
        }
        __syncthreads();
        if (wid == 0 && !dry) ssqg[(size_t)h * MALL + (row0 + (size_t)(nch - 1) * 64 + lane)] = (s_ssq[lane] + s_ssq[64 + lane]) + (s_ssq[128 + lane] + s_ssq[192 + lane]);
        if (!dry) { float* ho = p.out + (sample ? O_BSS : O_BSP) + ((size_t)b * 32 + h) * 64 * 128;
#pragma unroll
          for (int j = 0; j < 4; ++j) { const int nt = (wid & 1) * 4 + j;
#pragma unroll
              for (int i = 0; i < 4; ++i) ho[(size_t)(pt * 16 + 4 * lq + i) * 128 + nt * 16 + l16] = hacc[j][i]; } }
        __syncthreads();
    }
}

__device__ __forceinline__ void phase_bnorm(CPARAMS& p) {
    bf16_t* mix = (bf16_t*)(p.ws + W_MIX); const float* ssq = (const float*)(p.ws + W_SSQ); const float* nw = p.in[I_SNORM];
    const size_t n = (size_t)MALL * 256, stride = (size_t)gridDim.x * 512;
    const int tidb = opaque_tid();
    for (size_t i0 = (size_t)blockIdx.x * 512 + tidb; i0 < n; i0 += 4 * stride) {
        bf16x8 v[4]; float tot[4];
#pragma unroll
        for (int u = 0; u < 4; ++u) { const size_t i = i0 + u * stride; tot[u] = 0.f; v[u] = (bf16x8){0, 0, 0, 0, 0, 0, 0, 0};
            if (i < n) { const size_t row = i >> 8; const int c0 = (int)(i & 255) * 8, g = c0 >> 9;
                v[u] = *(const bf16x8*)(mix + row * 3072 + 1024 + c0);
#pragma unroll
                for (int hh = 0; hh < 8; ++hh) tot[u] += ssq[(size_t)(g * 8 + hh) * MALL + row]; } }
#pragma unroll
        for (int u = 0; u < 4; ++u) { const size_t i = i0 + u * stride;
            if (i < n) { const size_t row = i >> 8; const int c0 = (int)(i & 255) * 8;
                const float r = rsqrtf(tot[u] * (1.f / 512.f) + EPSV);
                const f32x4 w0 = *(const f32x4*)(nw + c0), w1 = *(const f32x4*)(nw + c0 + 4);
                float t[8];
#pragma unroll
                for (int e2 = 0; e2 < 8; ++e2) t[e2] = bf2f((bf16_t)v[u][e2]) * r * (e2 < 4 ? w0[e2] : w1[e2 - 4]);
                *(bf16x8*)(mix + row * 3072 + 1024 + c0) = pack8(t); } }
    }
}
__device__ __forceinline__ void phase_ln(CPARAMS& p, const float* gw, const float* bw, bf16_t* yb, const bool dry = false) {
    int tid_ = threadIdx.x; asm volatile("" : "+v"(tid_));
    const int wid = tid_ >> 6, lane = tid_ & 63;
    float* y = p.out + O_Y;
    for (int row = blockIdx.x * 8 + wid; row < MALL; row += gridDim.x * 8) {
        float* rp = y + (size_t)row * DM;
        f32x4 v[8]; float s = 0.f;
#pragma unroll
        for (int j = 0; j < 8; ++j) { v[j] = *(const f32x4*)(rp + j * 256 + lane * 4); s += v[j][0] + v[j][1] + v[j][2] + v[j][3]; }
        const float mu = wave_sum(s) * (1.f / DM);
        float q = 0.f;
#pragma unroll
        for (int j = 0; j < 8; ++j) { v[j] = v[j] - mu; q += v[j][0] * v[j][0] + v[j][1] * v[j][1] + v[j][2] * v[j][2] + v[j][3] * v[j][3]; }
        const float rs = rsqrtf(wave_sum(q) * (1.f / DM) + EPSV);
#pragma unroll
        for (int j = 0; j < 8; ++j) { const int c = j * 256 + lane * 4; const f32x4 gg = *(const f32x4*)(gw + c), bb = *(const f32x4*)(bw + c);
            const f32x4 o = v[j] * rs * gg + bb; if (!dry) { *(f32x4*)(rp + c) = o; if (yb) *(u32x2*)(yb + (size_t)row * DM + c) = pack4(o); } else if (o[0] == 1.2345e30f) rp[c] = 0.f; }
    }
}
__device__ __forceinline__ void phase_post1(CPARAMS& p) {
    const int tidp = opaque_tid(); const int wid = tidp >> 6, lane = tidp & 63;
    const float* cqkv = (const float*)(p.ws + W_CQKV); bf16_t* cqn = (bf16_t*)(p.ws + W_CQN); bf16_t* lat = (bf16_t*)(p.ws + W_LAT); bf16_t* krb = (bf16_t*)(p.ws + W_KR);
    const float2* tab = (const float2*)(p.ws + W_ROPE);
    for (int row = blockIdx.x * 8 + wid; row < MALL; row += gridDim.x * 8) {
        const float* rp = cqkv + (size_t)row * 1088;
        const f32x4 a0 = *(const f32x4*)(rp + lane * 8), a1 = *(const f32x4*)(rp + lane * 8 + 4), c0 = *(const f32x4*)(rp + 512 + lane * 8), c1 = *(const f32x4*)(rp + 512 + lane * 8 + 4);
        const float kv = rp[1024 + lane];
        float sa = 0.f, sc = 0.f;
#pragma unroll
        for (int e = 0; e < 4; ++e) { sa += a0[e] * a0[e] + a1[e] * a1[e]; sc += c0[e] * c0[e] + c1[e] * c1[e]; }
        const float ra = rsqrtf(wave_sum(sa) * (1.f / 512.f) + EPSV), rc = rsqrtf(wave_sum(sc) * (1.f / 512.f) + EPSV);
        const f32x4 qw0 = *(const f32x4*)(p.in[I_QNW] + lane * 8), qw1 = *(const f32x4*)(p.in[I_QNW] + lane * 8 + 4), kw0 = *(const f32x4*)(p.in[I_KVNW] + lane * 8), kw1 = *(const f32x4*)(p.in[I_KVNW] + lane * 8 + 4);
        const f32x4 qa = a0 * ra * qw0, qb = a1 * ra * qw1, la = c0 * rc * kw0, lb = c1 * rc * kw1;
        { const float t[8] = {qa[0], qa[1], qa[2], qa[3], qb[0], qb[1], qb[2], qb[3]}; *(bf16x8*)(cqn + (size_t)row * 512 + lane * 8) = pack8(t); }
        const int lr = latrow_of(row);
        { const float t[8] = {la[0], la[1], la[2], la[3], lb[0], lb[1], lb[2], lb[3]}; *(bf16x8*)(lat + (size_t)lr * 512 + lane * 8) = pack8(t); }
        float* clo = row < NP ? p.out + O_CLP + (size_t)row * 512 : p.out + O_CLS + (size_t)(row - NP) * 512;
        *(f32x4*)(clo + lane * 8) = la; *(f32x4*)(clo + lane * 8 + 4) = lb;
        const float other = __shfl_xor(kv, 32);
        const int i = lane & 31, pos = pos_of(row); const float2 cs = tab[(size_t)pos * 32 + i];
        const float o = lane < 32 ? kv * cs.x - other * cs.y : other * cs.y + kv * cs.x;
        float* cko = row < NP ? p.out + O_CKP + (size_t)row * 64 : p.out + O_CKS + (size_t)(row - NP) * 64;
        cko[lane] = o;
        krb[(size_t)lr * 64 + 4 * (i >> 1) + (i & 1) + (lane >= 32 ? 2 : 0)] = f2bf(o);
    }
    const size_t gtid = (size_t)blockIdx.x * 512 + tidp, gstride = (size_t)gridDim.x * 512;
    { const size_t n8 = (size_t)8 * PAST * 512 / 8;
      for (size_t i = gtid; i < n8; i += gstride) { const size_t e = i * 8, b = e / ((size_t)PAST * 512), rem = e % ((size_t)PAST * 512); const float* s = p.in[I_CLAT] + e;
        const f32x4 a = *(const f32x4*)s, c = *(const f32x4*)(s + 4); const float t[8] = {a[0], a[1], a[2], a[3], c[0], c[1], c[2], c[3]};
        *(bf16x8*)(lat + ((size_t)NP + b * LS) * 512 + rem) = pack8(t); } }
    { const size_t n = (size_t)8 * PAST * 64;
      for (size_t e = gtid; e < n; e += gstride) { const size_t b = e / ((size_t)PAST * 64), rem = e % ((size_t)PAST * 64), t = rem >> 6; const int j = (int)(rem & 63), i = j & 31;
        krb[((size_t)NP + b * LS + t) * 64 + 4 * (i >> 1) + (i & 1) + (j >= 32 ? 2 : 0)] = f2bf(p.in[I_CKR][e]); } }
}

__device__ __forceinline__ CPARAMS& get_params() {
    const unsigned long long v = (unsigned long long)__builtin_amdgcn_kernarg_segment_ptr(); unsigned lo = (unsigned)v, hi = (unsigned)(v >> 32);
    asm volatile("" : "+s"(lo), "+s"(hi));
    lo = __builtin_amdgcn_readfirstlane(lo); hi = __builtin_amdgcn_readfirstlane(hi);
    return *(CPARAMS*)(((unsigned long long)hi << 32) | lo);
}
#ifndef PROBE_STOP
#define PROBE_STOP 0
#endif
__device__ __forceinline__ void phase_dump(CPARAMS& p) {
    const unsigned short* w = (const unsigned short*)p.ws; float* y = p.out + O_Y; const size_t n = (size_t)MALL * DM;
#ifdef PROBE_THRASH
    { const f32x4* xs = (const f32x4*)p.in[I_XP] + (size_t)((blockIdx.x >> 3) & 31) * (NP * (size_t)DM / 4 / 32); f32x4 a = {0.f, 0.f, 0.f, 0.f};
      for (size_t i = threadIdx.x; i < NP * (size_t)DM / 4 / 32; i += 512) a += xs[i];
      if (a[0] + a[1] + a[2] + a[3] == 1.2345e30f) y[0] = 1.f;
      __syncthreads(); __threadfence(); }
    cg::this_grid().sync(); __threadfence();
#endif
    for (size_t i = (size_t)blockIdx.x * 512 + threadIdx.x; i < n; i += (size_t)gridDim.x * 512) {
        unsigned h = 0x12345u;
#pragma unroll
        for (int r = 0; r < 8; ++r) { const size_t o = (size_t)r * n + i; const unsigned v = (o * 2 < W_END) ? w[o] : 0u; h = (h ^ v) * 0x9E3779B1u; }
        h ^= h >> 15; y[i] = (float)((h >> 8) & 127u);
    }
}
#define PROBE_AT(k) do { if (PROBE_STOP == (k)) { CPARAMS& pq = get_params(); phase_dump(pq); return; } } while (0)
__global__ void __launch_bounds__(512) fwd_megakernel(Params p_unused) {
    extern __shared__ __attribute__((aligned(16))) char lds[];
    cg::grid_group grid = cg::this_grid();
#ifndef TIME_X2
#define TIME_X2 0
#endif
    const bool dryflag = get_params().ws != nullptr;
    unsigned nbar = 0;
#define GSYNC_CG() do { __builtin_amdgcn_fence(__ATOMIC_RELEASE, "agent"); asm volatile("s_waitcnt vmcnt(0)" ::: "memory"); grid.sync(); __builtin_amdgcn_fence(__ATOMIC_ACQUIRE, "agent"); } while (0)
#define GSYNC() do { ++nbar; asm volatile("s_waitcnt vmcnt(0)" ::: "memory"); __syncthreads(); \
        if (threadIdx.x == 0) { unsigned* ctr_ = (unsigned*)(get_params().ws + W_BAR); const unsigned tgt_ = nbar * gridDim.x; \
            __builtin_amdgcn_fence(__ATOMIC_RELEASE, "agent"); asm volatile("s_waitcnt vmcnt(0)" ::: "memory"); \
            __hip_atomic_fetch_add(ctr_, 1u, __ATOMIC_RELAXED, __HIP_MEMORY_SCOPE_AGENT); \
            while (__hip_atomic_load(ctr_, __ATOMIC_RELAXED, __HIP_MEMORY_SCOPE_AGENT) < tgt_) __builtin_amdgcn_s_sleep(1); \
            __builtin_amdgcn_fence(__ATOMIC_ACQUIRE, "agent"); asm volatile("s_waitcnt vmcnt(0)" ::: "memory"); } \
        __syncthreads(); } while (0)
    if (TIME_X2 == 1) { CPARAMS& p = get_params(); phase_prep(p, lds); __syncthreads(); }
    { CPARAMS& p = get_params(); phase_prep(p, lds); }
    if (__builtin_expect(get_params().ws == nullptr, 0)) GSYNC_CG();
    GSYNC();
    PROBE_AT(1);
    if (TIME_X2 == 2)
    { CPARAMS& p = get_params(); pg8::Gemm g; g.A = (const bf16_t*)(p.ws + W_XB); g.Bt = (const bf16_t*)(p.ws + W_BT0); g.M = MALL; g.N = NIN0P; g.K = DM; g.lda = DM;
      pg8::StaticOrder S; S.init(MALL, NIN0P, (int)gridDim.x, (int)blockIdx.x); EpiInProj0 E{p.ws, p.out, p.in[I_DTB]};
      pg8::gemm_phase<EpiInProj0, pg8::StaticOrder>((PG8_LAS unsigned char*)lds, g, S, E); }
    { CPARAMS& p = get_params(); pg8::Gemm g; g.A = (const bf16_t*)(p.ws + W_XB); g.Bt = (const bf16_t*)(p.ws + W_BT0); g.M = MALL; g.N = NIN0P; g.K = DM; g.lda = DM;
      pg8::StaticOrder S; S.init(MALL, NIN0P, (int)gridDim.x, (int)blockIdx.x); EpiInProj0 E{p.ws, p.out, p.in[I_DTB]};
      pg8::gemm_phase<EpiInProj0, pg8::StaticOrder>((PG8_LAS unsigned char*)lds, g, S, E); }
    GSYNC();
    PROBE_AT(2);
    if (TIME_X2 == 3) { CPARAMS& p = get_params(); phase_index(p, lds); }
    if (TIME_X2 == 12) { CPARAMS& p = get_params(); phase_conv(p); }
    { CPARAMS& p = get_params(); phase_conv(p); }
    { CPARAMS& p = get_params(); phase_index(p, lds); }
    GSYNC();
    PROBE_AT(3);
    if (TIME_X2 == 4) { CPARAMS& p = get_params(); phase_attn_dsa(p, lds, dryflag); }
    if (TIME_X2 == 5) { CPARAMS& p = get_params(); phase_ssd(p, lds, dryflag); }
#ifndef PROBE_SKIP_DSA
    { CPARAMS& p = get_params(); phase_attn_dsa(p, lds); }
#endif
#ifndef PROBE_SKIP_SSD
    { CPARAMS& p = get_params(); phase_ssd(p, lds); }
#endif
    GSYNC();
    PROBE_AT(4);
    { CPARAMS& p = get_params(); phase_bnorm(p); }
    GSYNC();
    PROBE_AT(5);
    if (TIME_X2 == 6)
    { CPARAMS& p = get_params(); FResid f{p.in[I_XP], p.in[I_XS], p.out + O_Y}; run_gemm(lds, (const bf16_t*)(p.ws + W_MIX), 3072, (const bf16_t*)(p.ws + W_BTOUT0), MALL, DM, 3072, f); }
    { CPARAMS& p = get_params(); FResid f{p.in[I_XP], p.in[I_XS], p.out + O_Y}; run_gemm(lds, (const bf16_t*)(p.ws + W_MIX), 3072, (const bf16_t*)(p.ws + W_BTOUT0), MALL, DM, 3072, f); }
    GSYNC();
    PROBE_AT(6);
    if (TIME_X2 == 7) { CPARAMS& p = get_params(); phase_ln(p, p.in[I_LN0G], p.in[I_LN0B], (bf16_t*)(p.ws + W_XB), dryflag); }
    { CPARAMS& p = get_params(); phase_ln(p, p.in[I_LN0G], p.in[I_LN0B], (bf16_t*)(p.ws + W_XB)); }
    GSYNC();
    PROBE_AT(7);
    if (TIME_X2 == 8)
    { CPARAMS& p = get_params(); FInProj1 f{p.ws}; run_gemm(lds, (const bf16_t*)(p.ws + W_XB), DM, (const bf16_t*)(p.ws + W_BT1), MALL, NIN1P, DM, f); }
    { CPARAMS& p = get_params(); FInProj1 f{p.ws}; run_gemm(lds, (const bf16_t*)(p.ws + W_XB), DM, (const bf16_t*)(p.ws + W_BT1), MALL, NIN1P, DM, f); }
    GSYNC();
    PROBE_AT(8);
    if (TIME_X2 == 9) { CPARAMS& p = get_params(); phase_post1(p); }
    { CPARAMS& p = get_params(); phase_post1(p); }
    GSYNC();
    PROBE_AT(9);
    if (TIME_X2 == 10)
    { CPARAMS& p = get_params(); FQUp f{p.ws}; run_gemm(lds, (const bf16_t*)(p.ws + W_CQN), 512, (const bf16_t*)(p.ws + W_BTUQ), MALL, 3072, 512, f); }
    { CPARAMS& p = get_params(); FQUp f{p.ws}; run_gemm(lds, (const bf16_t*)(p.ws + W_CQN), 512, (const bf16_t*)(p.ws + W_BTUQ), MALL, 3072, 512, f); }
    { CPARAMS& p = get_params(); FKvUp f{p.ws}; run_gemm(lds, (const bf16_t*)(p.ws + W_LAT), 512, (const bf16_t*)(p.ws + W_BTUKV), LATROWS, 4096, 512, f, true); }
    GSYNC();
    PROBE_AT(10);
    if (TIME_X2 == 11) { CPARAMS& p = get_params(); phase_attn_mla(p, lds, dryflag); }
    { CPARAMS& p = get_params(); phase_attn_mla(p, lds); }
    GSYNC();
    PROBE_AT(11);
    { CPARAMS& p = get_params(); FResid f{p.out + O_Y, p.out + O_Y + (size_t)NP * DM, p.out + O_Y}; run_gemm(lds, (const bf16_t*)(p.ws + W_Q2), 3072, (const bf16_t*)(p.ws + W_BTOUT1), MALL, DM, DM, f); }
    GSYNC();
    PROBE_AT(12);
    { CPARAMS& p = get_params(); phase_ln(p, p.in[I_LN1G], p.in[I_LN1B], nullptr); }
}

extern "C" void kernel_launch(void* const* d_in, const int* in_sizes, int n_in, void* d_out, int out_size, void* d_ws, size_t ws_size, hipStream_t stream) {
    static int grid_blocks = 0;
    if (!grid_blocks) {
        if (n_in != N_IN || (size_t)out_size != O_END || ws_size < W_END) { fprintf(stderr, "kernel_launch: unexpected shapes n_in %d out %d ws %zu\n", n_in, out_size, ws_size); return; }
        if (hipFuncSetAttribute((const void*)fwd_megakernel, hipFuncAttributeMaxDynamicSharedMemorySize, LDS_BYTES) != hipSuccess) { fprintf(stderr, "kernel_launch: LDS attribute failed\n"); return; }
        int dev = 0, cus = 0, per_cu = 0;
        hipGetDevice(&dev); hipDeviceGetAttribute(&cus, hipDeviceAttributeMultiprocessorCount, dev);
        hipOccupancyMaxActiveBlocksPerMultiprocessor(&per_cu, fwd_megakernel, 512, LDS_BYTES);
        if (per_cu < 1) { fprintf(stderr, "kernel_launch: occupancy 0\n"); return; }
        grid_blocks = cus;
    }
    if (hipMemsetAsync((char*)d_ws + W_BAR, 0, 256, stream) != hipSuccess) { fprintf(stderr, "kernel_launch: memset failed\n"); return; }
    Params p{};
    for (int i = 0; i < N_IN; ++i) p.in[i] = (const float*)d_in[i];
    p.out = (float*)d_out; p.ws = (char*)d_ws;
    void* args[] = {&p};
    hipError_t e = hipLaunchCooperativeKernel((const void*)fwd_megakernel, dim3(grid_blocks), dim3(512), args, LDS_BYTES, stream);
    if (e != hipSuccess) fprintf(stderr, "cooperative launch failed: %s (grid %d)\n", hipGetErrorString(e), grid_blocks);
}
```
